# Optimizing an MI355X kernel written in HIP

```python
import math
import jax, jax.numpy as jnp
from jax import lax
import numpy as np

D_MODEL = 1024
BATCH = 32
SEQ = 2048
DEPTH = 1

D_MIX = D_MODEL
DIFF_HEADS = 4
DIFF_QK_DIM = 64
DIFF_V_DIM = 2 * DIFF_QK_DIM
DIFF_WIDTH = DIFF_HEADS * DIFF_V_DIM
DSA_HEADS = 4
DSA_LATENT = 128
DSA_V_DIM = 128
DSA_WIDTH = DSA_HEADS * DSA_V_DIM
IDX_HEADS = 8
IDX_DIM = 64
TOPK_MAX = 256
REL_BUCKETS = 32
REL_MAX_DIST = 128
N_ATTN_HEADS = DIFF_HEADS + DSA_HEADS
PEER_HEADS = 8
PEER_NKEYS = 128
PEER_QDIM = 128
PEER_HALF = PEER_QDIM // 2
PEER_TOPK = 16
N_EXPERTS = PEER_NKEYS * PEER_NKEYS
PEER_CHUNK = 128
Q_BLOCK = 128
RMS_EPS = 1e-6
D_IN_PROJ = (2 * DIFF_HEADS * 2 * DIFF_QK_DIM + DIFF_WIDTH + DSA_HEADS * DSA_LATENT
             + DSA_LATENT + IDX_HEADS * IDX_DIM + IDX_DIM + IDX_HEADS)

kernel_name = "hymba_diffattn_dsa_peer_block"


def rms_norm(x, g):
    xf = x.astype(jnp.float32)
    y = xf * lax.rsqrt(jnp.mean(xf * xf, axis=-1, keepdims=True) + RMS_EPS)
    return (y * g.astype(jnp.float32)).astype(x.dtype)


def rel_bucket(dist):
    n = jnp.maximum(dist, 0)
    max_exact = REL_BUCKETS // 2
    nf = jnp.maximum(n, max_exact).astype(jnp.float32)
    large = max_exact + (jnp.log(nf / max_exact) / math.log(REL_MAX_DIST / max_exact)
                         * (REL_BUCKETS - max_exact)).astype(jnp.int32)
    large = jnp.minimum(large, REL_BUCKETS - 1)
    return jnp.where(n < max_exact, n, large)


def to_blocks(a):
    B, S = a.shape[0], a.shape[1]
    a = a.reshape((B, S // Q_BLOCK, Q_BLOCK) + a.shape[2:])
    return jnp.moveaxis(a, 1, 0)


def from_blocks(a):
    a = jnp.moveaxis(a, 0, 1)
    return a.reshape((a.shape[0], a.shape[1] * a.shape[2]) + a.shape[3:])


def diff_attention(q1, q2, k1, k2, v, lam, bias_table):
    S = q1.shape[1]
    nb = S // Q_BLOCK
    scale = DIFF_QK_DIM ** -0.5
    s_pos = jnp.arange(S, dtype=jnp.int32)

    def block(args):
        q1b, q2b, blk = args
        t_pos = blk * Q_BLOCK + jnp.arange(Q_BLOCK, dtype=jnp.int32)
        dist = t_pos[:, None] - s_pos[None, :]
        bias = jnp.transpose(bias_table[rel_bucket(dist)], (2, 0, 1)).astype(jnp.float32)
        mask = dist >= 0
        l1 = jnp.einsum('bqhd,bshd->bhqs', q1b, k1).astype(jnp.float32) * scale + bias
        l2 = jnp.einsum('bqhd,bshd->bhqs', q2b, k2).astype(jnp.float32) * scale + bias
        p1 = jax.nn.softmax(jnp.where(mask, l1, -jnp.inf), axis=-1)
        p2 = jax.nn.softmax(jnp.where(mask, l2, -jnp.inf), axis=-1)
        attn = (p1 - lam * p2).astype(v.dtype)
        return jnp.einsum('bhqs,bshd->bqhd', attn, v)

    out = lax.map(block, (to_blocks(q1), to_blocks(q2), jnp.arange(nb, dtype=jnp.int32)))
    return from_blocks(out)


def dsa_attention(q, kv, iq, ik, iw, w_uv, bias_table):
    S = q.shape[1]
    nb = S // Q_BLOCK
    k_top = min(TOPK_MAX, S // 4)
    scale = DSA_LATENT ** -0.5
    idx_scale = IDX_DIM ** -0.5
    s_pos = jnp.arange(S, dtype=jnp.int32)
    gather_rows = jax.vmap(lambda a, i: a[i])

    def block(args):
        qb, iqb, iwb, blk = args
        t_pos = blk * Q_BLOCK + jnp.arange(Q_BLOCK, dtype=jnp.int32)
        dots = jax.nn.relu(jnp.einsum('bqhd,bsd->bqhs', iqb, ik).astype(jnp.float32) * idx_scale)
        score = jnp.einsum('bqhs,bqh->bqs', dots, iwb.astype(jnp.float32))
        score = jnp.where(s_pos[None, None, :] <= t_pos[None, :, None], score, -jnp.inf)
        _, sel = lax.top_k(score, k_top)
        dist = t_pos[None, :, None] - sel
        valid = dist >= 0
        kv_sel = gather_rows(kv, sel)
        bias = jnp.transpose(bias_table[rel_bucket(dist)], (0, 3, 1, 2)).astype(jnp.float32)
        logits = jnp.einsum('bqhd,bqkd->bhqk', qb, kv_sel).astype(jnp.float32) * scale + bias
        p = jax.nn.softmax(jnp.where(valid[:, None], logits, -jnp.inf), axis=-1).astype(kv.dtype)
        o = jnp.einsum('bhqk,bqkd->bqhd', p, kv_sel)
        return jnp.einsum('bqhc,hcd->bqhd', o, w_uv)

    out = lax.map(block, (to_blocks(q), to_blocks(iq), to_blocks(iw), jnp.arange(nb, dtype=jnp.int32)))
    return from_blocks(out)


def peer(h, w_q, keys, u_tab, v_tab):
    B, S, D = h.shape
    T = B * S
    xc = h.reshape(T // PEER_CHUNK, PEER_CHUNK, D)

    def chunk(xt):
        q = (xt @ w_q).reshape(PEER_CHUNK, PEER_HEADS, 2, PEER_HALF)
        sc = jnp.einsum('thpd,hpnd->thpn', q, keys).astype(jnp.float32)
        s1, i1 = lax.top_k(sc[:, :, 0], PEER_TOPK)
        s2, i2 = lax.top_k(sc[:, :, 1], PEER_TOPK)
        cand = (s1[..., :, None] + s2[..., None, :]).reshape(PEER_CHUNK, PEER_HEADS, PEER_TOPK * PEER_TOPK)
        cand_idx = (i1[..., :, None] * PEER_NKEYS + i2[..., None, :]).reshape(PEER_CHUNK, PEER_HEADS, PEER_TOPK * PEER_TOPK)
        top, pos = lax.top_k(cand, PEER_TOPK)
        e_idx = jnp.take_along_axis(cand_idx, pos, axis=-1)
        g = jax.nn.softmax(top, axis=-1)
        u_sel = u_tab[e_idx]
        v_sel = v_tab[e_idx]
        act = jax.nn.gelu(jnp.einsum('td,thkd->thk', xt, u_sel).astype(jnp.float32), approximate=False)
        return jnp.einsum('thk,thkd->td', (g * act).astype(xt.dtype), v_sel)

    return lax.map(chunk, xc).reshape(B, S, D)


def setup_inputs(seed: int = 0) -> dict:
    key = jax.random.key(seed)
    ks = jax.random.split(key, 24)
    f = jnp.float32
    D = D_MODEL
    nrm = lambda k, shape, s: jax.random.normal(k, shape, f) * s
    return {
        "x": nrm(ks[0], (BATCH, SEQ, D), 1.0),
        "c": nrm(ks[1], (BATCH, D), 1.0),
        "w_ada": nrm(ks[2], (DEPTH, D, 6 * D), 0.5 * D ** -0.5),
        "b_ada": nrm(ks[3], (DEPTH, 6 * D), 0.01),
        "g_norm_mix": 1.0 + nrm(ks[4], (DEPTH, D), 0.02),
        "w_in": nrm(ks[5], (DEPTH, D, D_IN_PROJ), D ** -0.5),
        "lam_q1": nrm(ks[6], (DEPTH, DIFF_QK_DIM), 0.1),
        "lam_k1": nrm(ks[7], (DEPTH, DIFF_QK_DIM), 0.1),
        "lam_q2": nrm(ks[8], (DEPTH, DIFF_QK_DIM), 0.1),
        "lam_k2": nrm(ks[9], (DEPTH, DIFF_QK_DIM), 0.1),
        "g_subln": 1.0 + nrm(ks[10], (DEPTH, DIFF_V_DIM), 0.02),
        "g_kv_norm": 1.0 + nrm(ks[11], (DEPTH, DSA_LATENT), 0.02),
        "w_uv": nrm(ks[12], (DEPTH, DSA_HEADS, DSA_LATENT, DSA_V_DIM), DSA_LATENT ** -0.5),
        "w_out": nrm(ks[13], (DEPTH, D_MIX, D), D_MIX ** -0.5),
        "g_norm_ffn": 1.0 + nrm(ks[14], (DEPTH, D), 0.02),
        "w_peer_q": nrm(ks[15], (DEPTH, D, PEER_HEADS * PEER_QDIM), D ** -0.5),
        "peer_keys": nrm(ks[16], (DEPTH, PEER_HEADS, 2, PEER_NKEYS, PEER_HALF), PEER_HALF ** -0.5),
        "peer_u": nrm(ks[17], (DEPTH, N_EXPERTS, D), D ** -0.5),
        "peer_v": nrm(ks[18], (DEPTH, N_EXPERTS, D), 1.0),
        "rel_bias": nrm(ks[19], (REL_BUCKETS, N_ATTN_HEADS), 0.2),
        "g_final": 1.0 + nrm(ks[20], (D,), 0.02),
    }


def reference(x, c, w_ada, b_ada, g_norm_mix, w_in, lam_q1, lam_k1, lam_q2, lam_k2,
              g_subln, g_kv_norm, w_uv, w_out, g_norm_ffn, w_peer_q, peer_keys,
              peer_u, peer_v, rel_bias, g_final):
    B, S, D = x.shape
    sizes = (DIFF_HEADS * 2 * DIFF_QK_DIM, DIFF_HEADS * 2 * DIFF_QK_DIM, DIFF_WIDTH,
             DSA_HEADS * DSA_LATENT, DSA_LATENT, IDX_HEADS * IDX_DIM, IDX_DIM, IDX_HEADS)
    offsets = [int(o) for o in np.cumsum(sizes)[:-1]]
    bias_diff = rel_bias[:, :DIFF_HEADS]
    bias_dsa = rel_bias[:, DIFF_HEADS:]
    c_act = jax.nn.silu(c)

    for l in range(DEPTH):
        mod = c_act @ w_ada[l] + b_ada[l]
        shift_a, scale_a, gate_a, shift_f, scale_f, gate_f = [m[:, None, :] for m in jnp.split(mod, 6, axis=-1)]

        h = rms_norm(x, g_norm_mix[l]) * (1.0 + scale_a) + shift_a
        proj = h @ w_in[l]
        dq, dk, dv, sq, skv, iq, ik, iw = jnp.split(proj, offsets, axis=-1)

        dq = dq.reshape(B, S, DIFF_HEADS, 2, DIFF_QK_DIM)
        dk = dk.reshape(B, S, DIFF_HEADS, 2, DIFF_QK_DIM)
        dv = dv.reshape(B, S, DIFF_HEADS, DIFF_V_DIM)
        lambda_init = 0.8 - 0.6 * math.exp(-0.3 * l)
        lam = (jnp.exp(jnp.sum(lam_q1[l].astype(jnp.float32) * lam_k1[l].astype(jnp.float32)))
               - jnp.exp(jnp.sum(lam_q2[l].astype(jnp.float32) * lam_k2[l].astype(jnp.float32)))
               + lambda_init)
        o_diff = diff_attention(dq[:, :, :, 0], dq[:, :, :, 1], dk[:, :, :, 0], dk[:, :, :, 1], dv, lam, bias_diff)
        o_diff = (rms_norm(o_diff, g_subln[l]) * (1.0 - lambda_init)).reshape(B, S, DIFF_WIDTH)

        sq = sq.reshape(B, S, DSA_HEADS, DSA_LATENT)
        skv = rms_norm(skv, g_kv_norm[l])
        iq = iq.reshape(B, S, IDX_HEADS, IDX_DIM)
        iw = iw * (IDX_HEADS ** -0.5)
        o_dsa = dsa_attention(sq, skv, iq, ik, iw, w_uv[l], bias_dsa).reshape(B, S, DSA_WIDTH)

        mix = jnp.concatenate([o_diff, o_dsa], axis=-1) @ w_out[l]
        x = x + gate_a * mix

        h2 = rms_norm(x, g_norm_ffn[l]) * (1.0 + scale_f) + shift_f
        x = x + gate_f * peer(h2, w_peer_q[l], peer_keys[l], peer_u[l], peer_v[l])

    return rms_norm(x, g_final)
```

```cpp
#include <hip/hip_runtime.h>
#include <stdint.h>
#include <stdio.h>

typedef unsigned short bf16_t;

constexpr int D = 1024, NB = 32, S = 2048, T = NB * S;
constexpr int NP = 2760, NPP = 2816;
constexpr int C_DQ = 0, C_DK = 512, C_DV = 1024, C_SQ = 1536, C_SKV = 2048, C_IQ = 2176, C_IK = 2688, C_IW = 2752;
constexpr int MOD_SHIFT_A = 0, MOD_SCALE_A = 1024, MOD_GATE_A = 2048, MOD_SHIFT_F = 3072, MOD_SCALE_F = 4096, MOD_GATE_F = 5120;
constexpr float EPS = 1e-6f;

__device__ __forceinline__ float bf2f(bf16_t v) { return __uint_as_float(((unsigned)v) << 16); }
__device__ __forceinline__ bf16_t f2bf(float f) { unsigned u = __float_as_uint(f); u += 0x7fffu + ((u >> 16) & 1u); return (bf16_t)(u >> 16); }

__device__ __forceinline__ int rel_bucket(int n) {
    if (n < 16) return n < 0 ? 0 : n;
    int b = 16;
    b += (n >= 19); b += (n >= 21); b += (n >= 24); b += (n >= 27); b += (n >= 31); b += (n >= 35); b += (n >= 40); b += (n >= 46);
    b += (n >= 52); b += (n >= 59); b += (n >= 67); b += (n >= 77); b += (n >= 87); b += (n >= 99); b += (n >= 113);
    return b;
}

__device__ __forceinline__ float wave_sum(float v) {
#pragma unroll
    for (int o = 32; o >= 1; o >>= 1) v += __shfl_xor(v, o);
    return v;
}
__device__ __forceinline__ float wave_max(float v) {
#pragma unroll
    for (int o = 32; o >= 1; o >>= 1) v = fmaxf(v, __shfl_xor(v, o));
    return v;
}
__device__ __forceinline__ float block_sum(float v, float* red) {
    v = wave_sum(v);
    __syncthreads();
    if ((threadIdx.x & 63) == 0) red[threadIdx.x >> 6] = v;
    __syncthreads();
    return red[0] + red[1] + red[2] + red[3];
}
__device__ __forceinline__ float block_max(float v, float* red) {
    v = wave_max(v);
    __syncthreads();
    if ((threadIdx.x & 63) == 0) red[threadIdx.x >> 6] = v;
    __syncthreads();
    return fmaxf(fmaxf(red[0], red[1]), fmaxf(red[2], red[3]));
}
__device__ __forceinline__ int block_sum_i(int v, int* red) {
#pragma unroll
    for (int o = 32; o >= 1; o >>= 1) v += __shfl_xor(v, o);
    __syncthreads();
    if ((threadIdx.x & 63) == 0) red[threadIdx.x >> 6] = v;
    __syncthreads();
    return red[0] + red[1] + red[2] + red[3];
}

__global__ void __launch_bounds__(256) k_mod(const float* __restrict__ c, const float* __restrict__ w_ada, const float* __restrict__ b_ada, float* __restrict__ mod,
                                             const float* lq1, const float* lk1, const float* lq2, const float* lk2, float* lam_out) {
    const int j = blockIdx.x * 256 + threadIdx.x, b = blockIdx.y;
    float acc = 0.f;
    for (int k = 0; k < D; ++k) { const float cv = c[b * D + k]; const float s = cv / (1.f + expf(-cv)); acc += s * w_ada[(size_t)k * 6144 + j]; }
    mod[b * 6144 + j] = acc + b_ada[j];
    if (blockIdx.x == 0 && blockIdx.y == 0 && threadIdx.x == 0) {
        float s1 = 0.f, s2 = 0.f;
        for (int i = 0; i < 64; ++i) { s1 += lq1[i] * lk1[i]; s2 += lq2[i] * lk2[i]; }
        lam_out[0] = expf(s1) - expf(s2) + 0.2f;
    }
}

__global__ void __launch_bounds__(256) k_norm_mod(const float* __restrict__ x, const float* __restrict__ g, const float* __restrict__ mod, int shift_off, int scale_off, bf16_t* __restrict__ out) {
    const int row = blockIdx.x * 4 + (threadIdx.x >> 6), lane = threadIdx.x & 63, b = row / S;
    const float4* xr = (const float4*)(x + (size_t)row * D);
    float4 v[4]; float ss = 0.f;
#pragma unroll
    for (int i = 0; i < 4; ++i) { v[i] = xr[lane + 64 * i]; ss += v[i].x * v[i].x + v[i].y * v[i].y + v[i].z * v[i].z + v[i].w * v[i].w; }
    ss = wave_sum(ss);
    const float r = rsqrtf(ss * (1.f / D) + EPS);
    const float* mb = mod + b * 6144;
#pragma unroll
    for (int i = 0; i < 4; ++i) {
        const int col = (lane + 64 * i) * 4;
        const float4 gg = *(const float4*)(g + col), sc = *(const float4*)(mb + scale_off + col), sh = *(const float4*)(mb + shift_off + col);
        ushort4 o;
        o.x = f2bf(v[i].x * r * gg.x * (1.f + sc.x) + sh.x); o.y = f2bf(v[i].y * r * gg.y * (1.f + sc.y) + sh.y);
        o.z = f2bf(v[i].z * r * gg.z * (1.f + sc.z) + sh.z); o.w = f2bf(v[i].w * r * gg.w * (1.f + sc.w) + sh.w);
        *(ushort4*)(out + (size_t)row * D + col) = o;
    }
}

template <int MODE>
__global__ void __launch_bounds__(256) k_gemm_naive(const bf16_t* __restrict__ A, const float* __restrict__ W, int N, void* __restrict__ Cout, int ldc,
                                                    const float* __restrict__ xres, const float* __restrict__ mod, int gate_off) {
    __shared__ float As[16][64 + 4];
    __shared__ float Bs[16][64];
    const int tid = threadIdx.x, tx = tid & 15, ty = tid >> 4;
    const int m0 = blockIdx.y * 64, n0 = blockIdx.x * 64;
    float acc[4][4] = {};
    for (int k0 = 0; k0 < D; k0 += 16) {
        { const int r = tid >> 2, kk = (tid & 3) * 4; const ushort4 a = *(const ushort4*)(A + (size_t)(m0 + r) * D + k0 + kk);
          As[kk + 0][r] = bf2f(a.x); As[kk + 1][r] = bf2f(a.y); As[kk + 2][r] = bf2f(a.z); As[kk + 3][r] = bf2f(a.w); }
        { const int kk = tid >> 4, cc = (tid & 15) * 4;
#pragma unroll
          for (int i = 0; i < 4; ++i) { const int col = n0 + cc + i; Bs[kk][cc + i] = col < N ? W[(size_t)(k0 + kk) * N + col] : 0.f; } }
        __syncthreads();
#pragma unroll
        for (int k = 0; k < 16; ++k) {
            float a[4], b[4];
#pragma unroll
            for (int i = 0; i < 4; ++i) { a[i] = As[k][ty * 4 + i]; b[i] = Bs[k][tx * 4 + i]; }
#pragma unroll
            for (int i = 0; i < 4; ++i)
#pragma unroll
                for (int j = 0; j < 4; ++j) acc[i][j] += a[i] * b[j];
        }
        __syncthreads();
    }
#pragma unroll
    for (int i = 0; i < 4; ++i) {
        const int row = m0 + ty * 4 + i;
#pragma unroll
        for (int j = 0; j < 4; ++j) {
            const int col = n0 + tx * 4 + j;
            if (col < N) {
                if (MODE == 0) ((bf16_t*)Cout)[(size_t)row * ldc + col] = f2bf(acc[i][j]);
                else if (MODE == 1) { const int b = row / S; ((float*)Cout)[(size_t)row * ldc + col] = xres[(size_t)row * D + col] + mod[b * 6144 + gate_off + col] * acc[i][j]; }
                else ((float*)Cout)[(size_t)row * ldc + col] = acc[i][j];
            }
        }
    }
}

__global__ void __launch_bounds__(256) k_kvnorm(const bf16_t* __restrict__ proj, const float* __restrict__ g_kv, bf16_t* __restrict__ kvn) {
    const int row = blockIdx.x * 4 + (threadIdx.x >> 6), lane = threadIdx.x & 63;
    const bf16_t* p = proj + (size_t)row * NPP + C_SKV;
    const float a = bf2f(p[lane]), b = bf2f(p[lane + 64]);
    const float ss = wave_sum(a * a + b * b);
    const float r = rsqrtf(ss * (1.f / 128.f) + EPS);
    kvn[(size_t)row * 128 + lane] = f2bf(a * r * g_kv[lane]);
    kvn[(size_t)row * 128 + lane + 64] = f2bf(b * r * g_kv[lane + 64]);
}

__global__ void __launch_bounds__(256) k_diff_naive(const bf16_t* __restrict__ proj, const float* __restrict__ rel_bias, const float* __restrict__ lam_p,
                                                    const float* __restrict__ g_subln, bf16_t* __restrict__ mixin) {
    __shared__ float l1[S], l2[S];
    __shared__ float qs[128];
    __shared__ float red[8];
    __shared__ float osum[256];
    const int tid = threadIdx.x;
    const int t = blockIdx.x % S, bh = blockIdx.x / S, h = bh & 3, b = bh >> 2;
    const size_t row = (size_t)b * S + t;
    if (tid < 128) qs[tid] = bf2f(proj[row * NPP + C_DQ + h * 128 + tid]);
    __syncthreads();
    float m1 = -INFINITY, m2 = -INFINITY;
    for (int s = tid; s <= t; s += 256) {
        const bf16_t* kr = proj + ((size_t)b * S + s) * NPP + C_DK + h * 128;
        float d1 = 0.f, d2 = 0.f;
        for (int d = 0; d < 64; ++d) { d1 += qs[d] * bf2f(kr[d]); d2 += qs[64 + d] * bf2f(kr[64 + d]); }
        const float bias = rel_bias[rel_bucket(t - s) * 8 + h];
        d1 = d1 * 0.125f + bias; d2 = d2 * 0.125f + bias;
        l1[s] = d1; l2[s] = d2; m1 = fmaxf(m1, d1); m2 = fmaxf(m2, d2);
    }
    m1 = block_max(m1, red); m2 = block_max(m2, red);
    float s1 = 0.f, s2 = 0.f;
    for (int s = tid; s <= t; s += 256) { const float e1 = expf(l1[s] - m1), e2 = expf(l2[s] - m2); l1[s] = e1; l2[s] = e2; s1 += e1; s2 += e2; }
    s1 = block_sum(s1, red); s2 = block_sum(s2, red);
    const float lam = lam_p[0];
    const float i1 = 1.f / s1, i2 = lam / s2;
    for (int s = tid; s <= t; s += 256) l1[s] = l1[s] * i1 - l2[s] * i2;
    __syncthreads();
    const int d = tid & 127, half = tid >> 7;
    float acc = 0.f;
    for (int s = half; s <= t; s += 2) acc += l1[s] * bf2f(proj[((size_t)b * S + s) * NPP + C_DV + h * 128 + d]);
    osum[tid] = acc;
    __syncthreads();
    float o = 0.f;
    if (tid < 128) o = osum[tid] + osum[tid + 128];
    const float ss = block_sum(tid < 128 ? o * o : 0.f, red);
    if (tid < 128) mixin[row * D + h * 128 + tid] = f2bf(o * rsqrtf(ss * (1.f / 128.f) + EPS) * g_subln[tid] * 0.8f);
}

__device__ __forceinline__ unsigned fkey(float f) { f = f + 0.0f; unsigned u = __float_as_uint(f); return (u & 0x80000000u) ? ~u : (u | 0x80000000u); }

__global__ void __launch_bounds__(256) k_dsa_naive(const bf16_t* __restrict__ proj, const bf16_t* __restrict__ kvn, const float* __restrict__ rel_bias,
                                                   const float* __restrict__ w_uv, bf16_t* __restrict__ mixin) {
    __shared__ float sc[S];
    __shared__ unsigned char selb[S];
    __shared__ float lg[4][S];
    __shared__ float iqs[512];
    __shared__ float iws[8];
    __shared__ float qs[512];
    __shared__ float red[8];
    __shared__ int redi[8];
    __shared__ float os[4][128];
    const int tid = threadIdx.x;
    const int t = blockIdx.x % S, b = blockIdx.x / S;
    const size_t row = (size_t)b * S + t;
    const bf16_t* pr = proj + row * NPP;
    iqs[tid] = bf2f(pr[C_IQ + tid]); iqs[tid + 256] = bf2f(pr[C_IQ + tid + 256]);
    qs[tid] = bf2f(pr[C_SQ + tid]); qs[tid + 256] = bf2f(pr[C_SQ + tid + 256]);
    if (tid < 8) iws[tid] = bf2f(pr[C_IW + tid]) * 0.35355339059327373f;
    __syncthreads();
    for (int s = tid; s <= t; s += 256) {
        const bf16_t* ik = proj + ((size_t)b * S + s) * NPP + C_IK;
        float ikf[64];
#pragma unroll
        for (int d = 0; d < 64; ++d) ikf[d] = bf2f(ik[d]);
        float score = 0.f;
        for (int hh = 0; hh < 8; ++hh) { float dd = 0.f;
#pragma unroll
            for (int d = 0; d < 64; ++d) dd += iqs[hh * 64 + d] * ikf[d];
            score += iws[hh] * fmaxf(dd * 0.125f, 0.f); }
        sc[s] = score;
    }
    __syncthreads();
    const int nk = t + 1;
    if (nk > 256) {
        unsigned prefix = 0u;
        for (int bit = 31; bit >= 0; --bit) {
            const unsigned cand = prefix | (1u << bit);
            int cnt = 0;
            for (int s = tid; s < nk; s += 256) cnt += (fkey(sc[s]) >= cand) ? 1 : 0;
            cnt = block_sum_i(cnt, redi);
            if (cnt >= 256) prefix = cand;
        }
        int cgt = 0;
        for (int s = tid; s < nk; s += 256) cgt += (fkey(sc[s]) > prefix) ? 1 : 0;
        cgt = block_sum_i(cgt, redi);
        for (int s = tid; s < nk; s += 256) selb[s] = (fkey(sc[s]) > prefix) ? 1 : 0;
        __syncthreads();
        if (tid == 0) { int need = 256 - cgt; for (int s = 0; s < nk && need > 0; ++s) if (fkey(sc[s]) == prefix) { selb[s] = 1; --need; } }
        __syncthreads();
    } else {
        for (int s = tid; s < nk; s += 256) selb[s] = 1;
        __syncthreads();
    }
    float mx[4] = {-INFINITY, -INFINITY, -INFINITY, -INFINITY};
    for (int s = tid; s < nk; s += 256) {
        if (selb[s]) {
            const bf16_t* kr = kvn + ((size_t)b * S + s) * 128;
            float d0 = 0.f, d1 = 0.f, d2 = 0.f, d3 = 0.f;
            for (int d = 0; d < 128; ++d) { const float kv = bf2f(kr[d]); d0 += qs[d] * kv; d1 += qs[128 + d] * kv; d2 += qs[256 + d] * kv; d3 += qs[384 + d] * kv; }
            const int bk = rel_bucket(t - s);
            const float sc128 = 0.08838834764831845f;
            d0 = d0 * sc128 + rel_bias[bk * 8 + 4]; d1 = d1 * sc128 + rel_bias[bk * 8 + 5]; d2 = d2 * sc128 + rel_bias[bk * 8 + 6]; d3 = d3 * sc128 + rel_bias[bk * 8 + 7];
            lg[0][s] = d0; lg[1][s] = d1; lg[2][s] = d2; lg[3][s] = d3;
            mx[0] = fmaxf(mx[0], d0); mx[1] = fmaxf(mx[1], d1); mx[2] = fmaxf(mx[2], d2); mx[3] = fmaxf(mx[3], d3);
        }
    }
    float sm[4];
    for (int hh = 0; hh < 4; ++hh) {
        mx[hh] = block_max(mx[hh], red);
        float su = 0.f;
        for (int s = tid; s < nk; s += 256) if (selb[s]) { const float e = expf(lg[hh][s] - mx[hh]); lg[hh][s] = e; su += e; }
        sm[hh] = block_sum(su, red);
    }
    __syncthreads();
    {
        const int d = tid & 127, hp = tid >> 7;
        float o0 = 0.f, o1 = 0.f;
        for (int s = 0; s < nk; ++s) if (selb[s]) { const float kv = bf2f(kvn[((size_t)b * S + s) * 128 + d]); o0 += lg[hp * 2][s] * kv; o1 += lg[hp * 2 + 1][s] * kv; }
        os[hp * 2][d] = o0 / sm[hp * 2]; os[hp * 2 + 1][d] = o1 / sm[hp * 2 + 1];
    }
    __syncthreads();
    {
        const int e = tid & 127, hp = tid >> 7;
        for (int hh = hp * 2; hh < hp * 2 + 2; ++hh) {
            float acc = 0.f;
            for (int cc = 0; cc < 128; ++cc) acc += os[hh][cc] * w_uv[((size_t)hh * 128 + cc) * 128 + e];
            mixin[row * D + 512 + hh * 128 + e] = f2bf(acc);
        }
    }
}

__device__ __forceinline__ void wave_argmax(float& v, int& i) {
#pragma unroll
    for (int o = 32; o >= 1; o >>= 1) { const float ov = __shfl_xor(v, o); const int oi = __shfl_xor(i, o); if (ov > v || (ov == v && oi < i)) { v = ov; i = oi; } }
}
__global__ void __launch_bounds__(256) k_peer_select(const float* __restrict__ qf, const float* __restrict__ keys, int* __restrict__ eidx, float* __restrict__ gate) {
    __shared__ float qsh[4][128];
    __shared__ float s12[4][2][16];
    __shared__ int i12[4][2][16];
    const int wid = threadIdx.x >> 6, lane = threadIdx.x & 63;
    const int th = blockIdx.x * 4 + wid, tok = th >> 3, h = th & 7;
    qsh[wid][lane] = qf[(size_t)tok * D + h * 128 + lane]; qsh[wid][lane + 64] = qf[(size_t)tok * D + h * 128 + lane + 64];
    __syncthreads();
    for (int p = 0; p < 2; ++p) {
        float v0 = 0.f, v1 = 0.f;
        const float* k0 = keys + (((size_t)h * 2 + p) * 128 + lane) * 64, *k1 = k0 + 64 * 64;
        for (int d = 0; d < 64; ++d) { const float q = qsh[wid][p * 64 + d]; v0 += q * k0[d]; v1 += q * k1[d]; }
        for (int r = 0; r < 16; ++r) {
            float bv; int bi;
            if (v0 >= v1) { bv = v0; bi = lane; } else { bv = v1; bi = lane + 64; }
            wave_argmax(bv, bi);
            if (lane == 0) { s12[wid][p][r] = bv; i12[wid][p][r] = bi; }
            if (bi == lane) v0 = -INFINITY; if (bi == lane + 64) v1 = -INFINITY;
        }
    }
    __syncthreads();
    float cv[4];
#pragma unroll
    for (int c = 0; c < 4; ++c) { const int pos = lane + 64 * c; cv[c] = s12[wid][0][pos >> 4] + s12[wid][1][pos & 15]; }
    float topv = 0.f; int tope = 0;
    for (int r = 0; r < 16; ++r) {
        float bv = cv[0]; int bi = lane;
#pragma unroll
        for (int c = 1; c < 4; ++c) if (cv[c] > bv) { bv = cv[c]; bi = lane + 64 * c; }
        wave_argmax(bv, bi);
#pragma unroll
        for (int c = 0; c < 4; ++c) if (bi == lane + 64 * c) cv[c] = -INFINITY;
        if (lane == r) { topv = bv; tope = i12[wid][0][bi >> 4] * 128 + i12[wid][1][bi & 15]; }
    }
    const float tmax = __shfl(topv, 0);
    const float e = lane < 16 ? expf(topv - tmax) : 0.f;
    const float su = wave_sum(e);
    if (lane < 16) { eidx[(size_t)tok * 128 + h * 16 + lane] = tope; gate[(size_t)tok * 128 + h * 16 + lane] = e / su; }
}

__global__ void __launch_bounds__(256) k_peer_gather_final(const bf16_t* __restrict__ h2, const int* __restrict__ eidx, const float* __restrict__ gate,
                                                           const float* __restrict__ u_tab, const float* __restrict__ v_tab, const float* __restrict__ mod,
                                                           const float* __restrict__ g_final, float* __restrict__ xio) {
    __shared__ float xs[D];
    __shared__ float wts[128];
    __shared__ int es[128];
    __shared__ float red[8];
    const int tid = threadIdx.x, wid = tid >> 6, lane = tid & 63;
    const size_t tok = blockIdx.x; const int b = (int)(tok / S);
    for (int i = tid; i < D; i += 256) xs[i] = bf2f(h2[tok * D + i]);
    if (tid < 128) es[tid] = eidx[tok * 128 + tid];
    __syncthreads();
    for (int k = wid * 32; k < wid * 32 + 32; ++k) {
        const float4* ur = (const float4*)(u_tab + (size_t)es[k] * D);
        float dsum = 0.f;
#pragma unroll
        for (int i = 0; i < 4; ++i) { const float4 u = ur[lane + 64 * i]; const float* xx = xs + (lane + 64 * i) * 4; dsum += u.x * xx[0] + u.y * xx[1] + u.z * xx[2] + u.w * xx[3]; }
        dsum = wave_sum(dsum);
        if (lane == 0) wts[k] = gate[tok * 128 + k] * 0.5f * dsum * (1.f + erff(dsum * 0.70710678118654752f));
    }
    __syncthreads();
    float4 acc = {0.f, 0.f, 0.f, 0.f};
    for (int k = 0; k < 128; ++k) { const float4 v = *(const float4*)(v_tab + (size_t)es[k] * D + tid * 4); const float w = wts[k]; acc.x += w * v.x; acc.y += w * v.y; acc.z += w * v.z; acc.w += w * v.w; }
    const float4 x1 = *(const float4*)(xio + tok * D + tid * 4);
    const float4 gf = *(const float4*)(mod + b * 6144 + MOD_GATE_F + tid * 4);
    float4 y; y.x = x1.x + gf.x * acc.x; y.y = x1.y + gf.y * acc.y; y.z = x1.z + gf.z * acc.z; y.w = x1.w + gf.w * acc.w;
    const float ss = block_sum(y.x * y.x + y.y * y.y + y.z * y.z + y.w * y.w, red);
    const float r = rsqrtf(ss * (1.f / D) + EPS);
    const float4 g4 = *(const float4*)(g_final + tid * 4);
    float4 o; o.x = y.x * r * g4.x; o.y = y.y * r * g4.y; o.z = y.z * r * g4.z; o.w = y.w * r * g4.w;
    *(float4*)(xio + tok * D + tid * 4) = o;
}

extern "C" void kernel_launch(void* const* d_in, const int* in_sizes, int n_in, void* d_out, int out_size, void* d_ws, size_t ws_size, hipStream_t stream) {
    const float* x = (const float*)d_in[0];
    const float* c = (const float*)d_in[1];
    const float* w_ada = (const float*)d_in[2];
    const float* b_ada = (const float*)d_in[3];
    const float* g_norm_mix = (const float*)d_in[4];
    const float* w_in = (const float*)d_in[5];
    const float* lq1 = (const float*)d_in[6];
    const float* lk1 = (const float*)d_in[7];
    const float* lq2 = (const float*)d_in[8];
    const float* lk2 = (const float*)d_in[9];
    const float* g_subln = (const float*)d_in[10];
    const float* g_kv = (const float*)d_in[11];
    const float* w_uv = (const float*)d_in[12];
    const float* w_out = (const float*)d_in[13];
    const float* g_norm_ffn = (const float*)d_in[14];
    const float* w_peer_q = (const float*)d_in[15];
    const float* peer_keys = (const float*)d_in[16];
    const float* peer_u = (const float*)d_in[17];
    const float* peer_v = (const float*)d_in[18];
    const float* rel_bias = (const float*)d_in[19];
    const float* g_final = (const float*)d_in[20];
    float* out = (float*)d_out;

    char* ws = (char*)d_ws;
    size_t off = 0;
    auto take = [&](size_t bytes) { char* p = ws + off; off += (bytes + 255) & ~(size_t)255; return p; };
    (void)take(16384);
    float* mod = (float*)take((size_t)NB * 6144 * 4);
    float* lam = (float*)take(256);
    bf16_t* hbuf = (bf16_t*)take((size_t)T * D * 2);
    bf16_t* mixin = (bf16_t*)take((size_t)T * D * 2);
    bf16_t* kvn = (bf16_t*)take((size_t)T * 128 * 2);
    int* eidx = (int*)take((size_t)T * 128 * 4);
    float* gate = (float*)take((size_t)T * 128 * 4);
    char* big = take((size_t)T * NPP * 2);
    bf16_t* proj = (bf16_t*)big;
    float* qf = (float*)big;
    if (off > ws_size) { fprintf(stderr, "workspace too small: need %zu have %zu\n", off, ws_size); return; }

    k_mod<<<dim3(24, NB), 256, 0, stream>>>(c, w_ada, b_ada, mod, lq1, lk1, lq2, lk2, lam);
    k_norm_mod<<<T / 4, 256, 0, stream>>>(x, g_norm_mix, mod, MOD_SHIFT_A, MOD_SCALE_A, hbuf);
    k_gemm_naive<0><<<dim3((NP + 63) / 64, T / 64), 256, 0, stream>>>(hbuf, w_in, NP, proj, NPP, nullptr, nullptr, 0);
    k_kvnorm<<<T / 4, 256, 0, stream>>>(proj, g_kv, kvn);
    k_diff_naive<<<T * 4, 256, 0, stream>>>(proj, rel_bias, lam, g_subln, mixin);
    k_dsa_naive<<<T, 256, 0, stream>>>(proj, kvn, rel_bias, w_uv, mixin);
    k_gemm_naive<1><<<dim3(D / 64, T / 64), 256, 0, stream>>>(mixin, w_out, D, out, D, x, mod, MOD_GATE_A);
    k_norm_mod<<<T / 4, 256, 0, stream>>>(out, g_norm_ffn, mod, MOD_SHIFT_F, MOD_SCALE_F, hbuf);
    k_gemm_naive<2><<<dim3(D / 64, T / 64), 256, 0, stream>>>(hbuf, w_peer_q, D, qf, D, nullptr, nullptr, 0);
    k_peer_select<<<T * 8 / 4, 256, 0, stream>>>(qf, peer_keys, eidx, gate);
    k_peer_gather_final<<<T, 256, 0, stream>>>(hbuf, eidx, gate, peer_u, peer_v, mod, g_final, out);
}
```

```cpp
#include <hip/hip_runtime.h>
#include <stdint.h>
#include <stdio.h>

typedef unsigned short bf16_t;
#define LAS __attribute__((address_space(3)))
#define GAS __attribute__((address_space(1)))

constexpr int D = 1024, NB = 32, S = 2048, T = NB * S;
constexpr int NP = 2760, NPP = 2816;
constexpr int C_DQ = 0, C_DK = 512, C_DV = 1024, C_SQ = 1536, C_SKV = 2048, C_IQ = 2176, C_IK = 2688, C_IW = 2752;
constexpr int MOD_SHIFT_A = 0, MOD_SCALE_A = 1024, MOD_GATE_A = 2048, MOD_SHIFT_F = 3072, MOD_SCALE_F = 4096, MOD_GATE_F = 5120;
constexpr float EPS = 1e-6f;
constexpr int NWAVES = 8, NTHREADS = 512;

__device__ __forceinline__ float bf2f(bf16_t v) { return __uint_as_float(((unsigned)v) << 16); }
__device__ __forceinline__ bf16_t f2bf(float f) { unsigned u = __float_as_uint(f); u += 0x7fffu + ((u >> 16) & 1u); return (bf16_t)(u >> 16); }
__device__ __forceinline__ unsigned pk2(float lo, float hi) { return (unsigned)f2bf(lo) | ((unsigned)f2bf(hi) << 16); }

__device__ __forceinline__ int rel_bucket(int n) {
    if (n < 16) return n < 0 ? 0 : n;
    int b = 16;
    b += (n >= 19); b += (n >= 21); b += (n >= 24); b += (n >= 27); b += (n >= 31); b += (n >= 35); b += (n >= 40); b += (n >= 46);
    b += (n >= 52); b += (n >= 59); b += (n >= 67); b += (n >= 77); b += (n >= 87); b += (n >= 99); b += (n >= 113);
    return b;
}

__device__ __forceinline__ float wave_sum(float v) {
#pragma unroll
    for (int o = 32; o >= 1; o >>= 1) v += __shfl_xor(v, o);
    return v;
}
__device__ __forceinline__ float wave_max(float v) {
#pragma unroll
    for (int o = 32; o >= 1; o >>= 1) v = fmaxf(v, __shfl_xor(v, o));
    return v;
}
__device__ __forceinline__ float block_sum(float v, float* red) {
    v = wave_sum(v);
    __syncthreads();
    if ((threadIdx.x & 63) == 0) red[threadIdx.x >> 6] = v;
    __syncthreads();
    return red[0] + red[1] + red[2] + red[3];
}
__device__ __forceinline__ float block_max(float v, float* red) {
    v = wave_max(v);
    __syncthreads();
    if ((threadIdx.x & 63) == 0) red[threadIdx.x >> 6] = v;
    __syncthreads();
    return fmaxf(fmaxf(red[0], red[1]), fmaxf(red[2], red[3]));
}
__device__ __forceinline__ int block_sum_i(int v, int* red) {
#pragma unroll
    for (int o = 32; o >= 1; o >>= 1) v += __shfl_xor(v, o);
    __syncthreads();
    if ((threadIdx.x & 63) == 0) red[threadIdx.x >> 6] = v;
    __syncthreads();
    return red[0] + red[1] + red[2] + red[3];
}

namespace pg8 {
#define PG8_LAS __attribute__((address_space(3)))
typedef unsigned short bf16_t;
typedef short bf16x8 __attribute__((ext_vector_type(8)));
typedef float f32x4 __attribute__((ext_vector_type(4)));
typedef unsigned u32x4 __attribute__((ext_vector_type(4)));
constexpr int BM = 256, BK = 64, HALF = 128, HTB = HALF * BK * 2  , STAGE_BYTES = 8 * HTB, NXCD = 8, WGM = 8;

__host__ __device__ __forceinline__ int lds_byte(int r, int c) { const int st = (r >> 4) * 2 + (c >> 5), rr = r & 15, cc = c & 31, ob = rr * 64 + cc * 2; return st * 1024 + (ob ^ (((ob >> 9) & 1) << 5)); }
__host__ __device__ __forceinline__ void stage_rc(int b, int& R, int& C) { const int st = b / 1024, sb = b % 1024, swz = sb ^ (((sb >> 9) & 1) << 5); R = (st >> 1) * 16 + swz / 64; C = (st & 1) * 32 + (swz % 64) / 2; }
__host__ __device__ __forceinline__ int perm32(int rho) { const int n = rho >> 4, i = rho & 15; return 8 * (i >> 2) + 4 * n + (i & 3); }

struct Unit { int pm, pn; };
struct Gemm { const bf16_t* A; const bf16_t* Bt; int M, N, K; };

struct StaticOrder {
    int nM, nN, nwg, G, c;
    __host__ __device__ void init(int M, int N, int G_, int c_) { nM = M / BM; nN = N / BM; nwg = nM * nN; G = G_; c = c_; }
    __host__ __device__ bool next(int i, Unit& u) const {
        const long L = (long)i * G + c; if (L >= nwg) return false;
        int wgid = (int)L; { const int q = nwg / NXCD, r = nwg % NXCD, xcd = wgid % NXCD, off = wgid / NXCD; wgid = (xcd < r ? xcd * (q + 1) : r * (q + 1) + (xcd - r) * q) + off; }
        const int nig = WGM * nN, gid = wgid / nig, fm = gid * WGM, gsz = (nM - fm) < WGM ? (nM - fm) : WGM;
        u.pm = fm + ((wgid % nig) % gsz); u.pn = (wgid % nig) / gsz; return true;
    }
    __device__ __forceinline__ void a_ready(const Unit&) const {}
    __device__ __forceinline__ void done(const Unit&) const {}
};
__device__ __forceinline__ unsigned cvt_pk_bf16(float lo, float hi) { unsigned r; asm volatile("v_cvt_pk_bf16_f32 %0, %1, %2" : "=v"(r) : "v"(lo), "v"(hi)); return r; }
typedef float f32x2 __attribute__((ext_vector_type(2)));
struct EpiBf16Plain {
    static constexpr bool PERM = true, AFTER_DRAIN = false;
    bf16_t* O; int ldc;
    __device__ __forceinline__ void operator()(const f32x4 (&acc)[2][2][4][2], const Unit& u, int wr, int wc, int fr, int fq) const {
        const int row0 = u.pm * BM + wr * 64 + fr, col0 = u.pn * BM + wc * 32 + 8 * fq;
#pragma unroll
        for (int ai = 0; ai < 2; ++ai)
#pragma unroll
            for (int m = 0; m < 4; ++m) { bf16_t* rowp = O + (size_t)(row0 + ai * HALF + m * 16) * ldc + col0;
#pragma unroll
                for (int bj = 0; bj < 2; ++bj) { const f32x4 v0 = acc[ai][bj][m][0], v1 = acc[ai][bj][m][1];
                    u32x4 w; w.x = cvt_pk_bf16(v0[0], v0[1]); w.y = cvt_pk_bf16(v0[2], v0[3]); w.z = cvt_pk_bf16(v1[0], v1[1]); w.w = cvt_pk_bf16(v1[2], v1[3]);
                    *(u32x4*)(rowp + bj * HALF) = w; } }
    }
};
struct EpiF32Res {
    static constexpr bool PERM = false, AFTER_DRAIN = false;
    float* C; const float* res; const float* gate;
    __device__ __forceinline__ void operator()(const f32x4 (&acc)[2][2][4][2], const Unit& u, int wr, int wc, int fr, int fq) const {
        const int row0 = u.pm * BM + wr * 64 + fr, col0 = u.pn * BM + wc * 32 + 4 * fq;
        f32x4 gv[2][2];
#pragma unroll
        for (int bj = 0; bj < 2; ++bj)
#pragma unroll
            for (int n = 0; n < 2; ++n) gv[bj][n] = res ? *(const f32x4*)(gate + (size_t)(u.pm >> 3) * 6144 + col0 + bj * HALF + n * 16) : (f32x4){1.f, 1.f, 1.f, 1.f};
#pragma unroll
        for (int ai = 0; ai < 2; ++ai)
#pragma unroll
            for (int m = 0; m < 4; ++m) { const size_t off = (size_t)(row0 + ai * HALF + m * 16) * 1024 + col0;
#pragma unroll
                for (int bj = 0; bj < 2; ++bj)
#pragma unroll
                    for (int n = 0; n < 2; ++n) { f32x4 o = acc[ai][bj][m][n] * gv[bj][n];
                        if (res) o = o + *(const f32x4*)(res + off + bj * HALF + n * 16);
                        *(f32x4*)(C + off + bj * HALF + n * 16) = o; } }
    }
};

template <class Epi, class Sched, bool ALIGN_EPI = false, bool SP2 = false>
__device__ __forceinline__ void gemm_phase(PG8_LAS unsigned char* lds, const Gemm g, const Sched& S, const Epi& E) {
    const int tid = threadIdx.x, wid = __builtin_amdgcn_readfirstlane(tid >> 6), lane = tid & 63, wr = wid >> 2, wc = wid & 3, fr = lane & 15, fq = lane >> 4;
    const int K = g.K, nt = K / BK;
    unsigned voffA[2], voffB[2];
#pragma unroll
    for (int i = 0; i < 2; ++i) { int R, C; stage_rc(tid * 16 + i * 8192, R, C); const int Rb = Epi::PERM ? ((R & ~31) + perm32(R & 31)) : R;
        voffA[i] = (unsigned)(R * K + C) * 2u; voffB[i] = (unsigned)(Rb * K + C) * 2u; }
    const size_t kstep = (size_t)(BK * 2);
    const size_t hstep = (size_t)HALF * K * 2;
    const size_t tstep = 2 * hstep;
    const unsigned ldsw = (unsigned)wid * 1024u;
    const int aoff = lds_byte(wr * 64 + fr, fq * 8), boff = lds_byte(wc * 32 + fr, fq * 8);
#define PG8_SA(b, h) (((b) * 2 + (h)) * HTB)
#define PG8_SB(b, h) ((4 + (b) * 2 + (h)) * HTB)
#define PG8_STAGE(bufoff, gbase, voff) do { _Pragma("unroll") for (int _i = 0; _i < 2; ++_i) \
        __builtin_amdgcn_global_load_lds((const unsigned*)((const char*)(gbase) + (voff)[_i]), (PG8_LAS unsigned*)(lds + (bufoff) + ldsw + _i * 8192), 16, 0, 0); } while (0)
#define PG8_LDA(dst, b, h) do { _Pragma("unroll") for (int m = 0; m < 4; ++m) _Pragma("unroll") for (int k = 0; k < 2; ++k) dst[m][k] = *(const PG8_LAS bf16x8*)(lds + PG8_SA(b, h) + aoff + m * 2048 + k * 1024); } while (0)
#define PG8_LDB(dst, b, h) do { _Pragma("unroll") for (int n = 0; n < 2; ++n) _Pragma("unroll") for (int k = 0; k < 2; ++k) dst[n][k] = *(const PG8_LAS bf16x8*)(lds + PG8_SB(b, h) + boff + n * 2048 + k * 1024); } while (0)
#define PG8_MMA(ai, bj, At, Bt) do { __builtin_amdgcn_s_setprio(1); _Pragma("unroll") for (int m = 0; m < 4; ++m) _Pragma("unroll") for (int n = 0; n < 2; ++n) _Pragma("unroll") for (int k = 0; k < 2; ++k) \
        acc[ai][bj][m][n] = __builtin_amdgcn_mfma_f32_16x16x32_bf16(Bt[n][k], At[m][k], acc[ai][bj][m][n], 0, 0, 0); __builtin_amdgcn_s_setprio(0); } while (0)
#define PG8_WAIT_V(n) asm volatile("s_waitcnt vmcnt(" #n ")" ::: "memory")
#define PG8_WAIT_L(n) asm volatile("s_waitcnt lgkmcnt(" #n ")" ::: "memory")
#define PG8_BAR __builtin_amdgcn_s_barrier()
#define PG8_SCHED __builtin_amdgcn_sched_barrier(0)
    Unit cur, nxt; int ui = 0;
    if (!S.next(0, cur)) return;
    f32x4 acc[2][2][4][2];
#pragma unroll
    for (int a = 0; a < 2; ++a)
#pragma unroll
        for (int b = 0; b < 2; ++b)
#pragma unroll
            for (int m = 0; m < 4; ++m)
#pragma unroll
                for (int n = 0; n < 2; ++n) acc[a][b][m][n] = (f32x4){0.f, 0.f, 0.f, 0.f};
    bf16x8 At[4][2], B0[2][2], B1[2][2];
    const char* cA = (const char*)g.A + (size_t)cur.pm * tstep; const char* cB = (const char*)g.Bt + (size_t)cur.pn * tstep;
    S.a_ready(cur);
    if constexpr (SP2) {
        PG8_STAGE(PG8_SB(0, 0), cB, voffB); PG8_STAGE(PG8_SB(0, 1), cB + hstep, voffB); PG8_STAGE(PG8_SA(0, 0), cA, voffA); PG8_STAGE(PG8_SA(0, 1), cA + hstep, voffA);
        if (wr == 1) PG8_BAR;
        PG8_WAIT_V(2); PG8_BAR;
        PG8_STAGE(PG8_SB(1, 0), cB + kstep, voffB); PG8_STAGE(PG8_SA(1, 0), cA + kstep, voffA); PG8_STAGE(PG8_SB(1, 1), cB + hstep + kstep, voffB);
        PG8_WAIT_V(6); PG8_BAR;
    } else {
        PG8_STAGE(PG8_SB(0, 0), cB, voffB); PG8_STAGE(PG8_SA(0, 0), cA, voffA); PG8_STAGE(PG8_SB(0, 1), cB + hstep, voffB); PG8_STAGE(PG8_SA(0, 1), cA + hstep, voffA);
        if (wr == 1) PG8_BAR;
        PG8_WAIT_V(4); PG8_BAR;
        PG8_STAGE(PG8_SB(1, 0), cB + kstep, voffB); PG8_STAGE(PG8_SA(1, 0), cA + kstep, voffA); PG8_STAGE(PG8_SB(1, 1), cB + hstep + kstep, voffB);
        PG8_WAIT_V(6); PG8_BAR;
    }
    for (;;) {
        const bool has_next = S.next(ui + 1, nxt);
        const char* nA = has_next ? (const char*)g.A + (size_t)nxt.pm * tstep : cA; const char* nB = has_next ? (const char*)g.Bt + (size_t)nxt.pn * tstep : cB;
        for (int t = 0; t < nt; t += 2) {
            const bool last = (t == nt - 2);
            const char* a1 = cA + (size_t)(t + 1) * kstep;
            const char* a2 = last ? nA : cA + (size_t)(t + 2) * kstep; const char* b2 = last ? nB : cB + (size_t)(t + 2) * kstep;
            const char* a3 = a2 + kstep; const char* b3 = b2 + kstep;
            if (last && has_next) S.a_ready(nxt);
            if constexpr (SP2) {
            PG8_LDB(B0, 0, 0); PG8_LDB(B1, 0, 1); PG8_SCHED; PG8_LDA(At, 0, 0); PG8_STAGE(PG8_SA(1, 1), a1 + hstep, voffA);
            PG8_WAIT_V(8); PG8_WAIT_L(0); PG8_BAR; PG8_MMA(0, 0, At, B0); PG8_MMA(0, 1, At, B1); PG8_BAR; PG8_SCHED;
            PG8_LDA(At, 0, 1); PG8_STAGE(PG8_SB(0, 0), b2, voffB); PG8_STAGE(PG8_SB(0, 1), b2 + hstep, voffB); PG8_STAGE(PG8_SA(0, 0), a2, voffA);
            PG8_WAIT_V(8); PG8_WAIT_L(0); PG8_BAR; PG8_MMA(1, 0, At, B0); PG8_MMA(1, 1, At, B1); PG8_BAR; PG8_SCHED;
            PG8_LDB(B0, 1, 0); PG8_LDB(B1, 1, 1); PG8_SCHED; PG8_LDA(At, 1, 0); PG8_STAGE(PG8_SA(0, 1), a2 + hstep, voffA);
            PG8_WAIT_V(8); PG8_WAIT_L(0); PG8_BAR; PG8_MMA(0, 0, At, B0); PG8_MMA(0, 1, At, B1); PG8_BAR; PG8_SCHED;
            PG8_LDA(At, 1, 1); PG8_STAGE(PG8_SB(1, 0), b3, voffB); PG8_STAGE(PG8_SB(1, 1), b3 + hstep, voffB); PG8_STAGE(PG8_SA(1, 0), a3, voffA);
            PG8_WAIT_V(8); PG8_WAIT_L(0); PG8_BAR; PG8_MMA(1, 0, At, B0); PG8_MMA(1, 1, At, B1); PG8_BAR; PG8_SCHED;
            } else {
            PG8_LDB(B0, 0, 0); PG8_SCHED; PG8_LDA(At, 0, 0); PG8_STAGE(PG8_SA(1, 1), a1 + hstep, voffA);
            PG8_WAIT_L(8); PG8_BAR; PG8_WAIT_L(0); PG8_MMA(0, 0, At, B0); PG8_BAR; PG8_SCHED;
            PG8_LDB(B1, 0, 1); PG8_STAGE(PG8_SB(0, 0), b2, voffB);
            PG8_BAR; PG8_WAIT_L(0); PG8_MMA(0, 1, At, B1); PG8_BAR;
            PG8_LDA(At, 0, 1); PG8_STAGE(PG8_SA(0, 0), a2, voffA);
            PG8_BAR; PG8_WAIT_L(0); PG8_MMA(1, 0, At, B0); PG8_BAR; PG8_SCHED;
            PG8_STAGE(PG8_SB(0, 1), b2 + hstep, voffB);
            PG8_WAIT_V(6); PG8_BAR; PG8_MMA(1, 1, At, B1); PG8_BAR;
            PG8_LDB(B0, 1, 0); PG8_SCHED; PG8_LDA(At, 1, 0); PG8_STAGE(PG8_SA(0, 1), a2 + hstep, voffA);
            PG8_WAIT_L(8); PG8_BAR; PG8_WAIT_L(0); PG8_MMA(0, 0, At, B0); PG8_BAR; PG8_SCHED;
            PG8_LDB(B1, 1, 1); PG8_STAGE(PG8_SB(1, 0), b3, voffB);
            PG8_BAR; PG8_WAIT_L(0); PG8_MMA(0, 1, At, B1); PG8_BAR;
            PG8_LDA(At, 1, 1); PG8_STAGE(PG8_SA(1, 0), a3, voffA);
            PG8_BAR; PG8_WAIT_L(0); PG8_MMA(1, 0, At, B0); PG8_BAR; PG8_SCHED;
            PG8_STAGE(PG8_SB(1, 1), b3 + hstep, voffB);
            PG8_WAIT_V(6); PG8_BAR; PG8_MMA(1, 1, At, B1); PG8_BAR;
            }
        }
        if constexpr (ALIGN_EPI) { if (wr == 0) PG8_BAR; }
        if constexpr (!Epi::AFTER_DRAIN) { E(acc, cur, wr, wc, fr, fq); S.done(cur); }
        if (!has_next) break;
#pragma unroll
        for (int a = 0; a < 2; ++a)
#pragma unroll
            for (int b = 0; b < 2; ++b)
#pragma unroll
                for (int m = 0; m < 4; ++m)
#pragma unroll
                    for (int n = 0; n < 2; ++n) acc[a][b][m][n] = (f32x4){0.f, 0.f, 0.f, 0.f};
        cur = nxt; cA = nA; cB = nB; ++ui;
        if constexpr (ALIGN_EPI) { if (wr == 1) PG8_BAR; }
    }
    PG8_WAIT_V(0);
    if constexpr (!ALIGN_EPI) { if (wr == 0) PG8_BAR; }
    PG8_BAR;
    if constexpr (Epi::AFTER_DRAIN) { E.fused(acc, cur, wr, wc, fr, fq, lds, wid, lane); S.done(cur); }
#undef PG8_SA
#undef PG8_SB
#undef PG8_STAGE
#undef PG8_LDA
#undef PG8_LDB
#undef PG8_MMA
#undef PG8_WAIT_V
#undef PG8_WAIT_L
#undef PG8_BAR
#undef PG8_SCHED
}
}
#define XB_TMO      128
#define XB_XCNT(j)  (256  + 64 * (j))
#define XB_XSUB(j)  (1280 + 64 * (j))
#define XB_XGEN(j)  (2304 + 64 * (j))
#define XB_TOP      3328
#define XB_TOPGEN   3392
#define XCD_BAR_WORDS 3456
#define XB_SPIN_CAP (1u << 18)

__device__ __forceinline__ unsigned xb_ld(unsigned* p)              { return __hip_atomic_load(p, __ATOMIC_RELAXED, __HIP_MEMORY_SCOPE_AGENT); }
__device__ __forceinline__ unsigned xb_add(unsigned* p, unsigned v) { return __hip_atomic_fetch_add(p, v, __ATOMIC_RELAXED, __HIP_MEMORY_SCOPE_AGENT); }
__device__ __forceinline__ unsigned xb_xcc_id() { return (unsigned)__builtin_amdgcn_s_getreg((3 << 11) | 20) & 0xFu; }
#define XB_SPIN(cond, bar) do { unsigned _sp = 0; while (cond) { __builtin_amdgcn_s_sleep(1); \
    if ((++_sp & 255u) == 0u) { if (xb_ld(&(bar)[XB_TMO])) break; if (_sp > XB_SPIN_CAP) { atomicAdd(&(bar)[XB_TMO], 1u); break; } } } } while (0)

struct XcdBarrier {
    unsigned* bar; unsigned x;
    volatile LAS unsigned* st;
};

__device__ __forceinline__ XcdBarrier xcd_barrier_post(unsigned* bar, volatile LAS unsigned* st) {
    XcdBarrier b; b.bar = bar; b.x = xb_xcc_id(); b.st = st;
    if (threadIdx.x == 0) (void)xb_add(&bar[XB_XCNT(b.x)], 1u);
    return b;
}
__device__ __forceinline__ void xcd_barrier_complete(unsigned* bar, unsigned x, unsigned& nloc, unsigned& nx) {
    const unsigned G = gridDim.x * gridDim.y * gridDim.z;
    unsigned sum, cnt, mine, sp = 0u;
    for (;;) {
        sum = 0u; cnt = 0u; mine = 0u;
#pragma unroll
        for (unsigned j = 0; j < 16; ++j) { const unsigned c = xb_ld(&bar[XB_XCNT(j)]); sum += c; cnt += (c > 0u) ? 1u : 0u; mine = (j == x) ? c : mine; }
        if (sum == G) break;
        __builtin_amdgcn_s_sleep(1);
        if ((++sp & 255u) == 0u) { if (xb_ld(&bar[XB_TMO])) break; if (sp > XB_SPIN_CAP) { atomicAdd(&bar[XB_TMO], 1u); break; } }
    }
    nloc = mine > 0u ? mine : 1u; nx = cnt > 0u ? cnt : 1u;
}

__device__ __forceinline__ void xcd_barrier(const XcdBarrier& b) {
    asm volatile("s_waitcnt vmcnt(0)" ::: "memory");
    __syncthreads();
    if (threadIdx.x == 0) {
        unsigned* bar = b.bar;
        __builtin_amdgcn_s_waitcnt(0);
        unsigned nloc = b.st[0], nx = b.st[1];
        if (nloc == 0u) { xcd_barrier_complete(bar, b.x, nloc, nx); b.st[0] = nloc; b.st[1] = nx; }
        const unsigned old = xb_add(&bar[XB_XSUB(b.x)], 1u);
        const unsigned gen = old / nloc;
        if (old + 1u == (gen + 1u) * nloc) {
            __builtin_amdgcn_fence(__ATOMIC_RELEASE, "agent");
            asm volatile("s_waitcnt vmcnt(0)" ::: "memory");
            const unsigned og = xb_add(&bar[XB_TOP], 1u);
            const unsigned tg = og / nx;
            if (og + 1u == (tg + 1u) * nx) xb_add(&bar[XB_TOPGEN], 1u);
            else XB_SPIN(xb_ld(&bar[XB_TOPGEN]) == tg, bar);
            __builtin_amdgcn_fence(__ATOMIC_ACQUIRE, "agent");
            xb_add(&bar[XB_XGEN(b.x)], 1u);
            asm volatile("s_waitcnt vmcnt(0)" ::: "memory");
        } else {
            XB_SPIN(xb_ld(&bar[XB_XGEN(b.x)]) == gen, bar);
            __builtin_amdgcn_fence(__ATOMIC_ACQUIRE, "agent");
            asm volatile("s_waitcnt vmcnt(0)" ::: "memory");
        }
    }
    __syncthreads();
}

constexpr size_t MiB = 1u << 20;
constexpr size_t WS_CTL = 0, CTL_ZERO_BYTES = 1 * MiB;
constexpr size_t WS_MOD = 1 * MiB;
constexpr size_t WS_LAM = 1 * MiB + 800 * 1024;
constexpr size_t WS_WIN_T = 2 * MiB;
constexpr size_t WS_WO_T = 8 * MiB;
constexpr size_t WS_WQ_T = 10 * MiB;
constexpr size_t WS_HBUF = 16 * MiB;
constexpr size_t WS_MIXIN = 144 * MiB;
constexpr size_t WS_KVN = 272 * MiB;
constexpr size_t WS_EIDX = 288 * MiB;
constexpr size_t WS_GATE = 320 * MiB;
constexpr size_t WS_BIG = 352 * MiB;
constexpr size_t WS_END = 704 * MiB;
constexpr int CW_BAR = 4096;
constexpr int MAX_FWD_LAUNCHES = 8;
static_assert((CW_BAR + MAX_FWD_LAUNCHES * XCD_BAR_WORDS) * 4 <= (int)CTL_ZERO_BYTES, "barrier words inside the memset region");

constexpr int RING_OFF = 0, RING_BYTES = 131072;
constexpr int LDSCTL_OFF = RING_BYTES, MISC_OFF = LDSCTL_OFF + 320;
constexpr int LDS_BYTES = 147456;

struct Args { const float* in[21]; float* out; unsigned char* ws; int ph_lo, ph_hi, li, pad; };

__device__ __forceinline__ void p0_transpose_item(const float* W, int K, int N, int Npad, bf16_t* WT, LAS float* scr, int item, int lane) {
    const int nblk = Npad / 32, kb = item / nblk, nb = item % nblk, k0 = 64 * kb, n0 = 32 * nb;
    const int n_in = n0 + (lane & 31);
#pragma unroll 8
    for (int i = 0; i < 32; ++i) { const int kk = 2 * i + (lane >> 5); scr[kk * 33 + (lane & 31)] = n_in < N ? W[(size_t)(k0 + kk) * N + n_in] : 0.f; }
    asm volatile("s_waitcnt lgkmcnt(0)" ::: "memory");
    const int c = lane & 7;
#pragma unroll
    for (int j = 0; j < 4; ++j) { const int n = (lane >> 3) + 8 * j; const LAS float* s = scr + (8 * c) * 33 + n;
        uint4 o; o.x = pk2(s[0 * 33], s[1 * 33]); o.y = pk2(s[2 * 33], s[3 * 33]); o.z = pk2(s[4 * 33], s[5 * 33]); o.w = pk2(s[6 * 33], s[7 * 33]);
        *(uint4*)(WT + (size_t)(n0 + n) * K + k0 + 8 * c) = o; }
    asm volatile("s_waitcnt lgkmcnt(0)" ::: "memory");
}

__device__ __forceinline__ void norm_mod_row(const float* xrow, const float* g, const float* mb, int shift_off, int scale_off, bf16_t* orow, int lane) {
    const float4* xr = (const float4*)xrow;
    float4 v[4]; float ss = 0.f;
#pragma unroll
    for (int i = 0; i < 4; ++i) { v[i] = xr[lane + 64 * i]; ss += v[i].x * v[i].x + v[i].y * v[i].y + v[i].z * v[i].z + v[i].w * v[i].w; }
    ss = wave_sum(ss);
    const float r = rsqrtf(ss * (1.f / D) + EPS);
#pragma unroll
    for (int i = 0; i < 4; ++i) {
        const int col = (lane + 64 * i) * 4;
        const float4 gg = *(const float4*)(g + col), sc = *(const float4*)(mb + scale_off + col), sh = *(const float4*)(mb + shift_off + col);
        uint2 o;
        o.x = pk2(v[i].x * r * gg.x * (1.f + sc.x) + sh.x, v[i].y * r * gg.y * (1.f + sc.y) + sh.y);
        o.y = pk2(v[i].z * r * gg.z * (1.f + sc.z) + sh.z, v[i].w * r * gg.w * (1.f + sc.w) + sh.w);
        *(uint2*)(orow + col) = o;
    }
}

__global__ void __launch_bounds__(NTHREADS, 2) fwd(Args args) {
    extern __shared__ __attribute__((aligned(16))) unsigned char lds_raw[];
    LAS unsigned char* lds = (LAS unsigned char*)lds_raw;
    volatile LAS unsigned* MISC = (volatile LAS unsigned*)(lds + MISC_OFF);
    const int tid = threadIdx.x, lane = tid & 63, wave = __builtin_amdgcn_readfirstlane(tid >> 6);
    const int G = gridDim.x;
    unsigned char* ws = args.ws;
    unsigned* ctl = (unsigned*)(ws + WS_CTL);
    for (int u = tid; u < (LDS_BYTES - LDSCTL_OFF) / 4; u += NTHREADS) ((LAS unsigned*)(lds + LDSCTL_OFF))[u] = 0u;
    __syncthreads();
    XcdBarrier bar = xcd_barrier_post(ctl + CW_BAR + args.li * XCD_BAR_WORDS, MISC + 8);
    const int lo = args.ph_lo, hi = args.ph_hi;
#define IN(k) (lo <= (k) && (k) < hi)
#define BOTH(k) (IN(k) && IN((k) + 1))
    const float* x = args.in[0];
    const float* g_norm_mix = args.in[4];
    const float* w_in = args.in[5];
    const float* w_out = args.in[13];
    const float* g_norm_ffn = args.in[14];
    const float* w_peer_q = args.in[15];
    float* out = args.out;
    const float* mod = (const float*)(ws + WS_MOD);
    bf16_t* Win_t = (bf16_t*)(ws + WS_WIN_T); bf16_t* Wo_t = (bf16_t*)(ws + WS_WO_T); bf16_t* Wq_t = (bf16_t*)(ws + WS_WQ_T);
    bf16_t* hbuf = (bf16_t*)(ws + WS_HBUF); bf16_t* mixin = (bf16_t*)(ws + WS_MIXIN);
    bf16_t* proj = (bf16_t*)(ws + WS_BIG); float* qf = (float*)(ws + WS_BIG);
    const int gw = blockIdx.x * NWAVES + wave, NGW = G * NWAVES;

    if (IN(0)) {
        LAS float* scr = (LAS float*)(lds + RING_OFF + wave * 16384);
        constexpr int I_IN = 16 * (NPP / 32), I_O = 16 * 32, I_Q = 16 * 32;
        for (int it = gw; it < I_IN + I_O + I_Q; it += NGW) {
            int r = it;
            if (r < I_IN) { p0_transpose_item(w_in, D, NP, NPP, Win_t, scr, r, lane); continue; } r -= I_IN;
            if (r < I_O) { p0_transpose_item(w_out, D, D, D, Wo_t, scr, r, lane); continue; } r -= I_O;
            p0_transpose_item(w_peer_q, D, D, D, Wq_t, scr, r, lane);
        }
        if (BOTH(0)) xcd_barrier(bar);
    }
    if (IN(1)) {
        for (int m = gw; m < T; m += NGW) norm_mod_row(x + (size_t)m * D, g_norm_mix, mod + (size_t)(m / S) * 6144, MOD_SHIFT_A, MOD_SCALE_A, hbuf + (size_t)m * D, lane);
        if (BOTH(1)) xcd_barrier(bar);
    }
    if (IN(2)) {
        pg8::Gemm g{hbuf, Win_t, T, NPP, D}; pg8::StaticOrder So; So.init(T, NPP, G, (int)blockIdx.x);
        pg8::EpiBf16Plain E{proj, NPP};
        pg8::gemm_phase<pg8::EpiBf16Plain, pg8::StaticOrder, true, true>(lds + RING_OFF, g, So, E);
        if (BOTH(2)) xcd_barrier(bar);
    }
    if (IN(3)) {
        pg8::Gemm g{mixin, Wo_t, T, D, D}; pg8::StaticOrder So; So.init(T, D, G, (int)blockIdx.x);
        pg8::EpiF32Res E{out, x, mod + MOD_GATE_A};
        pg8::gemm_phase<pg8::EpiF32Res, pg8::StaticOrder, true, true>(lds + RING_OFF, g, So, E);
        if (BOTH(3)) xcd_barrier(bar);
    }
    if (IN(4)) {
        for (int m = gw; m < T; m += NGW) norm_mod_row(out + (size_t)m * D, g_norm_ffn, mod + (size_t)(m / S) * 6144, MOD_SHIFT_F, MOD_SCALE_F, hbuf + (size_t)m * D, lane);
        if (BOTH(4)) xcd_barrier(bar);
    }
    if (IN(5)) {
        pg8::Gemm g{hbuf, Wq_t, T, D, D}; pg8::StaticOrder So; So.init(T, D, G, (int)blockIdx.x);
        pg8::EpiF32Res E{qf, nullptr, nullptr};
        pg8::gemm_phase<pg8::EpiF32Res, pg8::StaticOrder, true, true>(lds + RING_OFF, g, So, E);
        if (BOTH(5)) xcd_barrier(bar);
    }
#undef IN
#undef BOTH
}
__global__ void __launch_bounds__(256) k_mod(const float* __restrict__ c, const float* __restrict__ w_ada, const float* __restrict__ b_ada, float* __restrict__ mod,
                                             const float* lq1, const float* lk1, const float* lq2, const float* lk2, float* lam_out) {
    const int j = blockIdx.x * 256 + threadIdx.x, b = blockIdx.y;
    float acc = 0.f;
    for (int k = 0; k < D; ++k) { const float cv = c[b * D + k]; const float s = cv / (1.f + expf(-cv)); acc += s * w_ada[(size_t)k * 6144 + j]; }
    mod[b * 6144 + j] = acc + b_ada[j];
    if (blockIdx.x == 0 && blockIdx.y == 0 && threadIdx.x == 0) {
        float s1 = 0.f, s2 = 0.f;
        for (int i = 0; i < 64; ++i) { s1 += lq1[i] * lk1[i]; s2 += lq2[i] * lk2[i]; }
        lam_out[0] = expf(s1) - expf(s2) + 0.2f;
    }
}

__global__ void __launch_bounds__(256) k_kvnorm(const bf16_t* __restrict__ proj, const float* __restrict__ g_kv, bf16_t* __restrict__ kvn) {
    const int row = blockIdx.x * 4 + (threadIdx.x >> 6), lane = threadIdx.x & 63;
    const bf16_t* p = proj + (size_t)row * NPP + C_SKV;
    const float a = bf2f(p[lane]), b = bf2f(p[lane + 64]);
    const float ss = wave_sum(a * a + b * b);
    const float r = rsqrtf(ss * (1.f / 128.f) + EPS);
    kvn[(size_t)row * 128 + lane] = f2bf(a * r * g_kv[lane]);
    kvn[(size_t)row * 128 + lane + 64] = f2bf(b * r * g_kv[lane + 64]);
}

__global__ void __launch_bounds__(256) k_diff_naive(const bf16_t* __restrict__ proj, const float* __restrict__ rel_bias, const float* __restrict__ lam_p,
                                                    const float* __restrict__ g_subln, bf16_t* __restrict__ mixin) {
    __shared__ float l1[S], l2[S];
    __shared__ float qs[128];
    __shared__ float red[8];
    __shared__ float osum[256];
    const int tid = threadIdx.x;
    const int t = blockIdx.x % S, bh = blockIdx.x / S, h = bh & 3, b = bh >> 2;
    const size_t row = (size_t)b * S + t;
    if (tid < 128) qs[tid] = bf2f(proj[row * NPP + C_DQ + h * 128 + tid]);
    __syncthreads();
    float m1 = -INFINITY, m2 = -INFINITY;
    for (int s = tid; s <= t; s += 256) {
        const bf16_t* kr = proj + ((size_t)b * S + s) * NPP + C_DK + h * 128;
        float d1 = 0.f, d2 = 0.f;
        for (int d = 0; d < 64; ++d) { d1 += qs[d] * bf2f(kr[d]); d2 += qs[64 + d] * bf2f(kr[64 + d]); }
        const float bias = rel_bias[rel_bucket(t - s) * 8 + h];
        d1 = d1 * 0.125f + bias; d2 = d2 * 0.125f + bias;
        l1[s] = d1; l2[s] = d2; m1 = fmaxf(m1, d1); m2 = fmaxf(m2, d2);
    }
    m1 = block_max(m1, red); m2 = block_max(m2, red);
    float s1 = 0.f, s2 = 0.f;
    for (int s = tid; s <= t; s += 256) { const float e1 = expf(l1[s] - m1), e2 = expf(l2[s] - m2); l1[s] = e1; l2[s] = e2; s1 += e1; s2 += e2; }
    s1 = block_sum(s1, red); s2 = block_sum(s2, red);
    const float lam = lam_p[0];
    const float i1 = 1.f / s1, i2 = lam / s2;
    for (int s = tid; s <= t; s += 256) l1[s] = l1[s] * i1 - l2[s] * i2;
    __syncthreads();
    const int d = tid & 127, half = tid >> 7;
    float acc = 0.f;
    for (int s = half; s <= t; s += 2) acc += l1[s] * bf2f(proj[((size_t)b * S + s) * NPP + C_DV + h * 128 + d]);
    osum[tid] = acc;
    __syncthreads();
    float o = 0.f;
    if (tid < 128) o = osum[tid] + osum[tid + 128];
    const float ss = block_sum(tid < 128 ? o * o : 0.f, red);
    if (tid < 128) mixin[row * D + h * 128 + tid] = f2bf(o * rsqrtf(ss * (1.f / 128.f) + EPS) * g_subln[tid] * 0.8f);
}

__device__ __forceinline__ unsigned fkey(float f) { f = f + 0.0f; unsigned u = __float_as_uint(f); return (u & 0x80000000u) ? ~u : (u | 0x80000000u); }

__global__ void __launch_bounds__(256) k_dsa_naive(const bf16_t* __restrict__ proj, const bf16_t* __restrict__ kvn, const float* __restrict__ rel_bias,
                                                   const float* __restrict__ w_uv, bf16_t* __restrict__ mixin) {
    __shared__ float sc[S];
    __shared__ unsigned char selb[S];
    __shared__ float lg[4][S];
    __shared__ float iqs[512];
    __shared__ float iws[8];
    __shared__ float qs[512];
    __shared__ float red[8];
    __shared__ int redi[8];
    __shared__ float os[4][128];
    const int tid = threadIdx.x;
    const int t = blockIdx.x % S, b = blockIdx.x / S;
    const size_t row = (size_t)b * S + t;
    const bf16_t* pr = proj + row * NPP;
    iqs[tid] = bf2f(pr[C_IQ + tid]); iqs[tid + 256] = bf2f(pr[C_IQ + tid + 256]);
    qs[tid] = bf2f(pr[C_SQ + tid]); qs[tid + 256] = bf2f(pr[C_SQ + tid + 256]);
    if (tid < 8) iws[tid] = bf2f(pr[C_IW + tid]) * 0.35355339059327373f;
    __syncthreads();
    for (int s = tid; s <= t; s += 256) {
        const bf16_t* ik = proj + ((size_t)b * S + s) * NPP + C_IK;
        float ikf[64];
#pragma unroll
        for (int d = 0; d < 64; ++d) ikf[d] = bf2f(ik[d]);
        float score = 0.f;
        for (int hh = 0; hh < 8; ++hh) { float dd = 0.f;
#pragma unroll
            for (int d = 0; d < 64; ++d) dd += iqs[hh * 64 + d] * ikf[d];
            score += iws[hh] * fmaxf(dd * 0.125f, 0.f); }
        sc[s] = score;
    }
    __syncthreads();
    const int nk = t + 1;
    if (nk > 256) {
        unsigned prefix = 0u;
        for (int bit = 31; bit >= 0; --bit) {
            const unsigned cand = prefix | (1u << bit);
            int cnt = 0;
            for (int s = tid; s < nk; s += 256) cnt += (fkey(sc[s]) >= cand) ? 1 : 0;
            cnt = block_sum_i(cnt, redi);
            if (cnt >= 256) prefix = cand;
        }
        int cgt = 0;
        for (int s = tid; s < nk; s += 256) cgt += (fkey(sc[s]) > prefix) ? 1 : 0;
        cgt = block_sum_i(cgt, redi);
        for (int s = tid; s < nk; s += 256) selb[s] = (fkey(sc[s]) > prefix) ? 1 : 0;
        __syncthreads();
        if (tid == 0) { int need = 256 - cgt; for (int s = 0; s < nk && need > 0; ++s) if (fkey(sc[s]) == prefix) { selb[s] = 1; --need; } }
        __syncthreads();
    } else {
        for (int s = tid; s < nk; s += 256) selb[s] = 1;
        __syncthreads();
    }
    float mx[4] = {-INFINITY, -INFINITY, -INFINITY, -INFINITY};
    for (int s = tid; s < nk; s += 256) {
        if (selb[s]) {
            const bf16_t* kr = kvn + ((size_t)b * S + s) * 128;
            float d0 = 0.f, d1 = 0.f, d2 = 0.f, d3 = 0.f;
            for (int d = 0; d < 128; ++d) { const float kv = bf2f(kr[d]); d0 += qs[d] * kv; d1 += qs[128 + d] * kv; d2 += qs[256 + d] * kv; d3 += qs[384 + d] * kv; }
            const int bk = rel_bucket(t - s);
            const float sc128 = 0.08838834764831845f;
            d0 = d0 * sc128 + rel_bias[bk * 8 + 4]; d1 = d1 * sc128 + rel_bias[bk * 8 + 5]; d2 = d2 * sc128 + rel_bias[bk * 8 + 6]; d3 = d3 * sc128 + rel_bias[bk * 8 + 7];
            lg[0][s] = d0; lg[1][s] = d1; lg[2][s] = d2; lg[3][s] = d3;
            mx[0] = fmaxf(mx[0], d0); mx[1] = fmaxf(mx[1], d1); mx[2] = fmaxf(mx[2], d2); mx[3] = fmaxf(mx[3], d3);
        }
    }
    float sm[4];
    for (int hh = 0; hh < 4; ++hh) {
        mx[hh] = block_max(mx[hh], red);
        float su = 0.f;
        for (int s = tid; s < nk; s += 256) if (selb[s]) { const float e = expf(lg[hh][s] - mx[hh]); lg[hh][s] = e; su += e; }
        sm[hh] = block_sum(su, red);
    }
    __syncthreads();
    {
        const int d = tid & 127, hp = tid >> 7;
        float o0 = 0.f, o1 = 0.f;
        for (int s = 0; s < nk; ++s) if (selb[s]) { const float kv = bf2f(kvn[((size_t)b * S + s) * 128 + d]); o0 += lg[hp * 2][s] * kv; o1 += lg[hp * 2 + 1][s] * kv; }
        os[hp * 2][d] = o0 / sm[hp * 2]; os[hp * 2 + 1][d] = o1 / sm[hp * 2 + 1];
    }
    __syncthreads();
    {
        const int e = tid & 127, hp = tid >> 7;
        for (int hh = hp * 2; hh < hp * 2 + 2; ++hh) {
            float acc = 0.f;
            for (int cc = 0; cc < 128; ++cc) acc += os[hh][cc] * w_uv[((size_t)hh * 128 + cc) * 128 + e];
            mixin[row * D + 512 + hh * 128 + e] = f2bf(acc);
        }
    }
}

__device__ __forceinline__ void wave_argmax(float& v, int& i) {
#pragma unroll
    for (int o = 32; o >= 1; o >>= 1) { const float ov = __shfl_xor(v, o); const int oi = __shfl_xor(i, o); if (ov > v || (ov == v && oi < i)) { v = ov; i = oi; } }
}
__global__ void __launch_bounds__(256) k_peer_select(const float* __restrict__ qf, const float* __restrict__ keys, int* __restrict__ eidx, float* __restrict__ gate) {
    __shared__ float qsh[4][128];
    __shared__ float s12[4][2][16];
    __shared__ int i12[4][2][16];
    const int wid = threadIdx.x >> 6, lane = threadIdx.x & 63;
    const int th = blockIdx.x * 4 + wid, tok = th >> 3, h = th & 7;
    qsh[wid][lane] = qf[(size_t)tok * D + h * 128 + lane]; qsh[wid][lane + 64] = qf[(size_t)tok * D + h * 128 + lane + 64];
    __syncthreads();
    for (int p = 0; p < 2; ++p) {
        float v0 = 0.f, v1 = 0.f;
        const float* k0 = keys + (((size_t)h * 2 + p) * 128 + lane) * 64, *k1 = k0 + 64 * 64;
        for (int d = 0; d < 64; ++d) { const float q = qsh[wid][p * 64 + d]; v0 += q * k0[d]; v1 += q * k1[d]; }
        for (int r = 0; r < 16; ++r) {
            float bv; int bi;
            if (v0 >= v1) { bv = v0; bi = lane; } else { bv = v1; bi = lane + 64; }
            wave_argmax(bv, bi);
            if (lane == 0) { s12[wid][p][r] = bv; i12[wid][p][r] = bi; }
            if (bi == lane) v0 = -INFINITY; if (bi == lane + 64) v1 = -INFINITY;
        }
    }
    __syncthreads();
    float cv[4];
#pragma unroll
    for (int c = 0; c < 4; ++c) { const int pos = lane + 64 * c; cv[c] = s12[wid][0][pos >> 4] + s12[wid][1][pos & 15]; }
    float topv = 0.f; int tope = 0;
    for (int r = 0; r < 16; ++r) {
        float bv = cv[0]; int bi = lane;
#pragma unroll
        for (int c = 1; c < 4; ++c) if (cv[c] > bv) { bv = cv[c]; bi = lane + 64 * c; }
        wave_argmax(bv, bi);
#pragma unroll
        for (int c = 0; c < 4; ++c) if (bi == lane + 64 * c) cv[c] = -INFINITY;
        if (lane == r) { topv = bv; tope = i12[wid][0][bi >> 4] * 128 + i12[wid][1][bi & 15]; }
    }
    const float tmax = __shfl(topv, 0);
    const float e = lane < 16 ? expf(topv - tmax) : 0.f;
    const float su = wave_sum(e);
    if (lane < 16) { eidx[(size_t)tok * 128 + h * 16 + lane] = tope; gate[(size_t)tok * 128 + h * 16 + lane] = e / su; }
}

__global__ void __launch_bounds__(256) k_peer_gather_final(const bf16_t* __restrict__ h2, const int* __restrict__ eidx, const float* __restrict__ gate,
                                                           const float* __restrict__ u_tab, const float* __restrict__ v_tab, const float* __restrict__ mod,
                                                           const float* __restrict__ g_final, float* __restrict__ xio) {
    __shared__ float xs[D];
    __shared__ float wts[128];
    __shared__ int es[128];
    __shared__ float red[8];
    const int tid = threadIdx.x, wid = tid >> 6, lane = tid & 63;
    const size_t tok = blockIdx.x; const int b = (int)(tok / S);
    for (int i = tid; i < D; i += 256) xs[i] = bf2f(h2[tok * D + i]);
    if (tid < 128) es[tid] = eidx[tok * 128 + tid];
    __syncthreads();
    for (int k = wid * 32; k < wid * 32 + 32; ++k) {
        const float4* ur = (const float4*)(u_tab + (size_t)es[k] * D);
        float dsum = 0.f;
#pragma unroll
        for (int i = 0; i < 4; ++i) { const float4 u = ur[lane + 64 * i]; const float* xx = xs + (lane + 64 * i) * 4; dsum += u.x * xx[0] + u.y * xx[1] + u.z * xx[2] + u.w * xx[3]; }
        dsum = wave_sum(dsum);
        if (lane == 0) wts[k] = gate[tok * 128 + k] * 0.5f * dsum * (1.f + erff(dsum * 0.70710678118654752f));
    }
    __syncthreads();
    float4 acc = {0.f, 0.f, 0.f, 0.f};
    for (int k = 0; k < 128; ++k) { const float4 v = *(const float4*)(v_tab + (size_t)es[k] * D + tid * 4); const float w = wts[k]; acc.x += w * v.x; acc.y += w * v.y; acc.z += w * v.z; acc.w += w * v.w; }
    const float4 x1 = *(const float4*)(xio + tok * D + tid * 4);
    const float4 gf = *(const float4*)(mod + b * 6144 + MOD_GATE_F + tid * 4);
    float4 y; y.x = x1.x + gf.x * acc.x; y.y = x1.y + gf.y * acc.y; y.z = x1.z + gf.z * acc.z; y.w = x1.w + gf.w * acc.w;
    const float ss = block_sum(y.x * y.x + y.y * y.y + y.z * y.z + y.w * y.w, red);
    const float r = rsqrtf(ss * (1.f / D) + EPS);
    const float4 g4 = *(const float4*)(g_final + tid * 4);
    float4 o; o.x = y.x * r * g4.x; o.y = y.y * r * g4.y; o.z = y.z * r * g4.z; o.w = y.w * r * g4.w;
    *(float4*)(xio + tok * D + tid * 4) = o;
}

extern "C" void kernel_launch(void* const* d_in, const int* in_sizes, int n_in, void* d_out, int out_size, void* d_ws, size_t ws_size, hipStream_t stream) {
    static int grid = 0;
    if (grid == 0) {
        if (n_in != 21 || out_size != T * D || ws_size < WS_END) { fprintf(stderr, "kernel_launch: unexpected shapes (n_in %d out %d ws %zu)\n", n_in, out_size, ws_size); grid = -1; return; }
        int dev = 0, cus = 0, per_cu = 0;
        if (hipGetDevice(&dev) != hipSuccess || hipDeviceGetAttribute(&cus, hipDeviceAttributeMultiprocessorCount, dev) != hipSuccess) { grid = -1; return; }
        if (hipFuncSetAttribute((const void*)fwd, hipFuncAttributeMaxDynamicSharedMemorySize, LDS_BYTES) != hipSuccess) { fprintf(stderr, "kernel_launch: hipFuncSetAttribute failed\n"); grid = -1; return; }
        if (hipOccupancyMaxActiveBlocksPerMultiprocessor(&per_cu, (const void*)fwd, NTHREADS, LDS_BYTES) != hipSuccess || per_cu < 1)
            fprintf(stderr, "kernel_launch: occupancy query reports %d workgroups per CU\n", per_cu);
        (void)hipGetLastError();
        grid = cus;
        if (grid != 256) fprintf(stderr, "kernel_launch: %d CUs (expected 256)\n", grid);
    }
    if (grid < 0) return;
    const float* c = (const float*)d_in[1];
    const float* w_ada = (const float*)d_in[2];
    const float* b_ada = (const float*)d_in[3];
    const float* g_subln = (const float*)d_in[10];
    const float* g_kv = (const float*)d_in[11];
    const float* w_uv = (const float*)d_in[12];
    const float* peer_keys = (const float*)d_in[16];
    const float* peer_u = (const float*)d_in[17];
    const float* peer_v = (const float*)d_in[18];
    const float* rel_bias = (const float*)d_in[19];
    const float* g_final = (const float*)d_in[20];
    float* out = (float*)d_out;
    unsigned char* ws = (unsigned char*)d_ws;
    float* mod = (float*)(ws + WS_MOD); float* lam = (float*)(ws + WS_LAM);
    bf16_t* hbuf = (bf16_t*)(ws + WS_HBUF); bf16_t* mixin = (bf16_t*)(ws + WS_MIXIN); bf16_t* kvn = (bf16_t*)(ws + WS_KVN);
    int* eidx = (int*)(ws + WS_EIDX); float* gate = (float*)(ws + WS_GATE);
    bf16_t* proj = (bf16_t*)(ws + WS_BIG); float* qf = (float*)(ws + WS_BIG);

    (void)hipMemsetAsync(ws + WS_CTL, 0, CTL_ZERO_BYTES, stream);
    Args a{};
    for (int i = 0; i < 21; ++i) a.in[i] = (const float*)d_in[i];
    a.out = out; a.ws = ws;

    k_mod<<<dim3(24, NB), 256, 0, stream>>>(c, w_ada, b_ada, mod, (const float*)d_in[6], (const float*)d_in[7], (const float*)d_in[8], (const float*)d_in[9], lam);
    a.ph_lo = 0; a.ph_hi = 3; a.li = 0;
    hipLaunchKernelGGL(fwd, dim3(grid), dim3(NTHREADS), LDS_BYTES, stream, a);
    k_kvnorm<<<T / 4, 256, 0, stream>>>(proj, g_kv, kvn);
    k_diff_naive<<<T * 4, 256, 0, stream>>>(proj, rel_bias, lam, g_subln, mixin);
    k_dsa_naive<<<T, 256, 0, stream>>>(proj, kvn, rel_bias, w_uv, mixin);
    a.ph_lo = 3; a.ph_hi = 6; a.li = 1;
    hipLaunchKernelGGL(fwd, dim3(grid), dim3(NTHREADS), LDS_BYTES, stream, a);
    k_peer_select<<<T * 8 / 4, 256, 0, stream>>>(qf, peer_keys, eidx, gate);
    k_peer_gather_final<<<T, 256, 0, stream>>>(hbuf, eidx, gate, peer_u, peer_v, mod, g_final, out);
}
```

```cpp
#include <hip/hip_runtime.h>
#include <stdint.h>
#include <stdio.h>

typedef unsigned short bf16_t;
#define LAS __attribute__((address_space(3)))
#define GAS __attribute__((address_space(1)))

constexpr int D = 1024, NB = 32, S = 2048, T = NB * S;
constexpr int NP = 2760, NPP = 2816;
constexpr int C_DQ = 0, C_DK = 512, C_DV = 1024, C_SQ = 1536, C_SKV = 2048, C_IQ = 2176, C_IK = 2688, C_IW = 2752;
constexpr int MOD_SHIFT_A = 0, MOD_SCALE_A = 1024, MOD_GATE_A = 2048, MOD_SHIFT_F = 3072, MOD_SCALE_F = 4096, MOD_GATE_F = 5120;
constexpr float EPS = 1e-6f;
constexpr int NWAVES = 8, NTHREADS = 512;

__device__ __forceinline__ float bf2f(bf16_t v) { return __uint_as_float(((unsigned)v) << 16); }
__device__ __forceinline__ bf16_t f2bf(float f) { unsigned u = __float_as_uint(f); u += 0x7fffu + ((u >> 16) & 1u); return (bf16_t)(u >> 16); }
__device__ __forceinline__ unsigned pk2(float lo, float hi) { return (unsigned)f2bf(lo) | ((unsigned)f2bf(hi) << 16); }

__device__ __forceinline__ int rel_bucket(int n) {
    if (n < 16) return n < 0 ? 0 : n;
    int b = 16;
    b += (n >= 19); b += (n >= 21); b += (n >= 24); b += (n >= 27); b += (n >= 31); b += (n >= 35); b += (n >= 40); b += (n >= 46);
    b += (n >= 52); b += (n >= 59); b += (n >= 67); b += (n >= 77); b += (n >= 87); b += (n >= 99); b += (n >= 113);
    return b;
}

__device__ __forceinline__ float wave_sum(float v) {
#pragma unroll
    for (int o = 32; o >= 1; o >>= 1) v += __shfl_xor(v, o);
    return v;
}
__device__ __forceinline__ float wave_max(float v) {
#pragma unroll
    for (int o = 32; o >= 1; o >>= 1) v = fmaxf(v, __shfl_xor(v, o));
    return v;
}
__device__ __forceinline__ float block_sum(float v, float* red) {
    v = wave_sum(v);
    __syncthreads();
    if ((threadIdx.x & 63) == 0) red[threadIdx.x >> 6] = v;
    __syncthreads();
    return red[0] + red[1] + red[2] + red[3];
}
__device__ __forceinline__ float block_max(float v, float* red) {
    v = wave_max(v);
    __syncthreads();
    if ((threadIdx.x & 63) == 0) red[threadIdx.x >> 6] = v;
    __syncthreads();
    return fmaxf(fmaxf(red[0], red[1]), fmaxf(red[2], red[3]));
}
__device__ __forceinline__ int block_sum_i(int v, int* red) {
#pragma unroll
    for (int o = 32; o >= 1; o >>= 1) v += __shfl_xor(v, o);
    __syncthreads();
    if ((threadIdx.x & 63) == 0) red[threadIdx.x >> 6] = v;
    __syncthreads();
    return red[0] + red[1] + red[2] + red[3];
}

namespace pg8 {
#define PG8_LAS __attribute__((address_space(3)))
typedef unsigned short bf16_t;
typedef short bf16x8 __attribute__((ext_vector_type(8)));
typedef float f32x4 __attribute__((ext_vector_type(4)));
typedef unsigned u32x4 __attribute__((ext_vector_type(4)));
constexpr int BM = 256, BK = 64, HALF = 128, HTB = HALF * BK * 2  , STAGE_BYTES = 8 * HTB, NXCD = 8, WGM = 8;

__host__ __device__ __forceinline__ int lds_byte(int r, int c) { const int st = (r >> 4) * 2 + (c >> 5), rr = r & 15, cc = c & 31, ob = rr * 64 + cc * 2; return st * 1024 + (ob ^ (((ob >> 9) & 1) << 5)); }
__host__ __device__ __forceinline__ void stage_rc(int b, int& R, int& C) { const int st = b / 1024, sb = b % 1024, swz = sb ^ (((sb >> 9) & 1) << 5); R = (st >> 1) * 16 + swz / 64; C = (st & 1) * 32 + (swz % 64) / 2; }
__host__ __device__ __forceinline__ int perm32(int rho) { const int n = rho >> 4, i = rho & 15; return 8 * (i >> 2) + 4 * n + (i & 3); }

struct Unit { int pm, pn; };
struct Gemm { const bf16_t* A; const bf16_t* Bt; int M, N, K; };

struct StaticOrder {
    int nM, nN, nwg, G, c;
    __host__ __device__ void init(int M, int N, int G_, int c_) { nM = M / BM; nN = N / BM; nwg = nM * nN; G = G_; c = c_; }
    __host__ __device__ bool next(int i, Unit& u) const {
        const long L = (long)i * G + c; if (L >= nwg) return false;
        int wgid = (int)L; { const int q = nwg / NXCD, r = nwg % NXCD, xcd = wgid % NXCD, off = wgid / NXCD; wgid = (xcd < r ? xcd * (q + 1) : r * (q + 1) + (xcd - r) * q) + off; }
        const int nig = WGM * nN, gid = wgid / nig, fm = gid * WGM, gsz = (nM - fm) < WGM ? (nM - fm) : WGM;
        u.pm = fm + ((wgid % nig) % gsz); u.pn = (wgid % nig) / gsz; return true;
    }
    __device__ __forceinline__ void a_ready(const Unit&) const {}
    __device__ __forceinline__ void done(const Unit&) const {}
};
__device__ __forceinline__ unsigned cvt_pk_bf16(float lo, float hi) { unsigned r; asm volatile("v_cvt_pk_bf16_f32 %0, %1, %2" : "=v"(r) : "v"(lo), "v"(hi)); return r; }
typedef float f32x2 __attribute__((ext_vector_type(2)));
struct EpiBf16Plain {
    static constexpr bool PERM = true, AFTER_DRAIN = false;
    bf16_t* O; int ldc;
    __device__ __forceinline__ void operator()(const f32x4 (&acc)[2][2][4][2], const Unit& u, int wr, int wc, int fr, int fq) const {
        const int row0 = u.pm * BM + wr * 64 + fr, col0 = u.pn * BM + wc * 32 + 8 * fq;
#pragma unroll
        for (int ai = 0; ai < 2; ++ai)
#pragma unroll
            for (int m = 0; m < 4; ++m) { bf16_t* rowp = O + (size_t)(row0 + ai * HALF + m * 16) * ldc + col0;
#pragma unroll
                for (int bj = 0; bj < 2; ++bj) { const f32x4 v0 = acc[ai][bj][m][0], v1 = acc[ai][bj][m][1];
                    u32x4 w; w.x = cvt_pk_bf16(v0[0], v0[1]); w.y = cvt_pk_bf16(v0[2], v0[3]); w.z = cvt_pk_bf16(v1[0], v1[1]); w.w = cvt_pk_bf16(v1[2], v1[3]);
                    *(u32x4*)(rowp + bj * HALF) = w; } }
    }
};
struct EpiF32Res {
    static constexpr bool PERM = false, AFTER_DRAIN = false;
    float* C; const float* res; const float* gate;
    __device__ __forceinline__ void operator()(const f32x4 (&acc)[2][2][4][2], const Unit& u, int wr, int wc, int fr, int fq) const {
        const int row0 = u.pm * BM + wr * 64 + fr, col0 = u.pn * BM + wc * 32 + 4 * fq;
        f32x4 gv[2][2];
#pragma unroll
        for (int bj = 0; bj < 2; ++bj)
#pragma unroll
            for (int n = 0; n < 2; ++n) gv[bj][n] = res ? *(const f32x4*)(gate + (size_t)(u.pm >> 3) * 6144 + col0 + bj * HALF + n * 16) : (f32x4){1.f, 1.f, 1.f, 1.f};
#pragma unroll
        for (int ai = 0; ai < 2; ++ai)
#pragma unroll
            for (int m = 0; m < 4; ++m) { const size_t off = (size_t)(row0 + ai * HALF + m * 16) * 1024 + col0;
#pragma unroll
                for (int bj = 0; bj < 2; ++bj)
#pragma unroll
                    for (int n = 0; n < 2; ++n) { f32x4 o = acc[ai][bj][m][n] * gv[bj][n];
                        if (res) o = o + *(const f32x4*)(res + off + bj * HALF + n * 16);
                        *(f32x4*)(C + off + bj * HALF + n * 16) = o; } }
    }
};

template <class Epi, class Sched, bool ALIGN_EPI = false, bool SP2 = false>
__device__ __forceinline__ void gemm_phase(PG8_LAS unsigned char* lds, const Gemm g, const Sched& S, const Epi& E) {
    const int tid = threadIdx.x, wid = __builtin_amdgcn_readfirstlane(tid >> 6), lane = tid & 63, wr = wid >> 2, wc = wid & 3, fr = lane & 15, fq = lane >> 4;
    const int K = g.K, nt = K / BK;
    unsigned voffA[2], voffB[2];
#pragma unroll
    for (int i = 0; i < 2; ++i) { int R, C; stage_rc(tid * 16 + i * 8192, R, C); const int Rb = Epi::PERM ? ((R & ~31) + perm32(R & 31)) : R;
        voffA[i] = (unsigned)(R * K + C) * 2u; voffB[i] = (unsigned)(Rb * K + C) * 2u; }
    const size_t kstep = (size_t)(BK * 2);
    const size_t hstep = (size_t)HALF * K * 2;
    const size_t tstep = 2 * hstep;
    const unsigned ldsw = (unsigned)wid * 1024u;
    const int aoff = lds_byte(wr * 64 + fr, fq * 8), boff = lds_byte(wc * 32 + fr, fq * 8);
#define PG8_SA(b, h) (((b) * 2 + (h)) * HTB)
#define PG8_SB(b, h) ((4 + (b) * 2 + (h)) * HTB)
#define PG8_STAGE(bufoff, gbase, voff) do { _Pragma("unroll") for (int _i = 0; _i < 2; ++_i) \
        __builtin_amdgcn_global_load_lds((const unsigned*)((const char*)(gbase) + (voff)[_i]), (PG8_LAS unsigned*)(lds + (bufoff) + ldsw + _i * 8192), 16, 0, 0); } while (0)
#define PG8_LDA(dst, b, h) do { _Pragma("unroll") for (int m = 0; m < 4; ++m) _Pragma("unroll") for (int k = 0; k < 2; ++k) dst[m][k] = *(const PG8_LAS bf16x8*)(lds + PG8_SA(b, h) + aoff + m * 2048 + k * 1024); } while (0)
#define PG8_LDB(dst, b, h) do { _Pragma("unroll") for (int n = 0; n < 2; ++n) _Pragma("unroll") for (int k = 0; k < 2; ++k) dst[n][k] = *(const PG8_LAS bf16x8*)(lds + PG8_SB(b, h) + boff + n * 2048 + k * 1024); } while (0)
#define PG8_MMA(ai, bj, At, Bt) do { __builtin_amdgcn_s_setprio(1); _Pragma("unroll") for (int m = 0; m < 4; ++m) _Pragma("unroll") for (int n = 0; n < 2; ++n) _Pragma("unroll") for (int k = 0; k < 2; ++k) \
        acc[ai][bj][m][n] = __builtin_amdgcn_mfma_f32_16x16x32_bf16(Bt[n][k], At[m][k], acc[ai][bj][m][n], 0, 0, 0); __builtin_amdgcn_s_setprio(0); } while (0)
#define PG8_WAIT_V(n) asm volatile("s_waitcnt vmcnt(" #n ")" ::: "memory")
#define PG8_WAIT_L(n) asm volatile("s_waitcnt lgkmcnt(" #n ")" ::: "memory")
#define PG8_BAR __builtin_amdgcn_s_barrier()
#define PG8_SCHED __builtin_amdgcn_sched_barrier(0)
    Unit cur, nxt; int ui = 0;
    if (!S.next(0, cur)) return;
    f32x4 acc[2][2][4][2];
#pragma unroll
    for (int a = 0; a < 2; ++a)
#pragma unroll
        for (int b = 0; b < 2; ++b)
#pragma unroll
            for (int m = 0; m < 4; ++m)
#pragma unroll
                for (int n = 0; n < 2; ++n) acc[a][b][m][n] = (f32x4){0.f, 0.f, 0.f, 0.f};
    bf16x8 At[4][2], B0[2][2], B1[2][2];
    const char* cA = (const char*)g.A + (size_t)cur.pm * tstep; const char* cB = (const char*)g.Bt + (size_t)cur.pn * tstep;
    S.a_ready(cur);
    if constexpr (SP2) {
        PG8_STAGE(PG8_SB(0, 0), cB, voffB); PG8_STAGE(PG8_SB(0, 1), cB + hstep, voffB); PG8_STAGE(PG8_SA(0, 0), cA, voffA); PG8_STAGE(PG8_SA(0, 1), cA + hstep, voffA);
        if (wr == 1) PG8_BAR;
        PG8_WAIT_V(2); PG8_BAR;
        PG8_STAGE(PG8_SB(1, 0), cB + kstep, voffB); PG8_STAGE(PG8_SA(1, 0), cA + kstep, voffA); PG8_STAGE(PG8_SB(1, 1), cB + hstep + kstep, voffB);
        PG8_WAIT_V(6); PG8_BAR;
    } else {
        PG8_STAGE(PG8_SB(0, 0), cB, voffB); PG8_STAGE(PG8_SA(0, 0), cA, voffA); PG8_STAGE(PG8_SB(0, 1), cB + hstep, voffB); PG8_STAGE(PG8_SA(0, 1), cA + hstep, voffA);
        if (wr == 1) PG8_BAR;
        PG8_WAIT_V(4); PG8_BAR;
        PG8_STAGE(PG8_SB(1, 0), cB + kstep, voffB); PG8_STAGE(PG8_SA(1, 0), cA + kstep, voffA); PG8_STAGE(PG8_SB(1, 1), cB + hstep + kstep, voffB);
        PG8_WAIT_V(6); PG8_BAR;
    }
    for (;;) {
        const bool has_next = S.next(ui + 1, nxt);
        const char* nA = has_next ? (const char*)g.A + (size_t)nxt.pm * tstep : cA; const char* nB = has_next ? (const char*)g.Bt + (size_t)nxt.pn * tstep : cB;
        for (int t = 0; t < nt; t += 2) {
            const bool last = (t == nt - 2);
            const char* a1 = cA + (size_t)(t + 1) * kstep;
            const char* a2 = last ? nA : cA + (size_t)(t + 2) * kstep; const char* b2 = last ? nB : cB + (size_t)(t + 2) * kstep;
            const char* a3 = a2 + kstep; const char* b3 = b2 + kstep;
            if (last && has_next) S.a_ready(nxt);
            if constexpr (SP2) {
            PG8_LDB(B0, 0, 0); PG8_LDB(B1, 0, 1); PG8_SCHED; PG8_LDA(At, 0, 0); PG8_STAGE(PG8_SA(1, 1), a1 + hstep, voffA);
            PG8_WAIT_V(8); PG8_WAIT_L(0); PG8_BAR; PG8_MMA(0, 0, At, B0); PG8_MMA(0, 1, At, B1); PG8_BAR; PG8_SCHED;
            PG8_LDA(At, 0, 1); PG8_STAGE(PG8_SB(0, 0), b2, voffB); PG8_STAGE(PG8_SB(0, 1), b2 + hstep, voffB); PG8_STAGE(PG8_SA(0, 0), a2, voffA);
            PG8_WAIT_V(8); PG8_WAIT_L(0); PG8_BAR; PG8_MMA(1, 0, At, B0); PG8_MMA(1, 1, At, B1); PG8_BAR; PG8_SCHED;
            PG8_LDB(B0, 1, 0); PG8_LDB(B1, 1, 1); PG8_SCHED; PG8_LDA(At, 1, 0); PG8_STAGE(PG8_SA(0, 1), a2 + hstep, voffA);
            PG8_WAIT_V(8); PG8_WAIT_L(0); PG8_BAR; PG8_MMA(0, 0, At, B0); PG8_MMA(0, 1, At, B1); PG8_BAR; PG8_SCHED;
            PG8_LDA(At, 1, 1); PG8_STAGE(PG8_SB(1, 0), b3, voffB); PG8_STAGE(PG8_SB(1, 1), b3 + hstep, voffB); PG8_STAGE(PG8_SA(1, 0), a3, voffA);
            PG8_WAIT_V(8); PG8_WAIT_L(0); PG8_BAR; PG8_MMA(1, 0, At, B0); PG8_MMA(1, 1, At, B1); PG8_BAR; PG8_SCHED;
            } else {
            PG8_LDB(B0, 0, 0); PG8_SCHED; PG8_LDA(At, 0, 0); PG8_STAGE(PG8_SA(1, 1), a1 + hstep, voffA);
            PG8_WAIT_L(8); PG8_BAR; PG8_WAIT_L(0); PG8_MMA(0, 0, At, B0); PG8_BAR; PG8_SCHED;
            PG8_LDB(B1, 0, 1); PG8_STAGE(PG8_SB(0, 0), b2, voffB);
            PG8_BAR; PG8_WAIT_L(0); PG8_MMA(0, 1, At, B1); PG8_BAR;
            PG8_LDA(At, 0, 1); PG8_STAGE(PG8_SA(0, 0), a2, voffA);
            PG8_BAR; PG8_WAIT_L(0); PG8_MMA(1, 0, At, B0); PG8_BAR; PG8_SCHED;
            PG8_STAGE(PG8_SB(0, 1), b2 + hstep, voffB);
            PG8_WAIT_V(6); PG8_BAR; PG8_MMA(1, 1, At, B1); PG8_BAR;
            PG8_LDB(B0, 1, 0); PG8_SCHED; PG8_LDA(At, 1, 0); PG8_STAGE(PG8_SA(0, 1), a2 + hstep, voffA);
            PG8_WAIT_L(8); PG8_BAR; PG8_WAIT_L(0); PG8_MMA(0, 0, At, B0); PG8_BAR; PG8_SCHED;
            PG8_LDB(B1, 1, 1); PG8_STAGE(PG8_SB(1, 0), b3, voffB);
            PG8_BAR; PG8_WAIT_L(0); PG8_MMA(0, 1, At, B1); PG8_BAR;
            PG8_LDA(At, 1, 1); PG8_STAGE(PG8_SA(1, 0), a3, voffA);
            PG8_BAR; PG8_WAIT_L(0); PG8_MMA(1, 0, At, B0); PG8_BAR; PG8_SCHED;
            PG8_STAGE(PG8_SB(1, 1), b3 + hstep, voffB);
            PG8_WAIT_V(6); PG8_BAR; PG8_MMA(1, 1, At, B1); PG8_BAR;
            }
        }
        if constexpr (ALIGN_EPI) { if (wr == 0) PG8_BAR; }
        if constexpr (!Epi::AFTER_DRAIN) { E(acc, cur, wr, wc, fr, fq); S.done(cur); }
        if (!has_next) break;
#pragma unroll
        for (int a = 0; a < 2; ++a)
#pragma unroll
            for (int b = 0; b < 2; ++b)
#pragma unroll
                for (int m = 0; m < 4; ++m)
#pragma unroll
                    for (int n = 0; n < 2; ++n) acc[a][b][m][n] = (f32x4){0.f, 0.f, 0.f, 0.f};
        cur = nxt; cA = nA; cB = nB; ++ui;
        if constexpr (ALIGN_EPI) { if (wr == 1) PG8_BAR; }
    }
    PG8_WAIT_V(0);
    if constexpr (!ALIGN_EPI) { if (wr == 0) PG8_BAR; }
    PG8_BAR;
    if constexpr (Epi::AFTER_DRAIN) { E.fused(acc, cur, wr, wc, fr, fq, lds, wid, lane); S.done(cur); }
#undef PG8_SA
#undef PG8_SB
#undef PG8_STAGE
#undef PG8_LDA
#undef PG8_LDB
#undef PG8_MMA
#undef PG8_WAIT_V
#undef PG8_WAIT_L
#undef PG8_BAR
#undef PG8_SCHED
}
}
#define XB_TMO      128
#define XB_XCNT(j)  (256  + 64 * (j))
#define XB_XSUB(j)  (1280 + 64 * (j))
#define XB_XGEN(j)  (2304 + 64 * (j))
#define XB_TOP      3328
#define XB_TOPGEN   3392
#define XCD_BAR_WORDS 3456
#define XB_SPIN_CAP (1u << 18)

__device__ __forceinline__ unsigned xb_ld(unsigned* p)              { return __hip_atomic_load(p, __ATOMIC_RELAXED, __HIP_MEMORY_SCOPE_AGENT); }
__device__ __forceinline__ unsigned xb_add(unsigned* p, unsigned v) { return __hip_atomic_fetch_add(p, v, __ATOMIC_RELAXED, __HIP_MEMORY_SCOPE_AGENT); }
__device__ __forceinline__ unsigned xb_xcc_id() { return (unsigned)__builtin_amdgcn_s_getreg((3 << 11) | 20) & 0xFu; }
#define XB_SPIN(cond, bar) do { unsigned _sp = 0; while (cond) { __builtin_amdgcn_s_sleep(1); \
    if ((++_sp & 255u) == 0u) { if (xb_ld(&(bar)[XB_TMO])) break; if (_sp > XB_SPIN_CAP) { atomicAdd(&(bar)[XB_TMO], 1u); break; } } } } while (0)

struct XcdBarrier {
    unsigned* bar; unsigned x;
    volatile LAS unsigned* st;
};

__device__ __forceinline__ XcdBarrier xcd_barrier_post(unsigned* bar, volatile LAS unsigned* st) {
    XcdBarrier b; b.bar = bar; b.x = xb_xcc_id(); b.st = st;
    if (threadIdx.x == 0) (void)xb_add(&bar[XB_XCNT(b.x)], 1u);
    return b;
}
__device__ __forceinline__ void xcd_barrier_complete(unsigned* bar, unsigned x, unsigned& nloc, unsigned& nx) {
    const unsigned G = gridDim.x * gridDim.y * gridDim.z;
    unsigned sum, cnt, mine, sp = 0u;
    for (;;) {
        sum = 0u; cnt = 0u; mine = 0u;
#pragma unroll
        for (unsigned j = 0; j < 16; ++j) { const unsigned c = xb_ld(&bar[XB_XCNT(j)]); sum += c; cnt += (c > 0u) ? 1u : 0u; mine = (j == x) ? c : mine; }
        if (sum == G) break;
        __builtin_amdgcn_s_sleep(1);
        if ((++sp & 255u) == 0u) { if (xb_ld(&bar[XB_TMO])) break; if (sp > XB_SPIN_CAP) { atomicAdd(&bar[XB_TMO], 1u); break; } }
    }
    nloc = mine > 0u ? mine : 1u; nx = cnt > 0u ? cnt : 1u;
}

__device__ __forceinline__ void xcd_barrier(const XcdBarrier& b) {
    asm volatile("s_waitcnt vmcnt(0)" ::: "memory");
    __syncthreads();
    if (threadIdx.x == 0) {
        unsigned* bar = b.bar;
        __builtin_amdgcn_s_waitcnt(0);
        unsigned nloc = b.st[0], nx = b.st[1];
        if (nloc == 0u) { xcd_barrier_complete(bar, b.x, nloc, nx); b.st[0] = nloc; b.st[1] = nx; }
        const unsigned old = xb_add(&bar[XB_XSUB(b.x)], 1u);
        const unsigned gen = old / nloc;
        if (old + 1u == (gen + 1u) * nloc) {
            __builtin_amdgcn_fence(__ATOMIC_RELEASE, "agent");
            asm volatile("s_waitcnt vmcnt(0)" ::: "memory");
            const unsigned og = xb_add(&bar[XB_TOP], 1u);
            const unsigned tg = og / nx;
            if (og + 1u == (tg + 1u) * nx) xb_add(&bar[XB_TOPGEN], 1u);
            else XB_SPIN(xb_ld(&bar[XB_TOPGEN]) == tg, bar);
            __builtin_amdgcn_fence(__ATOMIC_ACQUIRE, "agent");
            xb_add(&bar[XB_XGEN(b.x)], 1u);
            asm volatile("s_waitcnt vmcnt(0)" ::: "memory");
        } else {
            XB_SPIN(xb_ld(&bar[XB_XGEN(b.x)]) == gen, bar);
            __builtin_amdgcn_fence(__ATOMIC_ACQUIRE, "agent");
            asm volatile("s_waitcnt vmcnt(0)" ::: "memory");
        }
    }
    __syncthreads();
}

constexpr size_t MiB = 1u << 20;
constexpr size_t WS_CTL = 0, CTL_ZERO_BYTES = 1 * MiB;
constexpr size_t WS_MOD = 1 * MiB;
constexpr size_t WS_LAM = 1 * MiB + 800 * 1024;
constexpr size_t WS_WIN_T = 2 * MiB;
constexpr size_t WS_WO_T = 8 * MiB;
constexpr size_t WS_WQ_T = 10 * MiB;
constexpr size_t WS_HBUF = 16 * MiB;
constexpr size_t WS_MIXIN = 144 * MiB;
constexpr size_t WS_KVN = 272 * MiB;
constexpr size_t WS_EIDX = 288 * MiB;
constexpr size_t WS_GATE = 320 * MiB;
constexpr size_t WS_BIG = 352 * MiB;
constexpr size_t WS_UQ = 704 * MiB;
constexpr size_t WS_VQ = 720 * MiB;
constexpr size_t WS_SU = 736 * MiB;
constexpr size_t WS_SV = 736 * MiB + 65536;
constexpr size_t WS_XQ = 737 * MiB;
constexpr size_t WS_SX = 801 * MiB;
constexpr size_t WS_END = 802 * MiB;
constexpr int CW_BAR = 4096;
constexpr int MAX_FWD_LAUNCHES = 8;
static_assert((CW_BAR + MAX_FWD_LAUNCHES * XCD_BAR_WORDS) * 4 <= (int)CTL_ZERO_BYTES, "barrier words inside the memset region");

constexpr int RING_OFF = 0, RING_BYTES = 131072;
constexpr int LDSCTL_OFF = RING_BYTES, MISC_OFF = LDSCTL_OFF + 320;
constexpr int LDS_BYTES = 147456;

struct Args { const float* in[21]; float* out; unsigned char* ws; int ph_lo, ph_hi, li, pad; };

__device__ __forceinline__ void p0_transpose_item(const float* W, int K, int N, int Npad, bf16_t* WT, LAS float* scr, int item, int lane) {
    const int nblk = Npad / 32, kb = item / nblk, nb = item % nblk, k0 = 64 * kb, n0 = 32 * nb;
    const int n_in = n0 + (lane & 31);
#pragma unroll 8
    for (int i = 0; i < 32; ++i) { const int kk = 2 * i + (lane >> 5); scr[kk * 33 + (lane & 31)] = n_in < N ? W[(size_t)(k0 + kk) * N + n_in] : 0.f; }
    asm volatile("s_waitcnt lgkmcnt(0)" ::: "memory");
    const int c = lane & 7;
#pragma unroll
    for (int j = 0; j < 4; ++j) { const int n = (lane >> 3) + 8 * j; const LAS float* s = scr + (8 * c) * 33 + n;
        uint4 o; o.x = pk2(s[0 * 33], s[1 * 33]); o.y = pk2(s[2 * 33], s[3 * 33]); o.z = pk2(s[4 * 33], s[5 * 33]); o.w = pk2(s[6 * 33], s[7 * 33]);
        *(uint4*)(WT + (size_t)(n0 + n) * K + k0 + 8 * c) = o; }
    asm volatile("s_waitcnt lgkmcnt(0)" ::: "memory");
}

template <int OFFS> __device__ __forceinline__ void quant_row(const float4 (&v)[4], unsigned char* qrow, float* scale_out, int lane);
template <bool QUANT>
__device__ __forceinline__ void norm_mod_row(const float* xrow, const float* g, const float* mb, int shift_off, int scale_off, bf16_t* orow, int lane, unsigned char* qrow, float* qscale) {
    const float4* xr = (const float4*)xrow;
    float4 v[4]; float ss = 0.f;
#pragma unroll
    for (int i = 0; i < 4; ++i) { v[i] = xr[lane + 64 * i]; ss += v[i].x * v[i].x + v[i].y * v[i].y + v[i].z * v[i].z + v[i].w * v[i].w; }
    ss = wave_sum(ss);
    const float r = rsqrtf(ss * (1.f / D) + EPS);
#pragma unroll
    for (int i = 0; i < 4; ++i) {
        const int col = (lane + 64 * i) * 4;
        const float4 gg = *(const float4*)(g + col), sc = *(const float4*)(mb + scale_off + col), sh = *(const float4*)(mb + shift_off + col);
        v[i].x = v[i].x * r * gg.x * (1.f + sc.x) + sh.x; v[i].y = v[i].y * r * gg.y * (1.f + sc.y) + sh.y;
        v[i].z = v[i].z * r * gg.z * (1.f + sc.z) + sh.z; v[i].w = v[i].w * r * gg.w * (1.f + sc.w) + sh.w;
        uint2 o; o.x = pk2(v[i].x, v[i].y); o.y = pk2(v[i].z, v[i].w);
        *(uint2*)(orow + col) = o;
    }
    if (QUANT) quant_row<0>(v, qrow, qscale, lane);
}

template <int OFFS>
__device__ __forceinline__ void quant_row(const float4 (&v)[4], unsigned char* qrow, float* scale_out, int lane) {
    float am = 0.f;
#pragma unroll
    for (int i = 0; i < 4; ++i) am = fmaxf(am, fmaxf(fmaxf(fabsf(v[i].x), fabsf(v[i].y)), fmaxf(fabsf(v[i].z), fabsf(v[i].w))));
    am = wave_max(am);
    const float sc = am > 0.f ? am * (1.f / 127.f) : 1.f, inv = am > 0.f ? 127.f / am : 0.f;
    uint4 o; unsigned w[4];
#pragma unroll
    for (int i = 0; i < 4; ++i) {
        const int q0 = (int)rintf(v[i].x * inv) + OFFS, q1 = (int)rintf(v[i].y * inv) + OFFS, q2 = (int)rintf(v[i].z * inv) + OFFS, q3 = (int)rintf(v[i].w * inv) + OFFS;
        w[i] = (unsigned)(q0 & 255) | ((unsigned)(q1 & 255) << 8) | ((unsigned)(q2 & 255) << 16) | ((unsigned)(q3 & 255) << 24);
    }
    o.x = w[0]; o.y = w[1]; o.z = w[2]; o.w = w[3];
    *(uint4*)(qrow + 16 * lane) = o;
    if (lane == 0) *scale_out = sc;
}
__device__ __forceinline__ void quant_table_row(const float* row, unsigned char* qrow, float* scale_out, int lane, bool offs) {
    float4 v[4];
#pragma unroll
    for (int i = 0; i < 4; ++i) v[i] = ((const float4*)row)[lane + 64 * i];
    if (offs) quant_row<128>(v, qrow, scale_out, lane); else quant_row<0>(v, qrow, scale_out, lane);
}

__device__ __forceinline__ int treduce16(int (&v)[16], int lane) {
#pragma unroll
    for (int o = 8, n = 16; o >= 1; o >>= 1, n >>= 1) {
        const bool upper = (lane & o) != 0;
#pragma unroll
        for (int j = 0; j < n / 2; ++j) {
            const int keep = upper ? v[j + n / 2] : v[j];
            const int send = upper ? v[j] : v[j + n / 2];
            v[j] = keep + __shfl_xor(send, o);
        }
    }
    int t = v[0];
    t += __shfl_xor(t, 16); t += __shfl_xor(t, 32);
    return t;
}
__device__ __forceinline__ float gelu_erf(float a) { return 0.5f * a * (1.f + erff(a * 0.70710678118654752f)); }

__device__ __forceinline__ void peer_token(int tok, const unsigned char* __restrict__ xq, const float* __restrict__ sxs, const int* __restrict__ eidx, const float* __restrict__ gate,
                                           const unsigned char* __restrict__ uq, const unsigned char* __restrict__ vq, const float* __restrict__ su, const float* __restrict__ sv,
                                           const float* __restrict__ gate_f, const float* __restrict__ g_final, float* xio, int lane) {
    const uint4 x4 = *(const uint4*)(xq + (size_t)tok * 1024 + 16 * lane);
    const float sx = sxs[tok];
    const int e0 = eidx[(size_t)tok * 128 + lane], e1 = eidx[(size_t)tok * 128 + 64 + lane];
    const float g0 = gate[(size_t)tok * 128 + lane], g1 = gate[(size_t)tok * 128 + 64 + lane];
    float w0 = 0.f, w1 = 0.f;
#pragma unroll 1
    for (int batch = 0; batch < 2; ++batch) {
        const int er = batch ? e1 : e0;
        int tot = 0;
#pragma unroll 1
        for (int g = 0; g < 4; ++g) {
            uint4 rows[16]; int acc[16];
#pragma unroll
            for (int j = 0; j < 16; ++j) { const int e = __builtin_amdgcn_readlane(er, 16 * g + j); rows[j] = *(const uint4*)(uq + (size_t)e * 1024 + 16 * lane); }
#pragma unroll
            for (int j = 0; j < 16; ++j) {
                int a = __builtin_amdgcn_sdot4((int)rows[j].x, (int)x4.x, 0, false);
                a = __builtin_amdgcn_sdot4((int)rows[j].y, (int)x4.y, a, false);
                a = __builtin_amdgcn_sdot4((int)rows[j].z, (int)x4.z, a, false);
                a = __builtin_amdgcn_sdot4((int)rows[j].w, (int)x4.w, a, false);
                acc[j] = a;
            }
            const int t16 = treduce16(acc, lane);
            if ((lane >> 4) == g) tot = t16;
        }
        const float a = (float)tot * sx * su[er];
        const float w = (batch ? g1 : g0) * gelu_erf(a) * sv[er];
        if (batch) w1 = w; else w0 = w;
    }
    const float wsum = wave_sum(w0 + w1);
    float acc[16];
#pragma unroll
    for (int i = 0; i < 16; ++i) acc[i] = 0.f;
#pragma unroll 1
    for (int g = 0; g < 8; ++g) {
        const int er = g < 4 ? e0 : e1; const float wr = g < 4 ? w0 : w1;
        uint4 rows[16]; float wk[16];
#pragma unroll
        for (int j = 0; j < 16; ++j) { const int ln = 16 * (g & 3) + j; const int e = __builtin_amdgcn_readlane(er, ln); wk[j] = __int_as_float(__builtin_amdgcn_readlane(__float_as_int(wr), ln));
            rows[j] = *(const uint4*)(vq + (size_t)e * 1024 + 16 * lane); }
#pragma unroll
        for (int j = 0; j < 16; ++j) {
            const unsigned r0 = rows[j].x, r1 = rows[j].y, r2 = rows[j].z, r3 = rows[j].w; const float w = wk[j];
            acc[0] += w * (float)(r0 & 255u); acc[1] += w * (float)((r0 >> 8) & 255u); acc[2] += w * (float)((r0 >> 16) & 255u); acc[3] += w * (float)(r0 >> 24);
            acc[4] += w * (float)(r1 & 255u); acc[5] += w * (float)((r1 >> 8) & 255u); acc[6] += w * (float)((r1 >> 16) & 255u); acc[7] += w * (float)(r1 >> 24);
            acc[8] += w * (float)(r2 & 255u); acc[9] += w * (float)((r2 >> 8) & 255u); acc[10] += w * (float)((r2 >> 16) & 255u); acc[11] += w * (float)(r2 >> 24);
            acc[12] += w * (float)(r3 & 255u); acc[13] += w * (float)((r3 >> 8) & 255u); acc[14] += w * (float)((r3 >> 16) & 255u); acc[15] += w * (float)(r3 >> 24);
        }
    }
    float4 y[4]; float ss = 0.f; const float corr = 128.f * wsum;
#pragma unroll
    for (int i = 0; i < 4; ++i) {
        const int col = 256 * i + 4 * lane;
        const float4 x1 = *(const float4*)(xio + (size_t)tok * D + col), gf = *(const float4*)(gate_f + col);
        y[i].x = x1.x + gf.x * (acc[4 * i + 0] - corr); y[i].y = x1.y + gf.y * (acc[4 * i + 1] - corr);
        y[i].z = x1.z + gf.z * (acc[4 * i + 2] - corr); y[i].w = x1.w + gf.w * (acc[4 * i + 3] - corr);
        ss += y[i].x * y[i].x + y[i].y * y[i].y + y[i].z * y[i].z + y[i].w * y[i].w;
    }
    ss = wave_sum(ss);
    const float r = rsqrtf(ss * (1.f / D) + EPS);
#pragma unroll
    for (int i = 0; i < 4; ++i) {
        const int col = 256 * i + 4 * lane; const float4 gg = *(const float4*)(g_final + col);
        float4 o; o.x = y[i].x * r * gg.x; o.y = y[i].y * r * gg.y; o.z = y[i].z * r * gg.z; o.w = y[i].w * r * gg.w;
        *(float4*)(xio + (size_t)tok * D + col) = o;
    }
}

__global__ void __launch_bounds__(NTHREADS, 2) fwd(Args args) {
    extern __shared__ __attribute__((aligned(16))) unsigned char lds_raw[];
    LAS unsigned char* lds = (LAS unsigned char*)lds_raw;
    volatile LAS unsigned* MISC = (volatile LAS unsigned*)(lds + MISC_OFF);
    const int tid = threadIdx.x, lane = tid & 63, wave = __builtin_amdgcn_readfirstlane(tid >> 6);
    const int G = gridDim.x;
    unsigned char* ws = args.ws;
    unsigned* ctl = (unsigned*)(ws + WS_CTL);
    for (int u = tid; u < (LDS_BYTES - LDSCTL_OFF) / 4; u += NTHREADS) ((LAS unsigned*)(lds + LDSCTL_OFF))[u] = 0u;
    __syncthreads();
    XcdBarrier bar = xcd_barrier_post(ctl + CW_BAR + args.li * XCD_BAR_WORDS, MISC + 8);
    const int lo = args.ph_lo, hi = args.ph_hi;
#define IN(k) (lo <= (k) && (k) < hi)
#define BOTH(k) (IN(k) && IN((k) + 1))
    const float* x = args.in[0];
    const float* g_norm_mix = args.in[4];
    const float* w_in = args.in[5];
    const float* w_out = args.in[13];
    const float* g_norm_ffn = args.in[14];
    const float* w_peer_q = args.in[15];
    float* out = args.out;
    const float* mod = (const float*)(ws + WS_MOD);
    bf16_t* Win_t = (bf16_t*)(ws + WS_WIN_T); bf16_t* Wo_t = (bf16_t*)(ws + WS_WO_T); bf16_t* Wq_t = (bf16_t*)(ws + WS_WQ_T);
    bf16_t* hbuf = (bf16_t*)(ws + WS_HBUF); bf16_t* mixin = (bf16_t*)(ws + WS_MIXIN);
    bf16_t* proj = (bf16_t*)(ws + WS_BIG); float* qf = (float*)(ws + WS_BIG);
    unsigned char* uq = ws + WS_UQ; unsigned char* vq = ws + WS_VQ; float* su = (float*)(ws + WS_SU); float* sv = (float*)(ws + WS_SV);
    unsigned char* xq = ws + WS_XQ; float* sxs = (float*)(ws + WS_SX);
    const int gw = blockIdx.x * NWAVES + wave, NGW = G * NWAVES;

    if (IN(0)) {
        LAS float* scr = (LAS float*)(lds + RING_OFF + wave * 16384);
        constexpr int I_IN = 16 * (NPP / 32), I_O = 16 * 32, I_Q = 16 * 32;
        for (int it = gw; it < I_IN + I_O + I_Q; it += NGW) {
            int r = it;
            if (r < I_IN) { p0_transpose_item(w_in, D, NP, NPP, Win_t, scr, r, lane); continue; } r -= I_IN;
            if (r < I_O) { p0_transpose_item(w_out, D, D, D, Wo_t, scr, r, lane); continue; } r -= I_O;
            p0_transpose_item(w_peer_q, D, D, D, Wq_t, scr, r, lane);
        }
        for (int r = gw; r < 2 * 16384; r += NGW) {
            if (r < 16384) quant_table_row(args.in[17] + (size_t)r * D, uq + (size_t)r * 1024, su + r, lane, false);
            else quant_table_row(args.in[18] + (size_t)(r - 16384) * D, vq + (size_t)(r - 16384) * 1024, sv + (r - 16384), lane, true);
        }
        if (BOTH(0)) xcd_barrier(bar);
    }
    if (IN(1)) {
        for (int m = gw; m < T; m += NGW) norm_mod_row<false>(x + (size_t)m * D, g_norm_mix, mod + (size_t)(m / S) * 6144, MOD_SHIFT_A, MOD_SCALE_A, hbuf + (size_t)m * D, lane, nullptr, nullptr);
        if (BOTH(1)) xcd_barrier(bar);
    }
    if (IN(2)) {
        pg8::Gemm g{hbuf, Win_t, T, NPP, D}; pg8::StaticOrder So; So.init(T, NPP, G, (int)blockIdx.x);
        pg8::EpiBf16Plain E{proj, NPP};
        pg8::gemm_phase<pg8::EpiBf16Plain, pg8::StaticOrder, true, true>(lds + RING_OFF, g, So, E);
        if (BOTH(2)) xcd_barrier(bar);
    }
    if (IN(3)) {
        pg8::Gemm g{mixin, Wo_t, T, D, D}; pg8::StaticOrder So; So.init(T, D, G, (int)blockIdx.x);
        pg8::EpiF32Res E{out, x, mod + MOD_GATE_A};
        pg8::gemm_phase<pg8::EpiF32Res, pg8::StaticOrder, true, true>(lds + RING_OFF, g, So, E);
        if (BOTH(3)) xcd_barrier(bar);
    }
    if (IN(4)) {
        for (int m = gw; m < T; m += NGW) norm_mod_row<true>(out + (size_t)m * D, g_norm_ffn, mod + (size_t)(m / S) * 6144, MOD_SHIFT_F, MOD_SCALE_F, hbuf + (size_t)m * D, lane, xq + (size_t)m * 1024, sxs + m);
        if (BOTH(4)) xcd_barrier(bar);
    }
    if (IN(5)) {
        pg8::Gemm g{hbuf, Wq_t, T, D, D}; pg8::StaticOrder So; So.init(T, D, G, (int)blockIdx.x);
        pg8::EpiF32Res E{qf, nullptr, nullptr};
        pg8::gemm_phase<pg8::EpiF32Res, pg8::StaticOrder, true, true>(lds + RING_OFF, g, So, E);
        if (BOTH(5)) xcd_barrier(bar);
    }
    if (IN(6)) {
        const int* eidx = (const int*)(ws + WS_EIDX); const float* gate = (const float*)(ws + WS_GATE);
        for (int tok = gw; tok < T; tok += NGW)
            peer_token(tok, xq, sxs, eidx, gate, uq, vq, su, sv, mod + (size_t)(tok / S) * 6144 + MOD_GATE_F, args.in[20], out, lane);
    }
#undef IN
#undef BOTH
}
__global__ void __launch_bounds__(256) k_mod(const float* __restrict__ c, const float* __restrict__ w_ada, const float* __restrict__ b_ada, float* __restrict__ mod,
                                             const float* lq1, const float* lk1, const float* lq2, const float* lk2, float* lam_out) {
    const int j = blockIdx.x * 256 + threadIdx.x, b = blockIdx.y;
    float acc = 0.f;
    for (int k = 0; k < D; ++k) { const float cv = c[b * D + k]; const float s = cv / (1.f + expf(-cv)); acc += s * w_ada[(size_t)k * 6144 + j]; }
    mod[b * 6144 + j] = acc + b_ada[j];
    if (blockIdx.x == 0 && blockIdx.y == 0 && threadIdx.x == 0) {
        float s1 = 0.f, s2 = 0.f;
        for (int i = 0; i < 64; ++i) { s1 += lq1[i] * lk1[i]; s2 += lq2[i] * lk2[i]; }
        lam_out[0] = expf(s1) - expf(s2) + 0.2f;
    }
}

__global__ void __launch_bounds__(256) k_kvnorm(const bf16_t* __restrict__ proj, const float* __restrict__ g_kv, bf16_t* __restrict__ kvn) {
    const int row = blockIdx.x * 4 + (threadIdx.x >> 6), lane = threadIdx.x & 63;
    const bf16_t* p = proj + (size_t)row * NPP + C_SKV;
    const float a = bf2f(p[lane]), b = bf2f(p[lane + 64]);
    const float ss = wave_sum(a * a + b * b);
    const float r = rsqrtf(ss * (1.f / 128.f) + EPS);
    kvn[(size_t)row * 128 + lane] = f2bf(a * r * g_kv[lane]);
    kvn[(size_t)row * 128 + lane + 64] = f2bf(b * r * g_kv[lane + 64]);
}

__global__ void __launch_bounds__(256) k_diff_naive(const bf16_t* __restrict__ proj, const float* __restrict__ rel_bias, const float* __restrict__ lam_p,
                                                    const float* __restrict__ g_subln, bf16_t* __restrict__ mixin) {
    __shared__ float l1[S], l2[S];
    __shared__ float qs[128];
    __shared__ float red[8];
    __shared__ float osum[256];
    const int tid = threadIdx.x;
    const int t = blockIdx.x % S, bh = blockIdx.x / S, h = bh & 3, b = bh >> 2;
    const size_t row = (size_t)b * S + t;
    if (tid < 128) qs[tid] = bf2f(proj[row * NPP + C_DQ + h * 128 + tid]);
    __syncthreads();
    float m1 = -INFINITY, m2 = -INFINITY;
    for (int s = tid; s <= t; s += 256) {
        const bf16_t* kr = proj + ((size_t)b * S + s) * NPP + C_DK + h * 128;
        float d1 = 0.f, d2 = 0.f;
        for (int d = 0; d < 64; ++d) { d1 += qs[d] * bf2f(kr[d]); d2 += qs[64 + d] * bf2f(kr[64 + d]); }
        const float bias = rel_bias[rel_bucket(t - s) * 8 + h];
        d1 = d1 * 0.125f + bias; d2 = d2 * 0.125f + bias;
        l1[s] = d1; l2[s] = d2; m1 = fmaxf(m1, d1); m2 = fmaxf(m2, d2);
    }
    m1 = block_max(m1, red); m2 = block_max(m2, red);
    float s1 = 0.f, s2 = 0.f;
    for (int s = tid; s <= t; s += 256) { const float e1 = expf(l1[s] - m1), e2 = expf(l2[s] - m2); l1[s] = e1; l2[s] = e2; s1 += e1; s2 += e2; }
    s1 = block_sum(s1, red); s2 = block_sum(s2, red);
    const float lam = lam_p[0];
    const float i1 = 1.f / s1, i2 = lam / s2;
    for (int s = tid; s <= t; s += 256) l1[s] = l1[s] * i1 - l2[s] * i2;
    __syncthreads();
    const int d = tid & 127, half = tid >> 7;
    float acc = 0.f;
    for (int s = half; s <= t; s += 2) acc += l1[s] * bf2f(proj[((size_t)b * S + s) * NPP + C_DV + h * 128 + d]);
    osum[tid] = acc;
    __syncthreads();
    float o = 0.f;
    if (tid < 128) o = osum[tid] + osum[tid + 128];
    const float ss = block_sum(tid < 128 ? o * o : 0.f, red);
    if (tid < 128) mixin[row * D + h * 128 + tid] = f2bf(o * rsqrtf(ss * (1.f / 128.f) + EPS) * g_subln[tid] * 0.8f);
}

__device__ __forceinline__ unsigned fkey(float f) { f = f + 0.0f; unsigned u = __float_as_uint(f); return (u & 0x80000000u) ? ~u : (u | 0x80000000u); }

__global__ void __launch_bounds__(256) k_dsa_naive(const bf16_t* __restrict__ proj, const bf16_t* __restrict__ kvn, const float* __restrict__ rel_bias,
                                                   const float* __restrict__ w_uv, bf16_t* __restrict__ mixin) {
    __shared__ float sc[S];
    __shared__ unsigned char selb[S];
    __shared__ float lg[4][S];
    __shared__ float iqs[512];
    __shared__ float iws[8];
    __shared__ float qs[512];
    __shared__ float red[8];
    __shared__ int redi[8];
    __shared__ float os[4][128];
    const int tid = threadIdx.x;
    const int t = blockIdx.x % S, b = blockIdx.x / S;
    const size_t row = (size_t)b * S + t;
    const bf16_t* pr = proj + row * NPP;
    iqs[tid] = bf2f(pr[C_IQ + tid]); iqs[tid + 256] = bf2f(pr[C_IQ + tid + 256]);
    qs[tid] = bf2f(pr[C_SQ + tid]); qs[tid + 256] = bf2f(pr[C_SQ + tid + 256]);
    if (tid < 8) iws[tid] = bf2f(pr[C_IW + tid]) * 0.35355339059327373f;
    __syncthreads();
    for (int s = tid; s <= t; s += 256) {
        const bf16_t* ik = proj + ((size_t)b * S + s) * NPP + C_IK;
        float ikf[64];
#pragma unroll
        for (int d = 0; d < 64; ++d) ikf[d] = bf2f(ik[d]);
        float score = 0.f;
        for (int hh = 0; hh < 8; ++hh) { float dd = 0.f;
#pragma unroll
            for (int d = 0; d < 64; ++d) dd += iqs[hh * 64 + d] * ikf[d];
            score += iws[hh] * fmaxf(dd * 0.125f, 0.f); }
        sc[s] = score;
    }
    __syncthreads();
    const int nk = t + 1;
    if (nk > 256) {
        unsigned prefix = 0u;
        for (int bit = 31; bit >= 0; --bit) {
            const unsigned cand = prefix | (1u << bit);
            int cnt = 0;
            for (int s = tid; s < nk; s += 256) cnt += (fkey(sc[s]) >= cand) ? 1 : 0;
            cnt = block_sum_i(cnt, redi);
            if (cnt >= 256) prefix = cand;
        }
        int cgt = 0;
        for (int s = tid; s < nk; s += 256) cgt += (fkey(sc[s]) > prefix) ? 1 : 0;
        cgt = block_sum_i(cgt, redi);
        for (int s = tid; s < nk; s += 256) selb[s] = (fkey(sc[s]) > prefix) ? 1 : 0;
        __syncthreads();
        if (tid == 0) { int need = 256 - cgt; for (int s = 0; s < nk && need > 0; ++s) if (fkey(sc[s]) == prefix) { selb[s] = 1; --need; } }
        __syncthreads();
    } else {
        for (int s = tid; s < nk; s += 256) selb[s] = 1;
        __syncthreads();
    }
    float mx[4] = {-INFINITY, -INFINITY, -INFINITY, -INFINITY};
    for (int s = tid; s < nk; s += 256) {
        if (selb[s]) {
            const bf16_t* kr = kvn + ((size_t)b * S + s) * 128;
            float d0 = 0.f, d1 = 0.f, d2 = 0.f, d3 = 0.f;
            for (int d = 0; d < 128; ++d) { const float kv = bf2f(kr[d]); d0 += qs[d] * kv; d1 += qs[128 + d] * kv; d2 += qs[256 + d] * kv; d3 += qs[384 + d] * kv; }
            const int bk = rel_bucket(t - s);
            const float sc128 = 0.08838834764831845f;
            d0 = d0 * sc128 + rel_bias[bk * 8 + 4]; d1 = d1 * sc128 + rel_bias[bk * 8 + 5]; d2 = d2 * sc128 + rel_bias[bk * 8 + 6]; d3 = d3 * sc128 + rel_bias[bk * 8 + 7];
            lg[0][s] = d0; lg[1][s] = d1; lg[2][s] = d2; lg[3][s] = d3;
            mx[0] = fmaxf(mx[0], d0); mx[1] = fmaxf(mx[1], d1); mx[2] = fmaxf(mx[2], d2); mx[3] = fmaxf(mx[3], d3);
        }
    }
    float sm[4];
    for (int hh = 0; hh < 4; ++hh) {
        mx[hh] = block_max(mx[hh], red);
        float su = 0.f;
        for (int s = tid; s < nk; s += 256) if (selb[s]) { const float e = expf(lg[hh][s] - mx[hh]); lg[hh][s] = e; su += e; }
        sm[hh] = block_sum(su, red);
    }
    __syncthreads();
    {
        const int d = tid & 127, hp = tid >> 7;
        float o0 = 0.f, o1 = 0.f;
        for (int s = 0; s < nk; ++s) if (selb[s]) { const float kv = bf2f(kvn[((size_t)b * S + s) * 128 + d]); o0 += lg[hp * 2][s] * kv; o1 += lg[hp * 2 + 1][s] * kv; }
        os[hp * 2][d] = o0 / sm[hp * 2]; os[hp * 2 + 1][d] = o1 / sm[hp * 2 + 1];
    }
    __syncthreads();
    {
        const int e = tid & 127, hp = tid >> 7;
        for (int hh = hp * 2; hh < hp * 2 + 2; ++hh) {
            float acc = 0.f;
            for (int cc = 0; cc < 128; ++cc) acc += os[hh][cc] * w_uv[((size_t)hh * 128 + cc) * 128 + e];
            mixin[row * D + 512 + hh * 128 + e] = f2bf(acc);
        }
    }
}

__device__ __forceinline__ void wave_argmax(float& v, int& i) {
#pragma unroll
    for (int o = 32; o >= 1; o >>= 1) { const float ov = __shfl_xor(v, o); const int oi = __shfl_xor(i, o); if (ov > v || (ov == v && oi < i)) { v = ov; i = oi; } }
}
__global__ void __launch_bounds__(256) k_peer_select(const float* __restrict__ qf, const float* __restrict__ keys, int* __restrict__ eidx, float* __restrict__ gate) {
    __shared__ float qsh[4][128];
    __shared__ float s12[4][2][16];
    __shared__ int i12[4][2][16];
    const int wid = threadIdx.x >> 6, lane = threadIdx.x & 63;
    const int th = blockIdx.x * 4 + wid, tok = th >> 3, h = th & 7;
    qsh[wid][lane] = qf[(size_t)tok * D + h * 128 + lane]; qsh[wid][lane + 64] = qf[(size_t)tok * D + h * 128 + lane + 64];
    __syncthreads();
    for (int p = 0; p < 2; ++p) {
        float v0 = 0.f, v1 = 0.f;
        const float* k0 = keys + (((size_t)h * 2 + p) * 128 + lane) * 64, *k1 = k0 + 64 * 64;
        for (int d = 0; d < 64; ++d) { const float q = qsh[wid][p * 64 + d]; v0 += q * k0[d]; v1 += q * k1[d]; }
        for (int r = 0; r < 16; ++r) {
            float bv; int bi;
            if (v0 >= v1) { bv = v0; bi = lane; } else { bv = v1; bi = lane + 64; }
            wave_argmax(bv, bi);
            if (lane == 0) { s12[wid][p][r] = bv; i12[wid][p][r] = bi; }
            if (bi == lane) v0 = -INFINITY; if (bi == lane + 64) v1 = -INFINITY;
        }
    }
    __syncthreads();
    float cv[4];
#pragma unroll
    for (int c = 0; c < 4; ++c) { const int pos = lane + 64 * c; cv[c] = s12[wid][0][pos >> 4] + s12[wid][1][pos & 15]; }
    float topv = 0.f; int tope = 0;
    for (int r = 0; r < 16; ++r) {
        float bv = cv[0]; int bi = lane;
#pragma unroll
        for (int c = 1; c < 4; ++c) if (cv[c] > bv) { bv = cv[c]; bi = lane + 64 * c; }
        wave_argmax(bv, bi);
#pragma unroll
        for (int c = 0; c < 4; ++c) if (bi == lane + 64 * c) cv[c] = -INFINITY;
        if (lane == r) { topv = bv; tope = i12[wid][0][bi >> 4] * 128 + i12[wid][1][bi & 15]; }
    }
    const float tmax = __shfl(topv, 0);
    const float e = lane < 16 ? expf(topv - tmax) : 0.f;
    const float su = wave_sum(e);
    if (lane < 16) { eidx[(size_t)tok * 128 + h * 16 + lane] = tope; gate[(size_t)tok * 128 + h * 16 + lane] = e / su; }
}

__global__ void __launch_bounds__(256) k_peer_gather_final(const bf16_t* __restrict__ h2, const int* __restrict__ eidx, const float* __restrict__ gate,
                                                           const float* __restrict__ u_tab, const float* __restrict__ v_tab, const float* __restrict__ mod,
                                                           const float* __restrict__ g_final, float* __restrict__ xio) {
    __shared__ float xs[D];
    __shared__ float wts[128];
    __shared__ int es[128];
    __shared__ float red[8];
    const int tid = threadIdx.x, wid = tid >> 6, lane = tid & 63;
    const size_t tok = blockIdx.x; const int b = (int)(tok / S);
    for (int i = tid; i < D; i += 256) xs[i] = bf2f(h2[tok * D + i]);
    if (tid < 128) es[tid] = eidx[tok * 128 + tid];
    __syncthreads();
    for (int k = wid * 32; k < wid * 32 + 32; ++k) {
        const float4* ur = (const float4*)(u_tab + (size_t)es[k] * D);
        float dsum = 0.f;
#pragma unroll
        for (int i = 0; i < 4; ++i) { const float4 u = ur[lane + 64 * i]; const float* xx = xs + (lane + 64 * i) * 4; dsum += u.x * xx[0] + u.y * xx[1] + u.z * xx[2] + u.w * xx[3]; }
        dsum = wave_sum(dsum);
        if (lane == 0) wts[k] = gate[tok * 128 + k] * 0.5f * dsum * (1.f + erff(dsum * 0.70710678118654752f));
    }
    __syncthreads();
    float4 acc = {0.f, 0.f, 0.f, 0.f};
    for (int k = 0; k < 128; ++k) { const float4 v = *(const float4*)(v_tab + (size_t)es[k] * D + tid * 4); const float w = wts[k]; acc.x += w * v.x; acc.y += w * v.y; acc.z += w * v.z; acc.w += w * v.w; }
    const float4 x1 = *(const float4*)(xio + tok * D + tid * 4);
    const float4 gf = *(const float4*)(mod + b * 6144 + MOD_GATE_F + tid * 4);
    float4 y; y.x = x1.x + gf.x * acc.x; y.y = x1.y + gf.y * acc.y; y.z = x1.z + gf.z * acc.z; y.w = x1.w + gf.w * acc.w;
    const float ss = block_sum(y.x * y.x + y.y * y.y + y.z * y.z + y.w * y.w, red);
    const float r = rsqrtf(ss * (1.f / D) + EPS);
    const float4 g4 = *(const float4*)(g_final + tid * 4);
    float4 o; o.x = y.x * r * g4.x; o.y = y.y * r * g4.y; o.z = y.z * r * g4.z; o.w = y.w * r * g4.w;
    *(float4*)(xio + tok * D + tid * 4) = o;
}

extern "C" void kernel_launch(void* const* d_in, const int* in_sizes, int n_in, void* d_out, int out_size, void* d_ws, size_t ws_size, hipStream_t stream) {
    static int grid = 0;
    if (grid == 0) {
        if (n_in != 21 || out_size != T * D || ws_size < WS_END) { fprintf(stderr, "kernel_launch: unexpected shapes (n_in %d out %d ws %zu)\n", n_in, out_size, ws_size); grid = -1; return; }
        int dev = 0, cus = 0, per_cu = 0;
        if (hipGetDevice(&dev) != hipSuccess || hipDeviceGetAttribute(&cus, hipDeviceAttributeMultiprocessorCount, dev) != hipSuccess) { grid = -1; return; }
        if (hipFuncSetAttribute((const void*)fwd, hipFuncAttributeMaxDynamicSharedMemorySize, LDS_BYTES) != hipSuccess) { fprintf(stderr, "kernel_launch: hipFuncSetAttribute failed\n"); grid = -1; return; }
        if (hipOccupancyMaxActiveBlocksPerMultiprocessor(&per_cu, (const void*)fwd, NTHREADS, LDS_BYTES) != hipSuccess || per_cu < 1)
            fprintf(stderr, "kernel_launch: occupancy query reports %d workgroups per CU\n", per_cu);
        (void)hipGetLastError();
        grid = cus;
        if (grid != 256) fprintf(stderr, "kernel_launch: %d CUs (expected 256)\n", grid);
    }
    if (grid < 0) return;
    const float* c = (const float*)d_in[1];
    const float* w_ada = (const float*)d_in[2];
    const float* b_ada = (const float*)d_in[3];
    const float* g_subln = (const float*)d_in[10];
    const float* g_kv = (const float*)d_in[11];
    const float* w_uv = (const float*)d_in[12];
    const float* peer_keys = (const float*)d_in[16];
    const float* peer_u = (const float*)d_in[17];
    const float* peer_v = (const float*)d_in[18];
    const float* rel_bias = (const float*)d_in[19];
    const float* g_final = (const float*)d_in[20];
    float* out = (float*)d_out;
    unsigned char* ws = (unsigned char*)d_ws;
    float* mod = (float*)(ws + WS_MOD); float* lam = (float*)(ws + WS_LAM);
    bf16_t* hbuf = (bf16_t*)(ws + WS_HBUF); bf16_t* mixin = (bf16_t*)(ws + WS_MIXIN); bf16_t* kvn = (bf16_t*)(ws + WS_KVN);
    int* eidx = (int*)(ws + WS_EIDX); float* gate = (float*)(ws + WS_GATE);
    bf16_t* proj = (bf16_t*)(ws + WS_BIG); float* qf = (float*)(ws + WS_BIG);

    (void)hipMemsetAsync(ws + WS_CTL, 0, CTL_ZERO_BYTES, stream);
    Args a{};
    for (int i = 0; i < 21; ++i) a.in[i] = (const float*)d_in[i];
    a.out = out; a.ws = ws;

    k_mod<<<dim3(24, NB), 256, 0, stream>>>(c, w_ada, b_ada, mod, (const float*)d_in[6], (const float*)d_in[7], (const float*)d_in[8], (const float*)d_in[9], lam);
    a.ph_lo = 0; a.ph_hi = 3; a.li = 0;
    hipLaunchKernelGGL(fwd, dim3(grid), dim3(NTHREADS), LDS_BYTES, stream, a);
    k_kvnorm<<<T / 4, 256, 0, stream>>>(proj, g_kv, kvn);
    k_diff_naive<<<T * 4, 256, 0, stream>>>(proj, rel_bias, lam, g_subln, mixin);
    k_dsa_naive<<<T, 256, 0, stream>>>(proj, kvn, rel_bias, w_uv, mixin);
    a.ph_lo = 3; a.ph_hi = 6; a.li = 1;
    hipLaunchKernelGGL(fwd, dim3(grid), dim3(NTHREADS), LDS_BYTES, stream, a);
    k_peer_select<<<T * 8 / 4, 256, 0, stream>>>(qf, peer_keys, eidx, gate);
    a.ph_lo = 6; a.ph_hi = 7; a.li = 2;
    hipLaunchKernelGGL(fwd, dim3(grid), dim3(NTHREADS), LDS_BYTES, stream, a);
}
```

```cpp
#include <hip/hip_runtime.h>
#include <stdint.h>
#include <stdio.h>

typedef unsigned short bf16_t;
#define LAS __attribute__((address_space(3)))
#define GAS __attribute__((address_space(1)))

constexpr int D = 1024, NB = 32, S = 2048, T = NB * S;
constexpr int NP = 2760, NPP = 2816;
constexpr int C_DQ = 0, C_DK = 512, C_DV = 1024, C_SQ = 1536, C_SKV = 2048, C_IQ = 2176, C_IK = 2688, C_IW = 2752;
constexpr int MOD_SHIFT_A = 0, MOD_SCALE_A = 1024, MOD_GATE_A = 2048, MOD_SHIFT_F = 3072, MOD_SCALE_F = 4096, MOD_GATE_F = 5120;
constexpr float EPS = 1e-6f;
constexpr int NWAVES = 8, NTHREADS = 512;

__device__ __forceinline__ float bf2f(bf16_t v) { return __uint_as_float(((unsigned)v) << 16); }
__device__ __forceinline__ bf16_t f2bf(float f) { unsigned u = __float_as_uint(f); u += 0x7fffu + ((u >> 16) & 1u); return (bf16_t)(u >> 16); }
__device__ __forceinline__ unsigned pk2(float lo, float hi) { return (unsigned)f2bf(lo) | ((unsigned)f2bf(hi) << 16); }

__device__ __forceinline__ int rel_bucket(int n) {
    if (n < 16) return n < 0 ? 0 : n;
    int b = 16;
    b += (n >= 19); b += (n >= 21); b += (n >= 24); b += (n >= 27); b += (n >= 31); b += (n >= 35); b += (n >= 40); b += (n >= 46);
    b += (n >= 52); b += (n >= 59); b += (n >= 67); b += (n >= 77); b += (n >= 87); b += (n >= 99); b += (n >= 113);
    return b;
}

__device__ __forceinline__ float wave_sum(float v) {
#pragma unroll
    for (int o = 32; o >= 1; o >>= 1) v += __shfl_xor(v, o);
    return v;
}
__device__ __forceinline__ float wave_max(float v) {
#pragma unroll
    for (int o = 32; o >= 1; o >>= 1) v = fmaxf(v, __shfl_xor(v, o));
    return v;
}
__device__ __forceinline__ float block_sum(float v, float* red) {
    v = wave_sum(v);
    __syncthreads();
    if ((threadIdx.x & 63) == 0) red[threadIdx.x >> 6] = v;
    __syncthreads();
    return red[0] + red[1] + red[2] + red[3];
}
__device__ __forceinline__ float block_max(float v, float* red) {
    v = wave_max(v);
    __syncthreads();
    if ((threadIdx.x & 63) == 0) red[threadIdx.x >> 6] = v;
    __syncthreads();
    return fmaxf(fmaxf(red[0], red[1]), fmaxf(red[2], red[3]));
}
__device__ __forceinline__ int block_sum_i(int v, int* red) {
#pragma unroll
    for (int o = 32; o >= 1; o >>= 1) v += __shfl_xor(v, o);
    __syncthreads();
    if ((threadIdx.x & 63) == 0) red[threadIdx.x >> 6] = v;
    __syncthreads();
    return red[0] + red[1] + red[2] + red[3];
}

namespace pg8 {
#define PG8_LAS __attribute__((address_space(3)))
typedef unsigned short bf16_t;
typedef short bf16x8 __attribute__((ext_vector_type(8)));
typedef float f32x4 __attribute__((ext_vector_type(4)));
typedef unsigned u32x4 __attribute__((ext_vector_type(4)));
constexpr int BM = 256, BK = 64, HALF = 128, HTB = HALF * BK * 2  , STAGE_BYTES = 8 * HTB, NXCD = 8, WGM = 8;

__host__ __device__ __forceinline__ int lds_byte(int r, int c) { const int st = (r >> 4) * 2 + (c >> 5), rr = r & 15, cc = c & 31, ob = rr * 64 + cc * 2; return st * 1024 + (ob ^ (((ob >> 9) & 1) << 5)); }
__host__ __device__ __forceinline__ void stage_rc(int b, int& R, int& C) { const int st = b / 1024, sb = b % 1024, swz = sb ^ (((sb >> 9) & 1) << 5); R = (st >> 1) * 16 + swz / 64; C = (st & 1) * 32 + (swz % 64) / 2; }
__host__ __device__ __forceinline__ int perm32(int rho) { const int n = rho >> 4, i = rho & 15; return 8 * (i >> 2) + 4 * n + (i & 3); }

struct Unit { int pm, pn; };
struct Gemm { const bf16_t* A; const bf16_t* Bt; int M, N, K; };

struct StaticOrder {
    int nM, nN, nwg, G, c;
    __host__ __device__ void init(int M, int N, int G_, int c_) { nM = M / BM; nN = N / BM; nwg = nM * nN; G = G_; c = c_; }
    __host__ __device__ bool next(int i, Unit& u) const {
        const long L = (long)i * G + c; if (L >= nwg) return false;
        int wgid = (int)L; { const int q = nwg / NXCD, r = nwg % NXCD, xcd = wgid % NXCD, off = wgid / NXCD; wgid = (xcd < r ? xcd * (q + 1) : r * (q + 1) + (xcd - r) * q) + off; }
        const int nig = WGM * nN, gid = wgid / nig, fm = gid * WGM, gsz = (nM - fm) < WGM ? (nM - fm) : WGM;
        u.pm = fm + ((wgid % nig) % gsz); u.pn = (wgid % nig) / gsz; return true;
    }
    __device__ __forceinline__ void a_ready(const Unit&) const {}
    __device__ __forceinline__ void done(const Unit&) const {}
};
__device__ __forceinline__ unsigned cvt_pk_bf16(float lo, float hi) { unsigned r; asm volatile("v_cvt_pk_bf16_f32 %0, %1, %2" : "=v"(r) : "v"(lo), "v"(hi)); return r; }
typedef float f32x2 __attribute__((ext_vector_type(2)));
struct EpiBf16Plain {
    static constexpr bool PERM = true, AFTER_DRAIN = false;
    bf16_t* O; int ldc;
    __device__ __forceinline__ void operator()(const f32x4 (&acc)[2][2][4][2], const Unit& u, int wr, int wc, int fr, int fq) const {
        const int row0 = u.pm * BM + wr * 64 + fr, col0 = u.pn * BM + wc * 32 + 8 * fq;
#pragma unroll
        for (int ai = 0; ai < 2; ++ai)
#pragma unroll
            for (int m = 0; m < 4; ++m) { bf16_t* rowp = O + (size_t)(row0 + ai * HALF + m * 16) * ldc + col0;
#pragma unroll
                for (int bj = 0; bj < 2; ++bj) { const f32x4 v0 = acc[ai][bj][m][0], v1 = acc[ai][bj][m][1];
                    u32x4 w; w.x = cvt_pk_bf16(v0[0], v0[1]); w.y = cvt_pk_bf16(v0[2], v0[3]); w.z = cvt_pk_bf16(v1[0], v1[1]); w.w = cvt_pk_bf16(v1[2], v1[3]);
                    *(u32x4*)(rowp + bj * HALF) = w; } }
    }
};
struct EpiF32Res {
    static constexpr bool PERM = false, AFTER_DRAIN = false;
    float* C; const float* res; const float* gate;
    __device__ __forceinline__ void operator()(const f32x4 (&acc)[2][2][4][2], const Unit& u, int wr, int wc, int fr, int fq) const {
        const int row0 = u.pm * BM + wr * 64 + fr, col0 = u.pn * BM + wc * 32 + 4 * fq;
        f32x4 gv[2][2];
#pragma unroll
        for (int bj = 0; bj < 2; ++bj)
#pragma unroll
            for (int n = 0; n < 2; ++n) gv[bj][n] = res ? *(const f32x4*)(gate + (size_t)(u.pm >> 3) * 6144 + col0 + bj * HALF + n * 16) : (f32x4){1.f, 1.f, 1.f, 1.f};
#pragma unroll
        for (int ai = 0; ai < 2; ++ai)
#pragma unroll
            for (int m = 0; m < 4; ++m) { const size_t off = (size_t)(row0 + ai * HALF + m * 16) * 1024 + col0;
#pragma unroll
                for (int bj = 0; bj < 2; ++bj)
#pragma unroll
                    for (int n = 0; n < 2; ++n) { f32x4 o = acc[ai][bj][m][n] * gv[bj][n];
                        if (res) o = o + *(const f32x4*)(res + off + bj * HALF + n * 16);
                        *(f32x4*)(C + off + bj * HALF + n * 16) = o; } }
    }
};

template <class Epi, class Sched, bool ALIGN_EPI = false, bool SP2 = false>
__device__ __forceinline__ void gemm_phase(PG8_LAS unsigned char* lds, const Gemm g, const Sched& S, const Epi& E) {
    const int tid = threadIdx.x, wid = __builtin_amdgcn_readfirstlane(tid >> 6), lane = tid & 63, wr = wid >> 2, wc = wid & 3, fr = lane & 15, fq = lane >> 4;
    const int K = g.K, nt = K / BK;
    unsigned voffA[2], voffB[2];
#pragma unroll
    for (int i = 0; i < 2; ++i) { int R, C; stage_rc(tid * 16 + i * 8192, R, C); const int Rb = Epi::PERM ? ((R & ~31) + perm32(R & 31)) : R;
        voffA[i] = (unsigned)(R * K + C) * 2u; voffB[i] = (unsigned)(Rb * K + C) * 2u; }
    const size_t kstep = (size_t)(BK * 2);
    const size_t hstep = (size_t)HALF * K * 2;
    const size_t tstep = 2 * hstep;
    const unsigned ldsw = (unsigned)wid * 1024u;
    const int aoff = lds_byte(wr * 64 + fr, fq * 8), boff = lds_byte(wc * 32 + fr, fq * 8);
#define PG8_SA(b, h) (((b) * 2 + (h)) * HTB)
#define PG8_SB(b, h) ((4 + (b) * 2 + (h)) * HTB)
#define PG8_STAGE(bufoff, gbase, voff) do { _Pragma("unroll") for (int _i = 0; _i < 2; ++_i) \
        __builtin_amdgcn_global_load_lds((const unsigned*)((const char*)(gbase) + (voff)[_i]), (PG8_LAS unsigned*)(lds + (bufoff) + ldsw + _i * 8192), 16, 0, 0); } while (0)
#define PG8_LDA(dst, b, h) do { _Pragma("unroll") for (int m = 0; m < 4; ++m) _Pragma("unroll") for (int k = 0; k < 2; ++k) dst[m][k] = *(const PG8_LAS bf16x8*)(lds + PG8_SA(b, h) + aoff + m * 2048 + k * 1024); } while (0)
#define PG8_LDB(dst, b, h) do { _Pragma("unroll") for (int n = 0; n < 2; ++n) _Pragma("unroll") for (int k = 0; k < 2; ++k) dst[n][k] = *(const PG8_LAS bf16x8*)(lds + PG8_SB(b, h) + boff + n * 2048 + k * 1024); } while (0)
#define PG8_MMA(ai, bj, At, Bt) do { __builtin_amdgcn_s_setprio(1); _Pragma("unroll") for (int m = 0; m < 4; ++m) _Pragma("unroll") for (int n = 0; n < 2; ++n) _Pragma("unroll") for (int k = 0; k < 2; ++k) \
        acc[ai][bj][m][n] = __builtin_amdgcn_mfma_f32_16x16x32_bf16(Bt[n][k], At[m][k], acc[ai][bj][m][n], 0, 0, 0); __builtin_amdgcn_s_setprio(0); } while (0)
#define PG8_WAIT_V(n) asm volatile("s_waitcnt vmcnt(" #n ")" ::: "memory")
#define PG8_WAIT_L(n) asm volatile("s_waitcnt lgkmcnt(" #n ")" ::: "memory")
#define PG8_BAR __builtin_amdgcn_s_barrier()
#define PG8_SCHED __builtin_amdgcn_sched_barrier(0)
    Unit cur, nxt; int ui = 0;
    if (!S.next(0, cur)) return;
    f32x4 acc[2][2][4][2];
#pragma unroll
    for (int a = 0; a < 2; ++a)
#pragma unroll
        for (int b = 0; b < 2; ++b)
#pragma unroll
            for (int m = 0; m < 4; ++m)
#pragma unroll
                for (int n = 0; n < 2; ++n) acc[a][b][m][n] = (f32x4){0.f, 0.f, 0.f, 0.f};
    bf16x8 At[4][2], B0[2][2], B1[2][2];
    const char* cA = (const char*)g.A + (size_t)cur.pm * tstep; const char* cB = (const char*)g.Bt + (size_t)cur.pn * tstep;
    S.a_ready(cur);
    if constexpr (SP2) {
        PG8_STAGE(PG8_SB(0, 0), cB, voffB); PG8_STAGE(PG8_SB(0, 1), cB + hstep, voffB); PG8_STAGE(PG8_SA(0, 0), cA, voffA); PG8_STAGE(PG8_SA(0, 1), cA + hstep, voffA);
        if (wr == 1) PG8_BAR;
        PG8_WAIT_V(2); PG8_BAR;
        PG8_STAGE(PG8_SB(1, 0), cB + kstep, voffB); PG8_STAGE(PG8_SA(1, 0), cA + kstep, voffA); PG8_STAGE(PG8_SB(1, 1), cB + hstep + kstep, voffB);
        PG8_WAIT_V(6); PG8_BAR;
    } else {
        PG8_STAGE(PG8_SB(0, 0), cB, voffB); PG8_STAGE(PG8_SA(0, 0), cA, voffA); PG8_STAGE(PG8_SB(0, 1), cB + hstep, voffB); PG8_STAGE(PG8_SA(0, 1), cA + hstep, voffA);
        if (wr == 1) PG8_BAR;
        PG8_WAIT_V(4); PG8_BAR;
        PG8_STAGE(PG8_SB(1, 0), cB + kstep, voffB); PG8_STAGE(PG8_SA(1, 0), cA + kstep, voffA); PG8_STAGE(PG8_SB(1, 1), cB + hstep + kstep, voffB);
        PG8_WAIT_V(6); PG8_BAR;
    }
    for (;;) {
        const bool has_next = S.next(ui + 1, nxt);
        const char* nA = has_next ? (const char*)g.A + (size_t)nxt.pm * tstep : cA; const char* nB = has_next ? (const char*)g.Bt + (size_t)nxt.pn * tstep : cB;
        for (int t = 0; t < nt; t += 2) {
            const bool last = (t == nt - 2);
            const char* a1 = cA + (size_t)(t + 1) * kstep;
            const char* a2 = last ? nA : cA + (size_t)(t + 2) * kstep; const char* b2 = last ? nB : cB + (size_t)(t + 2) * kstep;
            const char* a3 = a2 + kstep; const char* b3 = b2 + kstep;
            if (last && has_next) S.a_ready(nxt);
            if constexpr (SP2) {
            PG8_LDB(B0, 0, 0); PG8_LDB(B1, 0, 1); PG8_SCHED; PG8_LDA(At, 0, 0); PG8_STAGE(PG8_SA(1, 1), a1 + hstep, voffA);
            PG8_WAIT_V(8); PG8_WAIT_L(0); PG8_BAR; PG8_MMA(0, 0, At, B0); PG8_MMA(0, 1, At, B1); PG8_BAR; PG8_SCHED;
            PG8_LDA(At, 0, 1); PG8_STAGE(PG8_SB(0, 0), b2, voffB); PG8_STAGE(PG8_SB(0, 1), b2 + hstep, voffB); PG8_STAGE(PG8_SA(0, 0), a2, voffA);
            PG8_WAIT_V(8); PG8_WAIT_L(0); PG8_BAR; PG8_MMA(1, 0, At, B0); PG8_MMA(1, 1, At, B1); PG8_BAR; PG8_SCHED;
            PG8_LDB(B0, 1, 0); PG8_LDB(B1, 1, 1); PG8_SCHED; PG8_LDA(At, 1, 0); PG8_STAGE(PG8_SA(0, 1), a2 + hstep, voffA);
            PG8_WAIT_V(8); PG8_WAIT_L(0); PG8_BAR; PG8_MMA(0, 0, At, B0); PG8_MMA(0, 1, At, B1); PG8_BAR; PG8_SCHED;
            PG8_LDA(At, 1, 1); PG8_STAGE(PG8_SB(1, 0), b3, voffB); PG8_STAGE(PG8_SB(1, 1), b3 + hstep, voffB); PG8_STAGE(PG8_SA(1, 0), a3, voffA);
            PG8_WAIT_V(8); PG8_WAIT_L(0); PG8_BAR; PG8_MMA(1, 0, At, B0); PG8_MMA(1, 1, At, B1); PG8_BAR; PG8_SCHED;
            } else {
            PG8_LDB(B0, 0, 0); PG8_SCHED; PG8_LDA(At, 0, 0); PG8_STAGE(PG8_SA(1, 1), a1 + hstep, voffA);
            PG8_WAIT_L(8); PG8_BAR; PG8_WAIT_L(0); PG8_MMA(0, 0, At, B0); PG8_BAR; PG8_SCHED;
            PG8_LDB(B1, 0, 1); PG8_STAGE(PG8_SB(0, 0), b2, voffB);
            PG8_BAR; PG8_WAIT_L(0); PG8_MMA(0, 1, At, B1); PG8_BAR;
            PG8_LDA(At, 0, 1); PG8_STAGE(PG8_SA(0, 0), a2, voffA);
            PG8_BAR; PG8_WAIT_L(0); PG8_MMA(1, 0, At, B0); PG8_BAR; PG8_SCHED;
            PG8_STAGE(PG8_SB(0, 1), b2 + hstep, voffB);
            PG8_WAIT_V(6); PG8_BAR; PG8_MMA(1, 1, At, B1); PG8_BAR;
            PG8_LDB(B0, 1, 0); PG8_SCHED; PG8_LDA(At, 1, 0); PG8_STAGE(PG8_SA(0, 1), a2 + hstep, voffA);
            PG8_WAIT_L(8); PG8_BAR; PG8_WAIT_L(0); PG8_MMA(0, 0, At, B0); PG8_BAR; PG8_SCHED;
            PG8_LDB(B1, 1, 1); PG8_STAGE(PG8_SB(1, 0), b3, voffB);
            PG8_BAR; PG8_WAIT_L(0); PG8_MMA(0, 1, At, B1); PG8_BAR;
            PG8_LDA(At, 1, 1); PG8_STAGE(PG8_SA(1, 0), a3, voffA);
            PG8_BAR; PG8_WAIT_L(0); PG8_MMA(1, 0, At, B0); PG8_BAR; PG8_SCHED;
            PG8_STAGE(PG8_SB(1, 1), b3 + hstep, voffB);
            PG8_WAIT_V(6); PG8_BAR; PG8_MMA(1, 1, At, B1); PG8_BAR;
            }
        }
        if constexpr (ALIGN_EPI) { if (wr == 0) PG8_BAR; }
        if constexpr (!Epi::AFTER_DRAIN) { E(acc, cur, wr, wc, fr, fq); S.done(cur); }
        if (!has_next) break;
#pragma unroll
        for (int a = 0; a < 2; ++a)
#pragma unroll
            for (int b = 0; b < 2; ++b)
#pragma unroll
                for (int m = 0; m < 4; ++m)
#pragma unroll
                    for (int n = 0; n < 2; ++n) acc[a][b][m][n] = (f32x4){0.f, 0.f, 0.f, 0.f};
        cur = nxt; cA = nA; cB = nB; ++ui;
        if constexpr (ALIGN_EPI) { if (wr == 1) PG8_BAR; }
    }
    PG8_WAIT_V(0);
    if constexpr (!ALIGN_EPI) { if (wr == 0) PG8_BAR; }
    PG8_BAR;
    if constexpr (Epi::AFTER_DRAIN) { E.fused(acc, cur, wr, wc, fr, fq, lds, wid, lane); S.done(cur); }
#undef PG8_SA
#undef PG8_SB
#undef PG8_STAGE
#undef PG8_LDA
#undef PG8_LDB
#undef PG8_MMA
#undef PG8_WAIT_V
#undef PG8_WAIT_L
#undef PG8_BAR
#undef PG8_SCHED
}
}
#define XB_TMO      128
#define XB_XCNT(j)  (256  + 64 * (j))
#define XB_XSUB(j)  (1280 + 64 * (j))
#define XB_XGEN(j)  (2304 + 64 * (j))
#define XB_TOP      3328
#define XB_TOPGEN   3392
#define XCD_BAR_WORDS 3456
#define XB_SPIN_CAP (1u << 18)

__device__ __forceinline__ unsigned xb_ld(unsigned* p)              { return __hip_atomic_load(p, __ATOMIC_RELAXED, __HIP_MEMORY_SCOPE_AGENT); }
__device__ __forceinline__ unsigned xb_add(unsigned* p, unsigned v) { return __hip_atomic_fetch_add(p, v, __ATOMIC_RELAXED, __HIP_MEMORY_SCOPE_AGENT); }
__device__ __forceinline__ unsigned xb_xcc_id() { return (unsigned)__builtin_amdgcn_s_getreg((3 << 11) | 20) & 0xFu; }
#define XB_SPIN(cond, bar) do { unsigned _sp = 0; while (cond) { __builtin_amdgcn_s_sleep(1); \
    if ((++_sp & 255u) == 0u) { if (xb_ld(&(bar)[XB_TMO])) break; if (_sp > XB_SPIN_CAP) { atomicAdd(&(bar)[XB_TMO], 1u); break; } } } } while (0)

struct XcdBarrier {
    unsigned* bar; unsigned x;
    volatile LAS unsigned* st;
};

__device__ __forceinline__ XcdBarrier xcd_barrier_post(unsigned* bar, volatile LAS unsigned* st) {
    XcdBarrier b; b.bar = bar; b.x = xb_xcc_id(); b.st = st;
    if (threadIdx.x == 0) (void)xb_add(&bar[XB_XCNT(b.x)], 1u);
    return b;
}
__device__ __forceinline__ void xcd_barrier_complete(unsigned* bar, unsigned x, unsigned& nloc, unsigned& nx) {
    const unsigned G = gridDim.x * gridDim.y * gridDim.z;
    unsigned sum, cnt, mine, sp = 0u;
    for (;;) {
        sum = 0u; cnt = 0u; mine = 0u;
#pragma unroll
        for (unsigned j = 0; j < 16; ++j) { const unsigned c = xb_ld(&bar[XB_XCNT(j)]); sum += c; cnt += (c > 0u) ? 1u : 0u; mine = (j == x) ? c : mine; }
        if (sum == G) break;
        __builtin_amdgcn_s_sleep(1);
        if ((++sp & 255u) == 0u) { if (xb_ld(&bar[XB_TMO])) break; if (sp > XB_SPIN_CAP) { atomicAdd(&bar[XB_TMO], 1u); break; } }
    }
    nloc = mine > 0u ? mine : 1u; nx = cnt > 0u ? cnt : 1u;
}

__device__ __forceinline__ void xcd_barrier(const XcdBarrier& b) {
    asm volatile("s_waitcnt vmcnt(0)" ::: "memory");
    __syncthreads();
    if (threadIdx.x == 0) {
        unsigned* bar = b.bar;
        __builtin_amdgcn_s_waitcnt(0);
        unsigned nloc = b.st[0], nx = b.st[1];
        if (nloc == 0u) { xcd_barrier_complete(bar, b.x, nloc, nx); b.st[0] = nloc; b.st[1] = nx; }
        const unsigned old = xb_add(&bar[XB_XSUB(b.x)], 1u);
        const unsigned gen = old / nloc;
        if (old + 1u == (gen + 1u) * nloc) {
            __builtin_amdgcn_fence(__ATOMIC_RELEASE, "agent");
            asm volatile("s_waitcnt vmcnt(0)" ::: "memory");
            const unsigned og = xb_add(&bar[XB_TOP], 1u);
            const unsigned tg = og / nx;
            if (og + 1u == (tg + 1u) * nx) xb_add(&bar[XB_TOPGEN], 1u);
            else XB_SPIN(xb_ld(&bar[XB_TOPGEN]) == tg, bar);
            __builtin_amdgcn_fence(__ATOMIC_ACQUIRE, "agent");
            xb_add(&bar[XB_XGEN(b.x)], 1u);
            asm volatile("s_waitcnt vmcnt(0)" ::: "memory");
        } else {
            XB_SPIN(xb_ld(&bar[XB_XGEN(b.x)]) == gen, bar);
            __builtin_amdgcn_fence(__ATOMIC_ACQUIRE, "agent");
            asm volatile("s_waitcnt vmcnt(0)" ::: "memory");
        }
    }
    __syncthreads();
}

typedef short bf16x8_t __attribute__((ext_vector_type(8)));
typedef unsigned u32x4_t __attribute__((ext_vector_type(4)));
typedef unsigned u32x2_t __attribute__((ext_vector_type(2)));
typedef short s16x4_t __attribute__((ext_vector_type(4)));
typedef float f32x16_t __attribute__((ext_vector_type(16)));
typedef float f32x2_t __attribute__((ext_vector_type(2)));
typedef __bf16 bf16x2_t __attribute__((ext_vector_type(2)));
#define MFMA32(a, b, c) __builtin_amdgcn_mfma_f32_32x32x16_bf16((a), (b), (c), 0, 0, 0)
constexpr float LOG2E = 1.4426950408889634f;

__device__ __forceinline__ int crow(int r, int hi) { return (r & 3) + 8 * (r >> 2) + 4 * hi; }
__device__ __forceinline__ unsigned cvtpk(float lo, float hi) { f32x2_t v = {lo, hi}; bf16x2_t b = __builtin_convertvector(v, bf16x2_t); return __builtin_bit_cast(unsigned, b); }
__device__ __forceinline__ s16x4_t vtr(const LAS unsigned char* p) { return __builtin_bit_cast(s16x4_t, __builtin_amdgcn_ds_read_tr16_b64_v4i16((LAS s16x4_t*)p)); }
__device__ __forceinline__ float xhalf_max(float m) { auto rr = __builtin_amdgcn_permlane32_swap(__float_as_uint(m), __float_as_uint(m), false, false); return fmaxf(__uint_as_float(rr[0]), __uint_as_float(rr[1])); }
__device__ __forceinline__ float xhalf_sum(float m) { auto rr = __builtin_amdgcn_permlane32_swap(__float_as_uint(m), __float_as_uint(m), false, false); return __uint_as_float(rr[0]) + __uint_as_float(rr[1]); }
__device__ __forceinline__ bf16x8_t pack8(const f32x16_t& p, int s) {
    u32x4_t u; u.x = cvtpk(p[8 * s + 0], p[8 * s + 1]); u.y = cvtpk(p[8 * s + 2], p[8 * s + 3]); u.z = cvtpk(p[8 * s + 4], p[8 * s + 5]); u.w = cvtpk(p[8 * s + 6], p[8 * s + 7]);
    return __builtin_bit_cast(bf16x8_t, u);
}

constexpr int DA_KBUF = 0, DA_VBUF = 32768, DA_BIAS = 65536, DA_LDS = 65536 + 1024;
__device__ __forceinline__ void diff_unit(const bf16_t* __restrict__ proj, bf16_t* __restrict__ mixin, const float* __restrict__ rel_bias, const float lam, const float* __restrict__ g_subln,
                                          LAS unsigned char* lds, int b, int h, int qt, int tid, int lane, int wave) {
    const int rg = wave >> 1, map = wave & 1, r32 = lane & 31, hh = lane >> 5;
    const int t0 = 128 * qt + 32 * rg;
    const int ntb = 2 * qt + 2;
    const int ntw = (t0 + 31) / 64 + 1;
    const size_t rowbase = (size_t)b * S;
    LAS float* biasT = (LAS float*)(lds + DA_BIAS);
    if (tid < 256) biasT[tid] = rel_bias[rel_bucket(tid) * 8 + h] * LOG2E;
    const float c31 = rel_bias[31 * 8 + h] * LOG2E;
    bf16x8_t qf[4];
    { const bf16_t* qrow = proj + (rowbase + t0 + r32) * NPP + C_DQ + h * 128 + map * 64 + 8 * hh;
#pragma unroll
      for (int ks = 0; ks < 4; ++ks) qf[ks] = *(const bf16x8_t*)(qrow + 16 * ks); }
    const int skey = tid >> 4, sc = tid & 15;
    const bf16_t* kg = proj + (rowbase + skey) * NPP + C_DK + h * 128 + 8 * sc;
    const bf16_t* vg = proj + (rowbase + skey) * NPP + C_DV + h * 128 + 8 * sc;
    const unsigned koff0 = skey * 256 + ((sc ^ (skey & 15)) * 16), koff1 = koff0 + 32 * 256;
    const unsigned voff0 = (sc >> 2) * 4096 + skey * 64 + (sc & 3) * 16, voff1 = voff0 + 32 * 64;
    u32x4_t sk0, sk1, sv0, sv1;
#define DA_LOAD(j) do { const size_t o_ = (size_t)(64 * (j)) * NPP; sk0 = *(const u32x4_t*)(kg + o_); sk1 = *(const u32x4_t*)(kg + o_ + (size_t)32 * NPP); sv0 = *(const u32x4_t*)(vg + o_); sv1 = *(const u32x4_t*)(vg + o_ + (size_t)32 * NPP); } while (0)
#define DA_WRITE(bf) do { LAS unsigned char* kb_ = lds + DA_KBUF + (bf) * 16384; LAS unsigned char* vb_ = lds + DA_VBUF + (bf) * 16384; \
        *(LAS u32x4_t*)(kb_ + koff0) = sk0; *(LAS u32x4_t*)(kb_ + koff1) = sk1; *(LAS u32x4_t*)(vb_ + voff0) = sv0; *(LAS u32x4_t*)(vb_ + voff1) = sv1; } while (0)
    DA_LOAD(0); DA_WRITE(0);
    __syncthreads();
    f32x16_t O[4];
#pragma unroll
    for (int i = 0; i < 4; ++i)
#pragma unroll
        for (int r = 0; r < 16; ++r) O[i][r] = 0.f;
    float m = -INFINITY, l = 0.f;
    const int t = t0 + r32;
    const float SC = 0.125f * LOG2E;
    const int i16 = lane & 15, tq = i16 >> 2, tp = i16 & 3, g1 = (lane >> 4) & 1;
    const unsigned vrd = (4 * hh + tq) * 64 + g1 * 32 + tp * 8;
    const unsigned krd = r32 * 256;
    for (int j = 0; j < ntb; ++j) {
        if (j + 1 < ntb) DA_LOAD(j + 1);
        if (j < ntw) {
            const LAS unsigned char* kb = lds + DA_KBUF + (j & 1) * 16384; const LAS unsigned char* vb = lds + DA_VBUF + (j & 1) * 16384;
            f32x16_t s0, s1;
#pragma unroll
            for (int r = 0; r < 16; ++r) { s0[r] = 0.f; s1[r] = 0.f; }
#pragma unroll
            for (int ks = 0; ks < 4; ++ks) {
                const int chunk = map * 8 + 2 * ks + hh;
                const unsigned co = (unsigned)((chunk ^ (r32 & 15)) * 16);
                const bf16x8_t a0 = *(const LAS bf16x8_t*)(kb + krd + co), a1 = *(const LAS bf16x8_t*)(kb + krd + 32 * 256 + co);
                s0 = MFMA32(a0, qf[ks], s0); s1 = MFMA32(a1, qf[ks], s1);
            }
            const int kbase = 64 * j + 4 * hh;
            const bool nearb = (t0 - (64 * j + 63)) < 113;
            const bool diag = (64 * j + 63) > t0;
            if (nearb) {
#pragma unroll
                for (int r = 0; r < 16; ++r) { const int key = kbase + (r & 3) + 8 * (r >> 2);
                    int d0 = t - key, d1 = d0 - 32; d0 = d0 < 0 ? 0 : d0; d1 = d1 < 0 ? 0 : d1;
                    s0[r] = s0[r] * SC + biasT[d0]; s1[r] = s1[r] * SC + biasT[d1];
                    if (diag) { if (key > t) s0[r] = -INFINITY; if (key + 32 > t) s1[r] = -INFINITY; } }
            } else {
#pragma unroll
                for (int r = 0; r < 16; ++r) { s0[r] = s0[r] * SC + c31; s1[r] = s1[r] * SC + c31; }
            }
            float mt = fmaxf(s0[0], s1[0]);
#pragma unroll
            for (int r = 1; r < 16; ++r) mt = fmaxf(mt, fmaxf(s0[r], s1[r]));
            mt = xhalf_max(mt);
            const float mn = fmaxf(m, mt);
            const float alpha = __builtin_amdgcn_exp2f(m - mn);
            m = mn;
            float ps = 0.f;
#pragma unroll
            for (int r = 0; r < 16; ++r) { s0[r] = __builtin_amdgcn_exp2f(s0[r] - mn); s1[r] = __builtin_amdgcn_exp2f(s1[r] - mn); ps += s0[r] + s1[r]; }
            l = l * alpha + ps;
            if (__any(alpha != 1.f)) {
#pragma unroll
                for (int i = 0; i < 4; ++i)
#pragma unroll
                    for (int r = 0; r < 16; ++r) O[i][r] *= alpha;
            }
            bf16x8_t pb[2][2];
            pb[0][0] = pack8(s0, 0); pb[0][1] = pack8(s0, 1); pb[1][0] = pack8(s1, 0); pb[1][1] = pack8(s1, 1);
#pragma unroll
            for (int sub = 0; sub < 2; ++sub)
#pragma unroll
                for (int s = 0; s < 2; ++s)
#pragma unroll
                    for (int dblk = 0; dblk < 4; ++dblk) {
                        const LAS unsigned char* vp = vb + dblk * 4096 + (32 * sub + 16 * s) * 64 + vrd;
                        const s16x4_t lo = vtr(vp), hi = vtr(vp + 8 * 64);
                        const bf16x8_t va = __builtin_shufflevector(lo, hi, 0, 1, 2, 3, 4, 5, 6, 7);
                        O[dblk] = MFMA32(va, pb[sub][s], O[dblk]);
                    }
        }
        if (j + 1 < ntb) DA_WRITE((j + 1) & 1);
        __syncthreads();
    }
#undef DA_LOAD
#undef DA_WRITE
    l = xhalf_sum(l);
    const float inv = (map ? lam : 1.f) / l;
    LAS float* ex = (LAS float*)(lds + rg * 16384);
    if (map == 1) {
#pragma unroll
        for (int i = 0; i < 4; ++i)
#pragma unroll
            for (int r = 0; r < 16; ++r) ex[(i * 16 + r) * 64 + lane] = O[i][r] * inv;
    }
    __syncthreads();
    if (map == 0) {
        float ss = 0.f;
#pragma unroll
        for (int i = 0; i < 4; ++i)
#pragma unroll
            for (int r = 0; r < 16; ++r) { const float o = O[i][r] * inv - ex[(i * 16 + r) * 64 + lane]; O[i][r] = o; ss += o * o; }
        ss = xhalf_sum(ss);
        const float rn = rsqrtf(ss * (1.f / 128.f) + EPS) * 0.8f;
        bf16_t* orow = mixin + (rowbase + t) * D + h * 128;
#pragma unroll
        for (int i = 0; i < 4; ++i)
#pragma unroll
            for (int g = 0; g < 4; ++g) { const int d0 = 32 * i + 8 * g + 4 * hh; const float4 gs = *(const float4*)(g_subln + d0);
                uint2 o; o.x = cvtpk(O[i][4 * g + 0] * rn * gs.x, O[i][4 * g + 1] * rn * gs.y); o.y = cvtpk(O[i][4 * g + 2] * rn * gs.z, O[i][4 * g + 3] * rn * gs.w);
                *(uint2*)(orow + d0) = o; }
    }
    __syncthreads();
}

constexpr size_t MiB = 1u << 20;
constexpr size_t WS_CTL = 0, CTL_ZERO_BYTES = 1 * MiB;
constexpr size_t WS_MOD = 1 * MiB;
constexpr size_t WS_LAM = 1 * MiB + 800 * 1024;
constexpr size_t WS_WIN_T = 2 * MiB;
constexpr size_t WS_WO_T = 8 * MiB;
constexpr size_t WS_WQ_T = 10 * MiB;
constexpr size_t WS_HBUF = 16 * MiB;
constexpr size_t WS_MIXIN = 144 * MiB;
constexpr size_t WS_KVN = 272 * MiB;
constexpr size_t WS_EIDX = 288 * MiB;
constexpr size_t WS_GATE = 320 * MiB;
constexpr size_t WS_BIG = 352 * MiB;
constexpr size_t WS_UQ = 704 * MiB;
constexpr size_t WS_VQ = 720 * MiB;
constexpr size_t WS_SU = 736 * MiB;
constexpr size_t WS_SV = 736 * MiB + 65536;
constexpr size_t WS_XQ = 737 * MiB;
constexpr size_t WS_SX = 801 * MiB;
constexpr size_t WS_END = 802 * MiB;
constexpr int CW_BAR = 4096;
constexpr int MAX_FWD_LAUNCHES = 8;
static_assert((CW_BAR + MAX_FWD_LAUNCHES * XCD_BAR_WORDS) * 4 <= (int)CTL_ZERO_BYTES, "barrier words inside the memset region");

constexpr int RING_OFF = 0, RING_BYTES = 131072;
constexpr int LDSCTL_OFF = RING_BYTES, MISC_OFF = LDSCTL_OFF + 320;
constexpr int LDS_BYTES = 147456;

struct Args { const float* in[21]; float* out; unsigned char* ws; int ph_lo, ph_hi, li, pad; };

__device__ __forceinline__ void p0_transpose_item(const float* W, int K, int N, int Npad, bf16_t* WT, LAS float* scr, int item, int lane) {
    const int nblk = Npad / 32, kb = item / nblk, nb = item % nblk, k0 = 64 * kb, n0 = 32 * nb;
    const int n_in = n0 + (lane & 31);
#pragma unroll 8
    for (int i = 0; i < 32; ++i) { const int kk = 2 * i + (lane >> 5); scr[kk * 33 + (lane & 31)] = n_in < N ? W[(size_t)(k0 + kk) * N + n_in] : 0.f; }
    asm volatile("s_waitcnt lgkmcnt(0)" ::: "memory");
    const int c = lane & 7;
#pragma unroll
    for (int j = 0; j < 4; ++j) { const int n = (lane >> 3) + 8 * j; const LAS float* s = scr + (8 * c) * 33 + n;
        uint4 o; o.x = pk2(s[0 * 33], s[1 * 33]); o.y = pk2(s[2 * 33], s[3 * 33]); o.z = pk2(s[4 * 33], s[5 * 33]); o.w = pk2(s[6 * 33], s[7 * 33]);
        *(uint4*)(WT + (size_t)(n0 + n) * K + k0 + 8 * c) = o; }
    asm volatile("s_waitcnt lgkmcnt(0)" ::: "memory");
}

template <int OFFS> __device__ __forceinline__ void quant_row(const float4 (&v)[4], unsigned char* qrow, float* scale_out, int lane);
template <bool QUANT>
__device__ __forceinline__ void norm_mod_row(const float* xrow, const float* g, const float* mb, int shift_off, int scale_off, bf16_t* orow, int lane, unsigned char* qrow, float* qscale) {
    const float4* xr = (const float4*)xrow;
    float4 v[4]; float ss = 0.f;
#pragma unroll
    for (int i = 0; i < 4; ++i) { v[i] = xr[lane + 64 * i]; ss += v[i].x * v[i].x + v[i].y * v[i].y + v[i].z * v[i].z + v[i].w * v[i].w; }
    ss = wave_sum(ss);
    const float r = rsqrtf(ss * (1.f / D) + EPS);
#pragma unroll
    for (int i = 0; i < 4; ++i) {
        const int col = (lane + 64 * i) * 4;
        const float4 gg = *(const float4*)(g + col), sc = *(const float4*)(mb + scale_off + col), sh = *(const float4*)(mb + shift_off + col);
        v[i].x = v[i].x * r * gg.x * (1.f + sc.x) + sh.x; v[i].y = v[i].y * r * gg.y * (1.f + sc.y) + sh.y;
        v[i].z = v[i].z * r * gg.z * (1.f + sc.z) + sh.z; v[i].w = v[i].w * r * gg.w * (1.f + sc.w) + sh.w;
        uint2 o; o.x = pk2(v[i].x, v[i].y); o.y = pk2(v[i].z, v[i].w);
        *(uint2*)(orow + col) = o;
    }
    if (QUANT) quant_row<0>(v, qrow, qscale, lane);
}

template <int OFFS>
__device__ __forceinline__ void quant_row(const float4 (&v)[4], unsigned char* qrow, float* scale_out, int lane) {
    float am = 0.f;
#pragma unroll
    for (int i = 0; i < 4; ++i) am = fmaxf(am, fmaxf(fmaxf(fabsf(v[i].x), fabsf(v[i].y)), fmaxf(fabsf(v[i].z), fabsf(v[i].w))));
    am = wave_max(am);
    const float sc = am > 0.f ? am * (1.f / 127.f) : 1.f, inv = am > 0.f ? 127.f / am : 0.f;
    uint4 o; unsigned w[4];
#pragma unroll
    for (int i = 0; i < 4; ++i) {
        const int q0 = (int)rintf(v[i].x * inv) + OFFS, q1 = (int)rintf(v[i].y * inv) + OFFS, q2 = (int)rintf(v[i].z * inv) + OFFS, q3 = (int)rintf(v[i].w * inv) + OFFS;
        w[i] = (unsigned)(q0 & 255) | ((unsigned)(q1 & 255) << 8) | ((unsigned)(q2 & 255) << 16) | ((unsigned)(q3 & 255) << 24);
    }
    o.x = w[0]; o.y = w[1]; o.z = w[2]; o.w = w[3];
    *(uint4*)(qrow + 16 * lane) = o;
    if (lane == 0) *scale_out = sc;
}
__device__ __forceinline__ void quant_table_row(const float* row, unsigned char* qrow, float* scale_out, int lane, bool offs) {
    float4 v[4];
#pragma unroll
    for (int i = 0; i < 4; ++i) v[i] = ((const float4*)row)[lane + 64 * i];
    if (offs) quant_row<128>(v, qrow, scale_out, lane); else quant_row<0>(v, qrow, scale_out, lane);
}

__device__ __forceinline__ int treduce16(int (&v)[16], int lane) {
#pragma unroll
    for (int o = 8, n = 16; o >= 1; o >>= 1, n >>= 1) {
        const bool upper = (lane & o) != 0;
#pragma unroll
        for (int j = 0; j < n / 2; ++j) {
            const int keep = upper ? v[j + n / 2] : v[j];
            const int send = upper ? v[j] : v[j + n / 2];
            v[j] = keep + __shfl_xor(send, o);
        }
    }
    int t = v[0];
    t += __shfl_xor(t, 16); t += __shfl_xor(t, 32);
    return t;
}
__device__ __forceinline__ float gelu_erf(float a) { return 0.5f * a * (1.f + erff(a * 0.70710678118654752f)); }

__device__ __forceinline__ void peer_token(int tok, const unsigned char* __restrict__ xq, const float* __restrict__ sxs, const int* __restrict__ eidx, const float* __restrict__ gate,
                                           const unsigned char* __restrict__ uq, const unsigned char* __restrict__ vq, const float* __restrict__ su, const float* __restrict__ sv,
                                           const float* __restrict__ gate_f, const float* __restrict__ g_final, float* xio, int lane) {
    const uint4 x4 = *(const uint4*)(xq + (size_t)tok * 1024 + 16 * lane);
    const float sx = sxs[tok];
    const int e0 = eidx[(size_t)tok * 128 + lane], e1 = eidx[(size_t)tok * 128 + 64 + lane];
    const float g0 = gate[(size_t)tok * 128 + lane], g1 = gate[(size_t)tok * 128 + 64 + lane];
    float w0 = 0.f, w1 = 0.f;
#pragma unroll 1
    for (int batch = 0; batch < 2; ++batch) {
        const int er = batch ? e1 : e0;
        int tot = 0;
#pragma unroll 1
        for (int g = 0; g < 4; ++g) {
            uint4 rows[16]; int acc[16];
#pragma unroll
            for (int j = 0; j < 16; ++j) { const int e = __builtin_amdgcn_readlane(er, 16 * g + j); rows[j] = *(const uint4*)(uq + (size_t)e * 1024 + 16 * lane); }
#pragma unroll
            for (int j = 0; j < 16; ++j) {
                int a = __builtin_amdgcn_sdot4((int)rows[j].x, (int)x4.x, 0, false);
                a = __builtin_amdgcn_sdot4((int)rows[j].y, (int)x4.y, a, false);
                a = __builtin_amdgcn_sdot4((int)rows[j].z, (int)x4.z, a, false);
                a = __builtin_amdgcn_sdot4((int)rows[j].w, (int)x4.w, a, false);
                acc[j] = a;
            }
            const int t16 = treduce16(acc, lane);
            if ((lane >> 4) == g) tot = t16;
        }
        const float a = (float)tot * sx * su[er];
        const float w = (batch ? g1 : g0) * gelu_erf(a) * sv[er];
        if (batch) w1 = w; else w0 = w;
    }
    const float wsum = wave_sum(w0 + w1);
    float acc[16];
#pragma unroll
    for (int i = 0; i < 16; ++i) acc[i] = 0.f;
#pragma unroll 1
    for (int g = 0; g < 8; ++g) {
        const int er = g < 4 ? e0 : e1; const float wr = g < 4 ? w0 : w1;
        uint4 rows[16]; float wk[16];
#pragma unroll
        for (int j = 0; j < 16; ++j) { const int ln = 16 * (g & 3) + j; const int e = __builtin_amdgcn_readlane(er, ln); wk[j] = __int_as_float(__builtin_amdgcn_readlane(__float_as_int(wr), ln));
            rows[j] = *(const uint4*)(vq + (size_t)e * 1024 + 16 * lane); }
#pragma unroll
        for (int j = 0; j < 16; ++j) {
            const unsigned r0 = rows[j].x, r1 = rows[j].y, r2 = rows[j].z, r3 = rows[j].w; const float w = wk[j];
            acc[0] += w * (float)(r0 & 255u); acc[1] += w * (float)((r0 >> 8) & 255u); acc[2] += w * (float)((r0 >> 16) & 255u); acc[3] += w * (float)(r0 >> 24);
            acc[4] += w * (float)(r1 & 255u); acc[5] += w * (float)((r1 >> 8) & 255u); acc[6] += w * (float)((r1 >> 16) & 255u); acc[7] += w * (float)(r1 >> 24);
            acc[8] += w * (float)(r2 & 255u); acc[9] += w * (float)((r2 >> 8) & 255u); acc[10] += w * (float)((r2 >> 16) & 255u); acc[11] += w * (float)(r2 >> 24);
            acc[12] += w * (float)(r3 & 255u); acc[13] += w * (float)((r3 >> 8) & 255u); acc[14] += w * (float)((r3 >> 16) & 255u); acc[15] += w * (float)(r3 >> 24);
        }
    }
    float4 y[4]; float ss = 0.f; const float corr = 128.f * wsum;
#pragma unroll
    for (int i = 0; i < 4; ++i) {
        const int col = 256 * i + 4 * lane;
        const float4 x1 = *(const float4*)(xio + (size_t)tok * D + col), gf = *(const float4*)(gate_f + col);
        y[i].x = x1.x + gf.x * (acc[4 * i + 0] - corr); y[i].y = x1.y + gf.y * (acc[4 * i + 1] - corr);
        y[i].z = x1.z + gf.z * (acc[4 * i + 2] - corr); y[i].w = x1.w + gf.w * (acc[4 * i + 3] - corr);
        ss += y[i].x * y[i].x + y[i].y * y[i].y + y[i].z * y[i].z + y[i].w * y[i].w;
    }
    ss = wave_sum(ss);
    const float r = rsqrtf(ss * (1.f / D) + EPS);
#pragma unroll
    for (int i = 0; i < 4; ++i) {
        const int col = 256 * i + 4 * lane; const float4 gg = *(const float4*)(g_final + col);
        float4 o; o.x = y[i].x * r * gg.x; o.y = y[i].y * r * gg.y; o.z = y[i].z * r * gg.z; o.w = y[i].w * r * gg.w;
        *(float4*)(xio + (size_t)tok * D + col) = o;
    }
}

__global__ void __launch_bounds__(NTHREADS, 2) fwd(Args args) {
    extern __shared__ __attribute__((aligned(16))) unsigned char lds_raw[];
    LAS unsigned char* lds = (LAS unsigned char*)lds_raw;
    volatile LAS unsigned* MISC = (volatile LAS unsigned*)(lds + MISC_OFF);
    const int tid = threadIdx.x, lane = tid & 63, wave = __builtin_amdgcn_readfirstlane(tid >> 6);
    const int G = gridDim.x;
    unsigned char* ws = args.ws;
    unsigned* ctl = (unsigned*)(ws + WS_CTL);
    for (int u = tid; u < (LDS_BYTES - LDSCTL_OFF) / 4; u += NTHREADS) ((LAS unsigned*)(lds + LDSCTL_OFF))[u] = 0u;
    __syncthreads();
    XcdBarrier bar = xcd_barrier_post(ctl + CW_BAR + args.li * XCD_BAR_WORDS, MISC + 8);
    const int lo = args.ph_lo, hi = args.ph_hi;
#define IN(k) (lo <= (k) && (k) < hi)
#define BOTH(k) (IN(k) && IN((k) + 1))
    const float* x = args.in[0];
    const float* g_norm_mix = args.in[4];
    const float* w_in = args.in[5];
    const float* w_out = args.in[13];
    const float* g_norm_ffn = args.in[14];
    const float* w_peer_q = args.in[15];
    float* out = args.out;
    const float* mod = (const float*)(ws + WS_MOD);
    bf16_t* Win_t = (bf16_t*)(ws + WS_WIN_T); bf16_t* Wo_t = (bf16_t*)(ws + WS_WO_T); bf16_t* Wq_t = (bf16_t*)(ws + WS_WQ_T);
    bf16_t* hbuf = (bf16_t*)(ws + WS_HBUF); bf16_t* mixin = (bf16_t*)(ws + WS_MIXIN);
    bf16_t* proj = (bf16_t*)(ws + WS_BIG); float* qf = (float*)(ws + WS_BIG);
    unsigned char* uq = ws + WS_UQ; unsigned char* vq = ws + WS_VQ; float* su = (float*)(ws + WS_SU); float* sv = (float*)(ws + WS_SV);
    unsigned char* xq = ws + WS_XQ; float* sxs = (float*)(ws + WS_SX);
    const int gw = blockIdx.x * NWAVES + wave, NGW = G * NWAVES;
    const int vcu = (G % 8 == 0) ? ((int)blockIdx.x % 8) * (G / 8) + (int)blockIdx.x / 8 : (int)blockIdx.x;

    if (IN(0)) {
        LAS float* scr = (LAS float*)(lds + RING_OFF + wave * 16384);
        constexpr int I_IN = 16 * (NPP / 32), I_O = 16 * 32, I_Q = 16 * 32;
        for (int it = gw; it < I_IN + I_O + I_Q; it += NGW) {
            int r = it;
            if (r < I_IN) { p0_transpose_item(w_in, D, NP, NPP, Win_t, scr, r, lane); continue; } r -= I_IN;
            if (r < I_O) { p0_transpose_item(w_out, D, D, D, Wo_t, scr, r, lane); continue; } r -= I_O;
            p0_transpose_item(w_peer_q, D, D, D, Wq_t, scr, r, lane);
        }
        for (int r = gw; r < 2 * 16384; r += NGW) {
            if (r < 16384) quant_table_row(args.in[17] + (size_t)r * D, uq + (size_t)r * 1024, su + r, lane, false);
            else quant_table_row(args.in[18] + (size_t)(r - 16384) * D, vq + (size_t)(r - 16384) * 1024, sv + (r - 16384), lane, true);
        }
        if (BOTH(0)) xcd_barrier(bar);
    }
    if (IN(1)) {
        for (int m = gw; m < T; m += NGW) norm_mod_row<false>(x + (size_t)m * D, g_norm_mix, mod + (size_t)(m / S) * 6144, MOD_SHIFT_A, MOD_SCALE_A, hbuf + (size_t)m * D, lane, nullptr, nullptr);
        if (BOTH(1)) xcd_barrier(bar);
    }
    if (IN(2)) {
        pg8::Gemm g{hbuf, Win_t, T, NPP, D}; pg8::StaticOrder So; So.init(T, NPP, G, (int)blockIdx.x);
        pg8::EpiBf16Plain E{proj, NPP};
        pg8::gemm_phase<pg8::EpiBf16Plain, pg8::StaticOrder, true, true>(lds + RING_OFF, g, So, E);
        if (BOTH(2)) xcd_barrier(bar);
    }
    if (IN(3)) {
        const float lam = *(const float*)(ws + WS_LAM);
        for (int it = vcu; it < 1024; it += G) {
            const int b = it >> 5, h = (it >> 3) & 3, qp = it & 7;
            diff_unit(proj, mixin, args.in[19], lam, args.in[10], lds, b, h, 15 - qp, tid, lane, wave);
            diff_unit(proj, mixin, args.in[19], lam, args.in[10], lds, b, h, qp, tid, lane, wave);
        }
        if (BOTH(3)) xcd_barrier(bar);
    }
    if (IN(4)) {
        pg8::Gemm g{mixin, Wo_t, T, D, D}; pg8::StaticOrder So; So.init(T, D, G, (int)blockIdx.x);
        pg8::EpiF32Res E{out, x, mod + MOD_GATE_A};
        pg8::gemm_phase<pg8::EpiF32Res, pg8::StaticOrder, true, true>(lds + RING_OFF, g, So, E);
        if (BOTH(4)) xcd_barrier(bar);
    }
    if (IN(5)) {
        for (int m = gw; m < T; m += NGW) norm_mod_row<true>(out + (size_t)m * D, g_norm_ffn, mod + (size_t)(m / S) * 6144, MOD_SHIFT_F, MOD_SCALE_F, hbuf + (size_t)m * D, lane, xq + (size_t)m * 1024, sxs + m);
        if (BOTH(5)) xcd_barrier(bar);
    }
    if (IN(6)) {
        pg8::Gemm g{hbuf, Wq_t, T, D, D}; pg8::StaticOrder So; So.init(T, D, G, (int)blockIdx.x);
        pg8::EpiF32Res E{qf, nullptr, nullptr};
        pg8::gemm_phase<pg8::EpiF32Res, pg8::StaticOrder, true, true>(lds + RING_OFF, g, So, E);
        if (BOTH(6)) xcd_barrier(bar);
    }
    if (IN(8)) {
        const int* eidx = (const int*)(ws + WS_EIDX); const float* gate = (const float*)(ws + WS_GATE);
        for (int tok = gw; tok < T; tok += NGW)
            peer_token(tok, xq, sxs, eidx, gate, uq, vq, su, sv, mod + (size_t)(tok / S) * 6144 + MOD_GATE_F, args.in[20], out, lane);
    }
#undef IN
#undef BOTH
}
__global__ void __launch_bounds__(256) k_mod(const float* __restrict__ c, const float* __restrict__ w_ada, const float* __restrict__ b_ada, float* __restrict__ mod,
                                             const float* lq1, const float* lk1, const float* lq2, const float* lk2, float* lam_out) {
    const int j = blockIdx.x * 256 + threadIdx.x, b = blockIdx.y;
    float acc = 0.f;
    for (int k = 0; k < D; ++k) { const float cv = c[b * D + k]; const float s = cv / (1.f + expf(-cv)); acc += s * w_ada[(size_t)k * 6144 + j]; }
    mod[b * 6144 + j] = acc + b_ada[j];
    if (blockIdx.x == 0 && blockIdx.y == 0 && threadIdx.x == 0) {
        float s1 = 0.f, s2 = 0.f;
        for (int i = 0; i < 64; ++i) { s1 += lq1[i] * lk1[i]; s2 += lq2[i] * lk2[i]; }
        lam_out[0] = expf(s1) - expf(s2) + 0.2f;
    }
}

__global__ void __launch_bounds__(256) k_kvnorm(const bf16_t* __restrict__ proj, const float* __restrict__ g_kv, bf16_t* __restrict__ kvn) {
    const int row = blockIdx.x * 4 + (threadIdx.x >> 6), lane = threadIdx.x & 63;
    const bf16_t* p = proj + (size_t)row * NPP + C_SKV;
    const float a = bf2f(p[lane]), b = bf2f(p[lane + 64]);
    const float ss = wave_sum(a * a + b * b);
    const float r = rsqrtf(ss * (1.f / 128.f) + EPS);
    kvn[(size_t)row * 128 + lane] = f2bf(a * r * g_kv[lane]);
    kvn[(size_t)row * 128 + lane + 64] = f2bf(b * r * g_kv[lane + 64]);
}

__global__ void __launch_bounds__(256) k_diff_naive(const bf16_t* __restrict__ proj, const float* __restrict__ rel_bias, const float* __restrict__ lam_p,
                                                    const float* __restrict__ g_subln, bf16_t* __restrict__ mixin) {
    __shared__ float l1[S], l2[S];
    __shared__ float qs[128];
    __shared__ float red[8];
    __shared__ float osum[256];
    const int tid = threadIdx.x;
    const int t = blockIdx.x % S, bh = blockIdx.x / S, h = bh & 3, b = bh >> 2;
    const size_t row = (size_t)b * S + t;
    if (tid < 128) qs[tid] = bf2f(proj[row * NPP + C_DQ + h * 128 + tid]);
    __syncthreads();
    float m1 = -INFINITY, m2 = -INFINITY;
    for (int s = tid; s <= t; s += 256) {
        const bf16_t* kr = proj + ((size_t)b * S + s) * NPP + C_DK + h * 128;
        float d1 = 0.f, d2 = 0.f;
        for (int d = 0; d < 64; ++d) { d1 += qs[d] * bf2f(kr[d]); d2 += qs[64 + d] * bf2f(kr[64 + d]); }
        const float bias = rel_bias[rel_bucket(t - s) * 8 + h];
        d1 = d1 * 0.125f + bias; d2 = d2 * 0.125f + bias;
        l1[s] = d1; l2[s] = d2; m1 = fmaxf(m1, d1); m2 = fmaxf(m2, d2);
    }
    m1 = block_max(m1, red); m2 = block_max(m2, red);
    float s1 = 0.f, s2 = 0.f;
    for (int s = tid; s <= t; s += 256) { const float e1 = expf(l1[s] - m1), e2 = expf(l2[s] - m2); l1[s] = e1; l2[s] = e2; s1 += e1; s2 += e2; }
    s1 = block_sum(s1, red); s2 = block_sum(s2, red);
    const float lam = lam_p[0];
    const float i1 = 1.f / s1, i2 = lam / s2;
    for (int s = tid; s <= t; s += 256) l1[s] = l1[s] * i1 - l2[s] * i2;
    __syncthreads();
    const int d = tid & 127, half = tid >> 7;
    float acc = 0.f;
    for (int s = half; s <= t; s += 2) acc += l1[s] * bf2f(proj[((size_t)b * S + s) * NPP + C_DV + h * 128 + d]);
    osum[tid] = acc;
    __syncthreads();
    float o = 0.f;
    if (tid < 128) o = osum[tid] + osum[tid + 128];
    const float ss = block_sum(tid < 128 ? o * o : 0.f, red);
    if (tid < 128) mixin[row * D + h * 128 + tid] = f2bf(o * rsqrtf(ss * (1.f / 128.f) + EPS) * g_subln[tid] * 0.8f);
}

__device__ __forceinline__ unsigned fkey(float f) { f = f + 0.0f; unsigned u = __float_as_uint(f); return (u & 0x80000000u) ? ~u : (u | 0x80000000u); }

__global__ void __launch_bounds__(256) k_dsa_naive(const bf16_t* __restrict__ proj, const bf16_t* __restrict__ kvn, const float* __restrict__ rel_bias,
                                                   const float* __restrict__ w_uv, bf16_t* __restrict__ mixin) {
    __shared__ float sc[S];
    __shared__ unsigned char selb[S];
    __shared__ float lg[4][S];
    __shared__ float iqs[512];
    __shared__ float iws[8];
    __shared__ float qs[512];
    __shared__ float red[8];
    __shared__ int redi[8];
    __shared__ float os[4][128];
    const int tid = threadIdx.x;
    const int t = blockIdx.x % S, b = blockIdx.x / S;
    const size_t row = (size_t)b * S + t;
    const bf16_t* pr = proj + row * NPP;
    iqs[tid] = bf2f(pr[C_IQ + tid]); iqs[tid + 256] = bf2f(pr[C_IQ + tid + 256]);
    qs[tid] = bf2f(pr[C_SQ + tid]); qs[tid + 256] = bf2f(pr[C_SQ + tid + 256]);
    if (tid < 8) iws[tid] = bf2f(pr[C_IW + tid]) * 0.35355339059327373f;
    __syncthreads();
    for (int s = tid; s <= t; s += 256) {
        const bf16_t* ik = proj + ((size_t)b * S + s) * NPP + C_IK;
        float ikf[64];
#pragma unroll
        for (int d = 0; d < 64; ++d) ikf[d] = bf2f(ik[d]);
        float score = 0.f;
        for (int hh = 0; hh < 8; ++hh) { float dd = 0.f;
#pragma unroll
            for (int d = 0; d < 64; ++d) dd += iqs[hh * 64 + d] * ikf[d];
            score += iws[hh] * fmaxf(dd * 0.125f, 0.f); }
        sc[s] = score;
    }
    __syncthreads();
    const int nk = t + 1;
    if (nk > 256) {
        unsigned prefix = 0u;
        for (int bit = 31; bit >= 0; --bit) {
            const unsigned cand = prefix | (1u << bit);
            int cnt = 0;
            for (int s = tid; s < nk; s += 256) cnt += (fkey(sc[s]) >= cand) ? 1 : 0;
            cnt = block_sum_i(cnt, redi);
            if (cnt >= 256) prefix = cand;
        }
        int cgt = 0;
        for (int s = tid; s < nk; s += 256) cgt += (fkey(sc[s]) > prefix) ? 1 : 0;
        cgt = block_sum_i(cgt, redi);
        for (int s = tid; s < nk; s += 256) selb[s] = (fkey(sc[s]) > prefix) ? 1 : 0;
        __syncthreads();
        if (tid == 0) { int need = 256 - cgt; for (int s = 0; s < nk && need > 0; ++s) if (fkey(sc[s]) == prefix) { selb[s] = 1; --need; } }
        __syncthreads();
    } else {
        for (int s = tid; s < nk; s += 256) selb[s] = 1;
        __syncthreads();
    }
    float mx[4] = {-INFINITY, -INFINITY, -INFINITY, -INFINITY};
    for (int s = tid; s < nk; s += 256) {
        if (selb[s]) {
            const bf16_t* kr = kvn + ((size_t)b * S + s) * 128;
            float d0 = 0.f, d1 = 0.f, d2 = 0.f, d3 = 0.f;
            for (int d = 0; d < 128; ++d) { const float kv = bf2f(kr[d]); d0 += qs[d] * kv; d1 += qs[128 + d] * kv; d2 += qs[256 + d] * kv; d3 += qs[384 + d] * kv; }
            const int bk = rel_bucket(t - s);
            const float sc128 = 0.08838834764831845f;
            d0 = d0 * sc128 + rel_bias[bk * 8 + 4]; d1 = d1 * sc128 + rel_bias[bk * 8 + 5]; d2 = d2 * sc128 + rel_bias[bk * 8 + 6]; d3 = d3 * sc128 + rel_bias[bk * 8 + 7];
            lg[0][s] = d0; lg[1][s] = d1; lg[2][s] = d2; lg[3][s] = d3;
            mx[0] = fmaxf(mx[0], d0); mx[1] = fmaxf(mx[1], d1); mx[2] = fmaxf(mx[2], d2); mx[3] = fmaxf(mx[3], d3);
        }
    }
    float sm[4];
    for (int hh = 0; hh < 4; ++hh) {
        mx[hh] = block_max(mx[hh], red);
        float su = 0.f;
        for (int s = tid; s < nk; s += 256) if (selb[s]) { const float e = expf(lg[hh][s] - mx[hh]); lg[hh][s] = e; su += e; }
        sm[hh] = block_sum(su, red);
    }
    __syncthreads();
    {
        const int d = tid & 127, hp = tid >> 7;
        float o0 = 0.f, o1 = 0.f;
        for (int s = 0; s < nk; ++s) if (selb[s]) { const float kv = bf2f(kvn[((size_t)b * S + s) * 128 + d]); o0 += lg[hp * 2][s] * kv; o1 += lg[hp * 2 + 1][s] * kv; }
        os[hp * 2][d] = o0 / sm[hp * 2]; os[hp * 2 + 1][d] = o1 / sm[hp * 2 + 1];
    }
    __syncthreads();
    {
        const int e = tid & 127, hp = tid >> 7;
        for (int hh = hp * 2; hh < hp * 2 + 2; ++hh) {
            float acc = 0.f;
            for (int cc = 0; cc < 128; ++cc) acc += os[hh][cc] * w_uv[((size_t)hh * 128 + cc) * 128 + e];
            mixin[row * D + 512 + hh * 128 + e] = f2bf(acc);
        }
    }
}

__device__ __forceinline__ void wave_argmax(float& v, int& i) {
#pragma unroll
    for (int o = 32; o >= 1; o >>= 1) { const float ov = __shfl_xor(v, o); const int oi = __shfl_xor(i, o); if (ov > v || (ov == v && oi < i)) { v = ov; i = oi; } }
}
__global__ void __launch_bounds__(256) k_peer_select(const float* __restrict__ qf, const float* __restrict__ keys, int* __restrict__ eidx, float* __restrict__ gate) {
    __shared__ float qsh[4][128];
    __shared__ float s12[4][2][16];
    __shared__ int i12[4][2][16];
    const int wid = threadIdx.x >> 6, lane = threadIdx.x & 63;
    const int th = blockIdx.x * 4 + wid, tok = th >> 3, h = th & 7;
    qsh[wid][lane] = qf[(size_t)tok * D + h * 128 + lane]; qsh[wid][lane + 64] = qf[(size_t)tok * D + h * 128 + lane + 64];
    __syncthreads();
    for (int p = 0; p < 2; ++p) {
        float v0 = 0.f, v1 = 0.f;
        const float* k0 = keys + (((size_t)h * 2 + p) * 128 + lane) * 64, *k1 = k0 + 64 * 64;
        for (int d = 0; d < 64; ++d) { const float q = qsh[wid][p * 64 + d]; v0 += q * k0[d]; v1 += q * k1[d]; }
        for (int r = 0; r < 16; ++r) {
            float bv; int bi;
            if (v0 >= v1) { bv = v0; bi = lane; } else { bv = v1; bi = lane + 64; }
            wave_argmax(bv, bi);
            if (lane == 0) { s12[wid][p][r] = bv; i12[wid][p][r] = bi; }
            if (bi == lane) v0 = -INFINITY; if (bi == lane + 64) v1 = -INFINITY;
        }
    }
    __syncthreads();
    float cv[4];
#pragma unroll
    for (int c = 0; c < 4; ++c) { const int pos = lane + 64 * c; cv[c] = s12[wid][0][pos >> 4] + s12[wid][1][pos & 15]; }
    float topv = 0.f; int tope = 0;
    for (int r = 0; r < 16; ++r) {
        float bv = cv[0]; int bi = lane;
#pragma unroll
        for (int c = 1; c < 4; ++c) if (cv[c] > bv) { bv = cv[c]; bi = lane + 64 * c; }
        wave_argmax(bv, bi);
#pragma unroll
        for (int c = 0; c < 4; ++c) if (bi == lane + 64 * c) cv[c] = -INFINITY;
        if (lane == r) { topv = bv; tope = i12[wid][0][bi >> 4] * 128 + i12[wid][1][bi & 15]; }
    }
    const float tmax = __shfl(topv, 0);
    const float e = lane < 16 ? expf(topv - tmax) : 0.f;
    const float su = wave_sum(e);
    if (lane < 16) { eidx[(size_t)tok * 128 + h * 16 + lane] = tope; gate[(size_t)tok * 128 + h * 16 + lane] = e / su; }
}

__global__ void __launch_bounds__(256) k_peer_gather_final(const bf16_t* __restrict__ h2, const int* __restrict__ eidx, const float* __restrict__ gate,
                                                           const float* __restrict__ u_tab, const float* __restrict__ v_tab, const float* __restrict__ mod,
                                                           const float* __restrict__ g_final, float* __restrict__ xio) {
    __shared__ float xs[D];
    __shared__ float wts[128];
    __shared__ int es[128];
    __shared__ float red[8];
    const int tid = threadIdx.x, wid = tid >> 6, lane = tid & 63;
    const size_t tok = blockIdx.x; const int b = (int)(tok / S);
    for (int i = tid; i < D; i += 256) xs[i] = bf2f(h2[tok * D + i]);
    if (tid < 128) es[tid] = eidx[tok * 128 + tid];
    __syncthreads();
    for (int k = wid * 32; k < wid * 32 + 32; ++k) {
        const float4* ur = (const float4*)(u_tab + (size_t)es[k] * D);
        float dsum = 0.f;
#pragma unroll
        for (int i = 0; i < 4; ++i) { const float4 u = ur[lane + 64 * i]; const float* xx = xs + (lane + 64 * i) * 4; dsum += u.x * xx[0] + u.y * xx[1] + u.z * xx[2] + u.w * xx[3]; }
        dsum = wave_sum(dsum);
        if (lane == 0) wts[k] = gate[tok * 128 + k] * 0.5f * dsum * (1.f + erff(dsum * 0.70710678118654752f));
    }
    __syncthreads();
    float4 acc = {0.f, 0.f, 0.f, 0.f};
    for (int k = 0; k < 128; ++k) { const float4 v = *(const float4*)(v_tab + (size_t)es[k] * D + tid * 4); const float w = wts[k]; acc.x += w * v.x; acc.y += w * v.y; acc.z += w * v.z; acc.w += w * v.w; }
    const float4 x1 = *(const float4*)(xio + tok * D + tid * 4);
    const float4 gf = *(const float4*)(mod + b * 6144 + MOD_GATE_F + tid * 4);
    float4 y; y.x = x1.x + gf.x * acc.x; y.y = x1.y + gf.y * acc.y; y.z = x1.z + gf.z * acc.z; y.w = x1.w + gf.w * acc.w;
    const float ss = block_sum(y.x * y.x + y.y * y.y + y.z * y.z + y.w * y.w, red);
    const float r = rsqrtf(ss * (1.f / D) + EPS);
    const float4 g4 = *(const float4*)(g_final + tid * 4);
    float4 o; o.x = y.x * r * g4.x; o.y = y.y * r * g4.y; o.z = y.z * r * g4.z; o.w = y.w * r * g4.w;
    *(float4*)(xio + tok * D + tid * 4) = o;
}

extern "C" void kernel_launch(void* const* d_in, const int* in_sizes, int n_in, void* d_out, int out_size, void* d_ws, size_t ws_size, hipStream_t stream) {
    static int grid = 0;
    if (grid == 0) {
        if (n_in != 21 || out_size != T * D || ws_size < WS_END) { fprintf(stderr, "kernel_launch: unexpected shapes (n_in %d out %d ws %zu)\n", n_in, out_size, ws_size); grid = -1; return; }
        int dev = 0, cus = 0, per_cu = 0;
        if (hipGetDevice(&dev) != hipSuccess || hipDeviceGetAttribute(&cus, hipDeviceAttributeMultiprocessorCount, dev) != hipSuccess) { grid = -1; return; }
        if (hipFuncSetAttribute((const void*)fwd, hipFuncAttributeMaxDynamicSharedMemorySize, LDS_BYTES) != hipSuccess) { fprintf(stderr, "kernel_launch: hipFuncSetAttribute failed\n"); grid = -1; return; }
        if (hipOccupancyMaxActiveBlocksPerMultiprocessor(&per_cu, (const void*)fwd, NTHREADS, LDS_BYTES) != hipSuccess || per_cu < 1)
            fprintf(stderr, "kernel_launch: occupancy query reports %d workgroups per CU\n", per_cu);
        (void)hipGetLastError();
        grid = cus;
        if (grid != 256) fprintf(stderr, "kernel_launch: %d CUs (expected 256)\n", grid);
    }
    if (grid < 0) return;
    const float* c = (const float*)d_in[1];
    const float* w_ada = (const float*)d_in[2];
    const float* b_ada = (const float*)d_in[3];
    const float* g_subln = (const float*)d_in[10];
    const float* g_kv = (const float*)d_in[11];
    const float* w_uv = (const float*)d_in[12];
    const float* peer_keys = (const float*)d_in[16];
    const float* peer_u = (const float*)d_in[17];
    const float* peer_v = (const float*)d_in[18];
    const float* rel_bias = (const float*)d_in[19];
    const float* g_final = (const float*)d_in[20];
    float* out = (float*)d_out;
    unsigned char* ws = (unsigned char*)d_ws;
    float* mod = (float*)(ws + WS_MOD); float* lam = (float*)(ws + WS_LAM);
    bf16_t* hbuf = (bf16_t*)(ws + WS_HBUF); bf16_t* mixin = (bf16_t*)(ws + WS_MIXIN); bf16_t* kvn = (bf16_t*)(ws + WS_KVN);
    int* eidx = (int*)(ws + WS_EIDX); float* gate = (float*)(ws + WS_GATE);
    bf16_t* proj = (bf16_t*)(ws + WS_BIG); float* qf = (float*)(ws + WS_BIG);

    (void)hipMemsetAsync(ws + WS_CTL, 0, CTL_ZERO_BYTES, stream);
    Args a{};
    for (int i = 0; i < 21; ++i) a.in[i] = (const float*)d_in[i];
    a.out = out; a.ws = ws;

    k_mod<<<dim3(24, NB), 256, 0, stream>>>(c, w_ada, b_ada, mod, (const float*)d_in[6], (const float*)d_in[7], (const float*)d_in[8], (const float*)d_in[9], lam);
    a.ph_lo = 0; a.ph_hi = 4; a.li = 0;
    hipLaunchKernelGGL(fwd, dim3(grid), dim3(NTHREADS), LDS_BYTES, stream, a);
    k_kvnorm<<<T / 4, 256, 0, stream>>>(proj, g_kv, kvn);
    k_dsa_naive<<<T, 256, 0, stream>>>(proj, kvn, rel_bias, w_uv, mixin);
    a.ph_lo = 4; a.ph_hi = 7; a.li = 1;
    hipLaunchKernelGGL(fwd, dim3(grid), dim3(NTHREADS), LDS_BYTES, stream, a);
    k_peer_select<<<T * 8 / 4, 256, 0, stream>>>(qf, peer_keys, eidx, gate);
    a.ph_lo = 8; a.ph_hi = 9; a.li = 2;
    hipLaunchKernelGGL(fwd, dim3(grid), dim3(NTHREADS), LDS_BYTES, stream, a);
}
```

```cpp
#include <hip/hip_runtime.h>
#include <stdint.h>
#include <stdio.h>

typedef unsigned short bf16_t;
#define LAS __attribute__((address_space(3)))
#define GAS __attribute__((address_space(1)))

constexpr int D = 1024, NB = 32, S = 2048, T = NB * S;
constexpr int NP = 2760, NPP = 2816;
constexpr int C_DQ = 0, C_DK = 512, C_DV = 1024, C_SQ = 1536, C_SKV = 2048, C_IQ = 2176, C_IK = 2688, C_IW = 2752;
constexpr int MOD_SHIFT_A = 0, MOD_SCALE_A = 1024, MOD_GATE_A = 2048, MOD_SHIFT_F = 3072, MOD_SCALE_F = 4096, MOD_GATE_F = 5120;
constexpr float EPS = 1e-6f;
constexpr int NWAVES = 8, NTHREADS = 512;

__device__ __forceinline__ float bf2f(bf16_t v) { return __uint_as_float(((unsigned)v) << 16); }
__device__ __forceinline__ bf16_t f2bf(float f) { unsigned u = __float_as_uint(f); u += 0x7fffu + ((u >> 16) & 1u); return (bf16_t)(u >> 16); }
__device__ __forceinline__ unsigned pk2(float lo, float hi) { return (unsigned)f2bf(lo) | ((unsigned)f2bf(hi) << 16); }

__device__ __forceinline__ int rel_bucket(int n) {
    if (n < 16) return n < 0 ? 0 : n;
    int b = 16;
    b += (n >= 19); b += (n >= 21); b += (n >= 24); b += (n >= 27); b += (n >= 31); b += (n >= 35); b += (n >= 40); b += (n >= 46);
    b += (n >= 52); b += (n >= 59); b += (n >= 67); b += (n >= 77); b += (n >= 87); b += (n >= 99); b += (n >= 113);
    return b;
}

__device__ __forceinline__ float wave_sum(float v) {
#pragma unroll
    for (int o = 32; o >= 1; o >>= 1) v += __shfl_xor(v, o);
    return v;
}
__device__ __forceinline__ float wave_max(float v) {
#pragma unroll
    for (int o = 32; o >= 1; o >>= 1) v = fmaxf(v, __shfl_xor(v, o));
    return v;
}
__device__ __forceinline__ float block_sum(float v, float* red) {
    v = wave_sum(v);
    __syncthreads();
    if ((threadIdx.x & 63) == 0) red[threadIdx.x >> 6] = v;
    __syncthreads();
    return red[0] + red[1] + red[2] + red[3];
}
__device__ __forceinline__ float block_max(float v, float* red) {
    v = wave_max(v);
    __syncthreads();
    if ((threadIdx.x & 63) == 0) red[threadIdx.x >> 6] = v;
    __syncthreads();
    return fmaxf(fmaxf(red[0], red[1]), fmaxf(red[2], red[3]));
}
__device__ __forceinline__ int block_sum_i(int v, int* red) {
#pragma unroll
    for (int o = 32; o >= 1; o >>= 1) v += __shfl_xor(v, o);
    __syncthreads();
    if ((threadIdx.x & 63) == 0) red[threadIdx.x >> 6] = v;
    __syncthreads();
    return red[0] + red[1] + red[2] + red[3];
}

namespace pg8 {
#define PG8_LAS __attribute__((address_space(3)))
typedef unsigned short bf16_t;
typedef short bf16x8 __attribute__((ext_vector_type(8)));
typedef float f32x4 __attribute__((ext_vector_type(4)));
typedef unsigned u32x4 __attribute__((ext_vector_type(4)));
constexpr int BM = 256, BK = 64, HALF = 128, HTB = HALF * BK * 2  , STAGE_BYTES = 8 * HTB, NXCD = 8, WGM = 8;

__host__ __device__ __forceinline__ int lds_byte(int r, int c) { const int st = (r >> 4) * 2 + (c >> 5), rr = r & 15, cc = c & 31, ob = rr * 64 + cc * 2; return st * 1024 + (ob ^ (((ob >> 9) & 1) << 5)); }
__host__ __device__ __forceinline__ void stage_rc(int b, int& R, int& C) { const int st = b / 1024, sb = b % 1024, swz = sb ^ (((sb >> 9) & 1) << 5); R = (st >> 1) * 16 + swz / 64; C = (st & 1) * 32 + (swz % 64) / 2; }
__host__ __device__ __forceinline__ int perm32(int rho) { const int n = rho >> 4, i = rho & 15; return 8 * (i >> 2) + 4 * n + (i & 3); }

struct Unit { int pm, pn; };
struct Gemm { const bf16_t* A; const bf16_t* Bt; int M, N, K; };

struct StaticOrder {
    int nM, nN, nwg, G, c;
    __host__ __device__ void init(int M, int N, int G_, int c_) { nM = M / BM; nN = N / BM; nwg = nM * nN; G = G_; c = c_; }
    __host__ __device__ bool next(int i, Unit& u) const {
        const long L = (long)i * G + c; if (L >= nwg) return false;
        int wgid = (int)L; { const int q = nwg / NXCD, r = nwg % NXCD, xcd = wgid % NXCD, off = wgid / NXCD; wgid = (xcd < r ? xcd * (q + 1) : r * (q + 1) + (xcd - r) * q) + off; }
        const int nig = WGM * nN, gid = wgid / nig, fm = gid * WGM, gsz = (nM - fm) < WGM ? (nM - fm) : WGM;
        u.pm = fm + ((wgid % nig) % gsz); u.pn = (wgid % nig) / gsz; return true;
    }
    __device__ __forceinline__ void a_ready(const Unit&) const {}
    __device__ __forceinline__ void done(const Unit&) const {}
};
__device__ __forceinline__ unsigned cvt_pk_bf16(float lo, float hi) { unsigned r; asm volatile("v_cvt_pk_bf16_f32 %0, %1, %2" : "=v"(r) : "v"(lo), "v"(hi)); return r; }
typedef float f32x2 __attribute__((ext_vector_type(2)));
struct EpiBf16Plain {
    static constexpr bool PERM = true, AFTER_DRAIN = false;
    bf16_t* O; int ldc;
    __device__ __forceinline__ void operator()(const f32x4 (&acc)[2][2][4][2], const Unit& u, int wr, int wc, int fr, int fq) const {
        const int row0 = u.pm * BM + wr * 64 + fr, col0 = u.pn * BM + wc * 32 + 8 * fq;
#pragma unroll
        for (int ai = 0; ai < 2; ++ai)
#pragma unroll
            for (int m = 0; m < 4; ++m) { bf16_t* rowp = O + (size_t)(row0 + ai * HALF + m * 16) * ldc + col0;
#pragma unroll
                for (int bj = 0; bj < 2; ++bj) { const f32x4 v0 = acc[ai][bj][m][0], v1 = acc[ai][bj][m][1];
                    u32x4 w; w.x = cvt_pk_bf16(v0[0], v0[1]); w.y = cvt_pk_bf16(v0[2], v0[3]); w.z = cvt_pk_bf16(v1[0], v1[1]); w.w = cvt_pk_bf16(v1[2], v1[3]);
                    *(u32x4*)(rowp + bj * HALF) = w; } }
    }
};
struct EpiF32Res {
    static constexpr bool PERM = false, AFTER_DRAIN = false;
    float* C; const float* res; const float* gate;
    __device__ __forceinline__ void operator()(const f32x4 (&acc)[2][2][4][2], const Unit& u, int wr, int wc, int fr, int fq) const {
        const int row0 = u.pm * BM + wr * 64 + fr, col0 = u.pn * BM + wc * 32 + 4 * fq;
        f32x4 gv[2][2];
#pragma unroll
        for (int bj = 0; bj < 2; ++bj)
#pragma unroll
            for (int n = 0; n < 2; ++n) gv[bj][n] = res ? *(const f32x4*)(gate + (size_t)(u.pm >> 3) * 6144 + col0 + bj * HALF + n * 16) : (f32x4){1.f, 1.f, 1.f, 1.f};
#pragma unroll
        for (int ai = 0; ai < 2; ++ai)
#pragma unroll
            for (int m = 0; m < 4; ++m) { const size_t off = (size_t)(row0 + ai * HALF + m * 16) * 1024 + col0;
#pragma unroll
                for (int bj = 0; bj < 2; ++bj)
#pragma unroll
                    for (int n = 0; n < 2; ++n) { f32x4 o = acc[ai][bj][m][n] * gv[bj][n];
                        if (res) o = o + *(const f32x4*)(res + off + bj * HALF + n * 16);
                        *(f32x4*)(C + off + bj * HALF + n * 16) = o; } }
    }
};

template <class Epi, class Sched, bool ALIGN_EPI = false, bool SP2 = false>
__device__ __forceinline__ void gemm_phase(PG8_LAS unsigned char* lds, const Gemm g, const Sched& S, const Epi& E) {
    const int tid = threadIdx.x, wid = __builtin_amdgcn_readfirstlane(tid >> 6), lane = tid & 63, wr = wid >> 2, wc = wid & 3, fr = lane & 15, fq = lane >> 4;
    const int K = g.K, nt = K / BK;
    unsigned voffA[2], voffB[2];
#pragma unroll
    for (int i = 0; i < 2; ++i) { int R, C; stage_rc(tid * 16 + i * 8192, R, C); const int Rb = Epi::PERM ? ((R & ~31) + perm32(R & 31)) : R;
        voffA[i] = (unsigned)(R * K + C) * 2u; voffB[i] = (unsigned)(Rb * K + C) * 2u; }
    const size_t kstep = (size_t)(BK * 2);
    const size_t hstep = (size_t)HALF * K * 2;
    const size_t tstep = 2 * hstep;
    const unsigned ldsw = (unsigned)wid * 1024u;
    const int aoff = lds_byte(wr * 64 + fr, fq * 8), boff = lds_byte(wc * 32 + fr, fq * 8);
#define PG8_SA(b, h) (((b) * 2 + (h)) * HTB)
#define PG8_SB(b, h) ((4 + (b) * 2 + (h)) * HTB)
#define PG8_STAGE(bufoff, gbase, voff) do { _Pragma("unroll") for (int _i = 0; _i < 2; ++_i) \
        __builtin_amdgcn_global_load_lds((const unsigned*)((const char*)(gbase) + (voff)[_i]), (PG8_LAS unsigned*)(lds + (bufoff) + ldsw + _i * 8192), 16, 0, 0); } while (0)
#define PG8_LDA(dst, b, h) do { _Pragma("unroll") for (int m = 0; m < 4; ++m) _Pragma("unroll") for (int k = 0; k < 2; ++k) dst[m][k] = *(const PG8_LAS bf16x8*)(lds + PG8_SA(b, h) + aoff + m * 2048 + k * 1024); } while (0)
#define PG8_LDB(dst, b, h) do { _Pragma("unroll") for (int n = 0; n < 2; ++n) _Pragma("unroll") for (int k = 0; k < 2; ++k) dst[n][k] = *(const PG8_LAS bf16x8*)(lds + PG8_SB(b, h) + boff + n * 2048 + k * 1024); } while (0)
#define PG8_MMA(ai, bj, At, Bt) do { __builtin_amdgcn_s_setprio(1); _Pragma("unroll") for (int m = 0; m < 4; ++m) _Pragma("unroll") for (int n = 0; n < 2; ++n) _Pragma("unroll") for (int k = 0; k < 2; ++k) \
        acc[ai][bj][m][n] = __builtin_amdgcn_mfma_f32_16x16x32_bf16(Bt[n][k], At[m][k], acc[ai][bj][m][n], 0, 0, 0); __builtin_amdgcn_s_setprio(0); } while (0)
#define PG8_WAIT_V(n) asm volatile("s_waitcnt vmcnt(" #n ")" ::: "memory")
#define PG8_WAIT_L(n) asm volatile("s_waitcnt lgkmcnt(" #n ")" ::: "memory")
#define PG8_BAR __builtin_amdgcn_s_barrier()
#define PG8_SCHED __builtin_amdgcn_sched_barrier(0)
    Unit cur, nxt; int ui = 0;
    if (!S.next(0, cur)) return;
    f32x4 acc[2][2][4][2];
#pragma unroll
    for (int a = 0; a < 2; ++a)
#pragma unroll
        for (int b = 0; b < 2; ++b)
#pragma unroll
            for (int m = 0; m < 4; ++m)
#pragma unroll
                for (int n = 0; n < 2; ++n) acc[a][b][m][n] = (f32x4){0.f, 0.f, 0.f, 0.f};
    bf16x8 At[4][2], B0[2][2], B1[2][2];
    const char* cA = (const char*)g.A + (size_t)cur.pm * tstep; const char* cB = (const char*)g.Bt + (size_t)cur.pn * tstep;
    S.a_ready(cur);
    if constexpr (SP2) {
        PG8_STAGE(PG8_SB(0, 0), cB, voffB); PG8_STAGE(PG8_SB(0, 1), cB + hstep, voffB); PG8_STAGE(PG8_SA(0, 0), cA, voffA); PG8_STAGE(PG8_SA(0, 1), cA + hstep, voffA);
        if (wr == 1) PG8_BAR;
        PG8_WAIT_V(2); PG8_BAR;
        PG8_STAGE(PG8_SB(1, 0), cB + kstep, voffB); PG8_STAGE(PG8_SA(1, 0), cA + kstep, voffA); PG8_STAGE(PG8_SB(1, 1), cB + hstep + kstep, voffB);
        PG8_WAIT_V(6); PG8_BAR;
    } else {
        PG8_STAGE(PG8_SB(0, 0), cB, voffB); PG8_STAGE(PG8_SA(0, 0), cA, voffA); PG8_STAGE(PG8_SB(0, 1), cB + hstep, voffB); PG8_STAGE(PG8_SA(0, 1), cA + hstep, voffA);
        if (wr == 1) PG8_BAR;
        PG8_WAIT_V(4); PG8_BAR;
        PG8_STAGE(PG8_SB(1, 0), cB + kstep, voffB); PG8_STAGE(PG8_SA(1, 0), cA + kstep, voffA); PG8_STAGE(PG8_SB(1, 1), cB + hstep + kstep, voffB);
        PG8_WAIT_V(6); PG8_BAR;
    }
    for (;;) {
        const bool has_next = S.next(ui + 1, nxt);
        const char* nA = has_next ? (const char*)g.A + (size_t)nxt.pm * tstep : cA; const char* nB = has_next ? (const char*)g.Bt + (size_t)nxt.pn * tstep : cB;
        for (int t = 0; t < nt; t += 2) {
            const bool last = (t == nt - 2);
            const char* a1 = cA + (size_t)(t + 1) * kstep;
            const char* a2 = last ? nA : cA + (size_t)(t + 2) * kstep; const char* b2 = last ? nB : cB + (size_t)(t + 2) * kstep;
            const char* a3 = a2 + kstep; const char* b3 = b2 + kstep;
            if (last && has_next) S.a_ready(nxt);
            if constexpr (SP2) {
            PG8_LDB(B0, 0, 0); PG8_LDB(B1, 0, 1); PG8_SCHED; PG8_LDA(At, 0, 0); PG8_STAGE(PG8_SA(1, 1), a1 + hstep, voffA);
            PG8_WAIT_V(8); PG8_WAIT_L(0); PG8_BAR; PG8_MMA(0, 0, At, B0); PG8_MMA(0, 1, At, B1); PG8_BAR; PG8_SCHED;
            PG8_LDA(At, 0, 1); PG8_STAGE(PG8_SB(0, 0), b2, voffB); PG8_STAGE(PG8_SB(0, 1), b2 + hstep, voffB); PG8_STAGE(PG8_SA(0, 0), a2, voffA);
            PG8_WAIT_V(8); PG8_WAIT_L(0); PG8_BAR; PG8_MMA(1, 0, At, B0); PG8_MMA(1, 1, At, B1); PG8_BAR; PG8_SCHED;
            PG8_LDB(B0, 1, 0); PG8_LDB(B1, 1, 1); PG8_SCHED; PG8_LDA(At, 1, 0); PG8_STAGE(PG8_SA(0, 1), a2 + hstep, voffA);
            PG8_WAIT_V(8); PG8_WAIT_L(0); PG8_BAR; PG8_MMA(0, 0, At, B0); PG8_MMA(0, 1, At, B1); PG8_BAR; PG8_SCHED;
            PG8_LDA(At, 1, 1); PG8_STAGE(PG8_SB(1, 0), b3, voffB); PG8_STAGE(PG8_SB(1, 1), b3 + hstep, voffB); PG8_STAGE(PG8_SA(1, 0), a3, voffA);
            PG8_WAIT_V(8); PG8_WAIT_L(0); PG8_BAR; PG8_MMA(1, 0, At, B0); PG8_MMA(1, 1, At, B1); PG8_BAR; PG8_SCHED;
            } else {
            PG8_LDB(B0, 0, 0); PG8_SCHED; PG8_LDA(At, 0, 0); PG8_STAGE(PG8_SA(1, 1), a1 + hstep, voffA);
            PG8_WAIT_L(8); PG8_BAR; PG8_WAIT_L(0); PG8_MMA(0, 0, At, B0); PG8_BAR; PG8_SCHED;
            PG8_LDB(B1, 0, 1); PG8_STAGE(PG8_SB(0, 0), b2, voffB);
            PG8_BAR; PG8_WAIT_L(0); PG8_MMA(0, 1, At, B1); PG8_BAR;
            PG8_LDA(At, 0, 1); PG8_STAGE(PG8_SA(0, 0), a2, voffA);
            PG8_BAR; PG8_WAIT_L(0); PG8_MMA(1, 0, At, B0); PG8_BAR; PG8_SCHED;
            PG8_STAGE(PG8_SB(0, 1), b2 + hstep, voffB);
            PG8_WAIT_V(6); PG8_BAR; PG8_MMA(1, 1, At, B1); PG8_BAR;
            PG8_LDB(B0, 1, 0); PG8_SCHED; PG8_LDA(At, 1, 0); PG8_STAGE(PG8_SA(0, 1), a2 + hstep, voffA);
            PG8_WAIT_L(8); PG8_BAR; PG8_WAIT_L(0); PG8_MMA(0, 0, At, B0); PG8_BAR; PG8_SCHED;
            PG8_LDB(B1, 1, 1); PG8_STAGE(PG8_SB(1, 0), b3, voffB);
            PG8_BAR; PG8_WAIT_L(0); PG8_MMA(0, 1, At, B1); PG8_BAR;
            PG8_LDA(At, 1, 1); PG8_STAGE(PG8_SA(1, 0), a3, voffA);
            PG8_BAR; PG8_WAIT_L(0); PG8_MMA(1, 0, At, B0); PG8_BAR; PG8_SCHED;
            PG8_STAGE(PG8_SB(1, 1), b3 + hstep, voffB);
            PG8_WAIT_V(6); PG8_BAR; PG8_MMA(1, 1, At, B1); PG8_BAR;
            }
        }
        if constexpr (ALIGN_EPI) { if (wr == 0) PG8_BAR; }
        if constexpr (!Epi::AFTER_DRAIN) { E(acc, cur, wr, wc, fr, fq); S.done(cur); }
        if (!has_next) break;
#pragma unroll
        for (int a = 0; a < 2; ++a)
#pragma unroll
            for (int b = 0; b < 2; ++b)
#pragma unroll
                for (int m = 0; m < 4; ++m)
#pragma unroll
                    for (int n = 0; n < 2; ++n) acc[a][b][m][n] = (f32x4){0.f, 0.f, 0.f, 0.f};
        cur = nxt; cA = nA; cB = nB; ++ui;
        if constexpr (ALIGN_EPI) { if (wr == 1) PG8_BAR; }
    }
    PG8_WAIT_V(0);
    if constexpr (!ALIGN_EPI) { if (wr == 0) PG8_BAR; }
    PG8_BAR;
    if constexpr (Epi::AFTER_DRAIN) { E.fused(acc, cur, wr, wc, fr, fq, lds, wid, lane); S.done(cur); }
#undef PG8_SA
#undef PG8_SB
#undef PG8_STAGE
#undef PG8_LDA
#undef PG8_LDB
#undef PG8_MMA
#undef PG8_WAIT_V
#undef PG8_WAIT_L
#undef PG8_BAR
#undef PG8_SCHED
}
}
#define XB_TMO      128
#define XB_XCNT(j)  (256  + 64 * (j))
#define XB_XSUB(j)  (1280 + 64 * (j))
#define XB_XGEN(j)  (2304 + 64 * (j))
#define XB_TOP      3328
#define XB_TOPGEN   3392
#define XCD_BAR_WORDS 3456
#define XB_SPIN_CAP (1u << 18)

__device__ __forceinline__ unsigned xb_ld(unsigned* p)              { return __hip_atomic_load(p, __ATOMIC_RELAXED, __HIP_MEMORY_SCOPE_AGENT); }
__device__ __forceinline__ unsigned xb_add(unsigned* p, unsigned v) { return __hip_atomic_fetch_add(p, v, __ATOMIC_RELAXED, __HIP_MEMORY_SCOPE_AGENT); }
__device__ __forceinline__ unsigned xb_xcc_id() { return (unsigned)__builtin_amdgcn_s_getreg((3 << 11) | 20) & 0xFu; }
#define XB_SPIN(cond, bar) do { unsigned _sp = 0; while (cond) { __builtin_amdgcn_s_sleep(1); \
    if ((++_sp & 255u) == 0u) { if (xb_ld(&(bar)[XB_TMO])) break; if (_sp > XB_SPIN_CAP) { atomicAdd(&(bar)[XB_TMO], 1u); break; } } } } while (0)

struct XcdBarrier {
    unsigned* bar; unsigned x;
    volatile LAS unsigned* st;
};

__device__ __forceinline__ XcdBarrier xcd_barrier_post(unsigned* bar, volatile LAS unsigned* st) {
    XcdBarrier b; b.bar = bar; b.x = xb_xcc_id(); b.st = st;
    if (threadIdx.x == 0) (void)xb_add(&bar[XB_XCNT(b.x)], 1u);
    return b;
}
__device__ __forceinline__ void xcd_barrier_complete(unsigned* bar, unsigned x, unsigned& nloc, unsigned& nx) {
    const unsigned G = gridDim.x * gridDim.y * gridDim.z;
    unsigned sum, cnt, mine, sp = 0u;
    for (;;) {
        sum = 0u; cnt = 0u; mine = 0u;
#pragma unroll
        for (unsigned j = 0; j < 16; ++j) { const unsigned c = xb_ld(&bar[XB_XCNT(j)]); sum += c; cnt += (c > 0u) ? 1u : 0u; mine = (j == x) ? c : mine; }
        if (sum == G) break;
        __builtin_amdgcn_s_sleep(1);
        if ((++sp & 255u) == 0u) { if (xb_ld(&bar[XB_TMO])) break; if (sp > XB_SPIN_CAP) { atomicAdd(&bar[XB_TMO], 1u); break; } }
    }
    nloc = mine > 0u ? mine : 1u; nx = cnt > 0u ? cnt : 1u;
}

__device__ __forceinline__ void xcd_barrier(const XcdBarrier& b) {
    asm volatile("s_waitcnt vmcnt(0)" ::: "memory");
    __syncthreads();
    if (threadIdx.x == 0) {
        unsigned* bar = b.bar;
        __builtin_amdgcn_s_waitcnt(0);
        unsigned nloc = b.st[0], nx = b.st[1];
        if (nloc == 0u) { xcd_barrier_complete(bar, b.x, nloc, nx); b.st[0] = nloc; b.st[1] = nx; }
        const unsigned old = xb_add(&bar[XB_XSUB(b.x)], 1u);
        const unsigned gen = old / nloc;
        if (old + 1u == (gen + 1u) * nloc) {
            __builtin_amdgcn_fence(__ATOMIC_RELEASE, "agent");
            asm volatile("s_waitcnt vmcnt(0)" ::: "memory");
            const unsigned og = xb_add(&bar[XB_TOP], 1u);
            const unsigned tg = og / nx;
            if (og + 1u == (tg + 1u) * nx) xb_add(&bar[XB_TOPGEN], 1u);
            else XB_SPIN(xb_ld(&bar[XB_TOPGEN]) == tg, bar);
            __builtin_amdgcn_fence(__ATOMIC_ACQUIRE, "agent");
            xb_add(&bar[XB_XGEN(b.x)], 1u);
            asm volatile("s_waitcnt vmcnt(0)" ::: "memory");
        } else {
            XB_SPIN(xb_ld(&bar[XB_XGEN(b.x)]) == gen, bar);
            __builtin_amdgcn_fence(__ATOMIC_ACQUIRE, "agent");
            asm volatile("s_waitcnt vmcnt(0)" ::: "memory");
        }
    }
    __syncthreads();
}

typedef short bf16x8_t __attribute__((ext_vector_type(8)));
typedef unsigned u32x4_t __attribute__((ext_vector_type(4)));
typedef unsigned u32x2_t __attribute__((ext_vector_type(2)));
typedef short s16x4_t __attribute__((ext_vector_type(4)));
typedef float f32x16_t __attribute__((ext_vector_type(16)));
typedef float f32x2_t __attribute__((ext_vector_type(2)));
typedef __bf16 bf16x2_t __attribute__((ext_vector_type(2)));
#define MFMA32(a, b, c) __builtin_amdgcn_mfma_f32_32x32x16_bf16((a), (b), (c), 0, 0, 0)
constexpr float LOG2E = 1.4426950408889634f;

__device__ __forceinline__ int crow(int r, int hi) { return (r & 3) + 8 * (r >> 2) + 4 * hi; }
__device__ __forceinline__ unsigned cvtpk(float lo, float hi) { f32x2_t v = {lo, hi}; bf16x2_t b = __builtin_convertvector(v, bf16x2_t); return __builtin_bit_cast(unsigned, b); }
__device__ __forceinline__ s16x4_t vtr(const LAS unsigned char* p) { return __builtin_bit_cast(s16x4_t, __builtin_amdgcn_ds_read_tr16_b64_v4i16((LAS s16x4_t*)p)); }
__device__ __forceinline__ float xhalf_max(float m) { auto rr = __builtin_amdgcn_permlane32_swap(__float_as_uint(m), __float_as_uint(m), false, false); return fmaxf(__uint_as_float(rr[0]), __uint_as_float(rr[1])); }
__device__ __forceinline__ float xhalf_sum(float m) { auto rr = __builtin_amdgcn_permlane32_swap(__float_as_uint(m), __float_as_uint(m), false, false); return __uint_as_float(rr[0]) + __uint_as_float(rr[1]); }
__device__ __forceinline__ bf16x8_t pack8(const f32x16_t& p, int s) {
    u32x4_t u; u.x = cvtpk(p[8 * s + 0], p[8 * s + 1]); u.y = cvtpk(p[8 * s + 2], p[8 * s + 3]); u.z = cvtpk(p[8 * s + 4], p[8 * s + 5]); u.w = cvtpk(p[8 * s + 6], p[8 * s + 7]);
    return __builtin_bit_cast(bf16x8_t, u);
}

constexpr int DA_KBUF = 0, DA_VBUF = 32768, DA_BIAS = 65536, DA_LDS = 65536 + 1024;
__device__ __forceinline__ void diff_unit(const bf16_t* __restrict__ proj, bf16_t* __restrict__ mixin, const float* __restrict__ rel_bias, const float lam, const float* __restrict__ g_subln,
                                          LAS unsigned char* lds, int b, int h, int qt, int tid, int lane, int wave) {
    const int rg = wave >> 1, map = wave & 1, r32 = lane & 31, hh = lane >> 5;
    const int t0 = 128 * qt + 32 * rg;
    const int ntb = 2 * qt + 2;
    const int ntw = (t0 + 31) / 64 + 1;
    const size_t rowbase = (size_t)b * S;
    LAS float* biasT = (LAS float*)(lds + DA_BIAS);
    if (tid < 256) biasT[tid] = rel_bias[rel_bucket(tid) * 8 + h] * LOG2E;
    const float c31 = rel_bias[31 * 8 + h] * LOG2E;
    bf16x8_t qf[4];
    { const bf16_t* qrow = proj + (rowbase + t0 + r32) * NPP + C_DQ + h * 128 + map * 64 + 8 * hh;
#pragma unroll
      for (int ks = 0; ks < 4; ++ks) qf[ks] = *(const bf16x8_t*)(qrow + 16 * ks); }
    const int skey = tid >> 4, sc = tid & 15;
    const bf16_t* kg = proj + (rowbase + skey) * NPP + C_DK + h * 128 + 8 * sc;
    const bf16_t* vg = proj + (rowbase + skey) * NPP + C_DV + h * 128 + 8 * sc;
    const unsigned koff0 = skey * 256 + ((sc ^ (skey & 15)) * 16), koff1 = koff0 + 32 * 256;
    const unsigned voff0 = (sc >> 2) * 4096 + skey * 64 + (sc & 3) * 16, voff1 = voff0 + 32 * 64;
    u32x4_t sk0, sk1, sv0, sv1;
#define DA_LOAD(j) do { const size_t o_ = (size_t)(64 * (j)) * NPP; sk0 = *(const u32x4_t*)(kg + o_); sk1 = *(const u32x4_t*)(kg + o_ + (size_t)32 * NPP); sv0 = *(const u32x4_t*)(vg + o_); sv1 = *(const u32x4_t*)(vg + o_ + (size_t)32 * NPP); } while (0)
#define DA_WRITE(bf) do { LAS unsigned char* kb_ = lds + DA_KBUF + (bf) * 16384; LAS unsigned char* vb_ = lds + DA_VBUF + (bf) * 16384; \
        *(LAS u32x4_t*)(kb_ + koff0) = sk0; *(LAS u32x4_t*)(kb_ + koff1) = sk1; *(LAS u32x4_t*)(vb_ + voff0) = sv0; *(LAS u32x4_t*)(vb_ + voff1) = sv1; } while (0)
    DA_LOAD(0); DA_WRITE(0);
    __syncthreads();
    f32x16_t O[4];
#pragma unroll
    for (int i = 0; i < 4; ++i)
#pragma unroll
        for (int r = 0; r < 16; ++r) O[i][r] = 0.f;
    float m = -INFINITY, l = 0.f;
    const int t = t0 + r32;
    const float SC = 0.125f * LOG2E;
    const int i16 = lane & 15, tq = i16 >> 2, tp = i16 & 3, g1 = (lane >> 4) & 1;
    const unsigned vrd = (4 * hh + tq) * 64 + g1 * 32 + tp * 8;
    const unsigned krd = r32 * 256;
    for (int j = 0; j < ntb; ++j) {
        if (j + 1 < ntb) DA_LOAD(j + 1);
        if (j < ntw) {
            const LAS unsigned char* kb = lds + DA_KBUF + (j & 1) * 16384; const LAS unsigned char* vb = lds + DA_VBUF + (j & 1) * 16384;
            f32x16_t s0, s1;
#pragma unroll
            for (int r = 0; r < 16; ++r) { s0[r] = 0.f; s1[r] = 0.f; }
#pragma unroll
            for (int ks = 0; ks < 4; ++ks) {
                const int chunk = map * 8 + 2 * ks + hh;
                const unsigned co = (unsigned)((chunk ^ (r32 & 15)) * 16);
                const bf16x8_t a0 = *(const LAS bf16x8_t*)(kb + krd + co), a1 = *(const LAS bf16x8_t*)(kb + krd + 32 * 256 + co);
                s0 = MFMA32(a0, qf[ks], s0); s1 = MFMA32(a1, qf[ks], s1);
            }
            const int kbase = 64 * j + 4 * hh;
            const bool nearb = (t0 - (64 * j + 63)) < 113;
            const bool diag = (64 * j + 63) > t0;
            if (nearb) {
#pragma unroll
                for (int r = 0; r < 16; ++r) { const int key = kbase + (r & 3) + 8 * (r >> 2);
                    int d0 = t - key, d1 = d0 - 32; d0 = d0 < 0 ? 0 : d0; d1 = d1 < 0 ? 0 : d1;
                    s0[r] = s0[r] * SC + biasT[d0]; s1[r] = s1[r] * SC + biasT[d1];
                    if (diag) { if (key > t) s0[r] = -INFINITY; if (key + 32 > t) s1[r] = -INFINITY; } }
            } else {
#pragma unroll
                for (int r = 0; r < 16; ++r) { s0[r] = s0[r] * SC + c31; s1[r] = s1[r] * SC + c31; }
            }
            float mt = fmaxf(s0[0], s1[0]);
#pragma unroll
            for (int r = 1; r < 16; ++r) mt = fmaxf(mt, fmaxf(s0[r], s1[r]));
            mt = xhalf_max(mt);
            const float mn = fmaxf(m, mt);
            const float alpha = __builtin_amdgcn_exp2f(m - mn);
            m = mn;
            float ps = 0.f;
#pragma unroll
            for (int r = 0; r < 16; ++r) { s0[r] = __builtin_amdgcn_exp2f(s0[r] - mn); s1[r] = __builtin_amdgcn_exp2f(s1[r] - mn); ps += s0[r] + s1[r]; }
            l = l * alpha + ps;
            if (__any(alpha != 1.f)) {
#pragma unroll
                for (int i = 0; i < 4; ++i)
#pragma unroll
                    for (int r = 0; r < 16; ++r) O[i][r] *= alpha;
            }
            bf16x8_t pb[2][2];
            pb[0][0] = pack8(s0, 0); pb[0][1] = pack8(s0, 1); pb[1][0] = pack8(s1, 0); pb[1][1] = pack8(s1, 1);
#pragma unroll
            for (int sub = 0; sub < 2; ++sub)
#pragma unroll
                for (int s = 0; s < 2; ++s)
#pragma unroll
                    for (int dblk = 0; dblk < 4; ++dblk) {
                        const LAS unsigned char* vp = vb + dblk * 4096 + (32 * sub + 16 * s) * 64 + vrd;
                        const s16x4_t lo = vtr(vp), hi = vtr(vp + 8 * 64);
                        const bf16x8_t va = __builtin_shufflevector(lo, hi, 0, 1, 2, 3, 4, 5, 6, 7);
                        O[dblk] = MFMA32(va, pb[sub][s], O[dblk]);
                    }
        }
        if (j + 1 < ntb) DA_WRITE((j + 1) & 1);
        __syncthreads();
    }
#undef DA_LOAD
#undef DA_WRITE
    l = xhalf_sum(l);
    const float inv = (map ? lam : 1.f) / l;
    LAS float* ex = (LAS float*)(lds + rg * 16384);
    if (map == 1) {
#pragma unroll
        for (int i = 0; i < 4; ++i)
#pragma unroll
            for (int r = 0; r < 16; ++r) ex[(i * 16 + r) * 64 + lane] = O[i][r] * inv;
    }
    __syncthreads();
    if (map == 0) {
        float ss = 0.f;
#pragma unroll
        for (int i = 0; i < 4; ++i)
#pragma unroll
            for (int r = 0; r < 16; ++r) { const float o = O[i][r] * inv - ex[(i * 16 + r) * 64 + lane]; O[i][r] = o; ss += o * o; }
        ss = xhalf_sum(ss);
        const float rn = rsqrtf(ss * (1.f / 128.f) + EPS) * 0.8f;
        bf16_t* orow = mixin + (rowbase + t) * D + h * 128;
#pragma unroll
        for (int i = 0; i < 4; ++i)
#pragma unroll
            for (int g = 0; g < 4; ++g) { const int d0 = 32 * i + 8 * g + 4 * hh; const float4 gs = *(const float4*)(g_subln + d0);
                uint2 o; o.x = cvtpk(O[i][4 * g + 0] * rn * gs.x, O[i][4 * g + 1] * rn * gs.y); o.y = cvtpk(O[i][4 * g + 2] * rn * gs.z, O[i][4 * g + 3] * rn * gs.w);
                *(uint2*)(orow + d0) = o; }
    }
    __syncthreads();
}

__device__ __forceinline__ unsigned fkey(float f) { f = f + 0.0f; const unsigned u = __float_as_uint(f); return (u & 0x80000000u) ? ~u : (u | 0x80000000u); }
__device__ __forceinline__ void dsa_index_unit(const bf16_t* __restrict__ proj, unsigned* __restrict__ maskw, LAS unsigned char* lds, int b, int u16, int tid, int lane, int wave) {
    const int t_base = 16 * u16, ntile = ((t_base + 15) >> 5) + 1;
    const size_t rowbase = (size_t)b * S;
    LAS float* sc = (LAS float*)lds;
    const int r32 = lane & 31, hh = lane >> 5;
    {
        const int tg = wave & 3, kp = wave >> 2;
        const int hsel = (r32 >> 2) & 1, q = (r32 & 3) + 4 * (r32 >> 3), tokl = 2 * hsel + (q >> 3), head = q & 7;
        const bf16_t* ap = proj + (rowbase + t_base + 4 * tg + tokl) * NPP + C_IQ + head * 64 + 8 * hh;
        bf16x8_t af[4];
#pragma unroll
        for (int ks = 0; ks < 4; ++ks) af[ks] = *(const bf16x8_t*)(ap + 16 * ks);
        float wv[16];
#pragma unroll
        for (int r = 0; r < 16; ++r) wv[r] = bf2f(proj[(rowbase + t_base + 4 * tg + 2 * hh + (r >> 3)) * NPP + C_IW + (r & 7)]) * (0.35355339059327373f * 0.125f);
        const int tl = 4 * tg + 2 * hh, tA = t_base + tl;
        for (int tile = kp; tile < ntile; tile += 2) {
            const bf16_t* bp = proj + (rowbase + 32 * tile + r32) * NPP + C_IK + 8 * hh;
            bf16x8_t bfr[4];
#pragma unroll
            for (int ks = 0; ks < 4; ++ks) bfr[ks] = *(const bf16x8_t*)(bp + 16 * ks);
            f32x16_t acc;
#pragma unroll
            for (int r = 0; r < 16; ++r) acc[r] = 0.f;
#pragma unroll
            for (int ks = 0; ks < 4; ++ks) acc = MFMA32(af[ks], bfr[ks], acc);
            float sA = 0.f, sB = 0.f;
#pragma unroll
            for (int r = 0; r < 8; ++r) { sA += wv[r] * fmaxf(acc[r], 0.f); sB += wv[8 + r] * fmaxf(acc[8 + r], 0.f); }
            const int key = 32 * tile + r32;
            sc[tl * 2048 + key] = key <= tA ? sA : -INFINITY;
            sc[(tl + 1) * 2048 + key] = key <= tA + 1 ? sB : -INFINITY;
        }
    }
    __syncthreads();
#pragma unroll 1
    for (int tt = 0; tt < 2; ++tt) {
        const int tl = 2 * wave + tt, t = t_base + tl, nk = t + 1;
        unsigned* mrow = maskw + (rowbase + t) * 64;
        if (nk <= 256) {
            const int w0 = 32 * lane;
            unsigned v = 0u;
            if (w0 + 31 <= t) v = 0xFFFFFFFFu; else if (w0 <= t) v = (1u << (t - w0 + 1)) - 1u;
            mrow[lane] = v;
        } else {
            unsigned key[32];
#pragma unroll
            for (int i = 0; i < 32; ++i) { const int idx = lane + 64 * i; const float v = sc[tl * 2048 + (idx < nk ? idx : 0)]; key[i] = idx < nk ? fkey(v) : 0u; }
            unsigned prefix = 0u; bool exact = false;
#pragma unroll 1
            for (int bit = 31; bit >= 0; --bit) {
                const unsigned cand = prefix | (1u << bit);
                int c = 0;
#pragma unroll
                for (int i = 0; i < 32; ++i) c += __builtin_popcountll(__ballot(key[i] >= cand));
                if (c >= 256) prefix = cand;
                if (c == 256) { exact = true; break; }
            }
            unsigned long long mine = 0ull;
            if (exact) {
#pragma unroll
                for (int i = 0; i < 32; ++i) { const unsigned long long bal = __ballot(key[i] >= prefix); if (lane == i) mine = bal; }
            } else {
                int cgt = 0;
#pragma unroll
                for (int i = 0; i < 32; ++i) cgt += __builtin_popcountll(__ballot(key[i] > prefix));
                const int need = 256 - cgt; int running = 0;
                const unsigned long long lt = (1ull << lane) - 1ull;
#pragma unroll
                for (int i = 0; i < 32; ++i) {
                    const bool eq = key[i] == prefix; const unsigned long long be = __ballot(eq);
                    const int rank = running + __builtin_popcountll(be & lt);
                    const bool sel = key[i] > prefix || (eq && rank < need);
                    running += __builtin_popcountll(be);
                    const unsigned long long bal = __ballot(sel); if (lane == i) mine = bal;
                }
            }
            if (lane < 32) *(unsigned long long*)(mrow + 2 * lane) = mine;
        }
    }
    __syncthreads();
}

constexpr int DB_KV = 0, DB_BIAS = 32768, DB_Q = 36864, DB_LDS = 36864 + 65536;
__device__ __forceinline__ void dsa_attn_unit(const bf16_t* __restrict__ proj, const unsigned* __restrict__ maskw, const bf16_t* __restrict__ wuvF, const float* __restrict__ rel_bias, const float* __restrict__ g_kv,
                                              bf16_t* __restrict__ mixin, LAS unsigned char* lds, int b, int u64, int tid, int lane, int wave) {
    const int head = wave & 3, tgrp = wave >> 2, r32 = lane & 31, hh = lane >> 5;
    const int t0 = 64 * u64 + 32 * tgrp, t = t0 + r32;
    const int ntb = u64 + 1;
    const size_t rowbase = (size_t)b * S;
    LAS float* biasT = (LAS float*)(lds + DB_BIAS);
    for (int i = tid; i < 1024; i += NTHREADS) biasT[i] = rel_bias[rel_bucket(i & 255) * 8 + 4 + (i >> 8)] * LOG2E;
    const float c31 = rel_bias[31 * 8 + 4 + head] * LOG2E;
    LAS unsigned char* ql = lds + DB_Q + wave * 8192 + lane * 16;
    { const bf16_t* qrow = proj + (rowbase + t) * NPP + C_SQ + head * 128 + 8 * hh;
#pragma unroll
      for (int ks = 0; ks < 8; ++ks) *(LAS bf16x8_t*)(ql + 1024 * ks) = *(const bf16x8_t*)(qrow + 16 * ks); }
    const int skey = tid >> 4, sc = tid & 15;
    const bf16_t* sg = proj + (rowbase + skey) * NPP + C_SKV + 8 * sc;
    const unsigned soff0 = (sc >> 2) * 4096 + skey * 64 + (((sc & 3) ^ ((skey >> 2) & 3)) * 16), soff1 = soff0 + 32 * 64;
    u32x4_t raw0, raw1; u32x2_t mw, mwn;
    const unsigned* mrow = maskw + (rowbase + t) * 64;
#define DB_LOAD(j) do { const size_t o_ = (size_t)(64 * (j)) * NPP; raw0 = *(const u32x4_t*)(sg + o_); raw1 = *(const u32x4_t*)(sg + o_ + (size_t)32 * NPP); mwn = *(const u32x2_t*)(mrow + 2 * (j)); } while (0)
#define DB_NORM1(raw, off) do { float f_[8]; float ss_ = 0.f; \
        _Pragma("unroll") for (int jj = 0; jj < 4; ++jj) { f_[2 * jj] = __uint_as_float(raw[jj] << 16); f_[2 * jj + 1] = __uint_as_float(raw[jj] & 0xffff0000u); ss_ += f_[2 * jj] * f_[2 * jj] + f_[2 * jj + 1] * f_[2 * jj + 1]; } \
        ss_ += __shfl_xor(ss_, 1); ss_ += __shfl_xor(ss_, 2); ss_ += __shfl_xor(ss_, 4); ss_ += __shfl_xor(ss_, 8); \
        const float rr_ = rsqrtf(ss_ * (1.f / 128.f) + EPS); u32x4_t o_; const float4 ga_ = *(const float4*)(g_kv + 8 * sc), gb_ = *(const float4*)(g_kv + 8 * sc + 4); const float gk[8] = {ga_.x, ga_.y, ga_.z, ga_.w, gb_.x, gb_.y, gb_.z, gb_.w}; \
        _Pragma("unroll") for (int jj = 0; jj < 4; ++jj) o_[jj] = cvtpk(f_[2 * jj] * rr_ * gk[2 * jj], f_[2 * jj + 1] * rr_ * gk[2 * jj + 1]); \
        *(LAS u32x4_t*)(kvb_ + (off)) = o_; } while (0)
#define DB_WRITE(bf) do { LAS unsigned char* kvb_ = lds + DB_KV + (bf) * 16384; DB_NORM1(raw0, soff0); DB_NORM1(raw1, soff1); } while (0)
    DB_LOAD(0); DB_WRITE(0); mw = mwn;
    __syncthreads();
    f32x16_t O[4];
#pragma unroll
    for (int i = 0; i < 4; ++i)
#pragma unroll
        for (int r = 0; r < 16; ++r) O[i][r] = 0.f;
    float m = -1e30f, l = 0.f;
    const float SC = 0.08838834764831845f * LOG2E;
    const int i16 = lane & 15, tq = i16 >> 2, tp = i16 & 3, g1 = (lane >> 4) & 1;
    const unsigned vrd_lo = (4 * hh + tq) * 64 + (((2 * g1 + (tp >> 1)) ^ (hh & 3)) * 16) + 8 * (tp & 1);
    const unsigned vrd_hi = (4 * hh + 8 + tq) * 64 + (((2 * g1 + (tp >> 1)) ^ ((hh + 2) & 3)) * 16) + 8 * (tp & 1);
    const unsigned kx = (unsigned)((r32 >> 2) & 3);
    const LAS float* bT = biasT + head * 256;
    for (int j = 0; j < ntb; ++j) {
        if (j + 1 < ntb) DB_LOAD(j + 1);
        {
            const LAS unsigned char* kvb = lds + DB_KV + (j & 1) * 16384;
            const bool nearb = (t0 - (64 * j + 63)) < 113;
#pragma unroll 1
            for (int sub = 0; sub < 2; ++sub) {
                f32x16_t s0;
#pragma unroll
                for (int r = 0; r < 16; ++r) s0[r] = 0.f;
                const LAS unsigned char* kvs = kvb + sub * (32 * 64);
#pragma unroll
                for (int ks = 0; ks < 8; ++ks) {
                    const int c16 = 2 * ks + hh;
                    const unsigned ao = (unsigned)((c16 >> 2) * 4096 + r32 * 64) + (((unsigned)(c16 & 3) ^ kx) * 16u);
                    const bf16x8_t a0 = *(const LAS bf16x8_t*)(kvs + ao);
                    const bf16x8_t qk = *(const LAS bf16x8_t*)(ql + 1024 * ks);
                    s0 = MFMA32(a0, qk, s0);
                }
                const int kbase = 64 * j + 32 * sub + 4 * hh;
                const unsigned w0 = (sub ? mw.y : mw.x) >> (4 * hh);
                if (nearb) {
#pragma unroll
                    for (int r = 0; r < 16; ++r) { const int key = kbase + (r & 3) + 8 * (r >> 2);
                        int d0 = t - key; d0 = d0 < 0 ? 0 : d0;
                        s0[r] = s0[r] * SC + bT[d0]; }
                } else {
#pragma unroll
                    for (int r = 0; r < 16; ++r) s0[r] = s0[r] * SC + c31;
                }
#pragma unroll
                for (int r = 0; r < 16; ++r) { const int bp = (r & 3) + 8 * (r >> 2); if (!((w0 >> bp) & 1u)) s0[r] = -INFINITY; }
                float mt = s0[0];
#pragma unroll
                for (int r = 1; r < 16; ++r) mt = fmaxf(mt, s0[r]);
                mt = xhalf_max(mt);
                const float mn = fmaxf(m, mt);
                const float alpha = __builtin_amdgcn_exp2f(m - mn);
                m = mn;
                float ps = 0.f;
#pragma unroll
                for (int r = 0; r < 16; ++r) { s0[r] = __builtin_amdgcn_exp2f(s0[r] - mn); ps += s0[r]; }
                l = l * alpha + ps;
                if (__any(alpha != 1.f)) {
#pragma unroll
                    for (int i = 0; i < 4; ++i)
#pragma unroll
                        for (int r = 0; r < 16; ++r) O[i][r] *= alpha;
                }
                bf16x8_t pb[2];
                pb[0] = pack8(s0, 0); pb[1] = pack8(s0, 1);
#pragma unroll
                for (int s = 0; s < 2; ++s)
#pragma unroll
                    for (int dblk = 0; dblk < 4; ++dblk) {
                        const LAS unsigned char* vp = kvs + dblk * 4096 + (16 * s) * 64;
                        const s16x4_t lo = vtr(vp + vrd_lo), hi = vtr(vp + vrd_hi);
                        const bf16x8_t va = __builtin_shufflevector(lo, hi, 0, 1, 2, 3, 4, 5, 6, 7);
                        O[dblk] = MFMA32(va, pb[s], O[dblk]);
                    }
            }
        }
        if (j + 1 < ntb) { DB_WRITE((j + 1) & 1); mw = mwn; }
        __syncthreads();
    }
#undef DB_LOAD
#undef DB_NORM1
#undef DB_WRITE
    l = xhalf_sum(l);
    const float inv = 1.f / l;
#pragma unroll
    for (int i = 0; i < 4; ++i)
#pragma unroll
        for (int r = 0; r < 16; ++r) O[i][r] *= inv;
    bf16x8_t ob[4][2];
#pragma unroll
    for (int i = 0; i < 4; ++i) { ob[i][0] = pack8(O[i], 0); ob[i][1] = pack8(O[i], 1); }
    bf16_t* orow = mixin + (rowbase + t) * D + 512 + head * 128;
#pragma unroll 1
    for (int eb = 0; eb < 4; ++eb) {
        f32x16_t acc;
#pragma unroll
        for (int r = 0; r < 16; ++r) acc[r] = 0.f;
#pragma unroll
        for (int i = 0; i < 4; ++i)
#pragma unroll
            for (int s = 0; s < 2; ++s) {
                const bf16x8_t wa = *(const bf16x8_t*)(wuvF + ((((size_t)(head * 4 + eb) * 4 + i) * 2 + s) * 64 + lane) * 8);
                acc = MFMA32(wa, ob[i][s], acc);
            }
#pragma unroll
        for (int g = 0; g < 4; ++g) { const int e0 = 32 * eb + 8 * g + 4 * hh;
            u32x2_t o; o.x = cvtpk(acc[4 * g + 0], acc[4 * g + 1]); o.y = cvtpk(acc[4 * g + 2], acc[4 * g + 3]);
            *(u32x2_t*)(orow + e0) = o; }
    }
}

constexpr size_t MiB = 1u << 20;
constexpr size_t WS_CTL = 0, CTL_ZERO_BYTES = 1 * MiB;
constexpr size_t WS_MOD = 1 * MiB;
constexpr size_t WS_LAM = 1 * MiB + 800 * 1024;
constexpr size_t WS_WIN_T = 2 * MiB;
constexpr size_t WS_WO_T = 8 * MiB;
constexpr size_t WS_WQ_T = 10 * MiB;
constexpr size_t WS_HBUF = 16 * MiB;
constexpr size_t WS_MIXIN = 144 * MiB;
constexpr size_t WS_MASK = 272 * MiB;
constexpr size_t WS_WUVF = 12 * MiB;
constexpr size_t WS_EIDX = 288 * MiB;
constexpr size_t WS_GATE = 320 * MiB;
constexpr size_t WS_BIG = 352 * MiB;
constexpr size_t WS_UQ = 704 * MiB;
constexpr size_t WS_VQ = 720 * MiB;
constexpr size_t WS_SU = 736 * MiB;
constexpr size_t WS_SV = 736 * MiB + 65536;
constexpr size_t WS_XQ = 737 * MiB;
constexpr size_t WS_SX = 801 * MiB;
constexpr size_t WS_END = 802 * MiB;
constexpr int CW_BAR = 4096;
constexpr int MAX_FWD_LAUNCHES = 8;
static_assert((CW_BAR + MAX_FWD_LAUNCHES * XCD_BAR_WORDS) * 4 <= (int)CTL_ZERO_BYTES, "barrier words inside the memset region");

constexpr int RING_OFF = 0, RING_BYTES = 131072;
constexpr int LDSCTL_OFF = RING_BYTES, MISC_OFF = LDSCTL_OFF + 320;
constexpr int LDS_BYTES = 147456;

struct Args { const float* in[21]; float* out; unsigned char* ws; int ph_lo, ph_hi, li, pad; };

__device__ __forceinline__ void p0_transpose_item(const float* W, int K, int N, int Npad, bf16_t* WT, LAS float* scr, int item, int lane) {
    const int nblk = Npad / 32, kb = item / nblk, nb = item % nblk, k0 = 64 * kb, n0 = 32 * nb;
    const int n_in = n0 + (lane & 31);
#pragma unroll 8
    for (int i = 0; i < 32; ++i) { const int kk = 2 * i + (lane >> 5); scr[kk * 33 + (lane & 31)] = n_in < N ? W[(size_t)(k0 + kk) * N + n_in] : 0.f; }
    asm volatile("s_waitcnt lgkmcnt(0)" ::: "memory");
    const int c = lane & 7;
#pragma unroll
    for (int j = 0; j < 4; ++j) { const int n = (lane >> 3) + 8 * j; const LAS float* s = scr + (8 * c) * 33 + n;
        uint4 o; o.x = pk2(s[0 * 33], s[1 * 33]); o.y = pk2(s[2 * 33], s[3 * 33]); o.z = pk2(s[4 * 33], s[5 * 33]); o.w = pk2(s[6 * 33], s[7 * 33]);
        *(uint4*)(WT + (size_t)(n0 + n) * K + k0 + 8 * c) = o; }
    asm volatile("s_waitcnt lgkmcnt(0)" ::: "memory");
}

template <int OFFS> __device__ __forceinline__ void quant_row(const float4 (&v)[4], unsigned char* qrow, float* scale_out, int lane);
template <bool QUANT>
__device__ __forceinline__ void norm_mod_row(const float* xrow, const float* g, const float* mb, int shift_off, int scale_off, bf16_t* orow, int lane, unsigned char* qrow, float* qscale) {
    const float4* xr = (const float4*)xrow;
    float4 v[4]; float ss = 0.f;
#pragma unroll
    for (int i = 0; i < 4; ++i) { v[i] = xr[lane + 64 * i]; ss += v[i].x * v[i].x + v[i].y * v[i].y + v[i].z * v[i].z + v[i].w * v[i].w; }
    ss = wave_sum(ss);
    const float r = rsqrtf(ss * (1.f / D) + EPS);
#pragma unroll
    for (int i = 0; i < 4; ++i) {
        const int col = (lane + 64 * i) * 4;
        const float4 gg = *(const float4*)(g + col), sc = *(const float4*)(mb + scale_off + col), sh = *(const float4*)(mb + shift_off + col);
        v[i].x = v[i].x * r * gg.x * (1.f + sc.x) + sh.x; v[i].y = v[i].y * r * gg.y * (1.f + sc.y) + sh.y;
        v[i].z = v[i].z * r * gg.z * (1.f + sc.z) + sh.z; v[i].w = v[i].w * r * gg.w * (1.f + sc.w) + sh.w;
        uint2 o; o.x = pk2(v[i].x, v[i].y); o.y = pk2(v[i].z, v[i].w);
        *(uint2*)(orow + col) = o;
    }
    if (QUANT) quant_row<0>(v, qrow, qscale, lane);
}

template <int OFFS>
__device__ __forceinline__ void quant_row(const float4 (&v)[4], unsigned char* qrow, float* scale_out, int lane) {
    float am = 0.f;
#pragma unroll
    for (int i = 0; i < 4; ++i) am = fmaxf(am, fmaxf(fmaxf(fabsf(v[i].x), fabsf(v[i].y)), fmaxf(fabsf(v[i].z), fabsf(v[i].w))));
    am = wave_max(am);
    const float sc = am > 0.f ? am * (1.f / 127.f) : 1.f, inv = am > 0.f ? 127.f / am : 0.f;
    uint4 o; unsigned w[4];
#pragma unroll
    for (int i = 0; i < 4; ++i) {
        const int q0 = (int)rintf(v[i].x * inv) + OFFS, q1 = (int)rintf(v[i].y * inv) + OFFS, q2 = (int)rintf(v[i].z * inv) + OFFS, q3 = (int)rintf(v[i].w * inv) + OFFS;
        w[i] = (unsigned)(q0 & 255) | ((unsigned)(q1 & 255) << 8) | ((unsigned)(q2 & 255) << 16) | ((unsigned)(q3 & 255) << 24);
    }
    o.x = w[0]; o.y = w[1]; o.z = w[2]; o.w = w[3];
    *(uint4*)(qrow + 16 * lane) = o;
    if (lane == 0) *scale_out = sc;
}
__device__ __forceinline__ void quant_table_row(const float* row, unsigned char* qrow, float* scale_out, int lane, bool offs) {
    float4 v[4];
#pragma unroll
    for (int i = 0; i < 4; ++i) v[i] = ((const float4*)row)[lane + 64 * i];
    if (offs) quant_row<128>(v, qrow, scale_out, lane); else quant_row<0>(v, qrow, scale_out, lane);
}

__device__ __forceinline__ int treduce16(int (&v)[16], int lane) {
#pragma unroll
    for (int o = 8, n = 16; o >= 1; o >>= 1, n >>= 1) {
        const bool upper = (lane & o) != 0;
#pragma unroll
        for (int j = 0; j < n / 2; ++j) {
            const int keep = upper ? v[j + n / 2] : v[j];
            const int send = upper ? v[j] : v[j + n / 2];
            v[j] = keep + __shfl_xor(send, o);
        }
    }
    int t = v[0];
    t += __shfl_xor(t, 16); t += __shfl_xor(t, 32);
    return t;
}
__device__ __forceinline__ float gelu_erf(float a) { return 0.5f * a * (1.f + erff(a * 0.70710678118654752f)); }

__device__ __forceinline__ void peer_token(int tok, const unsigned char* __restrict__ xq, const float* __restrict__ sxs, const int* __restrict__ eidx, const float* __restrict__ gate,
                                           const unsigned char* __restrict__ uq, const unsigned char* __restrict__ vq, const float* __restrict__ su, const float* __restrict__ sv,
                                           const float* __restrict__ gate_f, const float* __restrict__ g_final, float* xio, int lane) {
    const uint4 x4 = *(const uint4*)(xq + (size_t)tok * 1024 + 16 * lane);
    const float sx = sxs[tok];
    const int e0 = eidx[(size_t)tok * 128 + lane], e1 = eidx[(size_t)tok * 128 + 64 + lane];
    const float g0 = gate[(size_t)tok * 128 + lane], g1 = gate[(size_t)tok * 128 + 64 + lane];
    float w0 = 0.f, w1 = 0.f;
#pragma unroll 1
    for (int batch = 0; batch < 2; ++batch) {
        const int er = batch ? e1 : e0;
        int tot = 0;
#pragma unroll 1
        for (int g = 0; g < 4; ++g) {
            uint4 rows[16]; int acc[16];
#pragma unroll
            for (int j = 0; j < 16; ++j) { const int e = __builtin_amdgcn_readlane(er, 16 * g + j); rows[j] = *(const uint4*)(uq + (size_t)e * 1024 + 16 * lane); }
#pragma unroll
            for (int j = 0; j < 16; ++j) {
                int a = __builtin_amdgcn_sdot4((int)rows[j].x, (int)x4.x, 0, false);
                a = __builtin_amdgcn_sdot4((int)rows[j].y, (int)x4.y, a, false);
                a = __builtin_amdgcn_sdot4((int)rows[j].z, (int)x4.z, a, false);
                a = __builtin_amdgcn_sdot4((int)rows[j].w, (int)x4.w, a, false);
                acc[j] = a;
            }
            const int t16 = treduce16(acc, lane);
            if ((lane >> 4) == g) tot = t16;
        }
        const float a = (float)tot * sx * su[er];
        const float w = (batch ? g1 : g0) * gelu_erf(a) * sv[er];
        if (batch) w1 = w; else w0 = w;
    }
    const float wsum = wave_sum(w0 + w1);
    float acc[16];
#pragma unroll
    for (int i = 0; i < 16; ++i) acc[i] = 0.f;
#pragma unroll 1
    for (int g = 0; g < 8; ++g) {
        const int er = g < 4 ? e0 : e1; const float wr = g < 4 ? w0 : w1;
        uint4 rows[16]; float wk[16];
#pragma unroll
        for (int j = 0; j < 16; ++j) { const int ln = 16 * (g & 3) + j; const int e = __builtin_amdgcn_readlane(er, ln); wk[j] = __int_as_float(__builtin_amdgcn_readlane(__float_as_int(wr), ln));
            rows[j] = *(const uint4*)(vq + (size_t)e * 1024 + 16 * lane); }
#pragma unroll
        for (int j = 0; j < 16; ++j) {
            const unsigned r0 = rows[j].x, r1 = rows[j].y, r2 = rows[j].z, r3 = rows[j].w; const float w = wk[j];
            acc[0] += w * (float)(r0 & 255u); acc[1] += w * (float)((r0 >> 8) & 255u); acc[2] += w * (float)((r0 >> 16) & 255u); acc[3] += w * (float)(r0 >> 24);
            acc[4] += w * (float)(r1 & 255u); acc[5] += w * (float)((r1 >> 8) & 255u); acc[6] += w * (float)((r1 >> 16) & 255u); acc[7] += w * (float)(r1 >> 24);
            acc[8] += w * (float)(r2 & 255u); acc[9] += w * (float)((r2 >> 8) & 255u); acc[10] += w * (float)((r2 >> 16) & 255u); acc[11] += w * (float)(r2 >> 24);
            acc[12] += w * (float)(r3 & 255u); acc[13] += w * (float)((r3 >> 8) & 255u); acc[14] += w * (float)((r3 >> 16) & 255u); acc[15] += w * (float)(r3 >> 24);
        }
    }
    float4 y[4]; float ss = 0.f; const float corr = 128.f * wsum;
#pragma unroll
    for (int i = 0; i < 4; ++i) {
        const int col = 256 * i + 4 * lane;
        const float4 x1 = *(const float4*)(xio + (size_t)tok * D + col), gf = *(const float4*)(gate_f + col);
        y[i].x = x1.x + gf.x * (acc[4 * i + 0] - corr); y[i].y = x1.y + gf.y * (acc[4 * i + 1] - corr);
        y[i].z = x1.z + gf.z * (acc[4 * i + 2] - corr); y[i].w = x1.w + gf.w * (acc[4 * i + 3] - corr);
        ss += y[i].x * y[i].x + y[i].y * y[i].y + y[i].z * y[i].z + y[i].w * y[i].w;
    }
    ss = wave_sum(ss);
    const float r = rsqrtf(ss * (1.f / D) + EPS);
#pragma unroll
    for (int i = 0; i < 4; ++i) {
        const int col = 256 * i + 4 * lane; const float4 gg = *(const float4*)(g_final + col);
        float4 o; o.x = y[i].x * r * gg.x; o.y = y[i].y * r * gg.y; o.z = y[i].z * r * gg.z; o.w = y[i].w * r * gg.w;
        *(float4*)(xio + (size_t)tok * D + col) = o;
    }
}

__global__ void __launch_bounds__(NTHREADS, 2) fwd(Args args) {
    extern __shared__ __attribute__((aligned(16))) unsigned char lds_raw[];
    LAS unsigned char* lds = (LAS unsigned char*)lds_raw;
    volatile LAS unsigned* MISC = (volatile LAS unsigned*)(lds + MISC_OFF);
    const int wave = __builtin_amdgcn_readfirstlane(threadIdx.x >> 6);
#define LANE_ID() ((int)__builtin_amdgcn_mbcnt_hi(~0u, __builtin_amdgcn_mbcnt_lo(~0u, 0u)))
    const int G = gridDim.x;
    unsigned char* ws = args.ws;
    unsigned* ctl = (unsigned*)(ws + WS_CTL);
    for (int u = threadIdx.x; u < (LDS_BYTES - LDSCTL_OFF) / 4; u += NTHREADS) ((LAS unsigned*)(lds + LDSCTL_OFF))[u] = 0u;
    __syncthreads();
    XcdBarrier bar = xcd_barrier_post(ctl + CW_BAR + args.li * XCD_BAR_WORDS, MISC + 8);
    const int lo = args.ph_lo, hi = args.ph_hi;
#define IN(k) (lo <= (k) && (k) < hi)
#define BOTH(k) (IN(k) && IN((k) + 1))
    const float* x = args.in[0];
    const float* g_norm_mix = args.in[4];
    const float* w_in = args.in[5];
    const float* w_out = args.in[13];
    const float* g_norm_ffn = args.in[14];
    const float* w_peer_q = args.in[15];
    float* out = args.out;
    const float* mod = (const float*)(ws + WS_MOD);
    bf16_t* Win_t = (bf16_t*)(ws + WS_WIN_T); bf16_t* Wo_t = (bf16_t*)(ws + WS_WO_T); bf16_t* Wq_t = (bf16_t*)(ws + WS_WQ_T);
    bf16_t* hbuf = (bf16_t*)(ws + WS_HBUF); bf16_t* mixin = (bf16_t*)(ws + WS_MIXIN);
    bf16_t* proj = (bf16_t*)(ws + WS_BIG); float* qf = (float*)(ws + WS_BIG);
    unsigned* maskw = (unsigned*)(ws + WS_MASK); bf16_t* wuvF = (bf16_t*)(ws + WS_WUVF);
    unsigned char* uq = ws + WS_UQ; unsigned char* vq = ws + WS_VQ; float* su = (float*)(ws + WS_SU); float* sv = (float*)(ws + WS_SV);
    unsigned char* xq = ws + WS_XQ; float* sxs = (float*)(ws + WS_SX);
    const int gw = blockIdx.x * NWAVES + wave, NGW = G * NWAVES;
    const int vcu = (G % 8 == 0) ? ((int)blockIdx.x % 8) * (G / 8) + (int)blockIdx.x / 8 : (int)blockIdx.x;

    if (IN(0)) {
        const int lane = LANE_ID(), tid = wave * 64 + lane; (void)tid;
        LAS float* scr = (LAS float*)(lds + RING_OFF + wave * 16384);
        constexpr int I_IN = 16 * (NPP / 32), I_O = 16 * 32, I_Q = 16 * 32;
        for (int it = gw; it < I_IN + I_O + I_Q; it += NGW) {
            int r = it;
            if (r < I_IN) { p0_transpose_item(w_in, D, NP, NPP, Win_t, scr, r, lane); continue; } r -= I_IN;
            if (r < I_O) { p0_transpose_item(w_out, D, D, D, Wo_t, scr, r, lane); continue; } r -= I_O;
            p0_transpose_item(w_peer_q, D, D, D, Wq_t, scr, r, lane);
        }
        for (int i = blockIdx.x * NTHREADS + tid; i < 4 * 4 * 4 * 2 * 64 * 8; i += G * NTHREADS) {
            const int j = i & 7, ln = (i >> 3) & 63, s2 = (i >> 9) & 1, db = (i >> 10) & 3, eb = (i >> 12) & 3, hd = i >> 14;
            const int cc = 32 * db + 16 * s2 + 8 * (j >> 2) + 4 * (ln >> 5) + (j & 3), e = 32 * eb + (ln & 31);
            wuvF[i] = f2bf(args.in[12][((size_t)hd * 128 + cc) * 128 + e]);
        }
        for (int r = gw; r < 2 * 16384; r += NGW) {
            if (r < 16384) quant_table_row(args.in[17] + (size_t)r * D, uq + (size_t)r * 1024, su + r, lane, false);
            else quant_table_row(args.in[18] + (size_t)(r - 16384) * D, vq + (size_t)(r - 16384) * 1024, sv + (r - 16384), lane, true);
        }
        if (BOTH(0)) xcd_barrier(bar);
    }
    if (IN(1)) {
        const int lane = LANE_ID(), tid = wave * 64 + lane; (void)tid;
        for (int m = gw; m < T; m += NGW) norm_mod_row<false>(x + (size_t)m * D, g_norm_mix, mod + (size_t)(m / S) * 6144, MOD_SHIFT_A, MOD_SCALE_A, hbuf + (size_t)m * D, lane, nullptr, nullptr);
        if (BOTH(1)) xcd_barrier(bar);
    }
    if (IN(2)) {
        pg8::Gemm g{hbuf, Win_t, T, NPP, D}; pg8::StaticOrder So; So.init(T, NPP, G, (int)blockIdx.x);
        pg8::EpiBf16Plain E{proj, NPP};
        pg8::gemm_phase<pg8::EpiBf16Plain, pg8::StaticOrder, true, true>(lds + RING_OFF, g, So, E);
        if (BOTH(2)) xcd_barrier(bar);
    }
    if (IN(3)) {
        const int lane = LANE_ID(), tid = wave * 64 + lane; (void)tid;
        const float lam = *(const float*)(ws + WS_LAM);
        for (int it = vcu; it < 1024; it += G) {
            const int b = it >> 5, h = (it >> 3) & 3, qp = it & 7;
            diff_unit(proj, mixin, args.in[19], lam, args.in[10], lds, b, h, 15 - qp, tid, lane, wave);
            diff_unit(proj, mixin, args.in[19], lam, args.in[10], lds, b, h, qp, tid, lane, wave);
        }
        for (int it = vcu; it < 2048; it += G) {
            const int b = it >> 6, up = it & 63;
            dsa_index_unit(proj, maskw, lds, b, 127 - up, tid, lane, wave);
            dsa_index_unit(proj, maskw, lds, b, up, tid, lane, wave);
        }
        if (BOTH(3)) xcd_barrier(bar);
    }
    if (IN(4)) {
        const int lane = LANE_ID(), tid = wave * 64 + lane; (void)tid;
        for (int it = vcu; it < 512; it += G) {
            const int b = it >> 4, up = it & 15;
            dsa_attn_unit(proj, maskw, wuvF, args.in[19], args.in[11], mixin, lds, b, 31 - up, tid, lane, wave);
            dsa_attn_unit(proj, maskw, wuvF, args.in[19], args.in[11], mixin, lds, b, up, tid, lane, wave);
        }
        if (BOTH(4)) xcd_barrier(bar);
    }
    if (IN(5)) {
        pg8::Gemm g{mixin, Wo_t, T, D, D}; pg8::StaticOrder So; So.init(T, D, G, (int)blockIdx.x);
        pg8::EpiF32Res E{out, x, mod + MOD_GATE_A};
        pg8::gemm_phase<pg8::EpiF32Res, pg8::StaticOrder, true, true>(lds + RING_OFF, g, So, E);
        if (BOTH(5)) xcd_barrier(bar);
    }
    if (IN(6)) {
        const int lane = LANE_ID(), tid = wave * 64 + lane; (void)tid;
        for (int m = gw; m < T; m += NGW) norm_mod_row<true>(out + (size_t)m * D, g_norm_ffn, mod + (size_t)(m / S) * 6144, MOD_SHIFT_F, MOD_SCALE_F, hbuf + (size_t)m * D, lane, xq + (size_t)m * 1024, sxs + m);
        if (BOTH(6)) xcd_barrier(bar);
    }
    if (IN(7)) {
        pg8::Gemm g{hbuf, Wq_t, T, D, D}; pg8::StaticOrder So; So.init(T, D, G, (int)blockIdx.x);
        pg8::EpiF32Res E{qf, nullptr, nullptr};
        pg8::gemm_phase<pg8::EpiF32Res, pg8::StaticOrder, true, true>(lds + RING_OFF, g, So, E);
        if (BOTH(7)) xcd_barrier(bar);
    }
    if (IN(9)) {
        const int lane = LANE_ID(), tid = wave * 64 + lane; (void)tid;
        const int* eidx = (const int*)(ws + WS_EIDX); const float* gate = (const float*)(ws + WS_GATE);
        for (int tok = gw; tok < T; tok += NGW)
            peer_token(tok, xq, sxs, eidx, gate, uq, vq, su, sv, mod + (size_t)(tok / S) * 6144 + MOD_GATE_F, args.in[20], out, lane);
    }
#undef IN
#undef BOTH
}
__global__ void __launch_bounds__(256) k_mod(const float* __restrict__ c, const float* __restrict__ w_ada, const float* __restrict__ b_ada, float* __restrict__ mod,
                                             const float* lq1, const float* lk1, const float* lq2, const float* lk2, float* lam_out) {
    const int j = blockIdx.x * 256 + threadIdx.x, b = blockIdx.y;
    float acc = 0.f;
    for (int k = 0; k < D; ++k) { const float cv = c[b * D + k]; const float s = cv / (1.f + expf(-cv)); acc += s * w_ada[(size_t)k * 6144 + j]; }
    mod[b * 6144 + j] = acc + b_ada[j];
    if (blockIdx.x == 0 && blockIdx.y == 0 && threadIdx.x == 0) {
        float s1 = 0.f, s2 = 0.f;
        for (int i = 0; i < 64; ++i) { s1 += lq1[i] * lk1[i]; s2 += lq2[i] * lk2[i]; }
        lam_out[0] = expf(s1) - expf(s2) + 0.2f;
    }
}

__device__ __forceinline__ void wave_argmax(float& v, int& i) {
#pragma unroll
    for (int o = 32; o >= 1; o >>= 1) { const float ov = __shfl_xor(v, o); const int oi = __shfl_xor(i, o); if (ov > v || (ov == v && oi < i)) { v = ov; i = oi; } }
}
__global__ void __launch_bounds__(256) k_peer_select(const float* __restrict__ qf, const float* __restrict__ keys, int* __restrict__ eidx, float* __restrict__ gate) {
    __shared__ float qsh[4][128];
    __shared__ float s12[4][2][16];
    __shared__ int i12[4][2][16];
    const int wid = threadIdx.x >> 6, lane = threadIdx.x & 63;
    const int th = blockIdx.x * 4 + wid, tok = th >> 3, h = th & 7;
    qsh[wid][lane] = qf[(size_t)tok * D + h * 128 + lane]; qsh[wid][lane + 64] = qf[(size_t)tok * D + h * 128 + lane + 64];
    __syncthreads();
    for (int p = 0; p < 2; ++p) {
        float v0 = 0.f, v1 = 0.f;
        const float* k0 = keys + (((size_t)h * 2 + p) * 128 + lane) * 64, *k1 = k0 + 64 * 64;
        for (int d = 0; d < 64; ++d) { const float q = qsh[wid][p * 64 + d]; v0 += q * k0[d]; v1 += q * k1[d]; }
        for (int r = 0; r < 16; ++r) {
            float bv; int bi;
            if (v0 >= v1) { bv = v0; bi = lane; } else { bv = v1; bi = lane + 64; }
            wave_argmax(bv, bi);
            if (lane == 0) { s12[wid][p][r] = bv; i12[wid][p][r] = bi; }
            if (bi == lane) v0 = -INFINITY; if (bi == lane + 64) v1 = -INFINITY;
        }
    }
    __syncthreads();
    float cv[4];
#pragma unroll
    for (int c = 0; c < 4; ++c) { const int pos = lane + 64 * c; cv[c] = s12[wid][0][pos >> 4] + s12[wid][1][pos & 15]; }
    float topv = 0.f; int tope = 0;
    for (int r = 0; r < 16; ++r) {
        float bv = cv[0]; int bi = lane;
#pragma unroll
        for (int c = 1; c < 4; ++c) if (cv[c] > bv) { bv = cv[c]; bi = lane + 64 * c; }
        wave_argmax(bv, bi);
#pragma unroll
        for (int c = 0; c < 4; ++c) if (bi == lane + 64 * c) cv[c] = -INFINITY;
        if (lane == r) { topv = bv; tope = i12[wid][0][bi >> 4] * 128 + i12[wid][1][bi & 15]; }
    }
    const float tmax = __shfl(topv, 0);
    const float e = lane < 16 ? expf(topv - tmax) : 0.f;
    const float su = wave_sum(e);
    if (lane < 16) { eidx[(size_t)tok * 128 + h * 16 + lane] = tope; gate[(size_t)tok * 128 + h * 16 + lane] = e / su; }
}

extern "C" void kernel_launch(void* const* d_in, const int* in_sizes, int n_in, void* d_out, int out_size, void* d_ws, size_t ws_size, hipStream_t stream) {
    static int grid = 0;
    if (grid == 0) {
        if (n_in != 21 || out_size != T * D || ws_size < WS_END) { fprintf(stderr, "kernel_launch: unexpected shapes (n_in %d out %d ws %zu)\n", n_in, out_size, ws_size); grid = -1; return; }
        int dev = 0, cus = 0, per_cu = 0;
        if (hipGetDevice(&dev) != hipSuccess || hipDeviceGetAttribute(&cus, hipDeviceAttributeMultiprocessorCount, dev) != hipSuccess) { grid = -1; return; }
        if (hipFuncSetAttribute((const void*)fwd, hipFuncAttributeMaxDynamicSharedMemorySize, LDS_BYTES) != hipSuccess) { fprintf(stderr, "kernel_launch: hipFuncSetAttribute failed\n"); grid = -1; return; }
        if (hipOccupancyMaxActiveBlocksPerMultiprocessor(&per_cu, (const void*)fwd, NTHREADS, LDS_BYTES) != hipSuccess || per_cu < 1)
            fprintf(stderr, "kernel_launch: occupancy query reports %d workgroups per CU\n", per_cu);
        (void)hipGetLastError();
        grid = cus;
        if (grid != 256) fprintf(stderr, "kernel_launch: %d CUs (expected 256)\n", grid);
    }
    if (grid < 0) return;
    const float* c = (const float*)d_in[1];
    const float* w_ada = (const float*)d_in[2];
    const float* b_ada = (const float*)d_in[3];
    const float* g_subln = (const float*)d_in[10];
    const float* g_kv = (const float*)d_in[11];
    const float* w_uv = (const float*)d_in[12];
    const float* peer_keys = (const float*)d_in[16];
    const float* peer_u = (const float*)d_in[17];
    const float* peer_v = (const float*)d_in[18];
    const float* rel_bias = (const float*)d_in[19];
    const float* g_final = (const float*)d_in[20];
    float* out = (float*)d_out;
    unsigned char* ws = (unsigned char*)d_ws;
    float* mod = (float*)(ws + WS_MOD); float* lam = (float*)(ws + WS_LAM);
    bf16_t* hbuf = (bf16_t*)(ws + WS_HBUF); bf16_t* mixin = (bf16_t*)(ws + WS_MIXIN);
    int* eidx = (int*)(ws + WS_EIDX); float* gate = (float*)(ws + WS_GATE);
    bf16_t* proj = (bf16_t*)(ws + WS_BIG); float* qf = (float*)(ws + WS_BIG);

    (void)hipMemsetAsync(ws + WS_CTL, 0, CTL_ZERO_BYTES, stream);
    Args a{};
    for (int i = 0; i < 21; ++i) a.in[i] = (const float*)d_in[i];
    a.out = out; a.ws = ws;

    k_mod<<<dim3(24, NB), 256, 0, stream>>>(c, w_ada, b_ada, mod, (const float*)d_in[6], (const float*)d_in[7], (const float*)d_in[8], (const float*)d_in[9], lam);
    a.ph_lo = 0; a.ph_hi = 5; a.li = 0;
    hipLaunchKernelGGL(fwd, dim3(grid), dim3(NTHREADS), LDS_BYTES, stream, a);
    a.ph_lo = 5; a.ph_hi = 8; a.li = 1;
    hipLaunchKernelGGL(fwd, dim3(grid), dim3(NTHREADS), LDS_BYTES, stream, a);
    k_peer_select<<<T * 8 / 4, 256, 0, stream>>>(qf, peer_keys, eidx, gate);
    a.ph_lo = 9; a.ph_hi = 10; a.li = 2;
    hipLaunchKernelGGL(fwd, dim3(grid), dim3(NTHREADS), LDS_BYTES, stream, a);
}
```

```cpp
#include <hip/hip_runtime.h>
#include <stdint.h>
#include <stdio.h>

typedef unsigned short bf16_t;
#define LAS __attribute__((address_space(3)))
#define GAS __attribute__((address_space(1)))

constexpr int D = 1024, NB = 32, S = 2048, T = NB * S;
constexpr int NP = 2760, NPP = 2816;
constexpr int C_DQ = 0, C_DK = 512, C_DV = 1024, C_SQ = 1536, C_SKV = 2048, C_IQ = 2176, C_IK = 2688, C_IW = 2752;
constexpr int MOD_SHIFT_A = 0, MOD_SCALE_A = 1024, MOD_GATE_A = 2048, MOD_SHIFT_F = 3072, MOD_SCALE_F = 4096, MOD_GATE_F = 5120;
constexpr float EPS = 1e-6f;
constexpr int NWAVES = 8, NTHREADS = 512;

__device__ __forceinline__ float bf2f(bf16_t v) { return __uint_as_float(((unsigned)v) << 16); }
__device__ __forceinline__ bf16_t f2bf(float f) { unsigned u = __float_as_uint(f); u += 0x7fffu + ((u >> 16) & 1u); return (bf16_t)(u >> 16); }
__device__ __forceinline__ unsigned pk2(float lo, float hi) { return (unsigned)f2bf(lo) | ((unsigned)f2bf(hi) << 16); }

__device__ __forceinline__ int rel_bucket(int n) {
    if (n < 16) return n < 0 ? 0 : n;
    int b = 16;
    b += (n >= 19); b += (n >= 21); b += (n >= 24); b += (n >= 27); b += (n >= 31); b += (n >= 35); b += (n >= 40); b += (n >= 46);
    b += (n >= 52); b += (n >= 59); b += (n >= 67); b += (n >= 77); b += (n >= 87); b += (n >= 99); b += (n >= 113);
    return b;
}

__device__ __forceinline__ float wave_sum(float v) {
#pragma unroll
    for (int o = 32; o >= 1; o >>= 1) v += __shfl_xor(v, o);
    return v;
}
__device__ __forceinline__ float wave_max(float v) {
#pragma unroll
    for (int o = 32; o >= 1; o >>= 1) v = fmaxf(v, __shfl_xor(v, o));
    return v;
}
__device__ __forceinline__ float block_sum(float v, float* red) {
    v = wave_sum(v);
    __syncthreads();
    if ((threadIdx.x & 63) == 0) red[threadIdx.x >> 6] = v;
    __syncthreads();
    return red[0] + red[1] + red[2] + red[3];
}
__device__ __forceinline__ float block_max(float v, float* red) {
    v = wave_max(v);
    __syncthreads();
    if ((threadIdx.x & 63) == 0) red[threadIdx.x >> 6] = v;
    __syncthreads();
    return fmaxf(fmaxf(red[0], red[1]), fmaxf(red[2], red[3]));
}
__device__ __forceinline__ int block_sum_i(int v, int* red) {
#pragma unroll
    for (int o = 32; o >= 1; o >>= 1) v += __shfl_xor(v, o);
    __syncthreads();
    if ((threadIdx.x & 63) == 0) red[threadIdx.x >> 6] = v;
    __syncthreads();
    return red[0] + red[1] + red[2] + red[3];
}

namespace pg8 {
#define PG8_LAS __attribute__((address_space(3)))
typedef unsigned short bf16_t;
typedef short bf16x8 __attribute__((ext_vector_type(8)));
typedef float f32x4 __attribute__((ext_vector_type(4)));
typedef unsigned u32x4 __attribute__((ext_vector_type(4)));
constexpr int BM = 256, BK = 64, HALF = 128, HTB = HALF * BK * 2  , STAGE_BYTES = 8 * HTB, NXCD = 8, WGM = 8;

__host__ __device__ __forceinline__ int lds_byte(int r, int c) { const int st = (r >> 4) * 2 + (c >> 5), rr = r & 15, cc = c & 31, ob = rr * 64 + cc * 2; return st * 1024 + (ob ^ (((ob >> 9) & 1) << 5)); }
__host__ __device__ __forceinline__ void stage_rc(int b, int& R, int& C) { const int st = b / 1024, sb = b % 1024, swz = sb ^ (((sb >> 9) & 1) << 5); R = (st >> 1) * 16 + swz / 64; C = (st & 1) * 32 + (swz % 64) / 2; }
__host__ __device__ __forceinline__ int perm32(int rho) { const int n = rho >> 4, i = rho & 15; return 8 * (i >> 2) + 4 * n + (i & 3); }

struct Unit { int pm, pn; };
struct Gemm { const bf16_t* A; const bf16_t* Bt; int M, N, K; };

struct StaticOrder {
    int nM, nN, nwg, G, c;
    __host__ __device__ void init(int M, int N, int G_, int c_) { nM = M / BM; nN = N / BM; nwg = nM * nN; G = G_; c = c_; }
    __host__ __device__ bool next(int i, Unit& u) const {
        const long L = (long)i * G + c; if (L >= nwg) return false;
        int wgid = (int)L; { const int q = nwg / NXCD, r = nwg % NXCD, xcd = wgid % NXCD, off = wgid / NXCD; wgid = (xcd < r ? xcd * (q + 1) : r * (q + 1) + (xcd - r) * q) + off; }
        const int nig = WGM * nN, gid = wgid / nig, fm = gid * WGM, gsz = (nM - fm) < WGM ? (nM - fm) : WGM;
        u.pm = fm + ((wgid % nig) % gsz); u.pn = (wgid % nig) / gsz; return true;
    }
    __device__ __forceinline__ void a_ready(const Unit&) const {}
    __device__ __forceinline__ void done(const Unit&) const {}
};
__device__ __forceinline__ unsigned cvt_pk_bf16(float lo, float hi) { unsigned r; asm volatile("v_cvt_pk_bf16_f32 %0, %1, %2" : "=v"(r) : "v"(lo), "v"(hi)); return r; }
typedef float f32x2 __attribute__((ext_vector_type(2)));
struct EpiBf16Plain {
    static constexpr bool PERM = true, AFTER_DRAIN = false;
    bf16_t* O; int ldc;
    __device__ __forceinline__ void operator()(const f32x4 (&acc)[2][2][4][2], const Unit& u, int wr, int wc, int fr, int fq) const {
        const int row0 = u.pm * BM + wr * 64 + fr, col0 = u.pn * BM + wc * 32 + 8 * fq;
#pragma unroll
        for (int ai = 0; ai < 2; ++ai)
#pragma unroll
            for (int m = 0; m < 4; ++m) { bf16_t* rowp = O + (size_t)(row0 + ai * HALF + m * 16) * ldc + col0;
#pragma unroll
                for (int bj = 0; bj < 2; ++bj) { const f32x4 v0 = acc[ai][bj][m][0], v1 = acc[ai][bj][m][1];
                    u32x4 w; w.x = cvt_pk_bf16(v0[0], v0[1]); w.y = cvt_pk_bf16(v0[2], v0[3]); w.z = cvt_pk_bf16(v1[0], v1[1]); w.w = cvt_pk_bf16(v1[2], v1[3]);
                    *(u32x4*)(rowp + bj * HALF) = w; } }
    }
};
struct EpiF32Res {
    static constexpr bool PERM = false, AFTER_DRAIN = false;
    float* C; const float* res; const float* gate;
    __device__ __forceinline__ void operator()(const f32x4 (&acc)[2][2][4][2], const Unit& u, int wr, int wc, int fr, int fq) const {
        const int row0 = u.pm * BM + wr * 64 + fr, col0 = u.pn * BM + wc * 32 + 4 * fq;
        f32x4 gv[2][2];
#pragma unroll
        for (int bj = 0; bj < 2; ++bj)
#pragma unroll
            for (int n = 0; n < 2; ++n) gv[bj][n] = res ? *(const f32x4*)(gate + (size_t)(u.pm >> 3) * 6144 + col0 + bj * HALF + n * 16) : (f32x4){1.f, 1.f, 1.f, 1.f};
#pragma unroll
        for (int ai = 0; ai < 2; ++ai)
#pragma unroll
            for (int m = 0; m < 4; ++m) { const size_t off = (size_t)(row0 + ai * HALF + m * 16) * 1024 + col0;
#pragma unroll
                for (int bj = 0; bj < 2; ++bj)
#pragma unroll
                    for (int n = 0; n < 2; ++n) { f32x4 o = acc[ai][bj][m][n] * gv[bj][n];
                        if (res) o = o + *(const f32x4*)(res + off + bj * HALF + n * 16);
                        *(f32x4*)(C + off + bj * HALF + n * 16) = o; } }
    }
};

struct EpiBf16Res {
    static constexpr bool PERM = true, AFTER_DRAIN = false;
    bf16_t* O; const float* res; const float* gate;
    __device__ __forceinline__ void operator()(const f32x4 (&acc)[2][2][4][2], const Unit& u, int wr, int wc, int fr, int fq) const {
        const int row0 = u.pm * BM + wr * 64 + fr, col0 = u.pn * BM + wc * 32 + 8 * fq;
        f32x4 gv[2][2];
#pragma unroll
        for (int bj = 0; bj < 2; ++bj)
#pragma unroll
            for (int n = 0; n < 2; ++n) gv[bj][n] = *(const f32x4*)(gate + (size_t)(u.pm >> 3) * 6144 + col0 + bj * HALF + 4 * n);
#pragma unroll
        for (int ai = 0; ai < 2; ++ai)
#pragma unroll
            for (int m = 0; m < 4; ++m) { const size_t off = (size_t)(row0 + ai * HALF + m * 16) * 1024 + col0;
#pragma unroll
                for (int bj = 0; bj < 2; ++bj) { const f32x4 r0 = *(const f32x4*)(res + off + bj * HALF), r1 = *(const f32x4*)(res + off + bj * HALF + 4);
                    const f32x4 v0 = r0 + acc[ai][bj][m][0] * gv[bj][0], v1 = r1 + acc[ai][bj][m][1] * gv[bj][1];
                    u32x4 w; w.x = cvt_pk_bf16(v0[0], v0[1]); w.y = cvt_pk_bf16(v0[2], v0[3]); w.z = cvt_pk_bf16(v1[0], v1[1]); w.w = cvt_pk_bf16(v1[2], v1[3]);
                    *(u32x4*)(O + off + bj * HALF) = w; } }
    }
};

struct EpiBf16ResB {
    static constexpr bool PERM = true, AFTER_DRAIN = false;
    bf16_t* O; const float* res; const float* gate;
    __device__ __forceinline__ void operator()(const f32x4 (&acc)[2][2][4][2], const Unit& u, int wr, int wc, int fr, int fq) const {
        const int row0 = u.pm * BM + wr * 64 + fr, col0 = u.pn * BM + wc * 32 + 8 * fq;
        f32x4 gv[2][2];
#pragma unroll
        for (int bj = 0; bj < 2; ++bj)
#pragma unroll
            for (int n = 0; n < 2; ++n) gv[bj][n] = *(const f32x4*)(gate + (size_t)(u.pm >> 3) * 6144 + col0 + bj * HALF + 4 * n);
#pragma unroll
        for (int ai = 0; ai < 2; ++ai) {
            f32x4 rr[4][2][2];
#pragma unroll
            for (int m = 0; m < 4; ++m) { const size_t off = (size_t)(row0 + ai * HALF + m * 16) * 1024 + col0;
#pragma unroll
                for (int bj = 0; bj < 2; ++bj) { rr[m][bj][0] = *(const f32x4*)(res + off + bj * HALF); rr[m][bj][1] = *(const f32x4*)(res + off + bj * HALF + 4); } }
            __builtin_amdgcn_sched_barrier(0);
#pragma unroll
            for (int m = 0; m < 4; ++m) { const size_t off = (size_t)(row0 + ai * HALF + m * 16) * 1024 + col0;
#pragma unroll
                for (int bj = 0; bj < 2; ++bj) { const f32x4 v0 = rr[m][bj][0] + acc[ai][bj][m][0] * gv[bj][0], v1 = rr[m][bj][1] + acc[ai][bj][m][1] * gv[bj][1];
                    u32x4 w; w.x = cvt_pk_bf16(v0[0], v0[1]); w.y = cvt_pk_bf16(v0[2], v0[3]); w.z = cvt_pk_bf16(v1[0], v1[1]); w.w = cvt_pk_bf16(v1[2], v1[3]);
                    *(u32x4*)(O + off + bj * HALF) = w; } }
            __builtin_amdgcn_sched_barrier(0);
        }
    }
};

template <class Epi, class Sched, bool ALIGN_EPI = false, bool SP2 = false>
__device__ __forceinline__ void gemm_phase(PG8_LAS unsigned char* lds, const Gemm g, const Sched& S, const Epi& E) {
    const int tid = threadIdx.x, wid = __builtin_amdgcn_readfirstlane(tid >> 6), lane = tid & 63, wr = wid >> 2, wc = wid & 3, fr = lane & 15, fq = lane >> 4;
    const int K = g.K, nt = K / BK;
    unsigned voffA[2], voffB[2];
#pragma unroll
    for (int i = 0; i < 2; ++i) { int R, C; stage_rc(tid * 16 + i * 8192, R, C); const int Rb = Epi::PERM ? ((R & ~31) + perm32(R & 31)) : R;
        voffA[i] = (unsigned)(R * K + C) * 2u; voffB[i] = (unsigned)(Rb * K + C) * 2u; }
    const size_t kstep = (size_t)(BK * 2);
    const size_t hstep = (size_t)HALF * K * 2;
    const size_t tstep = 2 * hstep;
    const unsigned ldsw = (unsigned)wid * 1024u;
    const int aoff = lds_byte(wr * 64 + fr, fq * 8), boff = lds_byte(wc * 32 + fr, fq * 8);
#define PG8_SA(b, h) (((b) * 2 + (h)) * HTB)
#define PG8_SB(b, h) ((4 + (b) * 2 + (h)) * HTB)
#define PG8_STAGE(bufoff, gbase, voff) do { _Pragma("unroll") for (int _i = 0; _i < 2; ++_i) \
        __builtin_amdgcn_global_load_lds((const unsigned*)((const char*)(gbase) + (voff)[_i]), (PG8_LAS unsigned*)(lds + (bufoff) + ldsw + _i * 8192), 16, 0, 0); } while (0)
#define PG8_LDA(dst, b, h) do { _Pragma("unroll") for (int m = 0; m < 4; ++m) _Pragma("unroll") for (int k = 0; k < 2; ++k) dst[m][k] = *(const PG8_LAS bf16x8*)(lds + PG8_SA(b, h) + aoff + m * 2048 + k * 1024); } while (0)
#define PG8_LDB(dst, b, h) do { _Pragma("unroll") for (int n = 0; n < 2; ++n) _Pragma("unroll") for (int k = 0; k < 2; ++k) dst[n][k] = *(const PG8_LAS bf16x8*)(lds + PG8_SB(b, h) + boff + n * 2048 + k * 1024); } while (0)
#define PG8_MMA(ai, bj, At, Bt) do { __builtin_amdgcn_s_setprio(1); _Pragma("unroll") for (int m = 0; m < 4; ++m) _Pragma("unroll") for (int n = 0; n < 2; ++n) _Pragma("unroll") for (int k = 0; k < 2; ++k) \
        acc[ai][bj][m][n] = __builtin_amdgcn_mfma_f32_16x16x32_bf16(Bt[n][k], At[m][k], acc[ai][bj][m][n], 0, 0, 0); __builtin_amdgcn_s_setprio(0); } while (0)
#define PG8_WAIT_V(n) asm volatile("s_waitcnt vmcnt(" #n ")" ::: "memory")
#define PG8_WAIT_L(n) asm volatile("s_waitcnt lgkmcnt(" #n ")" ::: "memory")
#define PG8_BAR __builtin_amdgcn_s_barrier()
#define PG8_SCHED __builtin_amdgcn_sched_barrier(0)
    Unit cur, nxt; int ui = 0;
    if (!S.next(0, cur)) return;
    f32x4 acc[2][2][4][2];
#pragma unroll
    for (int a = 0; a < 2; ++a)
#pragma unroll
        for (int b = 0; b < 2; ++b)
#pragma unroll
            for (int m = 0; m < 4; ++m)
#pragma unroll
                for (int n = 0; n < 2; ++n) acc[a][b][m][n] = (f32x4){0.f, 0.f, 0.f, 0.f};
    bf16x8 At[4][2], B0[2][2], B1[2][2];
    const char* cA = (const char*)g.A + (size_t)cur.pm * tstep; const char* cB = (const char*)g.Bt + (size_t)cur.pn * tstep;
    S.a_ready(cur);
    if constexpr (SP2) {
        PG8_STAGE(PG8_SB(0, 0), cB, voffB); PG8_STAGE(PG8_SB(0, 1), cB + hstep, voffB); PG8_STAGE(PG8_SA(0, 0), cA, voffA); PG8_STAGE(PG8_SA(0, 1), cA + hstep, voffA);
        if (wr == 1) PG8_BAR;
        PG8_WAIT_V(2); PG8_BAR;
        PG8_STAGE(PG8_SB(1, 0), cB + kstep, voffB); PG8_STAGE(PG8_SA(1, 0), cA + kstep, voffA); PG8_STAGE(PG8_SB(1, 1), cB + hstep + kstep, voffB);
        PG8_WAIT_V(6); PG8_BAR;
    } else {
        PG8_STAGE(PG8_SB(0, 0), cB, voffB); PG8_STAGE(PG8_SA(0, 0), cA, voffA); PG8_STAGE(PG8_SB(0, 1), cB + hstep, voffB); PG8_STAGE(PG8_SA(0, 1), cA + hstep, voffA);
        if (wr == 1) PG8_BAR;
        PG8_WAIT_V(4); PG8_BAR;
        PG8_STAGE(PG8_SB(1, 0), cB + kstep, voffB); PG8_STAGE(PG8_SA(1, 0), cA + kstep, voffA); PG8_STAGE(PG8_SB(1, 1), cB + hstep + kstep, voffB);
        PG8_WAIT_V(6); PG8_BAR;
    }
    for (;;) {
        const bool has_next = S.next(ui + 1, nxt);
        const char* nA = has_next ? (const char*)g.A + (size_t)nxt.pm * tstep : cA; const char* nB = has_next ? (const char*)g.Bt + (size_t)nxt.pn * tstep : cB;
        for (int t = 0; t < nt; t += 2) {
            const bool last = (t == nt - 2);
            const char* a1 = cA + (size_t)(t + 1) * kstep;
            const char* a2 = last ? nA : cA + (size_t)(t + 2) * kstep; const char* b2 = last ? nB : cB + (size_t)(t + 2) * kstep;
            const char* a3 = a2 + kstep; const char* b3 = b2 + kstep;
            if (last && has_next) S.a_ready(nxt);
            if constexpr (SP2) {
            PG8_LDB(B0, 0, 0); PG8_LDB(B1, 0, 1); PG8_SCHED; PG8_LDA(At, 0, 0); PG8_STAGE(PG8_SA(1, 1), a1 + hstep, voffA);
            PG8_WAIT_V(8); PG8_WAIT_L(0); PG8_BAR; PG8_MMA(0, 0, At, B0); PG8_MMA(0, 1, At, B1); PG8_BAR; PG8_SCHED;
            PG8_LDA(At, 0, 1); PG8_STAGE(PG8_SB(0, 0), b2, voffB); PG8_STAGE(PG8_SB(0, 1), b2 + hstep, voffB); PG8_STAGE(PG8_SA(0, 0), a2, voffA);
            PG8_WAIT_V(8); PG8_WAIT_L(0); PG8_BAR; PG8_MMA(1, 0, At, B0); PG8_MMA(1, 1, At, B1); PG8_BAR; PG8_SCHED;
            PG8_LDB(B0, 1, 0); PG8_LDB(B1, 1, 1); PG8_SCHED; PG8_LDA(At, 1, 0); PG8_STAGE(PG8_SA(0, 1), a2 + hstep, voffA);
            PG8_WAIT_V(8); PG8_WAIT_L(0); PG8_BAR; PG8_MMA(0, 0, At, B0); PG8_MMA(0, 1, At, B1); PG8_BAR; PG8_SCHED;
            PG8_LDA(At, 1, 1); PG8_STAGE(PG8_SB(1, 0), b3, voffB); PG8_STAGE(PG8_SB(1, 1), b3 + hstep, voffB); PG8_STAGE(PG8_SA(1, 0), a3, voffA);
            PG8_WAIT_V(8); PG8_WAIT_L(0); PG8_BAR; PG8_MMA(1, 0, At, B0); PG8_MMA(1, 1, At, B1); PG8_BAR; PG8_SCHED;
            } else {
            PG8_LDB(B0, 0, 0); PG8_SCHED; PG8_LDA(At, 0, 0); PG8_STAGE(PG8_SA(1, 1), a1 + hstep, voffA);
            PG8_WAIT_L(8); PG8_BAR; PG8_WAIT_L(0); PG8_MMA(0, 0, At, B0); PG8_BAR; PG8_SCHED;
            PG8_LDB(B1, 0, 1); PG8_STAGE(PG8_SB(0, 0), b2, voffB);
            PG8_BAR; PG8_WAIT_L(0); PG8_MMA(0, 1, At, B1); PG8_BAR;
            PG8_LDA(At, 0, 1); PG8_STAGE(PG8_SA(0, 0), a2, voffA);
            PG8_BAR; PG8_WAIT_L(0); PG8_MMA(1, 0, At, B0); PG8_BAR; PG8_SCHED;
            PG8_STAGE(PG8_SB(0, 1), b2 + hstep, voffB);
            PG8_WAIT_V(6); PG8_BAR; PG8_MMA(1, 1, At, B1); PG8_BAR;
            PG8_LDB(B0, 1, 0); PG8_SCHED; PG8_LDA(At, 1, 0); PG8_STAGE(PG8_SA(0, 1), a2 + hstep, voffA);
            PG8_WAIT_L(8); PG8_BAR; PG8_WAIT_L(0); PG8_MMA(0, 0, At, B0); PG8_BAR; PG8_SCHED;
            PG8_LDB(B1, 1, 1); PG8_STAGE(PG8_SB(1, 0), b3, voffB);
            PG8_BAR; PG8_WAIT_L(0); PG8_MMA(0, 1, At, B1); PG8_BAR;
            PG8_LDA(At, 1, 1); PG8_STAGE(PG8_SA(1, 0), a3, voffA);
            PG8_BAR; PG8_WAIT_L(0); PG8_MMA(1, 0, At, B0); PG8_BAR; PG8_SCHED;
            PG8_STAGE(PG8_SB(1, 1), b3 + hstep, voffB);
            PG8_WAIT_V(6); PG8_BAR; PG8_MMA(1, 1, At, B1); PG8_BAR;
            }
        }
        if constexpr (ALIGN_EPI) { if (wr == 0) PG8_BAR; }
        if constexpr (!Epi::AFTER_DRAIN) { E(acc, cur, wr, wc, fr, fq); S.done(cur); }
        if (!has_next) break;
#pragma unroll
        for (int a = 0; a < 2; ++a)
#pragma unroll
            for (int b = 0; b < 2; ++b)
#pragma unroll
                for (int m = 0; m < 4; ++m)
#pragma unroll
                    for (int n = 0; n < 2; ++n) acc[a][b][m][n] = (f32x4){0.f, 0.f, 0.f, 0.f};
        cur = nxt; cA = nA; cB = nB; ++ui;
        if constexpr (ALIGN_EPI) { if (wr == 1) PG8_BAR; }
    }
    PG8_WAIT_V(0);
    if constexpr (!ALIGN_EPI) { if (wr == 0) PG8_BAR; }
    PG8_BAR;
    if constexpr (Epi::AFTER_DRAIN) { E.fused(acc, cur, wr, wc, fr, fq, lds, wid, lane); S.done(cur); }
#undef PG8_SA
#undef PG8_SB
#undef PG8_STAGE
#undef PG8_LDA
#undef PG8_LDB
#undef PG8_MMA
#undef PG8_WAIT_V
#undef PG8_WAIT_L
#undef PG8_BAR
#undef PG8_SCHED
}
}
#define XB_TMO      128
#define XB_XCNT(j)  (256  + 64 * (j))
#define XB_XSUB(j)  (1280 + 64 * (j))
#define XB_XGEN(j)  (2304 + 64 * (j))
#define XB_TOP      3328
#define XB_TOPGEN   3392
#define XCD_BAR_WORDS 3456
#define XB_SPIN_CAP (1u << 18)

__device__ __forceinline__ unsigned xb_ld(unsigned* p)              { return __hip_atomic_load(p, __ATOMIC_RELAXED, __HIP_MEMORY_SCOPE_AGENT); }
__device__ __forceinline__ unsigned xb_add(unsigned* p, unsigned v) { return __hip_atomic_fetch_add(p, v, __ATOMIC_RELAXED, __HIP_MEMORY_SCOPE_AGENT); }
__device__ __forceinline__ unsigned xb_xcc_id() { return (unsigned)__builtin_amdgcn_s_getreg((3 << 11) | 20) & 0xFu; }
#define XB_SPIN(cond, bar) do { unsigned _sp = 0; while (cond) { __builtin_amdgcn_s_sleep(1); \
    if ((++_sp & 255u) == 0u) { if (xb_ld(&(bar)[XB_TMO])) break; if (_sp > XB_SPIN_CAP) { atomicAdd(&(bar)[XB_TMO], 1u); break; } } } } while (0)

struct XcdBarrier {
    unsigned* bar; unsigned x;
    volatile LAS unsigned* st;
};

__device__ __forceinline__ XcdBarrier xcd_barrier_post(unsigned* bar, volatile LAS unsigned* st) {
    XcdBarrier b; b.bar = bar; b.x = xb_xcc_id(); b.st = st;
    if (threadIdx.x == 0) (void)xb_add(&bar[XB_XCNT(b.x)], 1u);
    return b;
}
__device__ __forceinline__ void xcd_barrier_complete(unsigned* bar, unsigned x, unsigned& nloc, unsigned& nx) {
    const unsigned G = gridDim.x * gridDim.y * gridDim.z;
    unsigned sum, cnt, mine, sp = 0u;
    for (;;) {
        sum = 0u; cnt = 0u; mine = 0u;
#pragma unroll
        for (unsigned j = 0; j < 16; ++j) { const unsigned c = xb_ld(&bar[XB_XCNT(j)]); sum += c; cnt += (c > 0u) ? 1u : 0u; mine = (j == x) ? c : mine; }
        if (sum == G) break;
        __builtin_amdgcn_s_sleep(1);
        if ((++sp & 255u) == 0u) { if (xb_ld(&bar[XB_TMO])) break; if (sp > XB_SPIN_CAP) { atomicAdd(&bar[XB_TMO], 1u); break; } }
    }
    nloc = mine > 0u ? mine : 1u; nx = cnt > 0u ? cnt : 1u;
}

__device__ __forceinline__ void xcd_barrier(const XcdBarrier& b) {
    asm volatile("s_waitcnt vmcnt(0)" ::: "memory");
    __syncthreads();
    if (threadIdx.x == 0) {
        unsigned* bar = b.bar;
        __builtin_amdgcn_s_waitcnt(0);
        unsigned nloc = b.st[0], nx = b.st[1];
        if (nloc == 0u) { xcd_barrier_complete(bar, b.x, nloc, nx); b.st[0] = nloc; b.st[1] = nx; }
        const unsigned old = xb_add(&bar[XB_XSUB(b.x)], 1u);
        const unsigned gen = old / nloc;
        if (old + 1u == (gen + 1u) * nloc) {
            __builtin_amdgcn_fence(__ATOMIC_RELEASE, "agent");
            asm volatile("s_waitcnt vmcnt(0)" ::: "memory");
            const unsigned og = xb_add(&bar[XB_TOP], 1u);
            const unsigned tg = og / nx;
            if (og + 1u == (tg + 1u) * nx) xb_add(&bar[XB_TOPGEN], 1u);
            else XB_SPIN(xb_ld(&bar[XB_TOPGEN]) == tg, bar);
            __builtin_amdgcn_fence(__ATOMIC_ACQUIRE, "agent");
            xb_add(&bar[XB_XGEN(b.x)], 1u);
            asm volatile("s_waitcnt vmcnt(0)" ::: "memory");
        } else {
            XB_SPIN(xb_ld(&bar[XB_XGEN(b.x)]) == gen, bar);
            __builtin_amdgcn_fence(__ATOMIC_ACQUIRE, "agent");
            asm volatile("s_waitcnt vmcnt(0)" ::: "memory");
        }
    }
    __syncthreads();
}

typedef short bf16x8_t __attribute__((ext_vector_type(8)));
typedef unsigned u32x4_t __attribute__((ext_vector_type(4)));
typedef unsigned u32x2_t __attribute__((ext_vector_type(2)));
typedef short s16x4_t __attribute__((ext_vector_type(4)));
typedef float f32x16_t __attribute__((ext_vector_type(16)));
typedef float f32x4_t __attribute__((ext_vector_type(4)));
typedef float f32x2_t __attribute__((ext_vector_type(2)));
typedef __bf16 bf16x2_t __attribute__((ext_vector_type(2)));
#define MFMA32(a, b, c) __builtin_amdgcn_mfma_f32_32x32x16_bf16((a), (b), (c), 0, 0, 0)
constexpr float LOG2E = 1.4426950408889634f;

__device__ __forceinline__ float vmax2(float a, float b) { float r; asm("v_max_f32 %0, %1, %2" : "=v"(r) : "v"(a), "v"(b)); return r; }
__device__ __forceinline__ float vmax3(float a, float b, float c) { float r; asm("v_max3_f32 %0, %1, %2, %3" : "=v"(r) : "v"(a), "v"(b), "v"(c)); return r; }
__device__ __forceinline__ int crow(int r, int hi) { return (r & 3) + 8 * (r >> 2) + 4 * hi; }
__device__ __forceinline__ unsigned cvtpk(float lo, float hi) { f32x2_t v = {lo, hi}; bf16x2_t b = __builtin_convertvector(v, bf16x2_t); return __builtin_bit_cast(unsigned, b); }
__device__ __forceinline__ s16x4_t vtr(const LAS unsigned char* p) { return __builtin_bit_cast(s16x4_t, __builtin_amdgcn_ds_read_tr16_b64_v4i16((LAS s16x4_t*)p)); }
__device__ __forceinline__ float xhalf_max(float m) { auto rr = __builtin_amdgcn_permlane32_swap(__float_as_uint(m), __float_as_uint(m), false, false); return fmaxf(__uint_as_float(rr[0]), __uint_as_float(rr[1])); }
__device__ __forceinline__ float xhalf_sum(float m) { auto rr = __builtin_amdgcn_permlane32_swap(__float_as_uint(m), __float_as_uint(m), false, false); return __uint_as_float(rr[0]) + __uint_as_float(rr[1]); }
__device__ __forceinline__ bf16x8_t pack8(const f32x16_t& p, int s) {
    u32x4_t u; u.x = cvtpk(p[8 * s + 0], p[8 * s + 1]); u.y = cvtpk(p[8 * s + 2], p[8 * s + 3]); u.z = cvtpk(p[8 * s + 4], p[8 * s + 5]); u.w = cvtpk(p[8 * s + 6], p[8 * s + 7]);
    return __builtin_bit_cast(bf16x8_t, u);
}

__device__ __forceinline__ void glds16(const void* sbase, unsigned voff, unsigned lds_base) {
    unsigned sv; asm volatile("s_mov_b32 %0, m0\n\ts_mov_b32 m0, %3\n\ts_nop 0\n\tglobal_load_lds_dwordx4 %1, %2\n\ts_mov_b32 m0, %0" : "=&s"(sv) : "v"(voff), "s"(sbase), "s"(lds_base) : "memory"); }
#define ATT_WAIT_BAR(N) asm volatile("s_waitcnt vmcnt(" #N ") lgkmcnt(0)\n\ts_barrier" ::: "memory")
constexpr int DA_SLOT = 32768, DA_BIAS = 133120, DA_LDS = 133120 + 1024;
__device__ __forceinline__ void diff_unit(const bf16_t* __restrict__ proj, bf16_t* __restrict__ mixin, const float* __restrict__ rel_bias, const float lam, const float* __restrict__ g_subln,
                                          LAS unsigned char* lds, int b, int h, int qt, int tid, int lane, int wave) {
    const int rg = wave >> 1, map = wave & 1, r32 = lane & 31, hh = lane >> 5;
    const int t0 = 128 * qt + 32 * rg;
    const int ntb = 2 * qt + 2;
    const int ntw = (t0 + 31) / 64 + 1;
    const size_t rowbase = (size_t)b * S;
    LAS float* biasT = (LAS float*)(lds + DA_BIAS);
    if (tid < 256) biasT[tid] = rel_bias[rel_bucket(tid) * 8 + h] * LOG2E;
    const float c31 = rel_bias[31 * 8 + h] * LOG2E;
    bf16x8_t qf[4];
    { const bf16_t* qrow = proj + (rowbase + t0 + r32) * NPP + C_DQ + h * 128 + map * 64 + 8 * hh;
#pragma unroll
      for (int ks = 0; ks < 4; ++ks) qf[ks] = *(const bf16x8_t*)(qrow + 16 * ks); }
    unsigned ko0, ko1, vo0, vo1;
    { const int pa = wave, pb = wave + 8;
      const int ra = 4 * pa + (lane >> 4), rb = 4 * pb + (lane >> 4), pc = lane & 15;
      ko0 = (unsigned)(ra * NPP + C_DK + h * 128 + 8 * (pc ^ (ra & 15))) * 2u;
      ko1 = (unsigned)(rb * NPP + C_DK + h * 128 + 8 * (pc ^ (rb & 15))) * 2u;
      const int ka = 16 * (pa & 3) + (lane >> 2), kb2 = 16 * (pb & 3) + (lane >> 2), cc = lane & 3;
      vo0 = (unsigned)(ka * NPP + C_DV + h * 128 + 8 * (4 * (pa >> 2) + cc)) * 2u;
      vo1 = (unsigned)(kb2 * NPP + C_DV + h * 128 + 8 * (4 * (pb >> 2) + cc)) * 2u; }
    const bf16_t* pbase = proj + rowbase * NPP;
    const unsigned lds0 = (unsigned)(size_t)lds;
    const unsigned dsta = (unsigned)__builtin_amdgcn_readfirstlane((int)(lds0 + wave * 1024)), dstb = dsta + 8192;
#define DA_DMA(j) do { const bf16_t* sb_ = pbase + (size_t)(64 * (j)) * NPP; const unsigned sl_ = (unsigned)(((j) & 3) * DA_SLOT); \
        glds16(sb_, ko0, dsta + sl_); glds16(sb_, ko1, dstb + sl_); glds16(sb_, vo0, dsta + sl_ + 16384); glds16(sb_, vo1, dstb + sl_ + 16384); } while (0)
    DA_DMA(0);
    if (ntb > 1) { DA_DMA(1); ATT_WAIT_BAR(4); } else ATT_WAIT_BAR(0);
    f32x16_t O[4];
#pragma unroll
    for (int i = 0; i < 4; ++i)
#pragma unroll
        for (int r = 0; r < 16; ++r) O[i][r] = 0.f;
    float m = -INFINITY, l = 0.f;
    const int t = t0 + r32;
    const float SC = 0.125f * LOG2E;
    const int i16 = lane & 15, tq = i16 >> 2, tp = i16 & 3, g1 = (lane >> 4) & 1;
    const unsigned vrd = (4 * hh + tq) * 64 + g1 * 32 + tp * 8;
    const unsigned krd = r32 * 256;
    bf16x8_t pb[2][2];
#define DA_QKSM(j) do { \
        const LAS unsigned char* kb = lds + (j & 3) * DA_SLOT; \
        f32x16_t s0, s1; \
        _Pragma("unroll") \
        for (int r = 0; r < 16; ++r) { s0[r] = 0.f; s1[r] = 0.f; } \
        _Pragma("unroll") \
        for (int ks = 0; ks < 4; ++ks) { \
            const int chunk = map * 8 + 2 * ks + hh; \
            const unsigned co = (unsigned)((chunk ^ (r32 & 15)) * 16); \
            const bf16x8_t a0 = *(const LAS bf16x8_t*)(kb + krd + co), a1 = *(const LAS bf16x8_t*)(kb + krd + 32 * 256 + co); \
            s0 = MFMA32(a0, qf[ks], s0); s1 = MFMA32(a1, qf[ks], s1); \
        } \
        const int kbase = 64 * j + 4 * hh; \
        const bool nearb = (t0 - (64 * j + 63)) < 113; \
        const bool diag = (64 * j + 63) > t0; \
        float alpha, ps = 0.f; \
        if (nearb) { \
        _Pragma("unroll") \
            for (int r = 0; r < 16; ++r) { const int key = kbase + (r & 3) + 8 * (r >> 2); \
                int d0 = t - key, d1 = d0 - 32; d0 = d0 < 0 ? 0 : d0; d1 = d1 < 0 ? 0 : d1; \
                s0[r] = s0[r] * SC + biasT[d0]; s1[r] = s1[r] * SC + biasT[d1]; \
                if (diag) { if (key > t) s0[r] = -INFINITY; if (key + 32 > t) s1[r] = -INFINITY; } } \
            float mt = vmax3(s0[0], s1[0], s0[1]); \
        _Pragma("unroll") \
            for (int r = 1; r < 16; ++r) mt = r < 15 ? vmax3(mt, s1[r], s0[r + 1]) : vmax2(mt, s1[r]); \
            mt = xhalf_max(mt); \
            const float mn = vmax2(m, mt); \
            alpha = __builtin_amdgcn_exp2f(m - mn); \
            m = mn; \
        _Pragma("unroll") \
            for (int r = 0; r < 16; ++r) { s0[r] = __builtin_amdgcn_exp2f(s0[r] - mn); s1[r] = __builtin_amdgcn_exp2f(s1[r] - mn); ps += s0[r] + s1[r]; } \
        } else { \
             \
            float mr = vmax3(s0[0], s1[0], s0[1]); \
        _Pragma("unroll") \
            for (int r = 1; r < 16; ++r) mr = r < 15 ? vmax3(mr, s1[r], s0[r + 1]) : vmax2(mr, s1[r]); \
            mr = xhalf_max(mr); \
            const float mn = vmax2(m, mr * SC + c31); \
            alpha = __builtin_amdgcn_exp2f(m - mn); \
            m = mn; \
            const float off = c31 - mn; \
        _Pragma("unroll") \
            for (int r = 0; r < 16; ++r) { s0[r] = __builtin_amdgcn_exp2f(s0[r] * SC + off); s1[r] = __builtin_amdgcn_exp2f(s1[r] * SC + off); ps += s0[r] + s1[r]; } \
        } \
        l = l * alpha + ps; \
        if (__any(alpha != 1.f)) { \
        _Pragma("unroll") \
            for (int i = 0; i < 4; ++i) \
        _Pragma("unroll") \
                for (int r = 0; r < 16; ++r) O[i][r] *= alpha; \
        } \
        pb[0][0] = pack8(s0, 0); pb[0][1] = pack8(s0, 1); pb[1][0] = pack8(s1, 0); pb[1][1] = pack8(s1, 1); \
    } while (0)
#define DA_PV(jt) do { \
        const LAS unsigned char* vb = lds + (jt & 3) * DA_SLOT + 16384; \
        _Pragma("unroll") \
        for (int sub = 0; sub < 2; ++sub) \
        _Pragma("unroll") \
            for (int s = 0; s < 2; ++s) \
        _Pragma("unroll") \
                for (int dblk = 0; dblk < 4; ++dblk) { \
                    const LAS unsigned char* vp = vb + dblk * 4096 + (32 * sub + 16 * s) * 64 + vrd; \
                    const s16x4_t lo = vtr(vp), hi = vtr(vp + 8 * 64); \
                    const bf16x8_t va = __builtin_shufflevector(lo, hi, 0, 1, 2, 3, 4, 5, 6, 7); \
                    O[dblk] = MFMA32(va, pb[sub][s], O[dblk]); \
                } \
    } while (0)
    const int grp = wave >> 2;
    int jp = -1;
    for (int j = 0; j < ntb; ++j) {
        const bool pf = j + 2 < ntb;
        if (pf) DA_DMA(j + 2);
        if (jp >= 0) { DA_PV(jp); jp = -1; }
        if (j < ntw) { DA_QKSM(j); if (grp == 0) DA_PV(j); else jp = j; }
        if (pf) ATT_WAIT_BAR(4); else ATT_WAIT_BAR(0);
    }
    if (jp >= 0) DA_PV(jp);
#undef DA_QKSM
#undef DA_PV
    __syncthreads();
#undef DA_DMA
    l = xhalf_sum(l);
    const float inv = (map ? lam : 1.f) / l;
    LAS float* ex = (LAS float*)(lds + rg * 16384);
    if (map == 1) {
#pragma unroll
        for (int i = 0; i < 4; ++i)
#pragma unroll
            for (int r = 0; r < 16; ++r) ex[(i * 16 + r) * 64 + lane] = O[i][r] * inv;
    }
    __syncthreads();
    if (map == 0) {
        float ss = 0.f;
#pragma unroll
        for (int i = 0; i < 4; ++i)
#pragma unroll
            for (int r = 0; r < 16; ++r) { const float o = O[i][r] * inv - ex[(i * 16 + r) * 64 + lane]; O[i][r] = o; ss += o * o; }
        ss = xhalf_sum(ss);
        const float rn = rsqrtf(ss * (1.f / 128.f) + EPS) * 0.8f;
        bf16_t* orow = mixin + (rowbase + t) * D + h * 128;
#pragma unroll
        for (int i = 0; i < 4; ++i)
#pragma unroll
            for (int g = 0; g < 4; ++g) { const int d0 = 32 * i + 8 * g + 4 * hh; const float4 gs = *(const float4*)(g_subln + d0);
                uint2 o; o.x = cvtpk(O[i][4 * g + 0] * rn * gs.x, O[i][4 * g + 1] * rn * gs.y); o.y = cvtpk(O[i][4 * g + 2] * rn * gs.z, O[i][4 * g + 3] * rn * gs.w);
                *(uint2*)(orow + d0) = o; }
    }
    __syncthreads();
}

__device__ __forceinline__ unsigned fkey(float f) { f = f + 0.0f; const unsigned u = __float_as_uint(f); return (u & 0x80000000u) ? ~u : (u | 0x80000000u); }
__device__ __forceinline__ int wave_sum_dpp(int v) {
    v += __builtin_amdgcn_update_dpp(0, v, 0x111, 0xf, 0xf, true);
    v += __builtin_amdgcn_update_dpp(0, v, 0x112, 0xf, 0xf, true);
    v += __builtin_amdgcn_update_dpp(0, v, 0x114, 0xf, 0xf, true);
    v += __builtin_amdgcn_update_dpp(0, v, 0x118, 0xf, 0xf, true);
    v += __builtin_amdgcn_update_dpp(0, v, 0x142, 0xa, 0xf, true);
    v += __builtin_amdgcn_update_dpp(0, v, 0x143, 0xc, 0xf, true);
    return __builtin_amdgcn_readlane(v, 63);
}
__device__ __forceinline__ void bit_transpose32(unsigned (&A)[32]) {
#pragma unroll
    for (int s = 0; s < 5; ++s) { const int j = 16 >> s; const unsigned m = s == 0 ? 0x0000FFFFu : s == 1 ? 0x00FF00FFu : s == 2 ? 0x0F0F0F0Fu : s == 3 ? 0x33333333u : 0x55555555u;
#pragma unroll
        for (int k = 0; k < 32; ++k) if (!(k & j)) { const unsigned a = A[k], b = A[k + j]; A[k] = (a & m) | ((b << j) & ~m); A[k + j] = ((a >> j) & m) | (b & ~m); } }
}
template <int NI>
__device__ __forceinline__ void dsa_select_pair(const LAS float* sc, unsigned* __restrict__ maskw, size_t rowbase, int t_base, int lane, int wave) {
    {
        const int tlA = 2 * wave, tA = t_base + tlA, tB = tA + 1, nkA = tA + 1, nkB = tB + 1;
        unsigned* mrowA = maskw + (rowbase + tA) * 64; unsigned* mrowB = mrowA + 64;
        const bool smallA = nkA <= 256, smallB = nkB <= 256;
        unsigned PA[32], PB[32];
#pragma unroll
        for (int i = 0; i < 32; ++i) {
            if (i < NI) { const int idx = lane + 64 * i;
                const float vA = sc[tlA * 2048 + (idx < nkA ? idx : 0)], vB = sc[(tlA + 1) * 2048 + (idx < nkB ? idx : 0)];
                PA[i] = idx < nkA ? fkey(vA) : 0u; PB[i] = idx < nkB ? fkey(vB) : 0u; }
            else { PA[i] = 0u; PB[i] = 0u; } }
        bit_transpose32(PA); bit_transpose32(PB);
        unsigned gtA = 0u, eqA = 0xFFFFFFFFu, gtB = 0u, eqB = 0xFFFFFFFFu, selA = 0u, selB = 0u;
        bool doneA = smallA, doneB = smallB, exactA = false, exactB = false;
#pragma unroll
        for (int bit = 31; bit >= 0; --bit) if (!(doneA && doneB)) {
            const unsigned geA = gtA | (eqA & PA[bit]), geB = gtB | (eqB & PB[bit]);
            const int tot2 = wave_sum_dpp(__builtin_popcount(geA) | (__builtin_popcount(geB) << 16));
            const int totA = tot2 & 0xffff, totB = tot2 >> 16;
            if (!doneA) { if (totA >= 256) { eqA &= PA[bit]; if (totA == 256) { selA = geA; exactA = true; doneA = true; } } else { gtA = geA; eqA &= ~PA[bit]; } }
            if (!doneB) { if (totB >= 256) { eqB &= PB[bit]; if (totB == 256) { selB = geB; exactB = true; doneB = true; } } else { gtB = geB; eqB &= ~PB[bit]; } }
        }
#pragma unroll 1
        for (int tt = 0; tt < 2; ++tt) {
            const int t = tt ? tB : tA; unsigned* mrow = tt ? mrowB : mrowA; const bool small = tt ? smallB : smallA, exact = tt ? exactB : exactA;
            if (small) {
                const int w0 = 32 * lane;
                unsigned v = 0u;
                if (w0 + 31 <= t) v = 0xFFFFFFFFu; else if (w0 <= t) v = (1u << (t - w0 + 1)) - 1u;
                mrow[lane] = v;
            } else {
                unsigned sel = tt ? selB : selA;
                if (!exact) {
                    const unsigned gt = tt ? gtB : gtA, eq = tt ? eqB : eqA;
                    const int need = 256 - wave_sum_dpp(__builtin_popcount(gt)); int running = 0;
                    const unsigned long long lt = (1ull << lane) - 1ull;
                    sel = gt;
#pragma unroll
                    for (int i = 0; i < NI; ++i) {
                        const bool e = (eq >> i) & 1u; const unsigned long long be = __ballot(e);
                        const int rank = running + __builtin_popcountll(be & lt);
                        if (e && rank < need) sel |= 1u << i;
                        running += __builtin_popcountll(be);
                    }
                }
                unsigned long long mine = 0ull;
#pragma unroll
                for (int i = 0; i < NI; ++i) { const unsigned long long bal = __ballot(((sel >> i) & 1u) != 0u); if (lane == i) mine = bal; }
                if (lane < 32) *(unsigned long long*)(mrow + 2 * lane) = lane < NI ? mine : 0ull;
            }
        }
    }
}
__device__ __forceinline__ void dsa_index_unit(const bf16_t* __restrict__ proj, unsigned* __restrict__ maskw, LAS unsigned char* lds, int b, int u16, int tid, int lane, int wave) {
    const int t_base = 16 * u16, ntile = ((t_base + 15) >> 5) + 1;
    const size_t rowbase = (size_t)b * S;
    LAS float* sc = (LAS float*)lds;
    const int r32 = lane & 31, hh = lane >> 5;
    {
        LAS float* wl = (LAS float*)(lds + 132096);
        if (tid < 128) wl[tid] = bf2f(proj[(rowbase + t_base + (tid >> 3)) * NPP + C_IW + (tid & 7)]) * (0.35355339059327373f * 0.125f);
        const int hsel = (r32 >> 2) & 1, q = (r32 & 3) + 4 * (r32 >> 3), tokl = 2 * hsel + (q >> 3), head = q & 7;
        LAS unsigned char* afi = lds + 133120;
#pragma unroll
        for (int cc = 0; cc < 2; ++cc) { const int c = tid + 512 * cc, crt = c >> 8, cks = (c >> 6) & 3, chh = (c >> 5) & 1, cr = c & 31;
            const int chs = (cr >> 2) & 1, cq = (cr & 3) + 4 * (cr >> 3), ctok = 2 * chs + (cq >> 3), chead = cq & 7;
            const bf16x8_t cv = *(const bf16x8_t*)(proj + (rowbase + t_base + 4 * crt + ctok) * NPP + C_IQ + chead * 64 + 8 * chh + 16 * cks);
            *(LAS bf16x8_t*)(afi + c * 16) = cv; }
        bf16x8_t bfr[4], bnx[4];
        const bf16_t* bp0 = proj + (rowbase + r32) * NPP + C_IK + 8 * hh;
        if (wave < ntile) {
#pragma unroll
            for (int ks = 0; ks < 4; ++ks) bnx[ks] = *(const bf16x8_t*)(bp0 + (size_t)(32 * wave) * NPP + 16 * ks);
        }
        __syncthreads();
        bf16x8_t af[4][4];
#pragma unroll
        for (int rt = 0; rt < 4; ++rt)
#pragma unroll
            for (int ks = 0; ks < 4; ++ks) af[rt][ks] = *(const LAS bf16x8_t*)(afi + ((((rt * 4 + ks) * 2 + hh) * 32 + r32) * 16));
        (void)tokl; (void)head;
        for (int tile = wave; tile < ntile; tile += 8) {
#pragma unroll
            for (int ks = 0; ks < 4; ++ks) bfr[ks] = bnx[ks];
            if (tile + 8 < ntile) {
#pragma unroll
                for (int ks = 0; ks < 4; ++ks) bnx[ks] = *(const bf16x8_t*)(bp0 + (size_t)(32 * (tile + 8)) * NPP + 16 * ks);
            }
            const int key = 32 * tile + r32;
#pragma unroll
            for (int rt = 0; rt < 4; ++rt) {
                f32x16_t acc;
#pragma unroll
                for (int r = 0; r < 16; ++r) acc[r] = 0.f;
#pragma unroll
                for (int ks = 0; ks < 4; ++ks) acc = MFMA32(af[rt][ks], bfr[ks], acc);
                const int tl = 4 * rt + 2 * hh;
                const LAS f32x4_t* w4 = (const LAS f32x4_t*)(wl + tl * 8);
                const f32x4_t wa0 = w4[0], wa1 = w4[1], wb0 = w4[2], wb1 = w4[3];
                float sA = wa0.x * fmaxf(acc[0], 0.f) + wa0.y * fmaxf(acc[1], 0.f) + wa0.z * fmaxf(acc[2], 0.f) + wa0.w * fmaxf(acc[3], 0.f)
                         + wa1.x * fmaxf(acc[4], 0.f) + wa1.y * fmaxf(acc[5], 0.f) + wa1.z * fmaxf(acc[6], 0.f) + wa1.w * fmaxf(acc[7], 0.f);
                float sB = wb0.x * fmaxf(acc[8], 0.f) + wb0.y * fmaxf(acc[9], 0.f) + wb0.z * fmaxf(acc[10], 0.f) + wb0.w * fmaxf(acc[11], 0.f)
                         + wb1.x * fmaxf(acc[12], 0.f) + wb1.y * fmaxf(acc[13], 0.f) + wb1.z * fmaxf(acc[14], 0.f) + wb1.w * fmaxf(acc[15], 0.f);
                const int tA = t_base + tl;
                sc[tl * 2048 + key] = key <= tA ? sA : -INFINITY;
                sc[(tl + 1) * 2048 + key] = key <= tA + 1 ? sB : -INFINITY;
            }
        }
    }
    __syncthreads();
    {
        const int ni = (t_base + 16 + 63) >> 6;
        if (ni <= 8) dsa_select_pair<8>(sc, maskw, rowbase, t_base, lane, wave);
        else if (ni <= 16) dsa_select_pair<16>(sc, maskw, rowbase, t_base, lane, wave);
        else if (ni <= 24) dsa_select_pair<24>(sc, maskw, rowbase, t_base, lane, wave);
        else dsa_select_pair<32>(sc, maskw, rowbase, t_base, lane, wave);
    }
    __syncthreads();
}

constexpr int DB_KV = 0, DB_BIAS = 32768, DB_Q = 36864, DB_LDS = 36864 + 65536;
__device__ __forceinline__ void dsa_attn_unit(const bf16_t* __restrict__ proj, const unsigned* __restrict__ maskw, const bf16_t* __restrict__ wuvF, const float* __restrict__ rel_bias, const float* __restrict__ g_kv,
                                              bf16_t* __restrict__ mixin, LAS unsigned char* lds, int b, int u64, int tid, int lane, int wave) {
    const int head = wave & 3, tgrp = wave >> 2, r32 = lane & 31, hh = lane >> 5;
    const int t0 = 64 * u64 + 32 * tgrp, t = t0 + r32;
    const int ntb = u64 + 1;
    const size_t rowbase = (size_t)b * S;
    LAS float* biasT = (LAS float*)(lds + DB_BIAS);
    for (int i = tid; i < 1024; i += NTHREADS) biasT[i] = rel_bias[rel_bucket(i & 255) * 8 + 4 + (i >> 8)] * LOG2E;
    const float c31 = rel_bias[31 * 8 + 4 + head] * LOG2E;
    bf16x8_t qreg[8];
    { const bf16_t* qrow = proj + (rowbase + t) * NPP + C_SQ + head * 128 + 8 * hh;
#pragma unroll
      for (int ks = 0; ks < 8; ++ks) qreg[ks] = *(const bf16x8_t*)(qrow + 16 * ks); }
    const int skey = tid >> 4, sc = tid & 15;
    const bf16_t* sg = proj + (rowbase + skey) * NPP + C_SKV + 8 * sc;
    const unsigned soff0 = (sc >> 2) * 4096 + skey * 64 + (((sc & 3) ^ ((skey >> 2) & 3)) * 16), soff1 = soff0 + 32 * 64;
    u32x4_t raw0, raw1; u32x2_t mw, mwn;
    const unsigned* mrow = maskw + (rowbase + t) * 64;
#define DB_LOAD(j) do { const size_t o_ = (size_t)(64 * (j)) * NPP; raw0 = *(const u32x4_t*)(sg + o_); raw1 = *(const u32x4_t*)(sg + o_ + (size_t)32 * NPP); mwn = *(const u32x2_t*)(mrow + 2 * (j)); } while (0)
#define DB_NORM1(raw, off) do { float f_[8]; float ss_ = 0.f; \
        _Pragma("unroll") for (int jj = 0; jj < 4; ++jj) { f_[2 * jj] = __uint_as_float(raw[jj] << 16); f_[2 * jj + 1] = __uint_as_float(raw[jj] & 0xffff0000u); ss_ += f_[2 * jj] * f_[2 * jj] + f_[2 * jj + 1] * f_[2 * jj + 1]; } \
        ss_ += __shfl_xor(ss_, 1); ss_ += __shfl_xor(ss_, 2); ss_ += __shfl_xor(ss_, 4); ss_ += __shfl_xor(ss_, 8); \
        const float rr_ = rsqrtf(ss_ * (1.f / 128.f) + EPS); u32x4_t o_; const float4 ga_ = *(const float4*)(g_kv + 8 * sc), gb_ = *(const float4*)(g_kv + 8 * sc + 4); const float gk[8] = {ga_.x, ga_.y, ga_.z, ga_.w, gb_.x, gb_.y, gb_.z, gb_.w}; \
        _Pragma("unroll") for (int jj = 0; jj < 4; ++jj) o_[jj] = cvtpk(f_[2 * jj] * rr_ * gk[2 * jj], f_[2 * jj + 1] * rr_ * gk[2 * jj + 1]); \
        *(LAS u32x4_t*)(kvb_ + (off)) = o_; } while (0)
#define DB_WRITE(bf) do { LAS unsigned char* kvb_ = lds + DB_KV + (bf) * 16384; DB_NORM1(raw0, soff0); DB_NORM1(raw1, soff1); } while (0)
    DB_LOAD(0); DB_WRITE(0); mw = mwn;
    __syncthreads();
    f32x16_t O[4];
#pragma unroll
    for (int i = 0; i < 4; ++i)
#pragma unroll
        for (int r = 0; r < 16; ++r) O[i][r] = 0.f;
    float m = -1e30f, l = 0.f;
    const float SC = 0.08838834764831845f * LOG2E;
    const int i16 = lane & 15, tq = i16 >> 2, tp = i16 & 3, g1 = (lane >> 4) & 1;
    const unsigned vrd_lo = (4 * hh + tq) * 64 + (((2 * g1 + (tp >> 1)) ^ (hh & 3)) * 16) + 8 * (tp & 1);
    const unsigned vrd_hi = (4 * hh + 8 + tq) * 64 + (((2 * g1 + (tp >> 1)) ^ ((hh + 2) & 3)) * 16) + 8 * (tp & 1);
    const unsigned kx = (unsigned)((r32 >> 2) & 3);
    const LAS float* bT = biasT + head * 256;
    for (int j = 0; j < ntb; ++j) {
        if (j + 1 < ntb) DB_LOAD(j + 1);
        {
            const LAS unsigned char* kvb = lds + DB_KV + (j & 1) * 16384;
            const bool nearb = (t0 - (64 * j + 63)) < 113;
#pragma unroll
            for (int sub = 0; sub < 2; ++sub) {
                f32x16_t s0;
#pragma unroll
                for (int r = 0; r < 16; ++r) s0[r] = 0.f;
                const LAS unsigned char* kvs = kvb + sub * (32 * 64);
#pragma unroll
                for (int ks = 0; ks < 8; ++ks) {
                    const int c16 = 2 * ks + hh;
                    const unsigned ao = (unsigned)((c16 >> 2) * 4096 + r32 * 64) + (((unsigned)(c16 & 3) ^ kx) * 16u);
                    const bf16x8_t a0 = *(const LAS bf16x8_t*)(kvs + ao);
                    const bf16x8_t qk = qreg[ks];
                    s0 = MFMA32(a0, qk, s0);
                }
                const int kbase = 64 * j + 32 * sub + 4 * hh;
                const unsigned w0 = (sub ? mw.y : mw.x) >> (4 * hh);
                float alpha, ps = 0.f;
                if (nearb) {
#pragma unroll
                    for (int r = 0; r < 16; ++r) { const int key = kbase + (r & 3) + 8 * (r >> 2);
                        int d0 = t - key; d0 = d0 < 0 ? 0 : d0;
                        s0[r] = s0[r] * SC + bT[d0]; }
#pragma unroll
                    for (int r = 0; r < 16; ++r) { const int bp = (r & 3) + 8 * (r >> 2); if (!((w0 >> bp) & 1u)) s0[r] = -INFINITY; }
                    float mt = vmax3(s0[0], s0[1], s0[2]);
#pragma unroll
                    for (int r = 3; r < 15; r += 2) mt = vmax3(mt, s0[r], s0[r + 1]);
                    mt = vmax2(mt, s0[15]);
                    mt = xhalf_max(mt);
                    const float mn = vmax2(m, mt);
                    alpha = __builtin_amdgcn_exp2f(m - mn);
                    m = mn;
#pragma unroll
                    for (int r = 0; r < 16; ++r) { s0[r] = __builtin_amdgcn_exp2f(s0[r] - mn); ps += s0[r]; }
                } else {
#pragma unroll
                    for (int r = 0; r < 16; ++r) { const int bp = (r & 3) + 8 * (r >> 2); if (!((w0 >> bp) & 1u)) s0[r] = -INFINITY; }
                    float mr = vmax3(s0[0], s0[1], s0[2]);
#pragma unroll
                    for (int r = 3; r < 15; r += 2) mr = vmax3(mr, s0[r], s0[r + 1]);
                    mr = vmax2(mr, s0[15]);
                    mr = xhalf_max(mr);
                    const float mn = vmax2(m, mr * SC + c31);
                    alpha = __builtin_amdgcn_exp2f(m - mn);
                    m = mn;
                    const float off = c31 - mn;
#pragma unroll
                    for (int r = 0; r < 16; ++r) { s0[r] = __builtin_amdgcn_exp2f(s0[r] * SC + off); ps += s0[r]; }
                }
                l = l * alpha + ps;
                if (__any(alpha != 1.f)) {
#pragma unroll
                    for (int i = 0; i < 4; ++i)
#pragma unroll
                        for (int r = 0; r < 16; ++r) O[i][r] *= alpha;
                }
                bf16x8_t pb[2];
                pb[0] = pack8(s0, 0); pb[1] = pack8(s0, 1);
#pragma unroll
                for (int s = 0; s < 2; ++s)
#pragma unroll
                    for (int dblk = 0; dblk < 4; ++dblk) {
                        const LAS unsigned char* vp = kvs + dblk * 4096 + (16 * s) * 64;
                        const s16x4_t lo = vtr(vp + vrd_lo), hi = vtr(vp + vrd_hi);
                        const bf16x8_t va = __builtin_shufflevector(lo, hi, 0, 1, 2, 3, 4, 5, 6, 7);
                        O[dblk] = MFMA32(va, pb[s], O[dblk]);
                    }
            }
        }
        if (j + 1 < ntb) { DB_WRITE((j + 1) & 1); mw = mwn; }
        __syncthreads();
    }
#undef DB_LOAD
#undef DB_NORM1
#undef DB_WRITE
    l = xhalf_sum(l);
    const float inv = 1.f / l;
#pragma unroll
    for (int i = 0; i < 4; ++i)
#pragma unroll
        for (int r = 0; r < 16; ++r) O[i][r] *= inv;
    bf16x8_t ob[4][2];
#pragma unroll
    for (int i = 0; i < 4; ++i) { ob[i][0] = pack8(O[i], 0); ob[i][1] = pack8(O[i], 1); }
    bf16_t* orow = mixin + (rowbase + t) * D + 512 + head * 128;
    u32x2_t po[4][4];
#pragma unroll 1
    for (int e2 = 0; e2 < 2; ++e2) {
        bf16x8_t wa[2][8];
#pragma unroll
        for (int q = 0; q < 2; ++q)
#pragma unroll
            for (int i = 0; i < 4; ++i)
#pragma unroll
                for (int s = 0; s < 2; ++s) wa[q][2 * i + s] = *(const bf16x8_t*)(wuvF + ((((size_t)(head * 4 + 2 * e2 + q) * 4 + i) * 2 + s) * 64 + lane) * 8);
#pragma unroll
        for (int q = 0; q < 2; ++q) {
            f32x16_t acc;
#pragma unroll
            for (int r = 0; r < 16; ++r) acc[r] = 0.f;
#pragma unroll
            for (int i = 0; i < 4; ++i)
#pragma unroll
                for (int s = 0; s < 2; ++s) acc = MFMA32(wa[q][2 * i + s], ob[i][s], acc);
#pragma unroll
            for (int g = 0; g < 4; ++g) { u32x2_t o; o.x = cvtpk(acc[4 * g + 0], acc[4 * g + 1]); o.y = cvtpk(acc[4 * g + 2], acc[4 * g + 3]);
                if (e2 == 0) po[q][g] = o; else po[2 + q][g] = o; }
        }
    }
#pragma unroll
    for (int eb = 0; eb < 4; ++eb)
#pragma unroll
        for (int g = 0; g < 4; ++g) *(u32x2_t*)(orow + 32 * eb + 8 * g + 4 * hh) = po[eb][g];
}

__device__ __forceinline__ unsigned fkey_raw(float f) { const unsigned u = __float_as_uint(f); return (u & 0x80000000u) ? ~u : (u | 0x80000000u); }
__device__ __forceinline__ float fkey_inv(unsigned k) { const unsigned u = (k & 0x80000000u) ? (k & 0x7fffffffu) : ~k; return __uint_as_float(u); }
__device__ __forceinline__ unsigned ps_fmax(unsigned a, unsigned b) { unsigned r; asm("v_max_f32 %0, %1, %2" : "=v"(r) : "v"(a), "v"(b)); return r; }
__device__ __forceinline__ unsigned ps_fmin(unsigned a, unsigned b) { unsigned r; asm("v_min_f32 %0, %1, %2" : "=v"(r) : "v"(a), "v"(b)); return r; }
#define PS_CE(a, b) do { const unsigned hi_ = ps_fmax((a), (b)); const unsigned lo_ = ps_fmin((a), (b)); (a) = hi_; (b) = lo_; } while (0)
__device__ __forceinline__ void sort16_desc(unsigned (&k)[16]) {
    PS_CE(k[0], k[1]); PS_CE(k[2], k[3]); PS_CE(k[0], k[2]); PS_CE(k[1], k[3]); PS_CE(k[1], k[2]); PS_CE(k[4], k[5]); PS_CE(k[6], k[7]); PS_CE(k[4], k[6]); PS_CE(k[5], k[7]); PS_CE(k[5], k[6]); PS_CE(k[0], k[4]); PS_CE(k[2], k[6]); PS_CE(k[2], k[4]); PS_CE(k[1], k[5]); PS_CE(k[3], k[7]); PS_CE(k[3], k[5]); PS_CE(k[1], k[2]); PS_CE(k[3], k[4]); PS_CE(k[5], k[6]); PS_CE(k[8], k[9]); PS_CE(k[10], k[11]); PS_CE(k[8], k[10]); PS_CE(k[9], k[11]); PS_CE(k[9], k[10]); PS_CE(k[12], k[13]); PS_CE(k[14], k[15]); PS_CE(k[12], k[14]); PS_CE(k[13], k[15]); PS_CE(k[13], k[14]); PS_CE(k[8], k[12]); PS_CE(k[10], k[14]); PS_CE(k[10], k[12]); PS_CE(k[9], k[13]); PS_CE(k[11], k[15]); PS_CE(k[11], k[13]); PS_CE(k[9], k[10]); PS_CE(k[11], k[12]); PS_CE(k[13], k[14]); PS_CE(k[0], k[8]); PS_CE(k[4], k[12]); PS_CE(k[4], k[8]); PS_CE(k[2], k[10]); PS_CE(k[6], k[14]); PS_CE(k[6], k[10]); PS_CE(k[2], k[4]); PS_CE(k[6], k[8]); PS_CE(k[10], k[12]); PS_CE(k[1], k[9]); PS_CE(k[5], k[13]); PS_CE(k[5], k[9]); PS_CE(k[3], k[11]); PS_CE(k[7], k[15]); PS_CE(k[7], k[11]); PS_CE(k[3], k[5]); PS_CE(k[7], k[9]); PS_CE(k[11], k[13]); PS_CE(k[1], k[2]); PS_CE(k[3], k[4]); PS_CE(k[5], k[6]); PS_CE(k[7], k[8]); PS_CE(k[9], k[10]); PS_CE(k[11], k[12]); PS_CE(k[13], k[14]);
}
__device__ __forceinline__ void sort9_desc(unsigned (&k)[9]) {
    PS_CE(k[0], k[1]); PS_CE(k[2], k[3]); PS_CE(k[0], k[2]); PS_CE(k[1], k[3]); PS_CE(k[1], k[2]); PS_CE(k[4], k[5]); PS_CE(k[6], k[7]); PS_CE(k[4], k[6]); PS_CE(k[5], k[7]); PS_CE(k[5], k[6]); PS_CE(k[0], k[4]); PS_CE(k[2], k[6]); PS_CE(k[2], k[4]); PS_CE(k[1], k[5]); PS_CE(k[3], k[7]); PS_CE(k[3], k[5]); PS_CE(k[1], k[2]); PS_CE(k[3], k[4]); PS_CE(k[5], k[6]); PS_CE(k[0], k[8]); PS_CE(k[4], k[8]); PS_CE(k[2], k[4]); PS_CE(k[6], k[8]); PS_CE(k[3], k[5]); PS_CE(k[1], k[2]); PS_CE(k[3], k[4]); PS_CE(k[5], k[6]); PS_CE(k[7], k[8]);
}
__device__ __forceinline__ void merge16_top9(unsigned (&a)[16], const unsigned (&b)[9]) {
#pragma unroll
    for (int i = 7; i < 16; ++i) a[i] = ps_fmax(a[i], b[15 - i]);
#pragma unroll
    for (int j = 8; j > 0; j >>= 1)
#pragma unroll
        for (int i = 0; i < 16; ++i) { const int l = i ^ j; if (l > i) PS_CE(a[i], a[l]); }
}
__device__ __forceinline__ void merge16_top(unsigned (&a)[16], const unsigned (&b)[16]) {
#pragma unroll
    for (int i = 0; i < 16; ++i) a[i] = ps_fmax(a[i], b[15 - i]);
#pragma unroll
    for (int j = 8; j > 0; j >>= 1)
#pragma unroll
        for (int i = 0; i < 16; ++i) { const int l = i ^ j; if (l > i) PS_CE(a[i], a[l]); }
}
__device__ __forceinline__ unsigned xhalf_get(unsigned x, int hh) { auto rr = __builtin_amdgcn_permlane32_swap(x, x, false, false); return hh ? rr[0] : rr[1]; }
__device__ __forceinline__ void top16_of_pair(unsigned (&g0)[16], unsigned (&g1)[16], unsigned (&g2)[16], unsigned (&g3)[16], int hh) {
    sort16_desc(g0); sort16_desc(g1); sort16_desc(g2); sort16_desc(g3);
    merge16_top(g0, g1); merge16_top(g2, g3); merge16_top(g0, g2);
#pragma unroll
    for (int i = 0; i < 16; ++i) g1[i] = xhalf_get(g0[i], hh);
    merge16_top(g0, g1);
}
__device__ __forceinline__ void peer_select_wave(int tile, const bf16_t* __restrict__ qb, const bf16_t* __restrict__ keysb, unsigned short* __restrict__ eidx, float* __restrict__ gate, LAS unsigned char* kimg, int tid, int lane) {
    const int r32 = lane & 31, hh = lane >> 5;
    const int tok = tile * 32 + r32;
    const bf16_t* qrow0 = qb + (size_t)tok * D + 8 * hh;
    int kofs = 0; asm volatile("" : "+s"(kofs));
    const bf16_t* kch0; const bf16_t* kch1;
    { const int c0 = tid, c1 = tid + 512;
      kch0 = keysb + kofs + (size_t)(32 * (c0 >> 8) + (c0 & 31)) * 64 + 8 * ((c0 >> 5) & 1) + 16 * ((c0 >> 6) & 3);
      kch1 = keysb + kofs + (size_t)(32 * (c1 >> 8) + (c1 & 31)) * 64 + 8 * ((c1 >> 5) & 1) + 16 * ((c1 >> 6) & 3); }
    const LAS unsigned char* krd = kimg + (hh * 32 + r32) * 16;
    unsigned L1[16], L2[16];
#pragma unroll
    for (int i = 0; i < 16; ++i) { L1[i] = 0u; L2[i] = 0u; }
    bf16x8_t qfr[4], ka[4];
    unsigned tneg = 4u * hh, tpos = tneg ^ 127u;
    asm volatile("" : "+v"(tneg), "+v"(tpos));
#define PSW_LOADQ(HP) do { _Pragma("unroll") for (int ks = 0; ks < 4; ++ks) qfr[ks] = *(const bf16x8_t*)(qrow0 + (HP) * 64 + 16 * ks); } while (0)
#define PSW_LOADK(HP, KT) do { _Pragma("unroll") for (int ks = 0; ks < 4; ++ks) ka[ks] = *(const LAS bf16x8_t*)(krd + ((HP) & 1) * 16384 + ((KT) * 4 + ks) * 1024); } while (0)
#define PSW_FETCH(HP) do { kf0 = *(const bf16x8_t*)(kch0 + (size_t)(HP) * 128 * 64); kf1 = *(const bf16x8_t*)(kch1 + (size_t)(HP) * 128 * 64); } while (0)
#define PSW_PUT(HP) do { *(LAS bf16x8_t*)(kimg + ((HP) & 1) * 16384 + tid * 16) = kf0; *(LAS bf16x8_t*)(kimg + ((HP) & 1) * 16384 + (tid + 512) * 16) = kf1; } while (0)
#define PSW_MFMA() do { _Pragma("unroll") for (int r = 0; r < 16; ++r) acc[r] = 0.f; \
        _Pragma("unroll") for (int ks = 0; ks < 4; ++ks) acc = MFMA32(ka[ks], qfr[ks], acc); } while (0)
#define PSW_KEYS(KT) do { _Pragma("unroll") for (int r = 0; r < 16; ++r) { const unsigned C_ = 32 * (KT) + (r & 3) + 8 * (r >> 2); const unsigned ub = __float_as_uint(acc[r]); g[KT][r] = (ub & ~127u) | (((int)ub < 0 ? tneg : tpos) ^ C_); } } while (0)
    bf16x8_t kf0, kf1;
    PSW_LOADQ(0); PSW_FETCH(0);
    __syncthreads();
    PSW_PUT(0);
    __syncthreads();
    PSW_LOADK(0, 0);
#pragma unroll 1
    for (int hp = 0; hp < 16; ++hp) {
        const int h = hp >> 1, p = hp & 1, hn = hp + 1 < 16 ? hp + 1 : 15;
        unsigned g[4][16]; f32x16_t acc;
        PSW_FETCH(hn);
        PSW_MFMA(); PSW_LOADK(hp, 1);
        __builtin_amdgcn_sched_barrier(0);
        PSW_KEYS(0);
        PSW_MFMA(); PSW_LOADK(hp, 2);
        __builtin_amdgcn_sched_barrier(0);
        PSW_KEYS(1);
        PSW_MFMA(); PSW_LOADK(hp, 3);
        __builtin_amdgcn_sched_barrier(0);
        PSW_KEYS(2);
        PSW_MFMA(); PSW_LOADQ(hn);
        PSW_PUT(hp + 1);
        __builtin_amdgcn_sched_barrier(0);
        PSW_KEYS(3);
        top16_of_pair(g[0], g[1], g[2], g[3], hh);
#pragma unroll
        for (int i = 0; i < 16; ++i) { L1[i] = p == 0 ? g[0][i] : L1[i]; L2[i] = p == 0 ? L2[i] : g[0][i]; }
        if (p == 1) {
            float s1[16], s2[16];
#pragma unroll
            for (int i = 0; i < 16; ++i) { s1[i] = __uint_as_float(L1[i] & ~127u); s2[i] = __uint_as_float(L2[i] & ~127u); }
            unsigned c0[16], c1[16], c9[9];
#pragma unroll
            for (int i = 0; i < 16; ++i) c0[i] = 0xff800000u;
#pragma unroll
            for (int i = 0; i < 9; ++i) c9[i] = 0xff800000u;
            {
                int n = 0;
#pragma unroll
                for (int i = 0; i < 16; ++i)
#pragma unroll
                    for (int j = 0; j < 16; ++j) if ((i + 1) * (j + 1) <= 16) {
                        const unsigned sb = __float_as_uint(s1[i] + s2[j]); const unsigned ck = (sb & ~255u) | (unsigned)((sb >> 31) ? (i * 16 + j) : 255 - (i * 16 + j));
                        const int slot = n >> 1;
                        if (slot < 16) c0[slot] = ((n & 1) == hh) ? ck : c0[slot]; else c9[slot - 16] = ((n & 1) == hh) ? ck : c9[slot - 16];
                        ++n;
                    }
            }
            sort16_desc(c0); sort9_desc(c9); merge16_top9(c0, c9);
#pragma unroll
            for (int i = 0; i < 16; ++i) c1[i] = xhalf_get(c0[i], hh);
            merge16_top(c0, c1);
            float ev[16]; float su = 0.f;
            const float tmax = __uint_as_float(c0[0] & ~255u);
#pragma unroll
            for (int r = 0; r < 16; ++r) { ev[r] = __expf(__uint_as_float(c0[r] & ~255u) - tmax); su += ev[r]; }
            const float inv = 1.f / su;
            unsigned short* eo = eidx + (size_t)tok * 128 + h * 16 + 8 * hh; float* go = gate + (size_t)tok * 128 + h * 16 + 8 * hh;
            unsigned T1[4], T2[4];
#pragma unroll
            for (int w = 0; w < 4; ++w) { unsigned d1 = 0u, d2 = 0u;
#pragma unroll
                for (int bq = 0; bq < 4; ++bq) { const unsigned ka_ = L1[4 * w + bq], kb_ = L2[4 * w + bq];
                    const unsigned ia = ~(ka_ ^ (unsigned)((int)ka_ >> 31)) & 127u, ib = ~(kb_ ^ (unsigned)((int)kb_ >> 31)) & 127u;
                    d1 |= ia << (8 * bq); d2 |= ib << (8 * bq); }
                T1[w] = d1; T2[w] = d2; }
            int ei[8]; float gv[8];
#pragma unroll
            for (int r = 0; r < 8; ++r) {
                const unsigned ck = hh ? c0[8 + r] : c0[r]; const float e = hh ? ev[8 + r] : ev[r];
                const int pos = (ck >> 31) ? (int)(ck & 255u) : 255 - (int)(ck & 255u), pi = pos >> 4, pj = pos & 15;
                const unsigned s1_ = ((unsigned)pi & 7u) | 0x0c0c0c00u, s2_ = ((unsigned)pj & 7u) | 0x0c0c0c00u;
                const unsigned a1 = __builtin_amdgcn_perm(T1[1], T1[0], s1_), b1 = __builtin_amdgcn_perm(T1[3], T1[2], s1_);
                const unsigned a2 = __builtin_amdgcn_perm(T2[1], T2[0], s2_), b2 = __builtin_amdgcn_perm(T2[3], T2[2], s2_);
                const int i1 = (int)(pi >= 8 ? b1 : a1), i2 = (int)(pj >= 8 ? b2 : a2);
                ei[r] = i1 * 128 + i2; gv[r] = e * inv;
            }
            __builtin_amdgcn_s_waitcnt(0x0F70);
            *(uint4*)(eo) = make_uint4((unsigned)ei[0] | ((unsigned)ei[1] << 16), (unsigned)ei[2] | ((unsigned)ei[3] << 16), (unsigned)ei[4] | ((unsigned)ei[5] << 16), (unsigned)ei[6] | ((unsigned)ei[7] << 16));
            *(float4*)(go) = make_float4(gv[0], gv[1], gv[2], gv[3]); *(float4*)(go + 4) = make_float4(gv[4], gv[5], gv[6], gv[7]);
        }
        __syncthreads();
        PSW_LOADK(hp + 1, 0);
    }
#undef PSW_FETCH
#undef PSW_PUT
#undef PSW_LOADQ
#undef PSW_LOADK
#undef PSW_MFMA
#undef PSW_KEYS
}

__device__ __forceinline__ float gelu_erf(float a) { return 0.5f * a * (1.f + erff(a * 0.70710678118654752f)); }
template <int CTRL> __device__ __forceinline__ int dpp_i(int v) { return __builtin_amdgcn_update_dpp(0, v, CTRL, 0xf, 0xf, false); }
template <int CTRL> __device__ __forceinline__ float dpp_f(float v) { return __int_as_float(__builtin_amdgcn_update_dpp(0, __float_as_int(v), CTRL, 0xf, 0xf, false)); }
constexpr int DPP_XOR1 = 0xB1, DPP_XOR2 = 0x4E, DPP_HMIRROR = 0x141, DPP_ROR8 = 0x128;

__device__ __forceinline__ void peer_gather_tile(int tile, const unsigned char* __restrict__ xq, const float* __restrict__ sxs, const unsigned short* __restrict__ eidx, const float* __restrict__ gate,
                                                 const unsigned char* __restrict__ uq, const unsigned char* __restrict__ vq, const float* __restrict__ su, const float* __restrict__ sv,
                                                 const float* __restrict__ mod, const float* __restrict__ g_final, const bf16_t* xin, bf16_t* ybuf, float* outp,
                                                 LAS unsigned char* wlds, LAS unsigned char* wsc, int lane) {
    const int tok0 = tile * 32, e_sub = lane >> 3, part = lane & 7;
    const int b0 = lane & 1, b1 = (lane >> 1) & 1, b2 = (lane >> 2) & 1, b3 = (lane >> 3) & 1, b4 = (lane >> 4) & 1, b5 = (lane >> 5) & 1;
    unsigned idr[32];
#pragma unroll
    for (int t = 0; t < 32; ++t) idr[t] = ((const unsigned*)(eidx + (size_t)(tok0 + t) * 128))[lane];
    int c128 = 128, part16 = 16 * part;
    asm volatile("" : "+v"(c128), "+v"(part16));
    LAS int* accl = (LAS int*)wlds;
    const __amdgpu_buffer_rsrc_t urs = __builtin_amdgcn_make_buffer_rsrc((void*)uq, 0, 16384 * 1024, 0x00020000);
    const __amdgpu_buffer_rsrc_t vrs = __builtin_amdgcn_make_buffer_rsrc((void*)vq, 0, 16384 * 1024, 0x00020000);
#pragma unroll
    for (int i = 0; i < 16; ++i) *(LAS u32x4_t*)(wlds + i * 1024 + lane * 16) = (u32x4_t){0u, 0u, 0u, 0u};
#define PG_LOADIDXRAW(q_, tl_) do { q_ = idr[(tl_)]; } while (0)
#define PG_UNPACKIDX(dst, q_) do { ((LAS unsigned*)wsc)[lane] = q_; const u32x4_t q0_ = *(const LAS u32x4_t*)(wsc + 32 * e_sub), q1_ = *(const LAS u32x4_t*)(wsc + 32 * e_sub + 16); \
        dst[0] = q0_.x; dst[1] = q0_.y; dst[2] = q0_.z; dst[3] = q0_.w; dst[4] = q1_.x; dst[5] = q1_.y; dst[6] = q1_.z; dst[7] = q1_.w; } while (0)
#define PG_ROWOFF(vo_, w_, hi_) do { if (hi_) asm("v_mad_u32_u16 %0, %1, %2, %3 op_sel:[1,0,0,0]" : "=v"(vo_) : "v"(w_), "v"(c128), "v"(part16)); \
                                     else asm("v_mad_u32_u16 %0, %1, %2, %3 op_sel:[0,0,0,0]" : "=v"(vo_) : "v"(w_), "v"(c128), "v"(part16)); } while (0)
#define PG_LOADROWS8(dst, idx_, h_, rs_) do { _Pragma("unroll") for (int i_ = 0; i_ < 8; ++i_) { int vo_; PG_ROWOFF(vo_, idx_[(8 * (h_) + i_) >> 1], (i_ & 1)); dst[i_] = __builtin_amdgcn_raw_buffer_load_b128(rs_, vo_, soff, 0); } } while (0)
#define PG_LOADROWS8_AFTER(dst, idx_, h_, rs_, dep_) do { _Pragma("unroll") for (int i_ = 0; i_ < 8; ++i_) { int vo_; PG_ROWOFF(vo_, idx_[(8 * (h_) + i_) >> 1], (i_ & 1)); asm volatile("" : "+v"(vo_) : "v"(dep_)); \
        dst[i_] = __builtin_amdgcn_raw_buffer_load_b128(rs_, vo_, soff, 0); } } while (0)
#define PG_UDOT8(r_, xs_, h_) do { _Pragma("unroll") for (int i = 0; i < 8; ++i) { int a_ = __builtin_amdgcn_sdot4((int)r_[i][0], (int)xs_.x, 0, false); a_ = __builtin_amdgcn_sdot4((int)r_[i][1], (int)xs_.y, a_, false); \
            a_ = __builtin_amdgcn_sdot4((int)r_[i][2], (int)xs_.z, a_, false); d[8 * (h_) + i] = __builtin_amdgcn_sdot4((int)r_[i][3], (int)xs_.w, a_, false); } } while (0)
#pragma unroll 1
    for (int s = 0; s < 8; ++s) {
        const int loff = 128 * s + 16 * part; const int soff = s * (16384 * 128);
        unsigned idxN[8]; u32x4_t rP[8], rQ[8]; unsigned iqw;
        LAS unsigned char* xbuf = wsc + 512;
        const unsigned char* xsrc = xq + (size_t)(tok0 + (lane >> 3)) * 1024 + loff;
        u32x4_t xh0 = __builtin_nontemporal_load((const u32x4_t*)(xsrc)), xh1 = __builtin_nontemporal_load((const u32x4_t*)(xsrc + 8 * 1024));
        PG_LOADIDXRAW(iqw, 0); PG_UNPACKIDX(idxN, iqw);
        PG_LOADROWS8(rP, idxN, 0, urs); PG_LOADROWS8(rQ, idxN, 1, urs);
        PG_LOADIDXRAW(iqw, 1);
        *(LAS u32x4_t*)(xbuf + lane * 16) = xh0; *(LAS u32x4_t*)(xbuf + 1024 + lane * 16) = xh1;
#pragma unroll 1
        for (int tl = 0; tl < 32; ++tl) {
            int d[16];
            const int tn2 = tl + 2 < 32 ? tl + 2 : 31;
            PG_UNPACKIDX(idxN, iqw);
            PG_LOADIDXRAW(iqw, tn2);
            if (tl == 8) { xh0 = __builtin_nontemporal_load((const u32x4_t*)(xsrc + 16 * 1024)); xh1 = __builtin_nontemporal_load((const u32x4_t*)(xsrc + 24 * 1024)); }
            if (tl == 16) { *(LAS u32x4_t*)(xbuf + lane * 16) = xh0; *(LAS u32x4_t*)(xbuf + 1024 + lane * 16) = xh1; }
            const u32x4_t xsC = *(const LAS u32x4_t*)(xbuf + (tl & 15) * 128 + part * 16);
            __builtin_amdgcn_sched_barrier(0);
            PG_UDOT8(rP, xsC, 0);
            PG_LOADROWS8_AFTER(rP, idxN, 0, urs, d[7]);
            __builtin_amdgcn_sched_barrier(0);
            PG_UDOT8(rQ, xsC, 1);
            PG_LOADROWS8_AFTER(rQ, idxN, 1, urs, d[15]);
            __builtin_amdgcn_sched_barrier(0);
#pragma unroll
            for (int j = 0; j < 8; ++j) { const int keep = b2 ? d[j + 8] : d[j], send = b2 ? d[j] : d[j + 8]; d[j] = keep + dpp_i<DPP_HMIRROR>(send); }
#pragma unroll
            for (int j = 0; j < 4; ++j) { const int keep = b0 ? d[j + 4] : d[j], send = b0 ? d[j] : d[j + 4]; d[j] = keep + dpp_i<DPP_XOR1>(send); }
#pragma unroll
            for (int j = 0; j < 2; ++j) { const int keep = b1 ? d[j + 2] : d[j], send = b1 ? d[j] : d[j + 2]; d[j] = keep + dpp_i<DPP_XOR2>(send); }
            LAS int* ap = accl + tl * 128 + 16 * e_sub + 8 * b2 + 4 * b0 + 2 * b1; ap[0] += d[0]; ap[1] += d[1];
        }
    }
#pragma unroll 1
    for (int t4 = 0; t4 < 32; t4 += 4) {
        int e_[4][2]; float g_[4][2], sx_[4], su_[4][2], sv_[4][2];
#pragma unroll
        for (int r = 0; r < 4; ++r) { const int tok = tok0 + t4 + r; sx_[r] = sxs[tok];
#pragma unroll
            for (int hf = 0; hf < 2; ++hf) { e_[r][hf] = (int)eidx[(size_t)tok * 128 + lane + 64 * hf]; g_[r][hf] = gate[(size_t)tok * 128 + lane + 64 * hf]; } }
        __builtin_amdgcn_sched_barrier(0);
#pragma unroll
        for (int r = 0; r < 4; ++r)
#pragma unroll
            for (int hf = 0; hf < 2; ++hf) { su_[r][hf] = su[e_[r][hf]]; sv_[r][hf] = sv[e_[r][hf]]; }
        __builtin_amdgcn_sched_barrier(0);
#pragma unroll
        for (int r = 0; r < 4; ++r) { const int tl = t4 + r;
            float wf[2];
#pragma unroll
            for (int hf = 0; hf < 2; ++hf) { const float a = (float)accl[tl * 128 + lane + 64 * hf] * sx_[r] * su_[r][hf]; wf[hf] = g_[r][hf] * gelu_erf(a) * sv_[r][hf]; }
            const float wm = wave_max(fmaxf(fabsf(wf[0]), fabsf(wf[1])));
            const float sw = wm > 0.f ? wm * (1.f / 127.f) : 1.f, inv = wm > 0.f ? 127.f / wm : 0.f;
            LAS signed char* wb = (LAS signed char*)(accl + tl * 128);
            wb[lane] = (signed char)(int)rintf(wf[0] * inv); wb[lane + 64] = (signed char)(int)rintf(wf[1] * inv);
            if (lane == 0) ((LAS float*)accl)[tl * 128 + 32] = sw;
        }
    }
#define PG_VACC8(r_, h_) do { _Pragma("unroll") for (int g_ = 0; g_ < 2; ++g_) { const int wq_ = (int)wq4[2 * (h_) + g_]; \
            _Pragma("unroll") for (int q = 0; q < 4; ++q) { const unsigned R0 = r_[4 * g_][q], R1 = r_[4 * g_ + 1][q], R2 = r_[4 * g_ + 2][q], R3 = r_[4 * g_ + 3][q]; \
                const unsigned A_ = __builtin_amdgcn_perm(R1, R0, 0x05010400u), B_ = __builtin_amdgcn_perm(R1, R0, 0x07030602u), C_ = __builtin_amdgcn_perm(R3, R2, 0x05010400u), D_ = __builtin_amdgcn_perm(R3, R2, 0x07030602u); \
                acc[4 * q + 0] = __builtin_amdgcn_sdot4((int)__builtin_amdgcn_perm(C_, A_, 0x05040100u), wq_, acc[4 * q + 0], false); \
                acc[4 * q + 1] = __builtin_amdgcn_sdot4((int)__builtin_amdgcn_perm(C_, A_, 0x07060302u), wq_, acc[4 * q + 1], false); \
                acc[4 * q + 2] = __builtin_amdgcn_sdot4((int)__builtin_amdgcn_perm(D_, B_, 0x05040100u), wq_, acc[4 * q + 2], false); \
                acc[4 * q + 3] = __builtin_amdgcn_sdot4((int)__builtin_amdgcn_perm(D_, B_, 0x07060302u), wq_, acc[4 * q + 3], false); } } } while (0)
#define PG_FLUSH(S_) do { _Pragma("unroll") for (int k = 0; k < 8; ++k) { const int f = 64 * k + lane, tkn = f >> 4, c = f & 15; \
            const u32x4_t yv = *(const LAS u32x4_t*)(wlds + tkn * 512 + 256 + 16 * c); \
            __builtin_nontemporal_store(yv, (u32x4_t*)(ybuf + (size_t)(tok0 + tkn) * D + 256 * (c >> 2) + 32 * (S_) + 8 * (c & 3))); } } while (0)
#pragma unroll 1
    for (int s = 0; s < 8; ++s) {
        const int soff = s * (16384 * 128);
        const int col = 256 * (2 * b3 + b5) + 32 * s + 4 * part + 2 * b4;
        LAS unsigned* ystage = (LAS unsigned*)(wlds + 256 + 64 * (2 * b3 + b5) + 8 * part + 4 * b4);
        const float2 gf = *(const float2*)(mod + (size_t)(tok0 / S) * 6144 + MOD_GATE_F + col);
        unsigned idxN[8]; u32x4_t rP[8], rQ[8]; unsigned iqw; unsigned x1pC, x1pN;
        PG_LOADIDXRAW(iqw, 0); PG_UNPACKIDX(idxN, iqw);
        x1pC = *(const unsigned*)(xin + (size_t)tok0 * D + col);
        PG_LOADROWS8(rP, idxN, 0, vrs); PG_LOADROWS8(rQ, idxN, 1, vrs);
        PG_LOADIDXRAW(iqw, 1);
        __builtin_amdgcn_sched_barrier(0);
        if (s > 0) PG_FLUSH(s - 1);
        __builtin_amdgcn_s_waitcnt(0x0F70);
#pragma unroll 1
        for (int tl = 0; tl < 32; ++tl) {
            const int tn = tl + 1 < 32 ? tl + 1 : 31, tn2 = tl + 2 < 32 ? tl + 2 : 31;
            PG_UNPACKIDX(idxN, iqw);
            PG_LOADIDXRAW(iqw, tn2);
            x1pN = *(const unsigned*)(xin + (size_t)(tok0 + tn) * D + col);
            const u32x4_t wq4 = *(const LAS u32x4_t*)((const LAS unsigned char*)(accl + tl * 128) + 16 * e_sub);
            const float sw = ((const LAS float*)accl)[tl * 128 + 32];
            int acc[16];
#pragma unroll
            for (int c = 0; c < 16; ++c) acc[c] = 0;
            __builtin_amdgcn_sched_barrier(0);
            PG_VACC8(rP, 0);
            PG_LOADROWS8_AFTER(rP, idxN, 0, vrs, acc[15]);
            __builtin_amdgcn_sched_barrier(0);
            PG_VACC8(rQ, 1);
            PG_LOADROWS8_AFTER(rQ, idxN, 1, vrs, acc[15]);
            __builtin_amdgcn_sched_barrier(0);
#pragma unroll
            for (int j = 0; j < 8; ++j) { const int keep = b3 ? acc[j + 8] : acc[j], send = b3 ? acc[j] : acc[j + 8]; acc[j] = keep + dpp_i<DPP_ROR8>(send); }
#pragma unroll
            for (int j = 0; j < 4; ++j) { auto rr = __builtin_amdgcn_permlane32_swap((unsigned)acc[j], (unsigned)acc[j + 4], false, false); acc[j] = (int)rr[0] + (int)rr[1]; }
#pragma unroll
            for (int j = 0; j < 2; ++j) { const int keep = b4 ? acc[j + 2] : acc[j], send = b4 ? acc[j] : acc[j + 2]; acc[j] = keep + __shfl_xor(send, 16); }
            float2 x1; x1.x = __uint_as_float(x1pC << 16); x1.y = __uint_as_float(x1pC & 0xffff0000u);
            ystage[tl * 128] = pk2(x1.x + gf.x * ((float)acc[0] * sw), x1.y + gf.y * ((float)acc[1] * sw));
            x1pC = x1pN;
        }
    }
    PG_FLUSH(7);
    __builtin_amdgcn_s_waitcnt(0x0F70);
#undef PG_FLUSH
#undef PG_LOADIDXRAW
#undef PG_UNPACKIDX
#undef PG_ROWOFF
#undef PG_LOADROWS8
#undef PG_LOADROWS8_AFTER
#undef PG_UDOT8
#undef PG_VACC8
    float4 gg[4];
#pragma unroll
    for (int i = 0; i < 4; ++i) gg[i] = *(const float4*)(g_final + 256 * i + 4 * lane);
#pragma unroll 1
    for (int tl = 0; tl < 32; tl += 4) {
        float4 y[4][4]; float ss[4];
#pragma unroll
        for (int r = 0; r < 4; ++r) { ss[r] = 0.f;
#pragma unroll
            for (int i = 0; i < 4; ++i) { const uint2 yb = *(const uint2*)(ybuf + (size_t)(tok0 + tl + r) * D + 256 * i + 4 * lane);
                y[r][i].x = __uint_as_float(yb.x << 16); y[r][i].y = __uint_as_float(yb.x & 0xffff0000u); y[r][i].z = __uint_as_float(yb.y << 16); y[r][i].w = __uint_as_float(yb.y & 0xffff0000u); } }
#pragma unroll
        for (int r = 0; r < 4; ++r)
#pragma unroll
            for (int i = 0; i < 4; ++i) ss[r] += y[r][i].x * y[r][i].x + y[r][i].y * y[r][i].y + y[r][i].z * y[r][i].z + y[r][i].w * y[r][i].w;
#pragma unroll
        for (int o = 32; o >= 1; o >>= 1)
#pragma unroll
            for (int r = 0; r < 4; ++r) ss[r] += __shfl_xor(ss[r], o);
#pragma unroll
        for (int r = 0; r < 4; ++r) { const float rn = rsqrtf(ss[r] * (1.f / D) + EPS);
#pragma unroll
            for (int i = 0; i < 4; ++i) { float4 o; o.x = y[r][i].x * rn * gg[i].x; o.y = y[r][i].y * rn * gg[i].y; o.z = y[r][i].z * rn * gg[i].z; o.w = y[r][i].w * rn * gg[i].w;
                *(float4*)(outp + (size_t)(tok0 + tl + r) * D + 256 * i + 4 * lane) = o; } }
    }
}

constexpr size_t MiB = 1u << 20;
constexpr size_t WS_CTL = 0, CTL_ZERO_BYTES = 1 * MiB;
constexpr size_t WS_MOD = 1 * MiB;
constexpr size_t WS_LAM = 1 * MiB + 800 * 1024;
constexpr size_t WS_WIN_T = 2 * MiB;
constexpr size_t WS_WO_T = 8 * MiB;
constexpr size_t WS_WQ_T = 10 * MiB;
constexpr size_t WS_HBUF = 16 * MiB;
constexpr size_t WS_MIXIN = 144 * MiB;
constexpr size_t WS_MASK = 272 * MiB;
constexpr size_t WS_KEYSB = 13 * MiB;
constexpr size_t WS_WUVF = 12 * MiB;
constexpr size_t WS_EIDX = 288 * MiB;
constexpr size_t WS_GATE = 320 * MiB;
constexpr size_t WS_BIG = 352 * MiB;
constexpr size_t WS_UQ = 704 * MiB;
constexpr size_t WS_VQ = 720 * MiB;
constexpr size_t WS_SU = 736 * MiB;
constexpr size_t WS_SV = 736 * MiB + 65536;
constexpr size_t WS_XQ = 737 * MiB;
constexpr size_t WS_SX = 801 * MiB;
constexpr size_t WS_END = 802 * MiB;
constexpr int CW_BAR = 4096;
constexpr int MAX_FWD_LAUNCHES = 8;
static_assert((CW_BAR + MAX_FWD_LAUNCHES * XCD_BAR_WORDS) * 4 <= (int)CTL_ZERO_BYTES, "barrier words inside the memset region");

constexpr int RING_OFF = 0, RING_BYTES = 131072;
constexpr int LDSCTL_OFF = RING_BYTES, MISC_OFF = LDSCTL_OFF + 320;
constexpr int LDS_BYTES = 163840;

constexpr int REPS[11] = {1, 1, 1, 1, 1, 1, 1, 1, 1, 1, 1};
struct Args { const float* in[21]; float* out; unsigned char* ws; int ph_lo, ph_hi, li, pad; };

__device__ __forceinline__ void p0_transpose_item(const float* W, int K, int N, int Npad, bf16_t* WT, LAS float* scr, int item, int lane) {
    const int nblk = Npad / 32, kb = item / nblk, nb = item % nblk, k0 = 64 * kb, n0 = 32 * nb;
    const int n_in = n0 + (lane & 31);
#pragma unroll 8
    for (int i = 0; i < 32; ++i) { const int kk = 2 * i + (lane >> 5); scr[kk * 33 + (lane & 31)] = n_in < N ? W[(size_t)(k0 + kk) * N + n_in] : 0.f; }
    asm volatile("s_waitcnt lgkmcnt(0)" ::: "memory");
    const int c = lane & 7;
#pragma unroll
    for (int j = 0; j < 4; ++j) { const int n = (lane >> 3) + 8 * j; const LAS float* s = scr + (8 * c) * 33 + n;
        uint4 o; o.x = pk2(s[0 * 33], s[1 * 33]); o.y = pk2(s[2 * 33], s[3 * 33]); o.z = pk2(s[4 * 33], s[5 * 33]); o.w = pk2(s[6 * 33], s[7 * 33]);
        *(uint4*)(WT + (size_t)(n0 + n) * K + k0 + 8 * c) = o; }
    asm volatile("s_waitcnt lgkmcnt(0)" ::: "memory");
}

template <int OFFS, bool SLICED = false> __device__ __forceinline__ void quant_row(const float4 (&v)[4], unsigned char* qrow, float* scale_out, int lane);
template <int OFFS, bool SLICED> __device__ __forceinline__ void quant_row(const float4 (&v)[4], unsigned char* qrow, float* scale_out, int lane);
template <bool QUANT, int NR, bool BF16IN>
__device__ __forceinline__ void norm_mod_rows(const void* xrows_v, const float* g, const float* mb, int shift_off, int scale_off, bf16_t* orows, int lane, unsigned char* qrows, float* qscale) {
    float4 v[NR][4]; float ss[NR];
#pragma unroll
    for (int r = 0; r < NR; ++r)
#pragma unroll
        for (int i = 0; i < 4; ++i) {
            if (BF16IN) { const uint2 b2 = ((const uint2*)((const bf16_t*)xrows_v + (size_t)r * D))[lane + 64 * i];
                v[r][i].x = __uint_as_float(b2.x << 16); v[r][i].y = __uint_as_float(b2.x & 0xffff0000u); v[r][i].z = __uint_as_float(b2.y << 16); v[r][i].w = __uint_as_float(b2.y & 0xffff0000u); }
            else v[r][i] = ((const float4*)((const float*)xrows_v + (size_t)r * D))[lane + 64 * i];
        }
#pragma unroll
    for (int r = 0; r < NR; ++r) { ss[r] = 0.f;
#pragma unroll
        for (int i = 0; i < 4; ++i) ss[r] += v[r][i].x * v[r][i].x + v[r][i].y * v[r][i].y + v[r][i].z * v[r][i].z + v[r][i].w * v[r][i].w; }
#pragma unroll
    for (int o = 32; o >= 1; o >>= 1)
#pragma unroll
        for (int r = 0; r < NR; ++r) ss[r] += __shfl_xor(ss[r], o);
#pragma unroll
    for (int i = 0; i < 4; ++i) {
        const int col = (lane + 64 * i) * 4;
        const float4 gg = *(const float4*)(g + col), sc = *(const float4*)(mb + scale_off + col), sh = *(const float4*)(mb + shift_off + col);
        const float mx = gg.x * (1.f + sc.x), my = gg.y * (1.f + sc.y), mz = gg.z * (1.f + sc.z), mw = gg.w * (1.f + sc.w);
#pragma unroll
        for (int r = 0; r < NR; ++r) {
            const float rn = rsqrtf(ss[r] * (1.f / D) + EPS);
            v[r][i].x = v[r][i].x * rn * mx + sh.x; v[r][i].y = v[r][i].y * rn * my + sh.y; v[r][i].z = v[r][i].z * rn * mz + sh.z; v[r][i].w = v[r][i].w * rn * mw + sh.w;
            uint2 o; o.x = pk2(v[r][i].x, v[r][i].y); o.y = pk2(v[r][i].z, v[r][i].w);
            *(uint2*)(orows + (size_t)r * D + col) = o;
        }
    }
    if (QUANT) {
#pragma unroll
        for (int r = 0; r < NR; ++r) quant_row<0>(v[r], qrows + (size_t)r * 1024, qscale + r, lane);
    }
}

template <int OFFS, bool SLICED>
__device__ __forceinline__ void quant_row(const float4 (&v)[4], unsigned char* qrow, float* scale_out, int lane) {
    float am = 0.f;
#pragma unroll
    for (int i = 0; i < 4; ++i) am = fmaxf(am, fmaxf(fmaxf(fabsf(v[i].x), fabsf(v[i].y)), fmaxf(fabsf(v[i].z), fabsf(v[i].w))));
    am = wave_max(am);
    const float sc = am > 0.f ? am * (1.f / 127.f) : 1.f, inv = am > 0.f ? 127.f / am : 0.f;
    uint4 o; unsigned w[4];
#pragma unroll
    for (int i = 0; i < 4; ++i) {
        const int q0 = (int)rintf(v[i].x * inv) + OFFS, q1 = (int)rintf(v[i].y * inv) + OFFS, q2 = (int)rintf(v[i].z * inv) + OFFS, q3 = (int)rintf(v[i].w * inv) + OFFS;
        w[i] = (unsigned)(q0 & 255) | ((unsigned)(q1 & 255) << 8) | ((unsigned)(q2 & 255) << 16) | ((unsigned)(q3 & 255) << 24);
    }
    o.x = w[0]; o.y = w[1]; o.z = w[2]; o.w = w[3];
    *(uint4*)(qrow + (SLICED ? (size_t)(lane >> 3) * (16384 * 128) + 16 * (lane & 7) : (size_t)16 * lane)) = o;
    if (lane == 0) *scale_out = sc;
}
__device__ __forceinline__ void quant_table_row(const float* row, unsigned char* qrow, float* scale_out, int lane, bool offs) {
    float4 v[4];
#pragma unroll
    for (int i = 0; i < 4; ++i) v[i] = ((const float4*)row)[lane + 64 * i];
    (void)offs; quant_row<0, true>(v, qrow, scale_out, lane);
}

__device__ __forceinline__ int treduce16(int (&v)[16], int lane) {
#pragma unroll
    for (int o = 8, n = 16; o >= 1; o >>= 1, n >>= 1) {
        const bool upper = (lane & o) != 0;
#pragma unroll
        for (int j = 0; j < n / 2; ++j) {
            const int keep = upper ? v[j + n / 2] : v[j];
            const int send = upper ? v[j] : v[j + n / 2];
            v[j] = keep + __shfl_xor(send, o);
        }
    }
    int t = v[0];
    t += __shfl_xor(t, 16); t += __shfl_xor(t, 32);
    return t;
}

typedef float f32x16m __attribute__((ext_vector_type(16)));
__device__ __forceinline__ void mod_block(const float* __restrict__ c, const float* __restrict__ w_ada, const float* __restrict__ b_ada, float* __restrict__ mod, LAS float* red, int blk, int tid, int lane, int wave) {
    const int r32 = lane & 31, hh = lane >> 5, j0 = 24 * blk;
    f32x16m acc;
#pragma unroll
    for (int r = 0; r < 16; ++r) acc[r] = 0.f;
    const int kb = 128 * wave;
#pragma unroll 8
    for (int s2 = 0; s2 < 64; ++s2) {
        const int k = kb + 2 * s2 + hh;
        const float cv = c[r32 * D + k];
        const float a = cv / (1.f + __expf(-cv));
        const float bw = r32 < 24 ? w_ada[(size_t)k * 6144 + j0 + r32] : 0.f;
        acc = __builtin_amdgcn_mfma_f32_32x32x2f32(a, bw, acc, 0, 0, 0);
    }
#pragma unroll
    for (int r = 0; r < 16; ++r) red[wave * 1024 + ((r & 3) + 8 * (r >> 2) + 4 * hh) * 32 + r32] = acc[r];
    __syncthreads();
    for (int o = tid; o < 32 * 24; o += NTHREADS) {
        const int b = o / 24, j = o - 24 * b; float sum = b_ada[j0 + j];
#pragma unroll
        for (int w = 0; w < 8; ++w) sum += red[w * 1024 + b * 32 + j];
        mod[b * 6144 + j0 + j] = sum;
    }
    __syncthreads();
}

__global__ void __launch_bounds__(NTHREADS, 2) fwd(Args args) {
    extern __shared__ __attribute__((aligned(16))) unsigned char lds_raw[];
    LAS unsigned char* lds = (LAS unsigned char*)lds_raw;
    volatile LAS unsigned* MISC = (volatile LAS unsigned*)(lds + MISC_OFF);
    const int wave = __builtin_amdgcn_readfirstlane(threadIdx.x >> 6);
#define LANE_ID() ((int)__builtin_amdgcn_mbcnt_hi(~0u, __builtin_amdgcn_mbcnt_lo(~0u, 0u)))
    const int G = gridDim.x;
    unsigned char* ws = args.ws;
    unsigned* ctl = (unsigned*)(ws + WS_CTL);
    for (int u = threadIdx.x; u < (LDS_BYTES - LDSCTL_OFF) / 4; u += NTHREADS) ((LAS unsigned*)(lds + LDSCTL_OFF))[u] = 0u;
    __syncthreads();
    XcdBarrier bar = xcd_barrier_post(ctl + CW_BAR + args.li * XCD_BAR_WORDS, MISC + 8);
    const int lo = args.ph_lo, hi = args.ph_hi;
#define IN(k) (lo <= (k) && (k) < hi)
#define BOTH(k) (IN(k) && IN((k) + 1))
    const float* x = args.in[0];
    const float* g_norm_mix = args.in[4];
    const float* w_in = args.in[5];
    const float* w_out = args.in[13];
    const float* g_norm_ffn = args.in[14];
    const float* w_peer_q = args.in[15];
    float* out = args.out;
    float* mod = (float*)(ws + WS_MOD);
    bf16_t* Win_t = (bf16_t*)(ws + WS_WIN_T); bf16_t* Wo_t = (bf16_t*)(ws + WS_WO_T); bf16_t* Wq_t = (bf16_t*)(ws + WS_WQ_T);
    bf16_t* hbuf = (bf16_t*)(ws + WS_HBUF); bf16_t* mixin = (bf16_t*)(ws + WS_MIXIN);
    bf16_t* proj = (bf16_t*)(ws + WS_BIG); bf16_t* qb = (bf16_t*)(ws + WS_BIG); bf16_t* keysb = (bf16_t*)(ws + WS_KEYSB);
    bf16_t* x1b = (bf16_t*)(ws + WS_BIG + 128 * MiB);
    unsigned* maskw = (unsigned*)(ws + WS_MASK); bf16_t* wuvF = (bf16_t*)(ws + WS_WUVF);
    unsigned char* uq = ws + WS_UQ; unsigned char* vq = ws + WS_VQ; float* su = (float*)(ws + WS_SU); float* sv = (float*)(ws + WS_SV);
    unsigned char* xq = ws + WS_XQ; float* sxs = (float*)(ws + WS_SX);
    const int gw = blockIdx.x * NWAVES + wave, NGW = G * NWAVES;
    const int vcu = (G % 8 == 0) ? ((int)blockIdx.x % 8) * (G / 8) + (int)blockIdx.x / 8 : (int)blockIdx.x;

    if (IN(0)) for (int rep_ = 0; rep_ < REPS[0]; ++rep_) {
        const int lane = LANE_ID(), tid = wave * 64 + lane; (void)tid;
        for (int blk = blockIdx.x; blk < 256; blk += G) mod_block(args.in[1], args.in[2], args.in[3], mod, (LAS float*)(lds + RING_OFF), blk, tid, lane, wave);
        if (blockIdx.x == 0 && tid == 0) {
            float s1 = 0.f, s2 = 0.f;
            for (int i = 0; i < 64; ++i) { s1 += args.in[6][i] * args.in[7][i]; s2 += args.in[8][i] * args.in[9][i]; }
            *(float*)(ws + WS_LAM) = expf(s1) - expf(s2) + 0.2f;
        }
        LAS float* scr = (LAS float*)(lds + RING_OFF + wave * 16384);
        constexpr int I_IN = 16 * (NPP / 32), I_O = 16 * 32, I_Q = 16 * 32;
        for (int it = gw; it < I_IN + I_O + I_Q; it += NGW) {
            int r = it;
            if (r < I_IN) { p0_transpose_item(w_in, D, NP, NPP, Win_t, scr, r, lane); continue; } r -= I_IN;
            if (r < I_O) { p0_transpose_item(w_out, D, D, D, Wo_t, scr, r, lane); continue; } r -= I_O;
            p0_transpose_item(w_peer_q, D, D, D, Wq_t, scr, r, lane);
        }
        for (int i = blockIdx.x * NTHREADS + tid; i < 4 * 4 * 4 * 2 * 64 * 8; i += G * NTHREADS) {
            const int j = i & 7, ln = (i >> 3) & 63, s2 = (i >> 9) & 1, db = (i >> 10) & 3, eb = (i >> 12) & 3, hd = i >> 14;
            const int cc = 32 * db + 16 * s2 + 8 * (j >> 2) + 4 * (ln >> 5) + (j & 3), e = 32 * eb + (ln & 31);
            wuvF[i] = f2bf(args.in[12][((size_t)hd * 128 + cc) * 128 + e]);
        }
        for (int i = blockIdx.x * NTHREADS + tid; i < 8 * 2 * 128 * 64; i += G * NTHREADS) keysb[i] = f2bf(args.in[16][i]);
        for (int r = gw; r < 2 * 16384; r += NGW) {
            if (r < 16384) quant_table_row(args.in[17] + (size_t)r * D, uq + (size_t)r * 128, su + r, lane, false);
            else quant_table_row(args.in[18] + (size_t)(r - 16384) * D, vq + (size_t)(r - 16384) * 128, sv + (r - 16384), lane, false);
        }
        if (BOTH(0)) xcd_barrier(bar);
    }
    if (IN(1)) for (int rep_ = 0; rep_ < REPS[1]; ++rep_) {
        const int lane = LANE_ID(), tid = wave * 64 + lane; (void)tid;
        for (int m = 4 * gw; m < T; m += 4 * NGW) norm_mod_rows<false, 4, false>(x + (size_t)m * D, g_norm_mix, mod + (size_t)(m / S) * 6144, MOD_SHIFT_A, MOD_SCALE_A, hbuf + (size_t)m * D, lane, nullptr, nullptr);
        if (BOTH(1)) xcd_barrier(bar);
    }
    if (IN(2)) for (int rep_ = 0; rep_ < REPS[2]; ++rep_) {
        pg8::Gemm g{hbuf, Win_t, T, NPP, D}; pg8::StaticOrder So; So.init(T, NPP, G, (int)blockIdx.x);
        pg8::EpiBf16Plain E{proj, NPP};
        pg8::gemm_phase<pg8::EpiBf16Plain, pg8::StaticOrder, true, true>(lds + RING_OFF, g, So, E);
        if (BOTH(2)) xcd_barrier(bar);
    }
    if (IN(3)) for (int rep_ = 0; rep_ < REPS[3]; ++rep_) {
        const int lane = LANE_ID(), tid = wave * 64 + lane; (void)tid;
        const float lam = *(const float*)(ws + WS_LAM);
        for (int it = vcu; it < 1024; it += G) {
            const int b = it >> 5, h = (it >> 3) & 3, qp = it & 7;
            diff_unit(proj, mixin, args.in[19], lam, args.in[10], lds, b, h, 15 - qp, tid, lane, wave);
            diff_unit(proj, mixin, args.in[19], lam, args.in[10], lds, b, h, qp, tid, lane, wave);
        }
    }
    if (IN(4)) for (int rep_ = 0; rep_ < REPS[4]; ++rep_) {
        const int lane = LANE_ID(), tid = wave * 64 + lane; (void)tid;
        for (int it = vcu; it < 512; it += G) {
            const int b = it >> 4, up = it & 15;
#pragma unroll 1
            for (int k8 = 0; k8 < 8; ++k8) dsa_index_unit(proj, maskw, lds, b, 4 * (k8 < 4 ? 31 - up : up) + (k8 & 3), tid, lane, wave);
        }
        asm volatile("s_waitcnt vmcnt(0)" ::: "memory");
        __syncthreads();
    }
    if (IN(5)) for (int rep_ = 0; rep_ < REPS[5]; ++rep_) {
        const int lane = LANE_ID(), tid = wave * 64 + lane; (void)tid;
        for (int it = vcu; it < 512; it += G) {
            const int b = it >> 4, up = it & 15;
            dsa_attn_unit(proj, maskw, wuvF, args.in[19], args.in[11], mixin, lds, b, 31 - up, tid, lane, wave);
            dsa_attn_unit(proj, maskw, wuvF, args.in[19], args.in[11], mixin, lds, b, up, tid, lane, wave);
        }
        if (BOTH(5)) xcd_barrier(bar);
    }
    if (IN(6)) for (int rep_ = 0; rep_ < REPS[6]; ++rep_) {
        pg8::Gemm g{mixin, Wo_t, T, D, D}; pg8::StaticOrder So; So.init(T, D, G, (int)blockIdx.x);
        pg8::EpiBf16ResB E{x1b, x, mod + MOD_GATE_A};
        pg8::gemm_phase<pg8::EpiBf16ResB, pg8::StaticOrder, true, false>(lds + RING_OFF, g, So, E);
        if (BOTH(6)) xcd_barrier(bar);
    }
    if (IN(7)) for (int rep_ = 0; rep_ < REPS[7]; ++rep_) {
        const int lane = LANE_ID(), tid = wave * 64 + lane; (void)tid;
        for (int m = 4 * gw; m < T; m += 4 * NGW) norm_mod_rows<true, 4, true>(x1b + (size_t)m * D, g_norm_ffn, mod + (size_t)(m / S) * 6144, MOD_SHIFT_F, MOD_SCALE_F, hbuf + (size_t)m * D, lane, xq + (size_t)m * 1024, sxs + m);
        if (BOTH(7)) xcd_barrier(bar);
    }
    if (IN(8)) for (int rep_ = 0; rep_ < REPS[8]; ++rep_) {
        pg8::Gemm g{hbuf, Wq_t, T, D, D}; pg8::StaticOrder So; So.init(T, D, G, (int)blockIdx.x);
        pg8::EpiBf16Plain E{qb, D};
        pg8::gemm_phase<pg8::EpiBf16Plain, pg8::StaticOrder, true, true>(lds + RING_OFF, g, So, E);
        if (BOTH(8)) xcd_barrier(bar);
    }
    if (IN(9)) for (int rep_ = 0; rep_ < REPS[9]; ++rep_) {
        const int lane = LANE_ID();
        for (int base = blockIdx.x * NWAVES; base < T / 32; base += NGW)
            peer_select_wave(base + wave, qb, keysb, (unsigned short*)(ws + WS_EIDX), (float*)(ws + WS_GATE), lds + RING_OFF, wave * 64 + lane, lane);
        asm volatile("s_waitcnt vmcnt(0)" ::: "memory");
    }
    if (IN(10)) for (int rep_ = 0; rep_ < REPS[10]; ++rep_) {
        const int lane = LANE_ID();
        const unsigned short* eidx = (const unsigned short*)(ws + WS_EIDX); const float* gate = (const float*)(ws + WS_GATE);
        bf16_t* ybuf = (bf16_t*)(ws + WS_BIG);
        for (int tile = gw; tile < T / 32; tile += NGW)
            peer_gather_tile(tile, xq, sxs, eidx, gate, uq, vq, su, sv, mod, args.in[20], x1b, ybuf, out, lds + RING_OFF + wave * 16384, lds + 133120 + wave * 3584, lane);
    }
#undef IN
#undef BOTH
}
#ifndef PROBE_PREFIX_N
#define PROBE_PREFIX_N 0
#endif
constexpr int PROBE_PREFIX = PROBE_PREFIX_N;
extern "C" void kernel_launch(void* const* d_in, const int* in_sizes, int n_in, void* d_out, int out_size, void* d_ws, size_t ws_size, hipStream_t stream) {
    static int grid = 0;
    if (grid == 0) {
        if (n_in != 21 || out_size != T * D || ws_size < WS_END) { fprintf(stderr, "kernel_launch: unexpected shapes (n_in %d out %d ws %zu)\n", n_in, out_size, ws_size); grid = -1; return; }
        int dev = 0, cus = 0, per_cu = 0;
        if (hipGetDevice(&dev) != hipSuccess || hipDeviceGetAttribute(&cus, hipDeviceAttributeMultiprocessorCount, dev) != hipSuccess) { grid = -1; return; }
        if (hipFuncSetAttribute((const void*)fwd, hipFuncAttributeMaxDynamicSharedMemorySize, LDS_BYTES) != hipSuccess) { fprintf(stderr, "kernel_launch: hipFuncSetAttribute failed\n"); grid = -1; return; }
        if (hipOccupancyMaxActiveBlocksPerMultiprocessor(&per_cu, (const void*)fwd, NTHREADS, LDS_BYTES) != hipSuccess || per_cu < 1)
            fprintf(stderr, "kernel_launch: occupancy query reports %d workgroups per CU\n", per_cu);
        (void)hipGetLastError();
        grid = cus;
        if (grid != 256) fprintf(stderr, "kernel_launch: %d CUs (expected 256)\n", grid);
    }
    if (grid < 0) return;
    float* out = (float*)d_out;
    unsigned char* ws = (unsigned char*)d_ws;
    (void)hipMemsetAsync(ws + WS_CTL, 0, CTL_ZERO_BYTES, stream);
    Args a{};
    for (int i = 0; i < 21; ++i) a.in[i] = (const float*)d_in[i];
    a.out = out; a.ws = ws;

    if (PROBE_PREFIX > 0) {
        a.ph_lo = 0; a.ph_hi = PROBE_PREFIX; a.li = 1;
        hipLaunchKernelGGL(fwd, dim3(grid), dim3(NTHREADS), LDS_BYTES, stream, a);
    }
    a.ph_lo = 0; a.ph_hi = 11; a.li = 0;
    hipLaunchKernelGGL(fwd, dim3(grid), dim3(NTHREADS), LDS_BYTES, stream, a);
}
```

```cpp
#include <hip/hip_runtime.h>
#include <stdint.h>
#include <stdio.h>

typedef unsigned short bf16_t;
#define LAS __attribute__((address_space(3)))
#define GAS __attribute__((address_space(1)))

constexpr int D = 1024, NB = 32, S = 2048, T = NB * S;
constexpr int NP = 2760, NPP = 2816;
constexpr int C_DQ = 0, C_DK = 512, C_DV = 1024, C_SQ = 1536, C_SKV = 2048, C_IQ = 2176, C_IK = 2688, C_IW = 2752;
constexpr int MOD_SHIFT_A = 0, MOD_SCALE_A = 1024, MOD_GATE_A = 2048, MOD_SHIFT_F = 3072, MOD_SCALE_F = 4096, MOD_GATE_F = 5120;
constexpr float EPS = 1e-6f;
constexpr int NWAVES = 8, NTHREADS = 512;

__device__ __forceinline__ float bf2f(bf16_t v) { return __uint_as_float(((unsigned)v) << 16); }
__device__ __forceinline__ bf16_t f2bf(float f) { unsigned u = __float_as_uint(f); u += 0x7fffu + ((u >> 16) & 1u); return (bf16_t)(u >> 16); }
__device__ __forceinline__ unsigned pk2(float lo, float hi) { return (unsigned)f2bf(lo) | ((unsigned)f2bf(hi) << 16); }

__device__ __forceinline__ int rel_bucket(int n) {
    if (n < 16) return n < 0 ? 0 : n;
    int b = 16;
    b += (n >= 19); b += (n >= 21); b += (n >= 24); b += (n >= 27); b += (n >= 31); b += (n >= 35); b += (n >= 40); b += (n >= 46);
    b += (n >= 52); b += (n >= 59); b += (n >= 67); b += (n >= 77); b += (n >= 87); b += (n >= 99); b += (n >= 113);
    return b;
}

__device__ __forceinline__ float wave_sum(float v) {
#pragma unroll
    for (int o = 32; o >= 1; o >>= 1) v += __shfl_xor(v, o);
    return v;
}
__device__ __forceinline__ float wave_max(float v) {
#pragma unroll
    for (int o = 32; o >= 1; o >>= 1) v = fmaxf(v, __shfl_xor(v, o));
    return v;
}
__device__ __forceinline__ float block_sum(float v, float* red) {
    v = wave_sum(v);
    __syncthreads();
    if ((threadIdx.x & 63) == 0) red[threadIdx.x >> 6] = v;
    __syncthreads();
    return red[0] + red[1] + red[2] + red[3];
}
__device__ __forceinline__ float block_max(float v, float* red) {
    v = wave_max(v);
    __syncthreads();
    if ((threadIdx.x & 63) == 0) red[threadIdx.x >> 6] = v;
    __syncthreads();
    return fmaxf(fmaxf(red[0], red[1]), fmaxf(red[2], red[3]));
}
__device__ __forceinline__ int block_sum_i(int v, int* red) {
#pragma unroll
    for (int o = 32; o >= 1; o >>= 1) v += __shfl_xor(v, o);
    __syncthreads();
    if ((threadIdx.x & 63) == 0) red[threadIdx.x >> 6] = v;
    __syncthreads();
    return red[0] + red[1] + red[2] + red[3];
}

namespace pg8 {
#define PG8_LAS __attribute__((address_space(3)))
typedef unsigned short bf16_t;
typedef short bf16x8 __attribute__((ext_vector_type(8)));
typedef float f32x4 __attribute__((ext_vector_type(4)));
typedef unsigned u32x4 __attribute__((ext_vector_type(4)));
constexpr int BM = 256, BK = 64, HALF = 128, HTB = HALF * BK * 2  , STAGE_BYTES = 8 * HTB, NXCD = 8, WGM = 8;

__host__ __device__ __forceinline__ int lds_byte(int r, int c) { const int st = (r >> 4) * 2 + (c >> 5), rr = r & 15, cc = c & 31, ob = rr * 64 + cc * 2; return st * 1024 + (ob ^ (((ob >> 9) & 1) << 5)); }
__host__ __device__ __forceinline__ void stage_rc(int b, int& R, int& C) { const int st = b / 1024, sb = b % 1024, swz = sb ^ (((sb >> 9) & 1) << 5); R = (st >> 1) * 16 + swz / 64; C = (st & 1) * 32 + (swz % 64) / 2; }
__host__ __device__ __forceinline__ int perm32(int rho) { const int n = rho >> 4, i = rho & 15; return 8 * (i >> 2) + 4 * n + (i & 3); }

struct Unit { int pm, pn; };
struct Gemm { const bf16_t* A; const bf16_t* Bt; int M, N, K; };

struct StaticOrder {
    int nM, nN, nwg, G, c;
    __host__ __device__ void init(int M, int N, int G_, int c_) { nM = M / BM; nN = N / BM; nwg = nM * nN; G = G_; c = c_; }
    __host__ __device__ bool next(int i, Unit& u) const {
        const long L = (long)i * G + c; if (L >= nwg) return false;
        int wgid = (int)L; { const int q = nwg / NXCD, r = nwg % NXCD, xcd = wgid % NXCD, off = wgid / NXCD; wgid = (xcd < r ? xcd * (q + 1) : r * (q + 1) + (xcd - r) * q) + off; }
        const int nig = WGM * nN, gid = wgid / nig, fm = gid * WGM, gsz = (nM - fm) < WGM ? (nM - fm) : WGM;
        u.pm = fm + ((wgid % nig) % gsz); u.pn = (wgid % nig) / gsz; return true;
    }
    __device__ __forceinline__ void a_ready(const Unit&) const {}
    __device__ __forceinline__ void done(const Unit&) const {}
};
__device__ __forceinline__ unsigned cvt_pk_bf16(float lo, float hi) { unsigned r; asm volatile("v_cvt_pk_bf16_f32 %0, %1, %2" : "=v"(r) : "v"(lo), "v"(hi)); return r; }
typedef float f32x2 __attribute__((ext_vector_type(2)));
struct EpiBf16Plain {
    static constexpr bool PERM = true, AFTER_DRAIN = false;
    bf16_t* O; int ldc;
    __device__ __forceinline__ void operator()(const f32x4 (&acc)[2][2][4][2], const Unit& u, int wr, int wc, int fr, int fq) const {
        const int row0 = u.pm * BM + wr * 64 + fr, col0 = u.pn * BM + wc * 32 + 8 * fq;
#pragma unroll
        for (int ai = 0; ai < 2; ++ai)
#pragma unroll
            for (int m = 0; m < 4; ++m) { bf16_t* rowp = O + (size_t)(row0 + ai * HALF + m * 16) * ldc + col0;
#pragma unroll
                for (int bj = 0; bj < 2; ++bj) { const f32x4 v0 = acc[ai][bj][m][0], v1 = acc[ai][bj][m][1];
                    u32x4 w; w.x = cvt_pk_bf16(v0[0], v0[1]); w.y = cvt_pk_bf16(v0[2], v0[3]); w.z = cvt_pk_bf16(v1[0], v1[1]); w.w = cvt_pk_bf16(v1[2], v1[3]);
                    *(u32x4*)(rowp + bj * HALF) = w; } }
    }
};
struct EpiF32Res {
    static constexpr bool PERM = false, AFTER_DRAIN = false;
    float* C; const float* res; const float* gate;
    __device__ __forceinline__ void operator()(const f32x4 (&acc)[2][2][4][2], const Unit& u, int wr, int wc, int fr, int fq) const {
        const int row0 = u.pm * BM + wr * 64 + fr, col0 = u.pn * BM + wc * 32 + 4 * fq;
        f32x4 gv[2][2];
#pragma unroll
        for (int bj = 0; bj < 2; ++bj)
#pragma unroll
            for (int n = 0; n < 2; ++n) gv[bj][n] = res ? *(const f32x4*)(gate + (size_t)(u.pm >> 3) * 6144 + col0 + bj * HALF + n * 16) : (f32x4){1.f, 1.f, 1.f, 1.f};
#pragma unroll
        for (int ai = 0; ai < 2; ++ai)
#pragma unroll
            for (int m = 0; m < 4; ++m) { const size_t off = (size_t)(row0 + ai * HALF + m * 16) * 1024 + col0;
#pragma unroll
                for (int bj = 0; bj < 2; ++bj)
#pragma unroll
                    for (int n = 0; n < 2; ++n) { f32x4 o = acc[ai][bj][m][n] * gv[bj][n];
                        if (res) o = o + *(const f32x4*)(res + off + bj * HALF + n * 16);
                        *(f32x4*)(C + off + bj * HALF + n * 16) = o; } }
    }
};

struct EpiBf16Res {
    static constexpr bool PERM = true, AFTER_DRAIN = false;
    bf16_t* O; const float* res; const float* gate;
    __device__ __forceinline__ void operator()(const f32x4 (&acc)[2][2][4][2], const Unit& u, int wr, int wc, int fr, int fq) const {
        const int row0 = u.pm * BM + wr * 64 + fr, col0 = u.pn * BM + wc * 32 + 8 * fq;
        f32x4 gv[2][2];
#pragma unroll
        for (int bj = 0; bj < 2; ++bj)
#pragma unroll
            for (int n = 0; n < 2; ++n) gv[bj][n] = *(const f32x4*)(gate + (size_t)(u.pm >> 3) * 6144 + col0 + bj * HALF + 4 * n);
#pragma unroll
        for (int ai = 0; ai < 2; ++ai)
#pragma unroll
            for (int m = 0; m < 4; ++m) { const size_t off = (size_t)(row0 + ai * HALF + m * 16) * 1024 + col0;
#pragma unroll
                for (int bj = 0; bj < 2; ++bj) { const f32x4 r0 = *(const f32x4*)(res + off + bj * HALF), r1 = *(const f32x4*)(res + off + bj * HALF + 4);
                    const f32x4 v0 = r0 + acc[ai][bj][m][0] * gv[bj][0], v1 = r1 + acc[ai][bj][m][1] * gv[bj][1];
                    u32x4 w; w.x = cvt_pk_bf16(v0[0], v0[1]); w.y = cvt_pk_bf16(v0[2], v0[3]); w.z = cvt_pk_bf16(v1[0], v1[1]); w.w = cvt_pk_bf16(v1[2], v1[3]);
                    *(u32x4*)(O + off + bj * HALF) = w; } }
    }
};

struct EpiBf16ResB {
    static constexpr bool PERM = true, AFTER_DRAIN = false;
    bf16_t* O; const float* res; const float* gate;
    __device__ __forceinline__ void operator()(const f32x4 (&acc)[2][2][4][2], const Unit& u, int wr, int wc, int fr, int fq) const {
        const int row0 = u.pm * BM + wr * 64 + fr, col0 = u.pn * BM + wc * 32 + 8 * fq;
        f32x4 gv[2][2];
#pragma unroll
        for (int bj = 0; bj < 2; ++bj)
#pragma unroll
            for (int n = 0; n < 2; ++n) gv[bj][n] = *(const f32x4*)(gate + (size_t)(u.pm >> 3) * 6144 + col0 + bj * HALF + 4 * n);
#pragma unroll
        for (int ai = 0; ai < 2; ++ai) {
            f32x4 rr[4][2][2];
#pragma unroll
            for (int m = 0; m < 4; ++m) { const size_t off = (size_t)(row0 + ai * HALF + m * 16) * 1024 + col0;
#pragma unroll
                for (int bj = 0; bj < 2; ++bj) { rr[m][bj][0] = __builtin_nontemporal_load((const f32x4*)(res + off + bj * HALF)); rr[m][bj][1] = __builtin_nontemporal_load((const f32x4*)(res + off + bj * HALF + 4)); } }
            __builtin_amdgcn_sched_barrier(0);
#pragma unroll
            for (int m = 0; m < 4; ++m) { const size_t off = (size_t)(row0 + ai * HALF + m * 16) * 1024 + col0;
#pragma unroll
                for (int bj = 0; bj < 2; ++bj) { const f32x4 v0 = rr[m][bj][0] + acc[ai][bj][m][0] * gv[bj][0], v1 = rr[m][bj][1] + acc[ai][bj][m][1] * gv[bj][1];
                    u32x4 w; w.x = cvt_pk_bf16(v0[0], v0[1]); w.y = cvt_pk_bf16(v0[2], v0[3]); w.z = cvt_pk_bf16(v1[0], v1[1]); w.w = cvt_pk_bf16(v1[2], v1[3]);
                    *(u32x4*)(O + off + bj * HALF) = w; } }
            __builtin_amdgcn_sched_barrier(0);
        }
    }
};

template <class Epi, class Sched, bool ALIGN_EPI = false, bool SP2 = false>
__device__ __forceinline__ void gemm_phase(PG8_LAS unsigned char* lds, const Gemm g, const Sched& S, const Epi& E) {
    const int tid = threadIdx.x, wid = __builtin_amdgcn_readfirstlane(tid >> 6), lane = tid & 63, wr = wid >> 2, wc = wid & 3, fr = lane & 15, fq = lane >> 4;
    const int K = g.K, nt = K / BK;
    unsigned voffA[2], voffB[2];
#pragma unroll
    for (int i = 0; i < 2; ++i) { int R, C; stage_rc(tid * 16 + i * 8192, R, C); const int Rb = Epi::PERM ? ((R & ~31) + perm32(R & 31)) : R;
        voffA[i] = (unsigned)(R * K + C) * 2u; voffB[i] = (unsigned)(Rb * K + C) * 2u; }
    const size_t kstep = (size_t)(BK * 2);
    const size_t hstep = (size_t)HALF * K * 2;
    const size_t tstep = 2 * hstep;
    const unsigned ldsw = (unsigned)wid * 1024u;
    const int aoff = lds_byte(wr * 64 + fr, fq * 8), boff = lds_byte(wc * 32 + fr, fq * 8);
#define PG8_SA(b, h) (((b) * 2 + (h)) * HTB)
#define PG8_SB(b, h) ((4 + (b) * 2 + (h)) * HTB)
#define PG8_STAGE(bufoff, gbase, voff) do { _Pragma("unroll") for (int _i = 0; _i < 2; ++_i) \
        __builtin_amdgcn_global_load_lds((const unsigned*)((const char*)(gbase) + (voff)[_i]), (PG8_LAS unsigned*)(lds + (bufoff) + ldsw + _i * 8192), 16, 0, 0); } while (0)
#define PG8_LDA(dst, b, h) do { _Pragma("unroll") for (int m = 0; m < 4; ++m) _Pragma("unroll") for (int k = 0; k < 2; ++k) dst[m][k] = *(const PG8_LAS bf16x8*)(lds + PG8_SA(b, h) + aoff + m * 2048 + k * 1024); } while (0)
#define PG8_LDB(dst, b, h) do { _Pragma("unroll") for (int n = 0; n < 2; ++n) _Pragma("unroll") for (int k = 0; k < 2; ++k) dst[n][k] = *(const PG8_LAS bf16x8*)(lds + PG8_SB(b, h) + boff + n * 2048 + k * 1024); } while (0)
#define PG8_MMA(ai, bj, At, Bt) do { __builtin_amdgcn_s_setprio(1); _Pragma("unroll") for (int m = 0; m < 4; ++m) _Pragma("unroll") for (int n = 0; n < 2; ++n) _Pragma("unroll") for (int k = 0; k < 2; ++k) \
        acc[ai][bj][m][n] = __builtin_amdgcn_mfma_f32_16x16x32_bf16(Bt[n][k], At[m][k], acc[ai][bj][m][n], 0, 0, 0); __builtin_amdgcn_s_setprio(0); } while (0)
#define PG8_WAIT_V(n) asm volatile("s_waitcnt vmcnt(" #n ")" ::: "memory")
#define PG8_WAIT_L(n) asm volatile("s_waitcnt lgkmcnt(" #n ")" ::: "memory")
#define PG8_BAR __builtin_amdgcn_s_barrier()
#define PG8_SCHED __builtin_amdgcn_sched_barrier(0)
    Unit cur, nxt; int ui = 0;
    if (!S.next(0, cur)) return;
    f32x4 acc[2][2][4][2];
#pragma unroll
    for (int a = 0; a < 2; ++a)
#pragma unroll
        for (int b = 0; b < 2; ++b)
#pragma unroll
            for (int m = 0; m < 4; ++m)
#pragma unroll
                for (int n = 0; n < 2; ++n) acc[a][b][m][n] = (f32x4){0.f, 0.f, 0.f, 0.f};
    bf16x8 At[4][2], B0[2][2], B1[2][2];
    const char* cA = (const char*)g.A + (size_t)cur.pm * tstep; const char* cB = (const char*)g.Bt + (size_t)cur.pn * tstep;
    S.a_ready(cur);
    if constexpr (SP2) {
        PG8_STAGE(PG8_SB(0, 0), cB, voffB); PG8_STAGE(PG8_SB(0, 1), cB + hstep, voffB); PG8_STAGE(PG8_SA(0, 0), cA, voffA); PG8_STAGE(PG8_SA(0, 1), cA + hstep, voffA);
        if (wr == 1) PG8_BAR;
        PG8_WAIT_V(2); PG8_BAR;
        PG8_STAGE(PG8_SB(1, 0), cB + kstep, voffB); PG8_STAGE(PG8_SA(1, 0), cA + kstep, voffA); PG8_STAGE(PG8_SB(1, 1), cB + hstep + kstep, voffB);
        PG8_WAIT_V(6); PG8_BAR;
    } else {
        PG8_STAGE(PG8_SB(0, 0), cB, voffB); PG8_STAGE(PG8_SA(0, 0), cA, voffA); PG8_STAGE(PG8_SB(0, 1), cB + hstep, voffB); PG8_STAGE(PG8_SA(0, 1), cA + hstep, voffA);
        if (wr == 1) PG8_BAR;
        PG8_WAIT_V(4); PG8_BAR;
        PG8_STAGE(PG8_SB(1, 0), cB + kstep, voffB); PG8_STAGE(PG8_SA(1, 0), cA + kstep, voffA); PG8_STAGE(PG8_SB(1, 1), cB + hstep + kstep, voffB);
        PG8_WAIT_V(6); PG8_BAR;
    }
    for (;;) {
        const bool has_next = S.next(ui + 1, nxt);
        const char* nA = has_next ? (const char*)g.A + (size_t)nxt.pm * tstep : cA; const char* nB = has_next ? (const char*)g.Bt + (size_t)nxt.pn * tstep : cB;
        for (int t = 0; t < nt; t += 2) {
            const bool last = (t == nt - 2);
            const char* a1 = cA + (size_t)(t + 1) * kstep;
            const char* a2 = last ? nA : cA + (size_t)(t + 2) * kstep; const char* b2 = last ? nB : cB + (size_t)(t + 2) * kstep;
            const char* a3 = a2 + kstep; const char* b3 = b2 + kstep;
            if (last && has_next) S.a_ready(nxt);
            if constexpr (SP2) {
            PG8_LDB(B0, 0, 0); PG8_LDB(B1, 0, 1); PG8_SCHED; PG8_LDA(At, 0, 0); PG8_STAGE(PG8_SA(1, 1), a1 + hstep, voffA);
            PG8_WAIT_V(8); PG8_WAIT_L(0); PG8_BAR; PG8_MMA(0, 0, At, B0); PG8_MMA(0, 1, At, B1); PG8_BAR; PG8_SCHED;
            PG8_LDA(At, 0, 1); PG8_STAGE(PG8_SB(0, 0), b2, voffB); PG8_STAGE(PG8_SB(0, 1), b2 + hstep, voffB); PG8_STAGE(PG8_SA(0, 0), a2, voffA);
            PG8_WAIT_V(8); PG8_WAIT_L(0); PG8_BAR; PG8_MMA(1, 0, At, B0); PG8_MMA(1, 1, At, B1); PG8_BAR; PG8_SCHED;
            PG8_LDB(B0, 1, 0); PG8_LDB(B1, 1, 1); PG8_SCHED; PG8_LDA(At, 1, 0); PG8_STAGE(PG8_SA(0, 1), a2 + hstep, voffA);
            PG8_WAIT_V(8); PG8_WAIT_L(0); PG8_BAR; PG8_MMA(0, 0, At, B0); PG8_MMA(0, 1, At, B1); PG8_BAR; PG8_SCHED;
            PG8_LDA(At, 1, 1); PG8_STAGE(PG8_SB(1, 0), b3, voffB); PG8_STAGE(PG8_SB(1, 1), b3 + hstep, voffB); PG8_STAGE(PG8_SA(1, 0), a3, voffA);
            PG8_WAIT_V(8); PG8_WAIT_L(0); PG8_BAR; PG8_MMA(1, 0, At, B0); PG8_MMA(1, 1, At, B1); PG8_BAR; PG8_SCHED;
            } else {
            PG8_LDB(B0, 0, 0); PG8_SCHED; PG8_LDA(At, 0, 0); PG8_STAGE(PG8_SA(1, 1), a1 + hstep, voffA);
            PG8_WAIT_L(8); PG8_BAR; PG8_WAIT_L(0); PG8_MMA(0, 0, At, B0); PG8_BAR; PG8_SCHED;
            PG8_LDB(B1, 0, 1); PG8_STAGE(PG8_SB(0, 0), b2, voffB);
            PG8_BAR; PG8_WAIT_L(0); PG8_MMA(0, 1, At, B1); PG8_BAR;
            PG8_LDA(At, 0, 1); PG8_STAGE(PG8_SA(0, 0), a2, voffA);
            PG8_BAR; PG8_WAIT_L(0); PG8_MMA(1, 0, At, B0); PG8_BAR; PG8_SCHED;
            PG8_STAGE(PG8_SB(0, 1), b2 + hstep, voffB);
            PG8_WAIT_V(6); PG8_BAR; PG8_MMA(1, 1, At, B1); PG8_BAR;
            PG8_LDB(B0, 1, 0); PG8_SCHED; PG8_LDA(At, 1, 0); PG8_STAGE(PG8_SA(0, 1), a2 + hstep, voffA);
            PG8_WAIT_L(8); PG8_BAR; PG8_WAIT_L(0); PG8_MMA(0, 0, At, B0); PG8_BAR; PG8_SCHED;
            PG8_LDB(B1, 1, 1); PG8_STAGE(PG8_SB(1, 0), b3, voffB);
            PG8_BAR; PG8_WAIT_L(0); PG8_MMA(0, 1, At, B1); PG8_BAR;
            PG8_LDA(At, 1, 1); PG8_STAGE(PG8_SA(1, 0), a3, voffA);
            PG8_BAR; PG8_WAIT_L(0); PG8_MMA(1, 0, At, B0); PG8_BAR; PG8_SCHED;
            PG8_STAGE(PG8_SB(1, 1), b3 + hstep, voffB);
            PG8_WAIT_V(6); PG8_BAR; PG8_MMA(1, 1, At, B1); PG8_BAR;
            }
        }
        if constexpr (ALIGN_EPI) { if (wr == 0) PG8_BAR; }
        if constexpr (!Epi::AFTER_DRAIN) { E(acc, cur, wr, wc, fr, fq); S.done(cur); }
        if (!has_next) break;
#pragma unroll
        for (int a = 0; a < 2; ++a)
#pragma unroll
            for (int b = 0; b < 2; ++b)
#pragma unroll
                for (int m = 0; m < 4; ++m)
#pragma unroll
                    for (int n = 0; n < 2; ++n) acc[a][b][m][n] = (f32x4){0.f, 0.f, 0.f, 0.f};
        cur = nxt; cA = nA; cB = nB; ++ui;
        if constexpr (ALIGN_EPI) { if (wr == 1) PG8_BAR; }
    }
    PG8_WAIT_V(0);
    if constexpr (!ALIGN_EPI) { if (wr == 0) PG8_BAR; }
    PG8_BAR;
    if constexpr (Epi::AFTER_DRAIN) { E.fused(acc, cur, wr, wc, fr, fq, lds, wid, lane); S.done(cur); }
#undef PG8_SA
#undef PG8_SB
#undef PG8_STAGE
#undef PG8_LDA
#undef PG8_LDB
#undef PG8_MMA
#undef PG8_WAIT_V
#undef PG8_WAIT_L
#undef PG8_BAR
#undef PG8_SCHED
}
}
#define XB_TMO      128
#define XB_XCNT(j)  (256  + 64 * (j))
#define XB_XSUB(j)  (1280 + 64 * (j))
#define XB_XGEN(j)  (2304 + 64 * (j))
#define XB_TOP      3328
#define XB_TOPGEN   3392
#define XCD_BAR_WORDS 3456
#define XB_SPIN_CAP (1u << 18)

__device__ __forceinline__ unsigned xb_ld(unsigned* p)              { return __hip_atomic_load(p, __ATOMIC_RELAXED, __HIP_MEMORY_SCOPE_AGENT); }
__device__ __forceinline__ unsigned xb_add(unsigned* p, unsigned v) { return __hip_atomic_fetch_add(p, v, __ATOMIC_RELAXED, __HIP_MEMORY_SCOPE_AGENT); }
__device__ __forceinline__ unsigned xb_xcc_id() { return (unsigned)__builtin_amdgcn_s_getreg((3 << 11) | 20) & 0xFu; }
#define XB_SPIN(cond, bar) do { unsigned _sp = 0; while (cond) { __builtin_amdgcn_s_sleep(1); \
    if ((++_sp & 255u) == 0u) { if (xb_ld(&(bar)[XB_TMO])) break; if (_sp > XB_SPIN_CAP) { atomicAdd(&(bar)[XB_TMO], 1u); break; } } } } while (0)

struct XcdBarrier {
    unsigned* bar; unsigned x;
    volatile LAS unsigned* st;
};

__device__ __forceinline__ XcdBarrier xcd_barrier_post(unsigned* bar, volatile LAS unsigned* st) {
    XcdBarrier b; b.bar = bar; b.x = xb_xcc_id(); b.st = st;
    if (threadIdx.x == 0) (void)xb_add(&bar[XB_XCNT(b.x)], 1u);
    return b;
}
__device__ __forceinline__ void xcd_barrier_complete(unsigned* bar, unsigned x, unsigned& nloc, unsigned& nx) {
    const unsigned G = gridDim.x * gridDim.y * gridDim.z;
    unsigned sum, cnt, mine, sp = 0u;
    for (;;) {
        sum = 0u; cnt = 0u; mine = 0u;
#pragma unroll
        for (unsigned j = 0; j < 16; ++j) { const unsigned c = xb_ld(&bar[XB_XCNT(j)]); sum += c; cnt += (c > 0u) ? 1u : 0u; mine = (j == x) ? c : mine; }
        if (sum == G) break;
        __builtin_amdgcn_s_sleep(1);
        if ((++sp & 255u) == 0u) { if (xb_ld(&bar[XB_TMO])) break; if (sp > XB_SPIN_CAP) { atomicAdd(&bar[XB_TMO], 1u); break; } }
    }
    nloc = mine > 0u ? mine : 1u; nx = cnt > 0u ? cnt : 1u;
}

__device__ __forceinline__ void xcd_barrier(const XcdBarrier& b) {
    asm volatile("s_waitcnt vmcnt(0)" ::: "memory");
    __syncthreads();
    if (threadIdx.x == 0) {
        unsigned* bar = b.bar;
        __builtin_amdgcn_s_waitcnt(0);
        unsigned nloc = b.st[0], nx = b.st[1];
        if (nloc == 0u) { xcd_barrier_complete(bar, b.x, nloc, nx); b.st[0] = nloc; b.st[1] = nx; }
        const unsigned old = xb_add(&bar[XB_XSUB(b.x)], 1u);
        const unsigned gen = old / nloc;
        if (old + 1u == (gen + 1u) * nloc) {
            __builtin_amdgcn_fence(__ATOMIC_RELEASE, "agent");
            asm volatile("s_waitcnt vmcnt(0)" ::: "memory");
            const unsigned og = xb_add(&bar[XB_TOP], 1u);
            const unsigned tg = og / nx;
            if (og + 1u == (tg + 1u) * nx) xb_add(&bar[XB_TOPGEN], 1u);
            else XB_SPIN(xb_ld(&bar[XB_TOPGEN]) == tg, bar);
            __builtin_amdgcn_fence(__ATOMIC_ACQUIRE, "agent");
            xb_add(&bar[XB_XGEN(b.x)], 1u);
            asm volatile("s_waitcnt vmcnt(0)" ::: "memory");
        } else {
            XB_SPIN(xb_ld(&bar[XB_XGEN(b.x)]) == gen, bar);
            __builtin_amdgcn_fence(__ATOMIC_ACQUIRE, "agent");
            asm volatile("s_waitcnt vmcnt(0)" ::: "memory");
        }
    }
    __syncthreads();
}

typedef short bf16x8_t __attribute__((ext_vector_type(8)));
typedef unsigned u32x4_t __attribute__((ext_vector_type(4)));
typedef unsigned u32x2_t __attribute__((ext_vector_type(2)));
typedef short s16x4_t __attribute__((ext_vector_type(4)));
typedef float f32x16_t __attribute__((ext_vector_type(16)));
typedef float f32x4_t __attribute__((ext_vector_type(4)));
typedef float f32x2_t __attribute__((ext_vector_type(2)));
typedef __bf16 bf16x2_t __attribute__((ext_vector_type(2)));
#define MFMA32(a, b, c) __builtin_amdgcn_mfma_f32_32x32x16_bf16((a), (b), (c), 0, 0, 0)
constexpr float LOG2E = 1.4426950408889634f;

__device__ __forceinline__ float vmax2(float a, float b) { float r; asm("v_max_f32 %0, %1, %2" : "=v"(r) : "v"(a), "v"(b)); return r; }
__device__ __forceinline__ float vmax3(float a, float b, float c) { float r; asm("v_max3_f32 %0, %1, %2, %3" : "=v"(r) : "v"(a), "v"(b), "v"(c)); return r; }
__device__ __forceinline__ int crow(int r, int hi) { return (r & 3) + 8 * (r >> 2) + 4 * hi; }
__device__ __forceinline__ unsigned cvtpk(float lo, float hi) { f32x2_t v = {lo, hi}; bf16x2_t b = __builtin_convertvector(v, bf16x2_t); return __builtin_bit_cast(unsigned, b); }
__device__ __forceinline__ s16x4_t vtr(const LAS unsigned char* p) { return __builtin_bit_cast(s16x4_t, __builtin_amdgcn_ds_read_tr16_b64_v4i16((LAS s16x4_t*)p)); }
__device__ __forceinline__ float xhalf_max(float m) { auto rr = __builtin_amdgcn_permlane32_swap(__float_as_uint(m), __float_as_uint(m), false, false); return fmaxf(__uint_as_float(rr[0]), __uint_as_float(rr[1])); }
__device__ __forceinline__ float xhalf_sum(float m) { auto rr = __builtin_amdgcn_permlane32_swap(__float_as_uint(m), __float_as_uint(m), false, false); return __uint_as_float(rr[0]) + __uint_as_float(rr[1]); }
__device__ __forceinline__ bf16x8_t pack8(const f32x16_t& p, int s) {
    u32x4_t u; u.x = cvtpk(p[8 * s + 0], p[8 * s + 1]); u.y = cvtpk(p[8 * s + 2], p[8 * s + 3]); u.z = cvtpk(p[8 * s + 4], p[8 * s + 5]); u.w = cvtpk(p[8 * s + 6], p[8 * s + 7]);
    return __builtin_bit_cast(bf16x8_t, u);
}

__device__ __forceinline__ void glds16(const void* sbase, unsigned voff, unsigned lds_base) {
    unsigned sv; asm volatile("s_mov_b32 %0, m0\n\ts_mov_b32 m0, %3\n\ts_nop 0\n\tglobal_load_lds_dwordx4 %1, %2\n\ts_mov_b32 m0, %0" : "=&s"(sv) : "v"(voff), "s"(sbase), "s"(lds_base) : "memory"); }
#define ATT_WAIT_BAR(N) asm volatile("s_waitcnt vmcnt(" #N ") lgkmcnt(0)\n\ts_barrier" ::: "memory")
constexpr int DA_SLOT = 32768, DA_BIAS = 133120, DA_LDS = 133120 + 1024;
__device__ __forceinline__ void diff_unit(const bf16_t* __restrict__ proj, bf16_t* __restrict__ mixin, const float* __restrict__ rel_bias, const float lam, const float* __restrict__ g_subln,
                                          LAS unsigned char* lds, int b, int h, int qt, int tid, int lane, int wave) {
    const int rg = wave >> 1, map = wave & 1, r32 = lane & 31, hh = lane >> 5;
    const int t0 = 128 * qt + 32 * rg;
    const int ntb = 2 * qt + 2;
    const int ntw = (t0 + 31) / 64 + 1;
    const size_t rowbase = (size_t)b * S;
    LAS float* biasT = (LAS float*)(lds + DA_BIAS);
    if (tid < 256) biasT[tid] = rel_bias[rel_bucket(tid) * 8 + h] * LOG2E;
    const float c31 = rel_bias[31 * 8 + h] * LOG2E;
    bf16x8_t qf[4];
    { const bf16_t* qrow = proj + (rowbase + t0 + r32) * NPP + C_DQ + h * 128 + map * 64 + 8 * hh;
#pragma unroll
      for (int ks = 0; ks < 4; ++ks) qf[ks] = *(const bf16x8_t*)(qrow + 16 * ks); }
    unsigned ko0, ko1, vo0, vo1;
    { const int pa = wave, pb = wave + 8;
      const int ra = 4 * pa + (lane >> 4), rb = 4 * pb + (lane >> 4), pc = lane & 15;
      ko0 = (unsigned)(ra * NPP + C_DK + h * 128 + 8 * (pc ^ (ra & 15))) * 2u;
      ko1 = (unsigned)(rb * NPP + C_DK + h * 128 + 8 * (pc ^ (rb & 15))) * 2u;
      const int ka = 16 * (pa & 3) + (lane >> 2), kb2 = 16 * (pb & 3) + (lane >> 2), cc = lane & 3;
      vo0 = (unsigned)(ka * NPP + C_DV + h * 128 + 8 * (4 * (pa >> 2) + cc)) * 2u;
      vo1 = (unsigned)(kb2 * NPP + C_DV + h * 128 + 8 * (4 * (pb >> 2) + cc)) * 2u; }
    const bf16_t* pbase = proj + rowbase * NPP;
    const unsigned lds0 = (unsigned)(size_t)lds;
    const unsigned dsta = (unsigned)__builtin_amdgcn_readfirstlane((int)(lds0 + wave * 1024)), dstb = dsta + 8192;
#define DA_DMA(j) do { const bf16_t* sb_ = pbase + (size_t)(64 * (j)) * NPP; const unsigned sl_ = (unsigned)(((j) & 3) * DA_SLOT); \
        glds16(sb_, ko0, dsta + sl_); glds16(sb_, ko1, dstb + sl_); glds16(sb_, vo0, dsta + sl_ + 16384); glds16(sb_, vo1, dstb + sl_ + 16384); } while (0)
    DA_DMA(0);
    if (ntb > 1) { DA_DMA(1); ATT_WAIT_BAR(4); } else ATT_WAIT_BAR(0);
    f32x16_t O[4];
#pragma unroll
    for (int i = 0; i < 4; ++i)
#pragma unroll
        for (int r = 0; r < 16; ++r) O[i][r] = 0.f;
    float m = -INFINITY, l = 0.f;
    const int t = t0 + r32;
    const float SC = 0.125f * LOG2E;
    const int i16 = lane & 15, tq = i16 >> 2, tp = i16 & 3, g1 = (lane >> 4) & 1;
    const unsigned vrd = (4 * hh + tq) * 64 + g1 * 32 + tp * 8;
    const unsigned krd = r32 * 256;
    bf16x8_t pb[2][2];
#define DA_QKSM(j) do { \
        const LAS unsigned char* kb = lds + (j & 3) * DA_SLOT; \
        f32x16_t s0, s1; \
        _Pragma("unroll") \
        for (int r = 0; r < 16; ++r) { s0[r] = 0.f; s1[r] = 0.f; } \
        _Pragma("unroll") \
        for (int ks = 0; ks < 4; ++ks) { \
            const int chunk = map * 8 + 2 * ks + hh; \
            const unsigned co = (unsigned)((chunk ^ (r32 & 15)) * 16); \
            const bf16x8_t a0 = *(const LAS bf16x8_t*)(kb + krd + co), a1 = *(const LAS bf16x8_t*)(kb + krd + 32 * 256 + co); \
            s0 = MFMA32(a0, qf[ks], s0); s1 = MFMA32(a1, qf[ks], s1); \
        } \
        const int kbase = 64 * j + 4 * hh; \
        const bool nearb = (t0 - (64 * j + 63)) < 113; \
        const bool diag = (64 * j + 63) > t0; \
        float alpha, ps = 0.f; \
        if (nearb) { \
        _Pragma("unroll") \
            for (int r = 0; r < 16; ++r) { const int key = kbase + (r & 3) + 8 * (r >> 2); \
                int d0 = t - key, d1 = d0 - 32; d0 = d0 < 0 ? 0 : d0; d1 = d1 < 0 ? 0 : d1; \
                s0[r] = s0[r] * SC + biasT[d0]; s1[r] = s1[r] * SC + biasT[d1]; \
                if (diag) { if (key > t) s0[r] = -INFINITY; if (key + 32 > t) s1[r] = -INFINITY; } } \
            float mt = vmax3(s0[0], s1[0], s0[1]); \
        _Pragma("unroll") \
            for (int r = 1; r < 16; ++r) mt = r < 15 ? vmax3(mt, s1[r], s0[r + 1]) : vmax2(mt, s1[r]); \
            mt = xhalf_max(mt); \
            const float mn = vmax2(m, mt); \
            alpha = __builtin_amdgcn_exp2f(m - mn); \
            m = mn; \
        _Pragma("unroll") \
            for (int r = 0; r < 16; ++r) { s0[r] = __builtin_amdgcn_exp2f(s0[r] - mn); s1[r] = __builtin_amdgcn_exp2f(s1[r] - mn); ps += s0[r] + s1[r]; } \
        } else { \
             \
            float mr = vmax3(s0[0], s1[0], s0[1]); \
        _Pragma("unroll") \
            for (int r = 1; r < 16; ++r) mr = r < 15 ? vmax3(mr, s1[r], s0[r + 1]) : vmax2(mr, s1[r]); \
            mr = xhalf_max(mr); \
            const float mn = vmax2(m, mr * SC + c31); \
            alpha = __builtin_amdgcn_exp2f(m - mn); \
            m = mn; \
            const float off = c31 - mn; \
        _Pragma("unroll") \
            for (int r = 0; r < 16; ++r) { s0[r] = __builtin_amdgcn_exp2f(s0[r] * SC + off); s1[r] = __builtin_amdgcn_exp2f(s1[r] * SC + off); ps += s0[r] + s1[r]; } \
        } \
        l = l * alpha + ps; \
        if (__any(alpha != 1.f)) { \
        _Pragma("unroll") \
            for (int i = 0; i < 4; ++i) \
        _Pragma("unroll") \
                for (int r = 0; r < 16; ++r) O[i][r] *= alpha; \
        } \
        pb[0][0] = pack8(s0, 0); pb[0][1] = pack8(s0, 1); pb[1][0] = pack8(s1, 0); pb[1][1] = pack8(s1, 1); \
    } while (0)
#define DA_PV(jt) do { \
        const LAS unsigned char* vb = lds + (jt & 3) * DA_SLOT + 16384; \
        _Pragma("unroll") \
        for (int sub = 0; sub < 2; ++sub) \
        _Pragma("unroll") \
            for (int s = 0; s < 2; ++s) \
        _Pragma("unroll") \
                for (int dblk = 0; dblk < 4; ++dblk) { \
                    const LAS unsigned char* vp = vb + dblk * 4096 + (32 * sub + 16 * s) * 64 + vrd; \
                    const s16x4_t lo = vtr(vp), hi = vtr(vp + 8 * 64); \
                    const bf16x8_t va = __builtin_shufflevector(lo, hi, 0, 1, 2, 3, 4, 5, 6, 7); \
                    O[dblk] = MFMA32(va, pb[sub][s], O[dblk]); \
                } \
    } while (0)
    const int grp = wave >> 2;
    int jp = -1;
    for (int j = 0; j < ntb; ++j) {
        const bool pf = j + 2 < ntb;
        if (pf) DA_DMA(j + 2);
        if (jp >= 0) { DA_PV(jp); jp = -1; }
        if (j < ntw) { DA_QKSM(j); if (grp == 0) DA_PV(j); else jp = j; }
        if (pf) ATT_WAIT_BAR(4); else ATT_WAIT_BAR(0);
    }
    if (jp >= 0) DA_PV(jp);
#undef DA_QKSM
#undef DA_PV
    __syncthreads();
#undef DA_DMA
    l = xhalf_sum(l);
    const float inv = (map ? lam : 1.f) / l;
    LAS float* ex = (LAS float*)(lds + rg * 16384);
    if (map == 1) {
#pragma unroll
        for (int i = 0; i < 4; ++i)
#pragma unroll
            for (int r = 0; r < 16; ++r) ex[(i * 16 + r) * 64 + lane] = O[i][r] * inv;
    }
    __syncthreads();
    if (map == 0) {
        float ss = 0.f;
#pragma unroll
        for (int i = 0; i < 4; ++i)
#pragma unroll
            for (int r = 0; r < 16; ++r) { const float o = O[i][r] * inv - ex[(i * 16 + r) * 64 + lane]; O[i][r] = o; ss += o * o; }
        ss = xhalf_sum(ss);
        const float rn = rsqrtf(ss * (1.f / 128.f) + EPS) * 0.8f;
        bf16_t* orow = mixin + (rowbase + t) * D + h * 128;
#pragma unroll
        for (int i = 0; i < 4; ++i)
#pragma unroll
            for (int g = 0; g < 4; ++g) { const int d0 = 32 * i + 8 * g + 4 * hh; const float4 gs = *(const float4*)(g_subln + d0);
                uint2 o; o.x = cvtpk(O[i][4 * g + 0] * rn * gs.x, O[i][4 * g + 1] * rn * gs.y); o.y = cvtpk(O[i][4 * g + 2] * rn * gs.z, O[i][4 * g + 3] * rn * gs.w);
                *(uint2*)(orow + d0) = o; }
    }
    __syncthreads();
}

__device__ __forceinline__ unsigned fkey(float f) { f = f + 0.0f; const unsigned u = __float_as_uint(f); return (u & 0x80000000u) ? ~u : (u | 0x80000000u); }
__device__ __forceinline__ int wave_sum_dpp(int v) {
    v += __builtin_amdgcn_update_dpp(0, v, 0x111, 0xf, 0xf, true);
    v += __builtin_amdgcn_update_dpp(0, v, 0x112, 0xf, 0xf, true);
    v += __builtin_amdgcn_update_dpp(0, v, 0x114, 0xf, 0xf, true);
    v += __builtin_amdgcn_update_dpp(0, v, 0x118, 0xf, 0xf, true);
    v += __builtin_amdgcn_update_dpp(0, v, 0x142, 0xa, 0xf, true);
    v += __builtin_amdgcn_update_dpp(0, v, 0x143, 0xc, 0xf, true);
    return __builtin_amdgcn_readlane(v, 63);
}
__device__ __forceinline__ void bit_transpose32(unsigned (&A)[32]) {
#pragma unroll
    for (int s = 0; s < 5; ++s) { const int j = 16 >> s; const unsigned m = s == 0 ? 0x0000FFFFu : s == 1 ? 0x00FF00FFu : s == 2 ? 0x0F0F0F0Fu : s == 3 ? 0x33333333u : 0x55555555u;
#pragma unroll
        for (int k = 0; k < 32; ++k) if (!(k & j)) { const unsigned a = A[k], b = A[k + j]; A[k] = (a & m) | ((b << j) & ~m); A[k + j] = ((a >> j) & m) | (b & ~m); } }
}
template <int NI>
__device__ __forceinline__ void dsa_select_pair(const LAS float* sc, unsigned* __restrict__ maskw, size_t rowbase, int t_base, int lane, int wave) {
    {
        const int tlA = 2 * wave, tA = t_base + tlA, tB = tA + 1, nkA = tA + 1, nkB = tB + 1;
        unsigned* mrowA = maskw + (rowbase + tA) * 64; unsigned* mrowB = mrowA + 64;
        const bool smallA = nkA <= 256, smallB = nkB <= 256;
        unsigned PA[32], PB[32];
#pragma unroll
        for (int i = 0; i < 32; ++i) {
            if (i < NI) { const int idx = lane + 64 * i;
                const float vA = sc[tlA * 2048 + (idx < nkA ? idx : 0)], vB = sc[(tlA + 1) * 2048 + (idx < nkB ? idx : 0)];
                PA[i] = idx < nkA ? fkey(vA) : 0u; PB[i] = idx < nkB ? fkey(vB) : 0u; }
            else { PA[i] = 0u; PB[i] = 0u; } }
        bit_transpose32(PA); bit_transpose32(PB);
        unsigned gtA = 0u, eqA = 0xFFFFFFFFu, gtB = 0u, eqB = 0xFFFFFFFFu, selA = 0u, selB = 0u;
        bool doneA = smallA, doneB = smallB, exactA = false, exactB = false;
#pragma unroll
        for (int bit = 31; bit >= 0; --bit) if (!(doneA && doneB)) {
            const unsigned geA = gtA | (eqA & PA[bit]), geB = gtB | (eqB & PB[bit]);
            const int tot2 = wave_sum_dpp(__builtin_popcount(geA) | (__builtin_popcount(geB) << 16));
            const int totA = tot2 & 0xffff, totB = tot2 >> 16;
            if (!doneA) { if (totA >= 256) { eqA &= PA[bit]; if (totA == 256) { selA = geA; exactA = true; doneA = true; } } else { gtA = geA; eqA &= ~PA[bit]; } }
            if (!doneB) { if (totB >= 256) { eqB &= PB[bit]; if (totB == 256) { selB = geB; exactB = true; doneB = true; } } else { gtB = geB; eqB &= ~PB[bit]; } }
        }
#pragma unroll 1
        for (int tt = 0; tt < 2; ++tt) {
            const int t = tt ? tB : tA; unsigned* mrow = tt ? mrowB : mrowA; const bool small = tt ? smallB : smallA, exact = tt ? exactB : exactA;
            if (small) {
                const int w0 = 32 * lane;
                unsigned v = 0u;
                if (w0 + 31 <= t) v = 0xFFFFFFFFu; else if (w0 <= t) v = (1u << (t - w0 + 1)) - 1u;
                mrow[lane] = v;
            } else {
                unsigned sel = tt ? selB : selA;
                if (!exact) {
                    const unsigned gt = tt ? gtB : gtA, eq = tt ? eqB : eqA;
                    const int need = 256 - wave_sum_dpp(__builtin_popcount(gt)); int running = 0;
                    const unsigned long long lt = (1ull << lane) - 1ull;
                    sel = gt;
#pragma unroll
                    for (int i = 0; i < NI; ++i) {
                        const bool e = (eq >> i) & 1u; const unsigned long long be = __ballot(e);
                        const int rank = running + __builtin_popcountll(be & lt);
                        if (e && rank < need) sel |= 1u << i;
                        running += __builtin_popcountll(be);
                    }
                }
                unsigned long long mine = 0ull;
#pragma unroll
                for (int i = 0; i < NI; ++i) { const unsigned long long bal = __ballot(((sel >> i) & 1u) != 0u); if (lane == i) mine = bal; }
                if (lane < 32) *(unsigned long long*)(mrow + 2 * lane) = lane < NI ? mine : 0ull;
            }
        }
    }
}
__device__ __forceinline__ void dsa_index_unit(const bf16_t* __restrict__ proj, unsigned* __restrict__ maskw, LAS unsigned char* lds, int b, int u16, int tid, int lane, int wave) {
    const int t_base = 16 * u16, ntile = ((t_base + 15) >> 5) + 1;
    const size_t rowbase = (size_t)b * S;
    LAS float* sc = (LAS float*)lds;
    const int r32 = lane & 31, hh = lane >> 5;
    {
        LAS float* wl = (LAS float*)(lds + 132096);
        if (tid < 128) wl[tid] = bf2f(proj[(rowbase + t_base + (tid >> 3)) * NPP + C_IW + (tid & 7)]) * (0.35355339059327373f * 0.125f);
        const int hsel = (r32 >> 2) & 1, q = (r32 & 3) + 4 * (r32 >> 3), tokl = 2 * hsel + (q >> 3), head = q & 7;
        LAS unsigned char* afi = lds + 133120;
#pragma unroll
        for (int cc = 0; cc < 2; ++cc) { const int c = tid + 512 * cc, crt = c >> 8, cks = (c >> 6) & 3, chh = (c >> 5) & 1, cr = c & 31;
            const int chs = (cr >> 2) & 1, cq = (cr & 3) + 4 * (cr >> 3), ctok = 2 * chs + (cq >> 3), chead = cq & 7;
            const bf16x8_t cv = *(const bf16x8_t*)(proj + (rowbase + t_base + 4 * crt + ctok) * NPP + C_IQ + chead * 64 + 8 * chh + 16 * cks);
            *(LAS bf16x8_t*)(afi + c * 16) = cv; }
        bf16x8_t bfr[4], bnx[4];
        const bf16_t* bp0 = proj + (rowbase + r32) * NPP + C_IK + 8 * hh;
        if (wave < ntile) {
#pragma unroll
            for (int ks = 0; ks < 4; ++ks) bnx[ks] = *(const bf16x8_t*)(bp0 + (size_t)(32 * wave) * NPP + 16 * ks);
        }
        __syncthreads();
        bf16x8_t af[4][4];
#pragma unroll
        for (int rt = 0; rt < 4; ++rt)
#pragma unroll
            for (int ks = 0; ks < 4; ++ks) af[rt][ks] = *(const LAS bf16x8_t*)(afi + ((((rt * 4 + ks) * 2 + hh) * 32 + r32) * 16));
        (void)tokl; (void)head;
        for (int tile = wave; tile < ntile; tile += 8) {
#pragma unroll
            for (int ks = 0; ks < 4; ++ks) bfr[ks] = bnx[ks];
            if (tile + 8 < ntile) {
#pragma unroll
                for (int ks = 0; ks < 4; ++ks) bnx[ks] = *(const bf16x8_t*)(bp0 + (size_t)(32 * (tile + 8)) * NPP + 16 * ks);
            }
            const int key = 32 * tile + r32;
#pragma unroll
            for (int rt = 0; rt < 4; ++rt) {
                f32x16_t acc;
#pragma unroll
                for (int r = 0; r < 16; ++r) acc[r] = 0.f;
#pragma unroll
                for (int ks = 0; ks < 4; ++ks) acc = MFMA32(af[rt][ks], bfr[ks], acc);
                const int tl = 4 * rt + 2 * hh;
                const LAS f32x4_t* w4 = (const LAS f32x4_t*)(wl + tl * 8);
                const f32x4_t wa0 = w4[0], wa1 = w4[1], wb0 = w4[2], wb1 = w4[3];
                float sA = wa0.x * fmaxf(acc[0], 0.f) + wa0.y * fmaxf(acc[1], 0.f) + wa0.z * fmaxf(acc[2], 0.f) + wa0.w * fmaxf(acc[3], 0.f)
                         + wa1.x * fmaxf(acc[4], 0.f) + wa1.y * fmaxf(acc[5], 0.f) + wa1.z * fmaxf(acc[6], 0.f) + wa1.w * fmaxf(acc[7], 0.f);
                float sB = wb0.x * fmaxf(acc[8], 0.f) + wb0.y * fmaxf(acc[9], 0.f) + wb0.z * fmaxf(acc[10], 0.f) + wb0.w * fmaxf(acc[11], 0.f)
                         + wb1.x * fmaxf(acc[12], 0.f) + wb1.y * fmaxf(acc[13], 0.f) + wb1.z * fmaxf(acc[14], 0.f) + wb1.w * fmaxf(acc[15], 0.f);
                const int tA = t_base + tl;
                sc[tl * 2048 + key] = key <= tA ? sA : -INFINITY;
                sc[(tl + 1) * 2048 + key] = key <= tA + 1 ? sB : -INFINITY;
            }
        }
    }
    __syncthreads();
    {
        const int ni = (t_base + 16 + 63) >> 6;
        if (ni <= 8) dsa_select_pair<8>(sc, maskw, rowbase, t_base, lane, wave);
        else if (ni <= 16) dsa_select_pair<16>(sc, maskw, rowbase, t_base, lane, wave);
        else if (ni <= 24) dsa_select_pair<24>(sc, maskw, rowbase, t_base, lane, wave);
        else dsa_select_pair<32>(sc, maskw, rowbase, t_base, lane, wave);
    }
    __syncthreads();
}

constexpr int DB_KV = 0, DB_BIAS = 32768, DB_Q = 36864, DB_LDS = 36864 + 65536;
__device__ __forceinline__ void dsa_attn_unit(const bf16_t* __restrict__ proj, const unsigned* __restrict__ maskw, const bf16_t* __restrict__ wuvF, const float* __restrict__ rel_bias, const float* __restrict__ g_kv,
                                              bf16_t* __restrict__ mixin, LAS unsigned char* lds, int b, int u64, int tid, int lane, int wave) {
    const int head = wave & 3, tgrp = wave >> 2, r32 = lane & 31, hh = lane >> 5;
    const int t0 = 64 * u64 + 32 * tgrp, t = t0 + r32;
    const int ntb = u64 + 1;
    const size_t rowbase = (size_t)b * S;
    LAS float* biasT = (LAS float*)(lds + DB_BIAS);
    for (int i = tid; i < 1024; i += NTHREADS) biasT[i] = rel_bias[rel_bucket(i & 255) * 8 + 4 + (i >> 8)] * LOG2E;
    const float c31 = rel_bias[31 * 8 + 4 + head] * LOG2E;
    bf16x8_t qreg[8];
    { const bf16_t* qrow = proj + (rowbase + t) * NPP + C_SQ + head * 128 + 8 * hh;
#pragma unroll
      for (int ks = 0; ks < 8; ++ks) qreg[ks] = *(const bf16x8_t*)(qrow + 16 * ks); }
    const int skey = tid >> 4, sc = tid & 15;
    const bf16_t* sg = proj + (rowbase + skey) * NPP + C_SKV + 8 * sc;
    const unsigned soff0 = (sc >> 2) * 4096 + skey * 64 + (((sc & 3) ^ ((skey >> 2) & 3)) * 16), soff1 = soff0 + 32 * 64;
    u32x4_t raw0, raw1; u32x2_t mw, mwn;
    const unsigned* mrow = maskw + (rowbase + t) * 64;
#define DB_LOAD(j) do { const size_t o_ = (size_t)(64 * (j)) * NPP; raw0 = *(const u32x4_t*)(sg + o_); raw1 = *(const u32x4_t*)(sg + o_ + (size_t)32 * NPP); mwn = *(const u32x2_t*)(mrow + 2 * (j)); } while (0)
#define DB_NORM1(raw, off) do { float f_[8]; float ss_ = 0.f; \
        _Pragma("unroll") for (int jj = 0; jj < 4; ++jj) { f_[2 * jj] = __uint_as_float(raw[jj] << 16); f_[2 * jj + 1] = __uint_as_float(raw[jj] & 0xffff0000u); ss_ += f_[2 * jj] * f_[2 * jj] + f_[2 * jj + 1] * f_[2 * jj + 1]; } \
        ss_ += __shfl_xor(ss_, 1); ss_ += __shfl_xor(ss_, 2); ss_ += __shfl_xor(ss_, 4); ss_ += __shfl_xor(ss_, 8); \
        const float rr_ = rsqrtf(ss_ * (1.f / 128.f) + EPS); u32x4_t o_; const float4 ga_ = *(const float4*)(g_kv + 8 * sc), gb_ = *(const float4*)(g_kv + 8 * sc + 4); const float gk[8] = {ga_.x, ga_.y, ga_.z, ga_.w, gb_.x, gb_.y, gb_.z, gb_.w}; \
        _Pragma("unroll") for (int jj = 0; jj < 4; ++jj) o_[jj] = cvtpk(f_[2 * jj] * rr_ * gk[2 * jj], f_[2 * jj + 1] * rr_ * gk[2 * jj + 1]); \
        *(LAS u32x4_t*)(kvb_ + (off)) = o_; } while (0)
#define DB_WRITE(bf) do { LAS unsigned char* kvb_ = lds + DB_KV + (bf) * 16384; DB_NORM1(raw0, soff0); DB_NORM1(raw1, soff1); } while (0)
    DB_LOAD(0); DB_WRITE(0); mw = mwn;
    __syncthreads();
    f32x16_t O[4];
#pragma unroll
    for (int i = 0; i < 4; ++i)
#pragma unroll
        for (int r = 0; r < 16; ++r) O[i][r] = 0.f;
    float m = -1e30f, l = 0.f;
    const float SC = 0.08838834764831845f * LOG2E;
    const int i16 = lane & 15, tq = i16 >> 2, tp = i16 & 3, g1 = (lane >> 4) & 1;
    const unsigned vrd_lo = (4 * hh + tq) * 64 + (((2 * g1 + (tp >> 1)) ^ (hh & 3)) * 16) + 8 * (tp & 1);
    const unsigned vrd_hi = (4 * hh + 8 + tq) * 64 + (((2 * g1 + (tp >> 1)) ^ ((hh + 2) & 3)) * 16) + 8 * (tp & 1);
    const unsigned kx = (unsigned)((r32 >> 2) & 3);
    const LAS float* bT = biasT + head * 256;
    for (int j = 0; j < ntb; ++j) {
        if (j + 1 < ntb) DB_LOAD(j + 1);
        {
            const LAS unsigned char* kvb = lds + DB_KV + (j & 1) * 16384;
            const bool nearb = (t0 - (64 * j + 63)) < 113;
#pragma unroll
            for (int sub = 0; sub < 2; ++sub) {
                f32x16_t s0;
#pragma unroll
                for (int r = 0; r < 16; ++r) s0[r] = 0.f;
                const LAS unsigned char* kvs = kvb + sub * (32 * 64);
#pragma unroll
                for (int ks = 0; ks < 8; ++ks) {
                    const int c16 = 2 * ks + hh;
                    const unsigned ao = (unsigned)((c16 >> 2) * 4096 + r32 * 64) + (((unsigned)(c16 & 3) ^ kx) * 16u);
                    const bf16x8_t a0 = *(const LAS bf16x8_t*)(kvs + ao);
                    const bf16x8_t qk = qreg[ks];
                    s0 = MFMA32(a0, qk, s0);
                }
                const int kbase = 64 * j + 32 * sub + 4 * hh;
                const unsigned w0 = (sub ? mw.y : mw.x) >> (4 * hh);
                float alpha, ps = 0.f;
                if (nearb) {
#pragma unroll
                    for (int r = 0; r < 16; ++r) { const int key = kbase + (r & 3) + 8 * (r >> 2);
                        int d0 = t - key; d0 = d0 < 0 ? 0 : d0;
                        s0[r] = s0[r] * SC + bT[d0]; }
#pragma unroll
                    for (int r = 0; r < 16; ++r) { const int bp = (r & 3) + 8 * (r >> 2); if (!((w0 >> bp) & 1u)) s0[r] = -INFINITY; }
                    float mt = vmax3(s0[0], s0[1], s0[2]);
#pragma unroll
                    for (int r = 3; r < 15; r += 2) mt = vmax3(mt, s0[r], s0[r + 1]);
                    mt = vmax2(mt, s0[15]);
                    mt = xhalf_max(mt);
                    const float mn = vmax2(m, mt);
                    alpha = __builtin_amdgcn_exp2f(m - mn);
                    m = mn;
#pragma unroll
                    for (int r = 0; r < 16; ++r) { s0[r] = __builtin_amdgcn_exp2f(s0[r] - mn); ps += s0[r]; }
                } else {
#pragma unroll
                    for (int r = 0; r < 16; ++r) { const int bp = (r & 3) + 8 * (r >> 2); if (!((w0 >> bp) & 1u)) s0[r] = -INFINITY; }
                    float mr = vmax3(s0[0], s0[1], s0[2]);
#pragma unroll
                    for (int r = 3; r < 15; r += 2) mr = vmax3(mr, s0[r], s0[r + 1]);
                    mr = vmax2(mr, s0[15]);
                    mr = xhalf_max(mr);
                    const float mn = vmax2(m, mr * SC + c31);
                    alpha = __builtin_amdgcn_exp2f(m - mn);
                    m = mn;
                    const float off = c31 - mn;
#pragma unroll
                    for (int r = 0; r < 16; ++r) { s0[r] = __builtin_amdgcn_exp2f(s0[r] * SC + off); ps += s0[r]; }
                }
                l = l * alpha + ps;
                if (__any(alpha != 1.f)) {
#pragma unroll
                    for (int i = 0; i < 4; ++i)
#pragma unroll
                        for (int r = 0; r < 16; ++r) O[i][r] *= alpha;
                }
                bf16x8_t pb[2];
                pb[0] = pack8(s0, 0); pb[1] = pack8(s0, 1);
#pragma unroll
                for (int s = 0; s < 2; ++s)
#pragma unroll
                    for (int dblk = 0; dblk < 4; ++dblk) {
                        const LAS unsigned char* vp = kvs + dblk * 4096 + (16 * s) * 64;
                        const s16x4_t lo = vtr(vp + vrd_lo), hi = vtr(vp + vrd_hi);
                        const bf16x8_t va = __builtin_shufflevector(lo, hi, 0, 1, 2, 3, 4, 5, 6, 7);
                        O[dblk] = MFMA32(va, pb[s], O[dblk]);
                    }
            }
        }
        if (j + 1 < ntb) { DB_WRITE((j + 1) & 1); mw = mwn; }
        __syncthreads();
    }
#undef DB_LOAD
#undef DB_NORM1
#undef DB_WRITE
    l = xhalf_sum(l);
    const float inv = 1.f / l;
#pragma unroll
    for (int i = 0; i < 4; ++i)
#pragma unroll
        for (int r = 0; r < 16; ++r) O[i][r] *= inv;
    bf16x8_t ob[4][2];
#pragma unroll
    for (int i = 0; i < 4; ++i) { ob[i][0] = pack8(O[i], 0); ob[i][1] = pack8(O[i], 1); }
    bf16_t* orow = mixin + (rowbase + t) * D + 512 + head * 128;
    u32x2_t po[4][4];
#pragma unroll 1
    for (int e2 = 0; e2 < 2; ++e2) {
        bf16x8_t wa[2][8];
#pragma unroll
        for (int q = 0; q < 2; ++q)
#pragma unroll
            for (int i = 0; i < 4; ++i)
#pragma unroll
                for (int s = 0; s < 2; ++s) wa[q][2 * i + s] = *(const bf16x8_t*)(wuvF + ((((size_t)(head * 4 + 2 * e2 + q) * 4 + i) * 2 + s) * 64 + lane) * 8);
#pragma unroll
        for (int q = 0; q < 2; ++q) {
            f32x16_t acc;
#pragma unroll
            for (int r = 0; r < 16; ++r) acc[r] = 0.f;
#pragma unroll
            for (int i = 0; i < 4; ++i)
#pragma unroll
                for (int s = 0; s < 2; ++s) acc = MFMA32(wa[q][2 * i + s], ob[i][s], acc);
#pragma unroll
            for (int g = 0; g < 4; ++g) { u32x2_t o; o.x = cvtpk(acc[4 * g + 0], acc[4 * g + 1]); o.y = cvtpk(acc[4 * g + 2], acc[4 * g + 3]);
                if (e2 == 0) po[q][g] = o; else po[2 + q][g] = o; }
        }
    }
#pragma unroll
    for (int eb = 0; eb < 4; ++eb)
#pragma unroll
        for (int g = 0; g < 4; ++g) *(u32x2_t*)(orow + 32 * eb + 8 * g + 4 * hh) = po[eb][g];
}

__device__ __forceinline__ unsigned fkey_raw(float f) { const unsigned u = __float_as_uint(f); return (u & 0x80000000u) ? ~u : (u | 0x80000000u); }
__device__ __forceinline__ float fkey_inv(unsigned k) { const unsigned u = (k & 0x80000000u) ? (k & 0x7fffffffu) : ~k; return __uint_as_float(u); }
__device__ __forceinline__ unsigned ps_fmax(unsigned a, unsigned b) { unsigned r; asm("v_max_f32 %0, %1, %2" : "=v"(r) : "v"(a), "v"(b)); return r; }
__device__ __forceinline__ unsigned ps_fmin(unsigned a, unsigned b) { unsigned r; asm("v_min_f32 %0, %1, %2" : "=v"(r) : "v"(a), "v"(b)); return r; }
#define PS_CE(a, b) do { const unsigned hi_ = ps_fmax((a), (b)); const unsigned lo_ = ps_fmin((a), (b)); (a) = hi_; (b) = lo_; } while (0)
__device__ __forceinline__ void sort16_desc(unsigned (&k)[16]) {
    PS_CE(k[0], k[1]); PS_CE(k[2], k[3]); PS_CE(k[0], k[2]); PS_CE(k[1], k[3]); PS_CE(k[1], k[2]); PS_CE(k[4], k[5]); PS_CE(k[6], k[7]); PS_CE(k[4], k[6]); PS_CE(k[5], k[7]); PS_CE(k[5], k[6]); PS_CE(k[0], k[4]); PS_CE(k[2], k[6]); PS_CE(k[2], k[4]); PS_CE(k[1], k[5]); PS_CE(k[3], k[7]); PS_CE(k[3], k[5]); PS_CE(k[1], k[2]); PS_CE(k[3], k[4]); PS_CE(k[5], k[6]); PS_CE(k[8], k[9]); PS_CE(k[10], k[11]); PS_CE(k[8], k[10]); PS_CE(k[9], k[11]); PS_CE(k[9], k[10]); PS_CE(k[12], k[13]); PS_CE(k[14], k[15]); PS_CE(k[12], k[14]); PS_CE(k[13], k[15]); PS_CE(k[13], k[14]); PS_CE(k[8], k[12]); PS_CE(k[10], k[14]); PS_CE(k[10], k[12]); PS_CE(k[9], k[13]); PS_CE(k[11], k[15]); PS_CE(k[11], k[13]); PS_CE(k[9], k[10]); PS_CE(k[11], k[12]); PS_CE(k[13], k[14]); PS_CE(k[0], k[8]); PS_CE(k[4], k[12]); PS_CE(k[4], k[8]); PS_CE(k[2], k[10]); PS_CE(k[6], k[14]); PS_CE(k[6], k[10]); PS_CE(k[2], k[4]); PS_CE(k[6], k[8]); PS_CE(k[10], k[12]); PS_CE(k[1], k[9]); PS_CE(k[5], k[13]); PS_CE(k[5], k[9]); PS_CE(k[3], k[11]); PS_CE(k[7], k[15]); PS_CE(k[7], k[11]); PS_CE(k[3], k[5]); PS_CE(k[7], k[9]); PS_CE(k[11], k[13]); PS_CE(k[1], k[2]); PS_CE(k[3], k[4]); PS_CE(k[5], k[6]); PS_CE(k[7], k[8]); PS_CE(k[9], k[10]); PS_CE(k[11], k[12]); PS_CE(k[13], k[14]);
}
__device__ __forceinline__ void sort9_desc(unsigned (&k)[9]) {
    PS_CE(k[0], k[1]); PS_CE(k[2], k[3]); PS_CE(k[0], k[2]); PS_CE(k[1], k[3]); PS_CE(k[1], k[2]); PS_CE(k[4], k[5]); PS_CE(k[6], k[7]); PS_CE(k[4], k[6]); PS_CE(k[5], k[7]); PS_CE(k[5], k[6]); PS_CE(k[0], k[4]); PS_CE(k[2], k[6]); PS_CE(k[2], k[4]); PS_CE(k[1], k[5]); PS_CE(k[3], k[7]); PS_CE(k[3], k[5]); PS_CE(k[1], k[2]); PS_CE(k[3], k[4]); PS_CE(k[5], k[6]); PS_CE(k[0], k[8]); PS_CE(k[4], k[8]); PS_CE(k[2], k[4]); PS_CE(k[6], k[8]); PS_CE(k[3], k[5]); PS_CE(k[1], k[2]); PS_CE(k[3], k[4]); PS_CE(k[5], k[6]); PS_CE(k[7], k[8]);
}
__device__ __forceinline__ void merge16_top9(unsigned (&a)[16], const unsigned (&b)[9]) {
#pragma unroll
    for (int i = 7; i < 16; ++i) a[i] = ps_fmax(a[i], b[15 - i]);
#pragma unroll
    for (int j = 8; j > 0; j >>= 1)
#pragma unroll
        for (int i = 0; i < 16; ++i) { const int l = i ^ j; if (l > i) PS_CE(a[i], a[l]); }
}
__device__ __forceinline__ void merge16_top(unsigned (&a)[16], const unsigned (&b)[16]) {
#pragma unroll
    for (int i = 0; i < 16; ++i) a[i] = ps_fmax(a[i], b[15 - i]);
#pragma unroll
    for (int j = 8; j > 0; j >>= 1)
#pragma unroll
        for (int i = 0; i < 16; ++i) { const int l = i ^ j; if (l > i) PS_CE(a[i], a[l]); }
}
__device__ __forceinline__ unsigned xhalf_get(unsigned x, int hh) { auto rr = __builtin_amdgcn_permlane32_swap(x, x, false, false); return hh ? rr[0] : rr[1]; }
__device__ __forceinline__ void top16_of_pair(unsigned (&g0)[16], unsigned (&g1)[16], unsigned (&g2)[16], unsigned (&g3)[16], int hh) {
    sort16_desc(g0); sort16_desc(g1); sort16_desc(g2); sort16_desc(g3);
    merge16_top(g0, g1); merge16_top(g2, g3); merge16_top(g0, g2);
#pragma unroll
    for (int i = 0; i < 16; ++i) g1[i] = xhalf_get(g0[i], hh);
    merge16_top(g0, g1);
}
__device__ __forceinline__ void peer_select_wave(int tile, const bf16_t* __restrict__ qb, const bf16_t* __restrict__ keysb, unsigned short* __restrict__ eidx, float* __restrict__ gate, LAS unsigned char* kimg, int tid, int lane) {
    const int r32 = lane & 31, hh = lane >> 5;
    const int tok = tile * 32 + r32;
    const bf16_t* qrow0 = qb + (size_t)tok * D + 8 * hh;
    int kofs = 0; asm volatile("" : "+s"(kofs));
    const bf16_t* kch0; const bf16_t* kch1;
    { const int c0 = tid, c1 = tid + 512;
      kch0 = keysb + kofs + (size_t)(32 * (c0 >> 8) + (c0 & 31)) * 64 + 8 * ((c0 >> 5) & 1) + 16 * ((c0 >> 6) & 3);
      kch1 = keysb + kofs + (size_t)(32 * (c1 >> 8) + (c1 & 31)) * 64 + 8 * ((c1 >> 5) & 1) + 16 * ((c1 >> 6) & 3); }
    const LAS unsigned char* krd = kimg + (hh * 32 + r32) * 16;
    unsigned L1[16], L2[16];
#pragma unroll
    for (int i = 0; i < 16; ++i) { L1[i] = 0u; L2[i] = 0u; }
    bf16x8_t qfr[4], ka[4];
    unsigned tneg = 4u * hh, tpos = tneg ^ 127u;
    asm volatile("" : "+v"(tneg), "+v"(tpos));
#define PSW_LOADQ(HP) do { _Pragma("unroll") for (int ks = 0; ks < 4; ++ks) qfr[ks] = *(const bf16x8_t*)(qrow0 + (HP) * 64 + 16 * ks); } while (0)
#define PSW_LOADK(HP, KT) do { _Pragma("unroll") for (int ks = 0; ks < 4; ++ks) ka[ks] = *(const LAS bf16x8_t*)(krd + ((HP) & 1) * 16384 + ((KT) * 4 + ks) * 1024); } while (0)
#define PSW_FETCH(HP) do { kf0 = *(const bf16x8_t*)(kch0 + (size_t)(HP) * 128 * 64); kf1 = *(const bf16x8_t*)(kch1 + (size_t)(HP) * 128 * 64); } while (0)
#define PSW_PUT(HP) do { *(LAS bf16x8_t*)(kimg + ((HP) & 1) * 16384 + tid * 16) = kf0; *(LAS bf16x8_t*)(kimg + ((HP) & 1) * 16384 + (tid + 512) * 16) = kf1; } while (0)
#define PSW_MFMA() do { _Pragma("unroll") for (int r = 0; r < 16; ++r) acc[r] = 0.f; \
        _Pragma("unroll") for (int ks = 0; ks < 4; ++ks) acc = MFMA32(ka[ks], qfr[ks], acc); } while (0)
#define PSW_KEYS(KT) do { _Pragma("unroll") for (int r = 0; r < 16; ++r) { const unsigned C_ = 32 * (KT) + (r & 3) + 8 * (r >> 2); const unsigned ub = __float_as_uint(acc[r]); g[KT][r] = (ub & ~127u) | (((int)ub < 0 ? tneg : tpos) ^ C_); } } while (0)
    bf16x8_t kf0, kf1;
    PSW_LOADQ(0); PSW_FETCH(0);
    __syncthreads();
    PSW_PUT(0);
    __syncthreads();
    PSW_LOADK(0, 0);
#pragma unroll 1
    for (int hp = 0; hp < 16; ++hp) {
        const int h = hp >> 1, p = hp & 1, hn = hp + 1 < 16 ? hp + 1 : 15;
        unsigned g[4][16]; f32x16_t acc;
        PSW_FETCH(hn);
        PSW_MFMA(); PSW_LOADK(hp, 1);
        __builtin_amdgcn_sched_barrier(0);
        PSW_KEYS(0);
        PSW_MFMA(); PSW_LOADK(hp, 2);
        __builtin_amdgcn_sched_barrier(0);
        PSW_KEYS(1);
        PSW_MFMA(); PSW_LOADK(hp, 3);
        __builtin_amdgcn_sched_barrier(0);
        PSW_KEYS(2);
        PSW_MFMA(); PSW_LOADQ(hn);
        PSW_PUT(hp + 1);
        __builtin_amdgcn_sched_barrier(0);
        PSW_KEYS(3);
        top16_of_pair(g[0], g[1], g[2], g[3], hh);
#pragma unroll
        for (int i = 0; i < 16; ++i) { L1[i] = p == 0 ? g[0][i] : L1[i]; L2[i] = p == 0 ? L2[i] : g[0][i]; }
        if (p == 1) {
            float s1[16], s2[16];
#pragma unroll
            for (int i = 0; i < 16; ++i) { s1[i] = __uint_as_float(L1[i] & ~127u); s2[i] = __uint_as_float(L2[i] & ~127u); }
            unsigned c0[16], c1[16], c9[9];
#pragma unroll
            for (int i = 0; i < 16; ++i) c0[i] = 0xff800000u;
#pragma unroll
            for (int i = 0; i < 9; ++i) c9[i] = 0xff800000u;
            {
                int n = 0;
#pragma unroll
                for (int i = 0; i < 16; ++i)
#pragma unroll
                    for (int j = 0; j < 16; ++j) if ((i + 1) * (j + 1) <= 16) {
                        const unsigned sb = __float_as_uint(s1[i] + s2[j]); const unsigned ck = (sb & ~255u) | (unsigned)((sb >> 31) ? (i * 16 + j) : 255 - (i * 16 + j));
                        const int slot = n >> 1;
                        if (slot < 16) c0[slot] = ((n & 1) == hh) ? ck : c0[slot]; else c9[slot - 16] = ((n & 1) == hh) ? ck : c9[slot - 16];
                        ++n;
                    }
            }
            sort16_desc(c0); sort9_desc(c9); merge16_top9(c0, c9);
#pragma unroll
            for (int i = 0; i < 16; ++i) c1[i] = xhalf_get(c0[i], hh);
            merge16_top(c0, c1);
            float ev[16]; float su = 0.f;
            const float tmax = __uint_as_float(c0[0] & ~255u);
#pragma unroll
            for (int r = 0; r < 16; ++r) { ev[r] = __expf(__uint_as_float(c0[r] & ~255u) - tmax); su += ev[r]; }
            const float inv = 1.f / su;
            unsigned short* eo = eidx + (size_t)tok * 128 + h * 16 + 8 * hh; float* go = gate + (size_t)tok * 128 + h * 16 + 8 * hh;
            unsigned T1[4], T2[4];
#pragma unroll
            for (int w = 0; w < 4; ++w) { unsigned d1 = 0u, d2 = 0u;
#pragma unroll
                for (int bq = 0; bq < 4; ++bq) { const unsigned ka_ = L1[4 * w + bq], kb_ = L2[4 * w + bq];
                    const unsigned ia = ~(ka_ ^ (unsigned)((int)ka_ >> 31)) & 127u, ib = ~(kb_ ^ (unsigned)((int)kb_ >> 31)) & 127u;
                    d1 |= ia << (8 * bq); d2 |= ib << (8 * bq); }
                T1[w] = d1; T2[w] = d2; }
            int ei[8]; float gv[8];
#pragma unroll
            for (int r = 0; r < 8; ++r) {
                const unsigned ck = hh ? c0[8 + r] : c0[r]; const float e = hh ? ev[8 + r] : ev[r];
                const int pos = (ck >> 31) ? (int)(ck & 255u) : 255 - (int)(ck & 255u), pi = pos >> 4, pj = pos & 15;
                const unsigned s1_ = ((unsigned)pi & 7u) | 0x0c0c0c00u, s2_ = ((unsigned)pj & 7u) | 0x0c0c0c00u;
                const unsigned a1 = __builtin_amdgcn_perm(T1[1], T1[0], s1_), b1 = __builtin_amdgcn_perm(T1[3], T1[2], s1_);
                const unsigned a2 = __builtin_amdgcn_perm(T2[1], T2[0], s2_), b2 = __builtin_amdgcn_perm(T2[3], T2[2], s2_);
                const int i1 = (int)(pi >= 8 ? b1 : a1), i2 = (int)(pj >= 8 ? b2 : a2);
                ei[r] = i1 * 128 + i2; gv[r] = e * inv;
            }
            __builtin_amdgcn_s_waitcnt(0x0F70);
            *(uint4*)(eo) = make_uint4((unsigned)ei[0] | ((unsigned)ei[1] << 16), (unsigned)ei[2] | ((unsigned)ei[3] << 16), (unsigned)ei[4] | ((unsigned)ei[5] << 16), (unsigned)ei[6] | ((unsigned)ei[7] << 16));
            *(float4*)(go) = make_float4(gv[0], gv[1], gv[2], gv[3]); *(float4*)(go + 4) = make_float4(gv[4], gv[5], gv[6], gv[7]);
        }
        __syncthreads();
        PSW_LOADK(hp + 1, 0);
    }
#undef PSW_FETCH
#undef PSW_PUT
#undef PSW_LOADQ
#undef PSW_LOADK
#undef PSW_MFMA
#undef PSW_KEYS
}

__device__ __forceinline__ float gelu_erf(float a) { return 0.5f * a * (1.f + erff(a * 0.70710678118654752f)); }
template <int CTRL> __device__ __forceinline__ int dpp_i(int v) { return __builtin_amdgcn_update_dpp(0, v, CTRL, 0xf, 0xf, false); }
template <int CTRL> __device__ __forceinline__ float dpp_f(float v) { return __int_as_float(__builtin_amdgcn_update_dpp(0, __float_as_int(v), CTRL, 0xf, 0xf, false)); }
constexpr int DPP_XOR1 = 0xB1, DPP_XOR2 = 0x4E, DPP_HMIRROR = 0x141, DPP_ROR8 = 0x128;

__device__ __forceinline__ void peer_gather_tile(int tile, const unsigned char* __restrict__ xq, const float* __restrict__ sxs, const unsigned short* __restrict__ eidx, const float* __restrict__ gate,
                                                 const unsigned char* __restrict__ uq, const unsigned char* __restrict__ vq, const float* __restrict__ su, const float* __restrict__ sv,
                                                 const float* __restrict__ mod, const float* __restrict__ g_final, const bf16_t* xin, bf16_t* ybuf, float* outp,
                                                 LAS unsigned char* wlds, LAS unsigned char* wsc, int lane) {
    const int tok0 = tile * 32, e_sub = lane >> 3, part = lane & 7;
    const int b0 = lane & 1, b1 = (lane >> 1) & 1, b2 = (lane >> 2) & 1, b3 = (lane >> 3) & 1, b4 = (lane >> 4) & 1, b5 = (lane >> 5) & 1;
    unsigned idr[32];
#pragma unroll
    for (int t = 0; t < 32; ++t) idr[t] = ((const unsigned*)(eidx + (size_t)(tok0 + t) * 128))[lane];
    int c128 = 128, part16 = 16 * part;
    asm volatile("" : "+v"(c128), "+v"(part16));
    LAS int* accl = (LAS int*)wlds;
    const __amdgpu_buffer_rsrc_t urs = __builtin_amdgcn_make_buffer_rsrc((void*)uq, 0, 16384 * 1024, 0x00020000);
    const __amdgpu_buffer_rsrc_t vrs = __builtin_amdgcn_make_buffer_rsrc((void*)vq, 0, 16384 * 1024, 0x00020000);
#pragma unroll
    for (int i = 0; i < 16; ++i) *(LAS u32x4_t*)(wlds + i * 1024 + lane * 16) = (u32x4_t){0u, 0u, 0u, 0u};
#define PG_LOADIDXRAW(q_, tl_) do { q_ = idr[(tl_)]; } while (0)
#define PG_UNPACKIDX(dst, q_) do { ((LAS unsigned*)wsc)[lane] = q_; const u32x4_t q0_ = *(const LAS u32x4_t*)(wsc + 32 * e_sub), q1_ = *(const LAS u32x4_t*)(wsc + 32 * e_sub + 16); \
        dst[0] = q0_.x; dst[1] = q0_.y; dst[2] = q0_.z; dst[3] = q0_.w; dst[4] = q1_.x; dst[5] = q1_.y; dst[6] = q1_.z; dst[7] = q1_.w; } while (0)
#define PG_ROWOFF(vo_, w_, hi_) do { if (hi_) asm("v_mad_u32_u16 %0, %1, %2, %3 op_sel:[1,0,0,0]" : "=v"(vo_) : "v"(w_), "v"(c128), "v"(part16)); \
                                     else asm("v_mad_u32_u16 %0, %1, %2, %3 op_sel:[0,0,0,0]" : "=v"(vo_) : "v"(w_), "v"(c128), "v"(part16)); } while (0)
#define PG_LOADROWS8(dst, idx_, h_, rs_) do { _Pragma("unroll") for (int i_ = 0; i_ < 8; ++i_) { int vo_; PG_ROWOFF(vo_, idx_[(8 * (h_) + i_) >> 1], (i_ & 1)); dst[i_] = __builtin_amdgcn_raw_buffer_load_b128(rs_, vo_, soff, 0); } } while (0)
#define PG_LOADROWS8_AFTER(dst, idx_, h_, rs_, dep_) do { _Pragma("unroll") for (int i_ = 0; i_ < 8; ++i_) { int vo_; PG_ROWOFF(vo_, idx_[(8 * (h_) + i_) >> 1], (i_ & 1)); asm volatile("" : "+v"(vo_) : "v"(dep_)); \
        dst[i_] = __builtin_amdgcn_raw_buffer_load_b128(rs_, vo_, soff, 0); } } while (0)
#define PG_UDOT8(r_, xs_, h_) do { _Pragma("unroll") for (int i = 0; i < 8; ++i) { int a_ = __builtin_amdgcn_sdot4((int)r_[i][0], (int)xs_.x, 0, false); a_ = __builtin_amdgcn_sdot4((int)r_[i][1], (int)xs_.y, a_, false); \
            a_ = __builtin_amdgcn_sdot4((int)r_[i][2], (int)xs_.z, a_, false); d[8 * (h_) + i] = __builtin_amdgcn_sdot4((int)r_[i][3], (int)xs_.w, a_, false); } } while (0)
#pragma unroll 1
    for (int s = 0; s < 8; ++s) {
        const int loff = 128 * s + 16 * part; const int soff = s * (16384 * 128);
        unsigned idxN[8]; u32x4_t rP[8], rQ[8]; unsigned iqw;
        LAS unsigned char* xbuf = wsc + 512;
        const unsigned char* xsrc = xq + (size_t)(tok0 + (lane >> 3)) * 1024 + loff;
        u32x4_t xh0 = __builtin_nontemporal_load((const u32x4_t*)(xsrc)), xh1 = __builtin_nontemporal_load((const u32x4_t*)(xsrc + 8 * 1024));
        PG_LOADIDXRAW(iqw, 0); PG_UNPACKIDX(idxN, iqw);
        PG_LOADROWS8(rP, idxN, 0, urs); PG_LOADROWS8(rQ, idxN, 1, urs);
        PG_LOADIDXRAW(iqw, 1);
        *(LAS u32x4_t*)(xbuf + lane * 16) = xh0; *(LAS u32x4_t*)(xbuf + 1024 + lane * 16) = xh1;
#pragma unroll 1
        for (int tl = 0; tl < 32; ++tl) {
            int d[16];
            const int tn2 = tl + 2 < 32 ? tl + 2 : 31;
            PG_UNPACKIDX(idxN, iqw);
            PG_LOADIDXRAW(iqw, tn2);
            if (tl == 8) { xh0 = __builtin_nontemporal_load((const u32x4_t*)(xsrc + 16 * 1024)); xh1 = __builtin_nontemporal_load((const u32x4_t*)(xsrc + 24 * 1024)); }
            if (tl == 16) { *(LAS u32x4_t*)(xbuf + lane * 16) = xh0; *(LAS u32x4_t*)(xbuf + 1024 + lane * 16) = xh1; }
            const u32x4_t xsC = *(const LAS u32x4_t*)(xbuf + (tl & 15) * 128 + part * 16);
            __builtin_amdgcn_sched_barrier(0);
            PG_UDOT8(rP, xsC, 0);
            PG_LOADROWS8_AFTER(rP, idxN, 0, urs, d[7]);
            __builtin_amdgcn_sched_barrier(0);
            PG_UDOT8(rQ, xsC, 1);
            PG_LOADROWS8_AFTER(rQ, idxN, 1, urs, d[15]);
            __builtin_amdgcn_sched_barrier(0);
#pragma unroll
            for (int j = 0; j < 8; ++j) { const int keep = b2 ? d[j + 8] : d[j], send = b2 ? d[j] : d[j + 8]; d[j] = keep + dpp_i<DPP_HMIRROR>(send); }
#pragma unroll
            for (int j = 0; j < 4; ++j) { const int keep = b0 ? d[j + 4] : d[j], send = b0 ? d[j] : d[j + 4]; d[j] = keep + dpp_i<DPP_XOR1>(send); }
#pragma unroll
            for (int j = 0; j < 2; ++j) { const int keep = b1 ? d[j + 2] : d[j], send = b1 ? d[j] : d[j + 2]; d[j] = keep + dpp_i<DPP_XOR2>(send); }
            LAS int* ap = accl + tl * 128 + 16 * e_sub + 8 * b2 + 4 * b0 + 2 * b1; ap[0] += d[0]; ap[1] += d[1];
        }
    }
#pragma unroll 1
    for (int t4 = 0; t4 < 32; t4 += 4) {
        int e_[4][2]; float g_[4][2], sx_[4], su_[4][2], sv_[4][2];
#pragma unroll
        for (int r = 0; r < 4; ++r) { const int tok = tok0 + t4 + r; sx_[r] = sxs[tok];
#pragma unroll
            for (int hf = 0; hf < 2; ++hf) { e_[r][hf] = (int)eidx[(size_t)tok * 128 + lane + 64 * hf]; g_[r][hf] = gate[(size_t)tok * 128 + lane + 64 * hf]; } }
        __builtin_amdgcn_sched_barrier(0);
#pragma unroll
        for (int r = 0; r < 4; ++r)
#pragma unroll
            for (int hf = 0; hf < 2; ++hf) { su_[r][hf] = su[e_[r][hf]]; sv_[r][hf] = sv[e_[r][hf]]; }
        __builtin_amdgcn_sched_barrier(0);
#pragma unroll
        for (int r = 0; r < 4; ++r) { const int tl = t4 + r;
            float wf[2];
#pragma unroll
            for (int hf = 0; hf < 2; ++hf) { const float a = (float)accl[tl * 128 + lane + 64 * hf] * sx_[r] * su_[r][hf]; wf[hf] = g_[r][hf] * gelu_erf(a) * sv_[r][hf]; }
            const float wm = wave_max(fmaxf(fabsf(wf[0]), fabsf(wf[1])));
            const float sw = wm > 0.f ? wm * (1.f / 127.f) : 1.f, inv = wm > 0.f ? 127.f / wm : 0.f;
            LAS signed char* wb = (LAS signed char*)(accl + tl * 128);
            wb[lane] = (signed char)(int)rintf(wf[0] * inv); wb[lane + 64] = (signed char)(int)rintf(wf[1] * inv);
            if (lane == 0) ((LAS float*)accl)[tl * 128 + 32] = sw;
        }
    }
#define PG_VACC8(r_, h_) do { _Pragma("unroll") for (int g_ = 0; g_ < 2; ++g_) { const int wq_ = (int)wq4[2 * (h_) + g_]; \
            _Pragma("unroll") for (int q = 0; q < 4; ++q) { const unsigned R0 = r_[4 * g_][q], R1 = r_[4 * g_ + 1][q], R2 = r_[4 * g_ + 2][q], R3 = r_[4 * g_ + 3][q]; \
                const unsigned A_ = __builtin_amdgcn_perm(R1, R0, 0x05010400u), B_ = __builtin_amdgcn_perm(R1, R0, 0x07030602u), C_ = __builtin_amdgcn_perm(R3, R2, 0x05010400u), D_ = __builtin_amdgcn_perm(R3, R2, 0x07030602u); \
                acc[4 * q + 0] = __builtin_amdgcn_sdot4((int)__builtin_amdgcn_perm(C_, A_, 0x05040100u), wq_, acc[4 * q + 0], false); \
                acc[4 * q + 1] = __builtin_amdgcn_sdot4((int)__builtin_amdgcn_perm(C_, A_, 0x07060302u), wq_, acc[4 * q + 1], false); \
                acc[4 * q + 2] = __builtin_amdgcn_sdot4((int)__builtin_amdgcn_perm(D_, B_, 0x05040100u), wq_, acc[4 * q + 2], false); \
                acc[4 * q + 3] = __builtin_amdgcn_sdot4((int)__builtin_amdgcn_perm(D_, B_, 0x07060302u), wq_, acc[4 * q + 3], false); } } } while (0)
#define PG_FLUSH(S_) do { _Pragma("unroll") for (int k = 0; k < 8; ++k) { const int f = 64 * k + lane, tkn = f >> 4, c = f & 15; \
            const u32x4_t yv = *(const LAS u32x4_t*)(wlds + tkn * 512 + 256 + 16 * c); \
            __builtin_nontemporal_store(yv, (u32x4_t*)(ybuf + (size_t)(tok0 + tkn) * D + 256 * (c >> 2) + 32 * (S_) + 8 * (c & 3))); } } while (0)
#pragma unroll 1
    for (int s = 0; s < 8; ++s) {
        const int soff = s * (16384 * 128);
        const int col = 256 * (2 * b3 + b5) + 32 * s + 4 * part + 2 * b4;
        LAS unsigned* ystage = (LAS unsigned*)(wlds + 256 + 64 * (2 * b3 + b5) + 8 * part + 4 * b4);
        const float2 gf = *(const float2*)(mod + (size_t)(tok0 / S) * 6144 + MOD_GATE_F + col);
        unsigned idxN[8]; u32x4_t rP[8], rQ[8]; unsigned iqw; unsigned x1pC, x1pN;
        PG_LOADIDXRAW(iqw, 0); PG_UNPACKIDX(idxN, iqw);
        x1pC = *(const unsigned*)(xin + (size_t)tok0 * D + col);
        PG_LOADROWS8(rP, idxN, 0, vrs); PG_LOADROWS8(rQ, idxN, 1, vrs);
        PG_LOADIDXRAW(iqw, 1);
        __builtin_amdgcn_sched_barrier(0);
        if (s > 0) PG_FLUSH(s - 1);
        __builtin_amdgcn_s_waitcnt(0x0F70);
#pragma unroll 1
        for (int tl = 0; tl < 32; ++tl) {
            const int tn = tl + 1 < 32 ? tl + 1 : 31, tn2 = tl + 2 < 32 ? tl + 2 : 31;
            PG_UNPACKIDX(idxN, iqw);
            PG_LOADIDXRAW(iqw, tn2);
            x1pN = *(const unsigned*)(xin + (size_t)(tok0 + tn) * D + col);
            const u32x4_t wq4 = *(const LAS u32x4_t*)((const LAS unsigned char*)(accl + tl * 128) + 16 * e_sub);
            const float sw = ((const LAS float*)accl)[tl * 128 + 32];
            int acc[16];
#pragma unroll
            for (int c = 0; c < 16; ++c) acc[c] = 0;
            __builtin_amdgcn_sched_barrier(0);
            PG_VACC8(rP, 0);
            PG_LOADROWS8_AFTER(rP, idxN, 0, vrs, acc[15]);
            __builtin_amdgcn_sched_barrier(0);
            PG_VACC8(rQ, 1);
            PG_LOADROWS8_AFTER(rQ, idxN, 1, vrs, acc[15]);
            __builtin_amdgcn_sched_barrier(0);
#pragma unroll
            for (int j = 0; j < 8; ++j) { const int keep = b3 ? acc[j + 8] : acc[j], send = b3 ? acc[j] : acc[j + 8]; acc[j] = keep + dpp_i<DPP_ROR8>(send); }
#pragma unroll
            for (int j = 0; j < 4; ++j) { auto rr = __builtin_amdgcn_permlane32_swap((unsigned)acc[j], (unsigned)acc[j + 4], false, false); acc[j] = (int)rr[0] + (int)rr[1]; }
#pragma unroll
            for (int j = 0; j < 2; ++j) { const int keep = b4 ? acc[j + 2] : acc[j], send = b4 ? acc[j] : acc[j + 2]; acc[j] = keep + __shfl_xor(send, 16); }
            float2 x1; x1.x = __uint_as_float(x1pC << 16); x1.y = __uint_as_float(x1pC & 0xffff0000u);
            ystage[tl * 128] = pk2(x1.x + gf.x * ((float)acc[0] * sw), x1.y + gf.y * ((float)acc[1] * sw));
            x1pC = x1pN;
        }
    }
    PG_FLUSH(7);
    __builtin_amdgcn_s_waitcnt(0x0F70);
#undef PG_FLUSH
#undef PG_LOADIDXRAW
#undef PG_UNPACKIDX
#undef PG_ROWOFF
#undef PG_LOADROWS8
#undef PG_LOADROWS8_AFTER
#undef PG_UDOT8
#undef PG_VACC8
    float4 gg[4];
#pragma unroll
    for (int i = 0; i < 4; ++i) gg[i] = *(const float4*)(g_final + 256 * i + 4 * lane);
#pragma unroll 1
    for (int tl = 0; tl < 32; tl += 4) {
        float4 y[4][4]; float ss[4];
#pragma unroll
        for (int r = 0; r < 4; ++r) { ss[r] = 0.f;
#pragma unroll
            for (int i = 0; i < 4; ++i) { const uint2 yb = *(const uint2*)(ybuf + (size_t)(tok0 + tl + r) * D + 256 * i + 4 * lane);
                y[r][i].x = __uint_as_float(yb.x << 16); y[r][i].y = __uint_as_float(yb.x & 0xffff0000u); y[r][i].z = __uint_as_float(yb.y << 16); y[r][i].w = __uint_as_float(yb.y & 0xffff0000u); } }
#pragma unroll
        for (int r = 0; r < 4; ++r)
#pragma unroll
            for (int i = 0; i < 4; ++i) ss[r] += y[r][i].x * y[r][i].x + y[r][i].y * y[r][i].y + y[r][i].z * y[r][i].z + y[r][i].w * y[r][i].w;
#pragma unroll
        for (int o = 32; o >= 1; o >>= 1)
#pragma unroll
            for (int r = 0; r < 4; ++r) ss[r] += __shfl_xor(ss[r], o);
#pragma unroll
        for (int r = 0; r < 4; ++r) { const float rn = rsqrtf(ss[r] * (1.f / D) + EPS);
#pragma unroll
            for (int i = 0; i < 4; ++i) { float4 o; o.x = y[r][i].x * rn * gg[i].x; o.y = y[r][i].y * rn * gg[i].y; o.z = y[r][i].z * rn * gg[i].z; o.w = y[r][i].w * rn * gg[i].w;
                *(float4*)(outp + (size_t)(tok0 + tl + r) * D + 256 * i + 4 * lane) = o; } }
    }
}

constexpr size_t MiB = 1u << 20;
constexpr size_t WS_CTL = 0, CTL_ZERO_BYTES = 1 * MiB;
constexpr size_t WS_MOD = 1 * MiB;
constexpr size_t WS_LAM = 1 * MiB + 800 * 1024;
constexpr size_t WS_WIN_T = 2 * MiB;
constexpr size_t WS_WO_T = 8 * MiB;
constexpr size_t WS_WQ_T = 10 * MiB;
constexpr size_t WS_HBUF = 16 * MiB;
constexpr size_t WS_MIXIN = 144 * MiB;
constexpr size_t WS_MASK = 272 * MiB;
constexpr size_t WS_KEYSB = 13 * MiB;
constexpr size_t WS_WUVF = 12 * MiB;
constexpr size_t WS_EIDX = 288 * MiB;
constexpr size_t WS_GATE = 320 * MiB;
constexpr size_t WS_BIG = 352 * MiB;
constexpr size_t WS_UQ = 704 * MiB;
constexpr size_t WS_VQ = 720 * MiB;
constexpr size_t WS_SU = 736 * MiB;
constexpr size_t WS_SV = 736 * MiB + 65536;
constexpr size_t WS_XQ = 737 * MiB;
constexpr size_t WS_SX = 801 * MiB;
constexpr size_t WS_END = 802 * MiB;
constexpr int CW_BAR = 4096;
constexpr int MAX_FWD_LAUNCHES = 8;
static_assert((CW_BAR + MAX_FWD_LAUNCHES * XCD_BAR_WORDS) * 4 <= (int)CTL_ZERO_BYTES, "barrier words inside the memset region");

constexpr int RING_OFF = 0, RING_BYTES = 131072;
constexpr int LDSCTL_OFF = RING_BYTES, MISC_OFF = LDSCTL_OFF + 320;
constexpr int LDS_BYTES = 163840;

constexpr int REPS[11] = {1, 1, 1, 1, 1, 1, 1, 1, 1, 1, 1};
struct Args { const float* in[21]; float* out; unsigned char* ws; int ph_lo, ph_hi, li, pad; };

__device__ __forceinline__ void p0_transpose_item(const float* W, int K, int N, int Npad, bf16_t* WT, LAS float* scr, int item, int lane) {
    const int nblk = Npad / 32, kb = item / nblk, nb = item % nblk, k0 = 64 * kb, n0 = 32 * nb;
    const int n_in = n0 + (lane & 31);
#pragma unroll 8
    for (int i = 0; i < 32; ++i) { const int kk = 2 * i + (lane >> 5); scr[kk * 33 + (lane & 31)] = n_in < N ? W[(size_t)(k0 + kk) * N + n_in] : 0.f; }
    asm volatile("s_waitcnt lgkmcnt(0)" ::: "memory");
    const int c = lane & 7;
#pragma unroll
    for (int j = 0; j < 4; ++j) { const int n = (lane >> 3) + 8 * j; const LAS float* s = scr + (8 * c) * 33 + n;
        uint4 o; o.x = pk2(s[0 * 33], s[1 * 33]); o.y = pk2(s[2 * 33], s[3 * 33]); o.z = pk2(s[4 * 33], s[5 * 33]); o.w = pk2(s[6 * 33], s[7 * 33]);
        *(uint4*)(WT + (size_t)(n0 + n) * K + k0 + 8 * c) = o; }
    asm volatile("s_waitcnt lgkmcnt(0)" ::: "memory");
}

template <int OFFS, bool SLICED = false> __device__ __forceinline__ void quant_row(const float4 (&v)[4], unsigned char* qrow, float* scale_out, int lane);
template <int OFFS, bool SLICED> __device__ __forceinline__ void quant_row(const float4 (&v)[4], unsigned char* qrow, float* scale_out, int lane);
template <bool QUANT, int NR, bool BF16IN>
__device__ __forceinline__ void norm_mod_rows(const void* xrows_v, const float* g, const float* mb, int shift_off, int scale_off, bf16_t* orows, int lane, unsigned char* qrows, float* qscale) {
    float4 v[NR][4]; float ss[NR];
#pragma unroll
    for (int r = 0; r < NR; ++r)
#pragma unroll
        for (int i = 0; i < 4; ++i) {
            if (BF16IN) { const uint2 b2 = ((const uint2*)((const bf16_t*)xrows_v + (size_t)r * D))[lane + 64 * i];
                v[r][i].x = __uint_as_float(b2.x << 16); v[r][i].y = __uint_as_float(b2.x & 0xffff0000u); v[r][i].z = __uint_as_float(b2.y << 16); v[r][i].w = __uint_as_float(b2.y & 0xffff0000u); }
            else v[r][i] = ((const float4*)((const float*)xrows_v + (size_t)r * D))[lane + 64 * i];
        }
#pragma unroll
    for (int r = 0; r < NR; ++r) { ss[r] = 0.f;
#pragma unroll
        for (int i = 0; i < 4; ++i) ss[r] += v[r][i].x * v[r][i].x + v[r][i].y * v[r][i].y + v[r][i].z * v[r][i].z + v[r][i].w * v[r][i].w; }
#pragma unroll
    for (int o = 32; o >= 1; o >>= 1)
#pragma unroll
        for (int r = 0; r < NR; ++r) ss[r] += __shfl_xor(ss[r], o);
#pragma unroll
    for (int i = 0; i < 4; ++i) {
        const int col = (lane + 64 * i) * 4;
        const float4 gg = *(const float4*)(g + col), sc = *(const float4*)(mb + scale_off + col), sh = *(const float4*)(mb + shift_off + col);
        const float mx = gg.x * (1.f + sc.x), my = gg.y * (1.f + sc.y), mz = gg.z * (1.f + sc.z), mw = gg.w * (1.f + sc.w);
#pragma unroll
        for (int r = 0; r < NR; ++r) {
            const float rn = rsqrtf(ss[r] * (1.f / D) + EPS);
            v[r][i].x = v[r][i].x * rn * mx + sh.x; v[r][i].y = v[r][i].y * rn * my + sh.y; v[r][i].z = v[r][i].z * rn * mz + sh.z; v[r][i].w = v[r][i].w * rn * mw + sh.w;
            uint2 o; o.x = pk2(v[r][i].x, v[r][i].y); o.y = pk2(v[r][i].z, v[r][i].w);
            *(uint2*)(orows + (size_t)r * D + col) = o;
        }
    }
    if (QUANT) {
#pragma unroll
        for (int r = 0; r < NR; ++r) quant_row<0>(v[r], qrows + (size_t)r * 1024, qscale + r, lane);
    }
}

template <int OFFS, bool SLICED>
__device__ __forceinline__ void quant_row(const float4 (&v)[4], unsigned char* qrow, float* scale_out, int lane) {
    float am = 0.f;
#pragma unroll
    for (int i = 0; i < 4; ++i) am = fmaxf(am, fmaxf(fmaxf(fabsf(v[i].x), fabsf(v[i].y)), fmaxf(fabsf(v[i].z), fabsf(v[i].w))));
    am = wave_max(am);
    const float sc = am > 0.f ? am * (1.f / 127.f) : 1.f, inv = am > 0.f ? 127.f / am : 0.f;
    uint4 o; unsigned w[4];
#pragma unroll
    for (int i = 0; i < 4; ++i) {
        const int q0 = (int)rintf(v[i].x * inv) + OFFS, q1 = (int)rintf(v[i].y * inv) + OFFS, q2 = (int)rintf(v[i].z * inv) + OFFS, q3 = (int)rintf(v[i].w * inv) + OFFS;
        w[i] = (unsigned)(q0 & 255) | ((unsigned)(q1 & 255) << 8) | ((unsigned)(q2 & 255) << 16) | ((unsigned)(q3 & 255) << 24);
    }
    o.x = w[0]; o.y = w[1]; o.z = w[2]; o.w = w[3];
    *(uint4*)(qrow + (SLICED ? (size_t)(lane >> 3) * (16384 * 128) + 16 * (lane & 7) : (size_t)16 * lane)) = o;
    if (lane == 0) *scale_out = sc;
}
__device__ __forceinline__ void quant_table_row(const float* row, unsigned char* qrow, float* scale_out, int lane, bool offs) {
    float4 v[4];
#pragma unroll
    for (int i = 0; i < 4; ++i) v[i] = ((const float4*)row)[lane + 64 * i];
    (void)offs; quant_row<0, true>(v, qrow, scale_out, lane);
}

__device__ __forceinline__ int treduce16(int (&v)[16], int lane) {
#pragma unroll
    for (int o = 8, n = 16; o >= 1; o >>= 1, n >>= 1) {
        const bool upper = (lane & o) != 0;
#pragma unroll
        for (int j = 0; j < n / 2; ++j) {
            const int keep = upper ? v[j + n / 2] : v[j];
            const int send = upper ? v[j] : v[j + n / 2];
            v[j] = keep + __shfl_xor(send, o);
        }
    }
    int t = v[0];
    t += __shfl_xor(t, 16); t += __shfl_xor(t, 32);
    return t;
}

typedef float f32x16m __attribute__((ext_vector_type(16)));
__device__ __forceinline__ void mod_block(const float* __restrict__ c, const float* __restrict__ w_ada, const float* __restrict__ b_ada, float* __restrict__ mod, LAS float* red, int blk, int tid, int lane, int wave) {
    const int r32 = lane & 31, hh = lane >> 5, j0 = 24 * blk;
    f32x16m acc;
#pragma unroll
    for (int r = 0; r < 16; ++r) acc[r] = 0.f;
    const int kb = 128 * wave;
#pragma unroll 8
    for (int s2 = 0; s2 < 64; ++s2) {
        const int k = kb + 2 * s2 + hh;
        const float cv = c[r32 * D + k];
        const float a = cv / (1.f + __expf(-cv));
        const float bw = r32 < 24 ? w_ada[(size_t)k * 6144 + j0 + r32] : 0.f;
        acc = __builtin_amdgcn_mfma_f32_32x32x2f32(a, bw, acc, 0, 0, 0);
    }
#pragma unroll
    for (int r = 0; r < 16; ++r) red[wave * 1024 + ((r & 3) + 8 * (r >> 2) + 4 * hh) * 32 + r32] = acc[r];
    __syncthreads();
    for (int o = tid; o < 32 * 24; o += NTHREADS) {
        const int b = o / 24, j = o - 24 * b; float sum = b_ada[j0 + j];
#pragma unroll
        for (int w = 0; w < 8; ++w) sum += red[w * 1024 + b * 32 + j];
        mod[b * 6144 + j0 + j] = sum;
    }
    __syncthreads();
}

__global__ void __launch_bounds__(NTHREADS, 2) fwd(Args args) {
    extern __shared__ __attribute__((aligned(16))) unsigned char lds_raw[];
    LAS unsigned char* lds = (LAS unsigned char*)lds_raw;
    volatile LAS unsigned* MISC = (volatile LAS unsigned*)(lds + MISC_OFF);
    const int wave = __builtin_amdgcn_readfirstlane(threadIdx.x >> 6);
#define LANE_ID() ((int)__builtin_amdgcn_mbcnt_hi(~0u, __builtin_amdgcn_mbcnt_lo(~0u, 0u)))
    const int G = gridDim.x;
    unsigned char* ws = args.ws;
    unsigned* ctl = (unsigned*)(ws + WS_CTL);
    for (int u = threadIdx.x; u < (LDS_BYTES - LDSCTL_OFF) / 4; u += NTHREADS) ((LAS unsigned*)(lds + LDSCTL_OFF))[u] = 0u;
    __syncthreads();
    XcdBarrier bar = xcd_barrier_post(ctl + CW_BAR + args.li * XCD_BAR_WORDS, MISC + 8);
    const int lo = args.ph_lo, hi = args.ph_hi;
#define IN(k) (lo <= (k) && (k) < hi)
#define BOTH(k) (IN(k) && IN((k) + 1))
    const float* x = args.in[0];
    const float* g_norm_mix = args.in[4];
    const float* w_in = args.in[5];
    const float* w_out = args.in[13];
    const float* g_norm_ffn = args.in[14];
    const float* w_peer_q = args.in[15];
    float* out = args.out;
    float* mod = (float*)(ws + WS_MOD);
    bf16_t* Win_t = (bf16_t*)(ws + WS_WIN_T); bf16_t* Wo_t = (bf16_t*)(ws + WS_WO_T); bf16_t* Wq_t = (bf16_t*)(ws + WS_WQ_T);
    bf16_t* hbuf = (bf16_t*)(ws + WS_HBUF); bf16_t* mixin = (bf16_t*)(ws + WS_MIXIN);
    bf16_t* proj = (bf16_t*)(ws + WS_BIG); bf16_t* qb = (bf16_t*)(ws + WS_BIG); bf16_t* keysb = (bf16_t*)(ws + WS_KEYSB);
    bf16_t* x1b = (bf16_t*)(ws + WS_BIG + 128 * MiB);
    unsigned* maskw = (unsigned*)(ws + WS_MASK); bf16_t* wuvF = (bf16_t*)(ws + WS_WUVF);
    unsigned char* uq = ws + WS_UQ; unsigned char* vq = ws + WS_VQ; float* su = (float*)(ws + WS_SU); float* sv = (float*)(ws + WS_SV);
    unsigned char* xq = ws + WS_XQ; float* sxs = (float*)(ws + WS_SX);
    const int gw = blockIdx.x * NWAVES + wave, NGW = G * NWAVES;
    const int vcu = (G % 8 == 0) ? ((int)blockIdx.x % 8) * (G / 8) + (int)blockIdx.x / 8 : (int)blockIdx.x;

    if (IN(0)) for (int rep_ = 0; rep_ < REPS[0]; ++rep_) {
        const int lane = LANE_ID(), tid = wave * 64 + lane; (void)tid;
        for (int blk = blockIdx.x; blk < 256; blk += G) mod_block(args.in[1], args.in[2], args.in[3], mod, (LAS float*)(lds + RING_OFF), blk, tid, lane, wave);
        if (blockIdx.x == 0 && tid == 0) {
            float s1 = 0.f, s2 = 0.f;
            for (int i = 0; i < 64; ++i) { s1 += args.in[6][i] * args.in[7][i]; s2 += args.in[8][i] * args.in[9][i]; }
            *(float*)(ws + WS_LAM) = expf(s1) - expf(s2) + 0.2f;
        }
        LAS float* scr = (LAS float*)(lds + RING_OFF + wave * 16384);
        constexpr int I_IN = 16 * (NPP / 32), I_O = 16 * 32, I_Q = 16 * 32;
        for (int it = gw; it < I_IN + I_O + I_Q; it += NGW) {
            int r = it;
            if (r < I_IN) { p0_transpose_item(w_in, D, NP, NPP, Win_t, scr, r, lane); continue; } r -= I_IN;
            if (r < I_O) { p0_transpose_item(w_out, D, D, D, Wo_t, scr, r, lane); continue; } r -= I_O;
            p0_transpose_item(w_peer_q, D, D, D, Wq_t, scr, r, lane);
        }
        for (int i = blockIdx.x * NTHREADS + tid; i < 4 * 4 * 4 * 2 * 64 * 8; i += G * NTHREADS) {
            const int j = i & 7, ln = (i >> 3) & 63, s2 = (i >> 9) & 1, db = (i >> 10) & 3, eb = (i >> 12) & 3, hd = i >> 14;
            const int cc = 32 * db + 16 * s2 + 8 * (j >> 2) + 4 * (ln >> 5) + (j & 3), e = 32 * eb + (ln & 31);
            wuvF[i] = f2bf(args.in[12][((size_t)hd * 128 + cc) * 128 + e]);
        }
        for (int i = blockIdx.x * NTHREADS + tid; i < 8 * 2 * 128 * 64; i += G * NTHREADS) keysb[i] = f2bf(args.in[16][i]);
        for (int r = gw; r < 2 * 16384; r += NGW) {
            if (r < 16384) quant_table_row(args.in[17] + (size_t)r * D, uq + (size_t)r * 128, su + r, lane, false);
            else quant_table_row(args.in[18] + (size_t)(r - 16384) * D, vq + (size_t)(r - 16384) * 128, sv + (r - 16384), lane, false);
        }
        if (BOTH(0)) xcd_barrier(bar);
    }
    if (IN(1)) for (int rep_ = 0; rep_ < REPS[1]; ++rep_) {
        const int lane = LANE_ID(), tid = wave * 64 + lane; (void)tid;
        for (int m = 4 * gw; m < T; m += 4 * NGW) norm_mod_rows<false, 4, false>(x + (size_t)m * D, g_norm_mix, mod + (size_t)(m / S) * 6144, MOD_SHIFT_A, MOD_SCALE_A, hbuf + (size_t)m * D, lane, nullptr, nullptr);
        if (BOTH(1)) xcd_barrier(bar);
    }
    if (IN(2)) for (int rep_ = 0; rep_ < REPS[2]; ++rep_) {
        pg8::Gemm g{hbuf, Win_t, T, NPP, D}; pg8::StaticOrder So; So.init(T, NPP, G, (int)blockIdx.x);
        pg8::EpiBf16Plain E{proj, NPP};
        pg8::gemm_phase<pg8::EpiBf16Plain, pg8::StaticOrder, true, true>(lds + RING_OFF, g, So, E);
        if (BOTH(2)) xcd_barrier(bar);
    }
    if (IN(3)) for (int rep_ = 0; rep_ < REPS[3]; ++rep_) {
        const int lane = LANE_ID(), tid = wave * 64 + lane; (void)tid;
        const float lam = *(const float*)(ws + WS_LAM);
        for (int it = vcu; it < 1024; it += G) {
            const int b = it >> 5, h = (it >> 3) & 3, qp = it & 7;
            diff_unit(proj, mixin, args.in[19], lam, args.in[10], lds, b, h, 15 - qp, tid, lane, wave);
            diff_unit(proj, mixin, args.in[19], lam, args.in[10], lds, b, h, qp, tid, lane, wave);
        }
    }
    if (IN(4)) for (int rep_ = 0; rep_ < REPS[4]; ++rep_) {
        const int lane = LANE_ID(), tid = wave * 64 + lane; (void)tid;
        for (int it = vcu; it < 512; it += G) {
            const int b = it >> 4, up = it & 15;
#pragma unroll 1
            for (int k8 = 0; k8 < 8; ++k8) dsa_index_unit(proj, maskw, lds, b, 4 * (k8 < 4 ? 31 - up : up) + (k8 & 3), tid, lane, wave);
        }
        asm volatile("s_waitcnt vmcnt(0)" ::: "memory");
        __syncthreads();
    }
    if (IN(5)) for (int rep_ = 0; rep_ < REPS[5]; ++rep_) {
        const int lane = LANE_ID(), tid = wave * 64 + lane; (void)tid;
        for (int it = vcu; it < 512; it += G) {
            const int b = it >> 4, up = it & 15;
            dsa_attn_unit(proj, maskw, wuvF, args.in[19], args.in[11], mixin, lds, b, 31 - up, tid, lane, wave);
            dsa_attn_unit(proj, maskw, wuvF, args.in[19], args.in[11], mixin, lds, b, up, tid, lane, wave);
        }
        if (BOTH(5)) xcd_barrier(bar);
    }
    if (IN(6)) for (int rep_ = 0; rep_ < REPS[6]; ++rep_) {
        pg8::Gemm g{mixin, Wo_t, T, D, D}; pg8::StaticOrder So; So.init(T, D, G, (int)blockIdx.x);
        pg8::EpiBf16ResB E{x1b, x, mod + MOD_GATE_A};
        pg8::gemm_phase<pg8::EpiBf16ResB, pg8::StaticOrder, true, false>(lds + RING_OFF, g, So, E);
        if (BOTH(6)) xcd_barrier(bar);
    }
    if (IN(7)) for (int rep_ = 0; rep_ < REPS[7]; ++rep_) {
        const int lane = LANE_ID(), tid = wave * 64 + lane; (void)tid;
        for (int m = 4 * gw; m < T; m += 4 * NGW) norm_mod_rows<true, 4, true>(x1b + (size_t)m * D, g_norm_ffn, mod + (size_t)(m / S) * 6144, MOD_SHIFT_F, MOD_SCALE_F, hbuf + (size_t)m * D, lane, xq + (size_t)m * 1024, sxs + m);
        if (BOTH(7)) xcd_barrier(bar);
    }
    if (IN(8)) for (int rep_ = 0; rep_ < REPS[8]; ++rep_) {
        pg8::Gemm g{hbuf, Wq_t, T, D, D}; pg8::StaticOrder So; So.init(T, D, G, (int)blockIdx.x);
        pg8::EpiBf16Plain E{qb, D};
        pg8::gemm_phase<pg8::EpiBf16Plain, pg8::StaticOrder, true, true>(lds + RING_OFF, g, So, E);
        if (BOTH(8)) xcd_barrier(bar);
    }
    if (IN(9)) for (int rep_ = 0; rep_ < REPS[9]; ++rep_) {
        const int lane = LANE_ID();
        for (int base = blockIdx.x * NWAVES; base < T / 32; base += NGW)
            peer_select_wave(base + wave, qb, keysb, (unsigned short*)(ws + WS_EIDX), (float*)(ws + WS_GATE), lds + RING_OFF, wave * 64 + lane, lane);
        asm volatile("s_waitcnt vmcnt(0)" ::: "memory");
    }
    if (IN(10)) for (int rep_ = 0; rep_ < REPS[10]; ++rep_) {
        const int lane = LANE_ID();
        const unsigned short* eidx = (const unsigned short*)(ws + WS_EIDX); const float* gate = (const float*)(ws + WS_GATE);
        bf16_t* ybuf = (bf16_t*)(ws + WS_BIG);
        for (int tile = gw; tile < T / 32; tile += NGW)
            peer_gather_tile(tile, xq, sxs, eidx, gate, uq, vq, su, sv, mod, args.in[20], x1b, ybuf, out, lds + RING_OFF + wave * 16384, lds + 133120 + wave * 3584, lane);
    }
#undef IN
#undef BOTH
}
#ifndef PROBE_PREFIX_N
#define PROBE_PREFIX_N 0
#endif
constexpr int PROBE_PREFIX = PROBE_PREFIX_N;
extern "C" void kernel_launch(void* const* d_in, const int* in_sizes, int n_in, void* d_out, int out_size, void* d_ws, size_t ws_size, hipStream_t stream) {
    static int grid = 0;
    if (grid == 0) {
        if (n_in != 21 || out_size != T * D || ws_size < WS_END) { fprintf(stderr, "kernel_launch: unexpected shapes (n_in %d out %d ws %zu)\n", n_in, out_size, ws_size); grid = -1; return; }
        int dev = 0, cus = 0, per_cu = 0;
        if (hipGetDevice(&dev) != hipSuccess || hipDeviceGetAttribute(&cus, hipDeviceAttributeMultiprocessorCount, dev) != hipSuccess) { grid = -1; return; }
        if (hipFuncSetAttribute((const void*)fwd, hipFuncAttributeMaxDynamicSharedMemorySize, LDS_BYTES) != hipSuccess) { fprintf(stderr, "kernel_launch: hipFuncSetAttribute failed\n"); grid = -1; return; }
        if (hipOccupancyMaxActiveBlocksPerMultiprocessor(&per_cu, (const void*)fwd, NTHREADS, LDS_BYTES) != hipSuccess || per_cu < 1)
            fprintf(stderr, "kernel_launch: occupancy query reports %d workgroups per CU\n", per_cu);
        (void)hipGetLastError();
        grid = cus;
        if (grid != 256) fprintf(stderr, "kernel_launch: %d CUs (expected 256)\n", grid);
    }
    if (grid < 0) return;
    float* out = (float*)d_out;
    unsigned char* ws = (unsigned char*)d_ws;
    (void)hipMemsetAsync(ws + WS_CTL, 0, CTL_ZERO_BYTES, stream);
    Args a{};
    for (int i = 0; i < 21; ++i) a.in[i] = (const float*)d_in[i];
    a.out = out; a.ws = ws;

    if (PROBE_PREFIX > 0) {
        a.ph_lo = 0; a.ph_hi = PROBE_PREFIX; a.li = 1;
        hipLaunchKernelGGL(fwd, dim3(grid), dim3(NTHREADS), LDS_BYTES, stream, a);
    }
    a.ph_lo = 0; a.ph_hi = 11; a.li = 0;
    hipLaunchKernelGGL(fwd, dim3(grid), dim3(NTHREADS), LDS_BYTES, stream, a);
}
```

```cpp
#include <hip/hip_runtime.h>
#include <stdint.h>
#include <stdio.h>

typedef unsigned short bf16_t;
#define LAS __attribute__((address_space(3)))
#define GAS __attribute__((address_space(1)))

constexpr int D = 1024, NB = 32, S = 2048, T = NB * S;
constexpr int NP = 2760, NPP = 2816;
constexpr int C_DQ = 0, C_DK = 512, C_DV = 1024, C_SQ = 1536, C_SKV = 2048, C_IQ = 2176, C_IK = 2688, C_IW = 2752;
constexpr int MOD_SHIFT_A = 0, MOD_SCALE_A = 1024, MOD_GATE_A = 2048, MOD_SHIFT_F = 3072, MOD_SCALE_F = 4096, MOD_GATE_F = 5120;
constexpr float EPS = 1e-6f;
constexpr int NWAVES = 8, NTHREADS = 512;

__device__ __forceinline__ float bf2f(bf16_t v) { return __uint_as_float(((unsigned)v) << 16); }
__device__ __forceinline__ bf16_t f2bf(float f) { unsigned u = __float_as_uint(f); u += 0x7fffu + ((u >> 16) & 1u); return (bf16_t)(u >> 16); }
__device__ __forceinline__ unsigned pk2(float lo, float hi) { return (unsigned)f2bf(lo) | ((unsigned)f2bf(hi) << 16); }

__device__ __forceinline__ int rel_bucket(int n) {
    if (n < 16) return n < 0 ? 0 : n;
    int b = 16;
    b += (n >= 19); b += (n >= 21); b += (n >= 24); b += (n >= 27); b += (n >= 31); b += (n >= 35); b += (n >= 40); b += (n >= 46);
    b += (n >= 52); b += (n >= 59); b += (n >= 67); b += (n >= 77); b += (n >= 87); b += (n >= 99); b += (n >= 113);
    return b;
}

__device__ __forceinline__ float wave_sum(float v) {
#pragma unroll
    for (int o = 32; o >= 1; o >>= 1) v += __shfl_xor(v, o);
    return v;
}
__device__ __forceinline__ float wave_max(float v) {
#pragma unroll
    for (int o = 32; o >= 1; o >>= 1) v = fmaxf(v, __shfl_xor(v, o));
    return v;
}
__device__ __forceinline__ float block_sum(float v, float* red) {
    v = wave_sum(v);
    __syncthreads();
    if ((threadIdx.x & 63) == 0) red[threadIdx.x >> 6] = v;
    __syncthreads();
    return red[0] + red[1] + red[2] + red[3];
}
__device__ __forceinline__ float block_max(float v, float* red) {
    v = wave_max(v);
    __syncthreads();
    if ((threadIdx.x & 63) == 0) red[threadIdx.x >> 6] = v;
    __syncthreads();
    return fmaxf(fmaxf(red[0], red[1]), fmaxf(red[2], red[3]));
}
__device__ __forceinline__ int block_sum_i(int v, int* red) {
#pragma unroll
    for (int o = 32; o >= 1; o >>= 1) v += __shfl_xor(v, o);
    __syncthreads();
    if ((threadIdx.x & 63) == 0) red[threadIdx.x >> 6] = v;
    __syncthreads();
    return red[0] + red[1] + red[2] + red[3];
}

namespace pg8 {
#define PG8_LAS __attribute__((address_space(3)))
typedef unsigned short bf16_t;
typedef short bf16x8 __attribute__((ext_vector_type(8)));
typedef float f32x4 __attribute__((ext_vector_type(4)));
typedef unsigned u32x4 __attribute__((ext_vector_type(4)));
constexpr int BM = 256, BK = 64, HALF = 128, HTB = HALF * BK * 2  , STAGE_BYTES = 8 * HTB, NXCD = 8, WGM = 8;

__host__ __device__ __forceinline__ int lds_byte(int r, int c) { const int st = (r >> 4) * 2 + (c >> 5), rr = r & 15, cc = c & 31, ob = rr * 64 + cc * 2; return st * 1024 + (ob ^ (((ob >> 9) & 1) << 5)); }
__host__ __device__ __forceinline__ void stage_rc(int b, int& R, int& C) { const int st = b / 1024, sb = b % 1024, swz = sb ^ (((sb >> 9) & 1) << 5); R = (st >> 1) * 16 + swz / 64; C = (st & 1) * 32 + (swz % 64) / 2; }
__host__ __device__ __forceinline__ int perm32(int rho) { const int n = rho >> 4, i = rho & 15; return 8 * (i >> 2) + 4 * n + (i & 3); }

struct Unit { int pm, pn; };
struct Gemm { const bf16_t* A; const bf16_t* Bt; int M, N, K; };

struct StaticOrder {
    int nM, nN, nwg, G, c;
    __host__ __device__ void init(int M, int N, int G_, int c_) { nM = M / BM; nN = N / BM; nwg = nM * nN; G = G_; c = c_; }
    __host__ __device__ bool next(int i, Unit& u) const {
        const long L = (long)i * G + c; if (L >= nwg) return false;
        int wgid = (int)L; { const int q = nwg / NXCD, r = nwg % NXCD, xcd = wgid % NXCD, off = wgid / NXCD; wgid = (xcd < r ? xcd * (q + 1) : r * (q + 1) + (xcd - r) * q) + off; }
        const int nig = WGM * nN, gid = wgid / nig, fm = gid * WGM, gsz = (nM - fm) < WGM ? (nM - fm) : WGM;
        u.pm = fm + ((wgid % nig) % gsz); u.pn = (wgid % nig) / gsz; return true;
    }
    __device__ __forceinline__ void a_ready(const Unit&) const {}
    __device__ __forceinline__ void done(const Unit&) const {}
};
__device__ __forceinline__ unsigned cvt_pk_bf16(float lo, float hi) { unsigned r; asm volatile("v_cvt_pk_bf16_f32 %0, %1, %2" : "=v"(r) : "v"(lo), "v"(hi)); return r; }
typedef float f32x2 __attribute__((ext_vector_type(2)));
struct EpiBf16Plain {
    static constexpr bool PERM = true, AFTER_DRAIN = false;
    bf16_t* O; int ldc;
    __device__ __forceinline__ void operator()(const f32x4 (&acc)[2][2][4][2], const Unit& u, int wr, int wc, int fr, int fq) const {
        const int row0 = u.pm * BM + wr * 64 + fr, col0 = u.pn * BM + wc * 32 + 8 * fq;
#pragma unroll
        for (int ai = 0; ai < 2; ++ai)
#pragma unroll
            for (int m = 0; m < 4; ++m) { bf16_t* rowp = O + (size_t)(row0 + ai * HALF + m * 16) * ldc + col0;
#pragma unroll
                for (int bj = 0; bj < 2; ++bj) { const f32x4 v0 = acc[ai][bj][m][0], v1 = acc[ai][bj][m][1];
                    u32x4 w; w.x = cvt_pk_bf16(v0[0], v0[1]); w.y = cvt_pk_bf16(v0[2], v0[3]); w.z = cvt_pk_bf16(v1[0], v1[1]); w.w = cvt_pk_bf16(v1[2], v1[3]);
                    *(u32x4*)(rowp + bj * HALF) = w; } }
    }
};
struct EpiF32Res {
    static constexpr bool PERM = false, AFTER_DRAIN = false;
    float* C; const float* res; const float* gate;
    __device__ __forceinline__ void operator()(const f32x4 (&acc)[2][2][4][2], const Unit& u, int wr, int wc, int fr, int fq) const {
        const int row0 = u.pm * BM + wr * 64 + fr, col0 = u.pn * BM + wc * 32 + 4 * fq;
        f32x4 gv[2][2];
#pragma unroll
        for (int bj = 0; bj < 2; ++bj)
#pragma unroll
            for (int n = 0; n < 2; ++n) gv[bj][n] = res ? *(const f32x4*)(gate + (size_t)(u.pm >> 3) * 6144 + col0 + bj * HALF + n * 16) : (f32x4){1.f, 1.f, 1.f, 1.f};
#pragma unroll
        for (int ai = 0; ai < 2; ++ai)
#pragma unroll
            for (int m = 0; m < 4; ++m) { const size_t off = (size_t)(row0 + ai * HALF + m * 16) * 1024 + col0;
#pragma unroll
                for (int bj = 0; bj < 2; ++bj)
#pragma unroll
                    for (int n = 0; n < 2; ++n) { f32x4 o = acc[ai][bj][m][n] * gv[bj][n];
                        if (res) o = o + *(const f32x4*)(res + off + bj * HALF + n * 16);
                        *(f32x4*)(C + off + bj * HALF + n * 16) = o; } }
    }
};

struct EpiBf16Res {
    static constexpr bool PERM = true, AFTER_DRAIN = false;
    bf16_t* O; const float* res; const float* gate;
    __device__ __forceinline__ void operator()(const f32x4 (&acc)[2][2][4][2], const Unit& u, int wr, int wc, int fr, int fq) const {
        const int row0 = u.pm * BM + wr * 64 + fr, col0 = u.pn * BM + wc * 32 + 8 * fq;
        f32x4 gv[2][2];
#pragma unroll
        for (int bj = 0; bj < 2; ++bj)
#pragma unroll
            for (int n = 0; n < 2; ++n) gv[bj][n] = *(const f32x4*)(gate + (size_t)(u.pm >> 3) * 6144 + col0 + bj * HALF + 4 * n);
#pragma unroll
        for (int ai = 0; ai < 2; ++ai)
#pragma unroll
            for (int m = 0; m < 4; ++m) { const size_t off = (size_t)(row0 + ai * HALF + m * 16) * 1024 + col0;
#pragma unroll
                for (int bj = 0; bj < 2; ++bj) { const f32x4 r0 = *(const f32x4*)(res + off + bj * HALF), r1 = *(const f32x4*)(res + off + bj * HALF + 4);
                    const f32x4 v0 = r0 + acc[ai][bj][m][0] * gv[bj][0], v1 = r1 + acc[ai][bj][m][1] * gv[bj][1];
                    u32x4 w; w.x = cvt_pk_bf16(v0[0], v0[1]); w.y = cvt_pk_bf16(v0[2], v0[3]); w.z = cvt_pk_bf16(v1[0], v1[1]); w.w = cvt_pk_bf16(v1[2], v1[3]);
                    *(u32x4*)(O + off + bj * HALF) = w; } }
    }
};

struct EpiBf16ResB {
    static constexpr bool PERM = true, AFTER_DRAIN = false;
    bf16_t* O; const float* res; const float* gate;
    __device__ __forceinline__ void operator()(const f32x4 (&acc)[2][2][4][2], const Unit& u, int wr, int wc, int fr, int fq) const {
        const int row0 = u.pm * BM + wr * 64 + fr, col0 = u.pn * BM + wc * 32 + 8 * fq;
        f32x4 gv[2][2];
#pragma unroll
        for (int bj = 0; bj < 2; ++bj)
#pragma unroll
            for (int n = 0; n < 2; ++n) gv[bj][n] = *(const f32x4*)(gate + (size_t)(u.pm >> 3) * 6144 + col0 + bj * HALF + 4 * n);
#pragma unroll
        for (int ai = 0; ai < 2; ++ai) {
            f32x4 rr[4][2][2];
#pragma unroll
            for (int m = 0; m < 4; ++m) { const size_t off = (size_t)(row0 + ai * HALF + m * 16) * 1024 + col0;
#pragma unroll
                for (int bj = 0; bj < 2; ++bj) { rr[m][bj][0] = __builtin_nontemporal_load((const f32x4*)(res + off + bj * HALF)); rr[m][bj][1] = __builtin_nontemporal_load((const f32x4*)(res + off + bj * HALF + 4)); } }
            __builtin_amdgcn_sched_barrier(0);
#pragma unroll
            for (int m = 0; m < 4; ++m) { const size_t off = (size_t)(row0 + ai * HALF + m * 16) * 1024 + col0;
#pragma unroll
                for (int bj = 0; bj < 2; ++bj) { const f32x4 v0 = rr[m][bj][0] + acc[ai][bj][m][0] * gv[bj][0], v1 = rr[m][bj][1] + acc[ai][bj][m][1] * gv[bj][1];
                    u32x4 w; w.x = cvt_pk_bf16(v0[0], v0[1]); w.y = cvt_pk_bf16(v0[2], v0[3]); w.z = cvt_pk_bf16(v1[0], v1[1]); w.w = cvt_pk_bf16(v1[2], v1[3]);
                    *(u32x4*)(O + off + bj * HALF) = w; } }
            __builtin_amdgcn_sched_barrier(0);
        }
    }
};

template <class Epi, class Sched, bool ALIGN_EPI = false, bool SP2 = false>
__device__ __forceinline__ void gemm_phase(PG8_LAS unsigned char* lds, const Gemm g, const Sched& S, const Epi& E) {
    const int tid = threadIdx.x, wid = __builtin_amdgcn_readfirstlane(tid >> 6), lane = tid & 63, wr = wid >> 2, wc = wid & 3, fr = lane & 15, fq = lane >> 4;
    const int K = g.K, nt = K / BK;
    unsigned voffA[2], voffB[2];
#pragma unroll
    for (int i = 0; i < 2; ++i) { int R, C; stage_rc(tid * 16 + i * 8192, R, C); const int Rb = Epi::PERM ? ((R & ~31) + perm32(R & 31)) : R;
        voffA[i] = (unsigned)(R * K + C) * 2u; voffB[i] = (unsigned)(Rb * K + C) * 2u; }
    const size_t kstep = (size_t)(BK * 2);
    const size_t hstep = (size_t)HALF * K * 2;
    const size_t tstep = 2 * hstep;
    const unsigned ldsw = (unsigned)wid * 1024u;
    const int aoff = lds_byte(wr * 64 + fr, fq * 8), boff = lds_byte(wc * 32 + fr, fq * 8);
#define PG8_SA(b, h) (((b) * 2 + (h)) * HTB)
#define PG8_SB(b, h) ((4 + (b) * 2 + (h)) * HTB)
#define PG8_STAGE(bufoff, gbase, voff) do { _Pragma("unroll") for (int _i = 0; _i < 2; ++_i) \
        __builtin_amdgcn_global_load_lds((const unsigned*)((const char*)(gbase) + (voff)[_i]), (PG8_LAS unsigned*)(lds + (bufoff) + ldsw + _i * 8192), 16, 0, 0); } while (0)
#define PG8_LDA(dst, b, h) do { _Pragma("unroll") for (int m = 0; m < 4; ++m) _Pragma("unroll") for (int k = 0; k < 2; ++k) dst[m][k] = *(const PG8_LAS bf16x8*)(lds + PG8_SA(b, h) + aoff + m * 2048 + k * 1024); } while (0)
#define PG8_LDB(dst, b, h) do { _Pragma("unroll") for (int n = 0; n < 2; ++n) _Pragma("unroll") for (int k = 0; k < 2; ++k) dst[n][k] = *(const PG8_LAS bf16x8*)(lds + PG8_SB(b, h) + boff + n * 2048 + k * 1024); } while (0)
#define PG8_MMA(ai, bj, At, Bt) do { __builtin_amdgcn_s_setprio(1); _Pragma("unroll") for (int m = 0; m < 4; ++m) _Pragma("unroll") for (int n = 0; n < 2; ++n) _Pragma("unroll") for (int k = 0; k < 2; ++k) \
        acc[ai][bj][m][n] = __builtin_amdgcn_mfma_f32_16x16x32_bf16(Bt[n][k], At[m][k], acc[ai][bj][m][n], 0, 0, 0); __builtin_amdgcn_s_setprio(0); } while (0)
#define PG8_WAIT_V(n) asm volatile("s_waitcnt vmcnt(" #n ")" ::: "memory")
#define PG8_WAIT_L(n) asm volatile("s_waitcnt lgkmcnt(" #n ")" ::: "memory")
#define PG8_BAR __builtin_amdgcn_s_barrier()
#define PG8_SCHED __builtin_amdgcn_sched_barrier(0)
    Unit cur, nxt; int ui = 0;
    if (!S.next(0, cur)) return;
    f32x4 acc[2][2][4][2];
#pragma unroll
    for (int a = 0; a < 2; ++a)
#pragma unroll
        for (int b = 0; b < 2; ++b)
#pragma unroll
            for (int m = 0; m < 4; ++m)
#pragma unroll
                for (int n = 0; n < 2; ++n) acc[a][b][m][n] = (f32x4){0.f, 0.f, 0.f, 0.f};
    bf16x8 At[4][2], B0[2][2], B1[2][2];
    const char* cA = (const char*)g.A + (size_t)cur.pm * tstep; const char* cB = (const char*)g.Bt + (size_t)cur.pn * tstep;
    S.a_ready(cur);
    if constexpr (SP2) {
        PG8_STAGE(PG8_SB(0, 0), cB, voffB); PG8_STAGE(PG8_SB(0, 1), cB + hstep, voffB); PG8_STAGE(PG8_SA(0, 0), cA, voffA); PG8_STAGE(PG8_SA(0, 1), cA + hstep, voffA);
        if (wr == 1) PG8_BAR;
        PG8_WAIT_V(2); PG8_BAR;
        PG8_STAGE(PG8_SB(1, 0), cB + kstep, voffB); PG8_STAGE(PG8_SA(1, 0), cA + kstep, voffA); PG8_STAGE(PG8_SB(1, 1), cB + hstep + kstep, voffB);
        PG8_WAIT_V(6); PG8_BAR;
    } else {
        PG8_STAGE(PG8_SB(0, 0), cB, voffB); PG8_STAGE(PG8_SA(0, 0), cA, voffA); PG8_STAGE(PG8_SB(0, 1), cB + hstep, voffB); PG8_STAGE(PG8_SA(0, 1), cA + hstep, voffA);
        if (wr == 1) PG8_BAR;
        PG8_WAIT_V(4); PG8_BAR;
        PG8_STAGE(PG8_SB(1, 0), cB + kstep, voffB); PG8_STAGE(PG8_SA(1, 0), cA + kstep, voffA); PG8_STAGE(PG8_SB(1, 1), cB + hstep + kstep, voffB);
        PG8_WAIT_V(6); PG8_BAR;
    }
    for (;;) {
        const bool has_next = S.next(ui + 1, nxt);
        const char* nA = has_next ? (const char*)g.A + (size_t)nxt.pm * tstep : cA; const char* nB = has_next ? (const char*)g.Bt + (size_t)nxt.pn * tstep : cB;
        for (int t = 0; t < nt; t += 2) {
            const bool last = (t == nt - 2);
            const char* a1 = cA + (size_t)(t + 1) * kstep;
            const char* a2 = last ? nA : cA + (size_t)(t + 2) * kstep; const char* b2 = last ? nB : cB + (size_t)(t + 2) * kstep;
            const char* a3 = a2 + kstep; const char* b3 = b2 + kstep;
            if (last && has_next) S.a_ready(nxt);
            if constexpr (SP2) {
            PG8_LDB(B0, 0, 0); PG8_LDB(B1, 0, 1); PG8_SCHED; PG8_LDA(At, 0, 0); PG8_STAGE(PG8_SA(1, 1), a1 + hstep, voffA);
            PG8_WAIT_V(8); PG8_WAIT_L(0); PG8_BAR; PG8_MMA(0, 0, At, B0); PG8_MMA(0, 1, At, B1); PG8_BAR; PG8_SCHED;
            PG8_LDA(At, 0, 1); PG8_STAGE(PG8_SB(0, 0), b2, voffB); PG8_STAGE(PG8_SB(0, 1), b2 + hstep, voffB); PG8_STAGE(PG8_SA(0, 0), a2, voffA);
            PG8_WAIT_V(8); PG8_WAIT_L(0); PG8_BAR; PG8_MMA(1, 0, At, B0); PG8_MMA(1, 1, At, B1); PG8_BAR; PG8_SCHED;
            PG8_LDB(B0, 1, 0); PG8_LDB(B1, 1, 1); PG8_SCHED; PG8_LDA(At, 1, 0); PG8_STAGE(PG8_SA(0, 1), a2 + hstep, voffA);
            PG8_WAIT_V(8); PG8_WAIT_L(0); PG8_BAR; PG8_MMA(0, 0, At, B0); PG8_MMA(0, 1, At, B1); PG8_BAR; PG8_SCHED;
            PG8_LDA(At, 1, 1); PG8_STAGE(PG8_SB(1, 0), b3, voffB); PG8_STAGE(PG8_SB(1, 1), b3 + hstep, voffB); PG8_STAGE(PG8_SA(1, 0), a3, voffA);
            PG8_WAIT_V(8); PG8_WAIT_L(0); PG8_BAR; PG8_MMA(1, 0, At, B0); PG8_MMA(1, 1, At, B1); PG8_BAR; PG8_SCHED;
            } else {
            PG8_LDB(B0, 0, 0); PG8_SCHED; PG8_LDA(At, 0, 0); PG8_STAGE(PG8_SA(1, 1), a1 + hstep, voffA);
            PG8_WAIT_L(8); PG8_BAR; PG8_WAIT_L(0); PG8_MMA(0, 0, At, B0); PG8_BAR; PG8_SCHED;
            PG8_LDB(B1, 0, 1); PG8_STAGE(PG8_SB(0, 0), b2, voffB);
            PG8_BAR; PG8_WAIT_L(0); PG8_MMA(0, 1, At, B1); PG8_BAR;
            PG8_LDA(At, 0, 1); PG8_STAGE(PG8_SA(0, 0), a2, voffA);
            PG8_BAR; PG8_WAIT_L(0); PG8_MMA(1, 0, At, B0); PG8_BAR; PG8_SCHED;
            PG8_STAGE(PG8_SB(0, 1), b2 + hstep, voffB);
            PG8_WAIT_V(6); PG8_BAR; PG8_MMA(1, 1, At, B1); PG8_BAR;
            PG8_LDB(B0, 1, 0); PG8_SCHED; PG8_LDA(At, 1, 0); PG8_STAGE(PG8_SA(0, 1), a2 + hstep, voffA);
            PG8_WAIT_L(8); PG8_BAR; PG8_WAIT_L(0); PG8_MMA(0, 0, At, B0); PG8_BAR; PG8_SCHED;
            PG8_LDB(B1, 1, 1); PG8_STAGE(PG8_SB(1, 0), b3, voffB);
            PG8_BAR; PG8_WAIT_L(0); PG8_MMA(0, 1, At, B1); PG8_BAR;
            PG8_LDA(At, 1, 1); PG8_STAGE(PG8_SA(1, 0), a3, voffA);
            PG8_BAR; PG8_WAIT_L(0); PG8_MMA(1, 0, At, B0); PG8_BAR; PG8_SCHED;
            PG8_STAGE(PG8_SB(1, 1), b3 + hstep, voffB);
            PG8_WAIT_V(6); PG8_BAR; PG8_MMA(1, 1, At, B1); PG8_BAR;
            }
        }
        if constexpr (ALIGN_EPI) { if (wr == 0) PG8_BAR; }
        if constexpr (!Epi::AFTER_DRAIN) { E(acc, cur, wr, wc, fr, fq); S.done(cur); }
        if (!has_next) break;
#pragma unroll
        for (int a = 0; a < 2; ++a)
#pragma unroll
            for (int b = 0; b < 2; ++b)
#pragma unroll
                for (int m = 0; m < 4; ++m)
#pragma unroll
                    for (int n = 0; n < 2; ++n) acc[a][b][m][n] = (f32x4){0.f, 0.f, 0.f, 0.f};
        cur = nxt; cA = nA; cB = nB; ++ui;
        if constexpr (ALIGN_EPI) { if (wr == 1) PG8_BAR; }
    }
    PG8_WAIT_V(0);
    if constexpr (!ALIGN_EPI) { if (wr == 0) PG8_BAR; }
    PG8_BAR;
    if constexpr (Epi::AFTER_DRAIN) { E.fused(acc, cur, wr, wc, fr, fq, lds, wid, lane); S.done(cur); }
#undef PG8_SA
#undef PG8_SB
#undef PG8_STAGE
#undef PG8_LDA
#undef PG8_LDB
#undef PG8_MMA
#undef PG8_WAIT_V
#undef PG8_WAIT_L
#undef PG8_BAR
#undef PG8_SCHED
}
}
#define XB_TMO      128
#define XB_XCNT(j)  (256  + 64 * (j))
#define XB_XSUB(j)  (1280 + 64 * (j))
#define XB_XGEN(j)  (2304 + 64 * (j))
#define XB_TOP      3328
#define XB_TOPGEN   3392
#define XCD_BAR_WORDS 3456
#define XB_SPIN_CAP (1u << 18)

__device__ __forceinline__ unsigned xb_ld(unsigned* p)              { return __hip_atomic_load(p, __ATOMIC_RELAXED, __HIP_MEMORY_SCOPE_AGENT); }
__device__ __forceinline__ unsigned xb_add(unsigned* p, unsigned v) { return __hip_atomic_fetch_add(p, v, __ATOMIC_RELAXED, __HIP_MEMORY_SCOPE_AGENT); }
__device__ __forceinline__ unsigned xb_xcc_id() { return (unsigned)__builtin_amdgcn_s_getreg((3 << 11) | 20) & 0xFu; }
#define XB_SPIN(cond, bar) do { unsigned _sp = 0; while (cond) { __builtin_amdgcn_s_sleep(1); \
    if ((++_sp & 255u) == 0u) { if (xb_ld(&(bar)[XB_TMO])) break; if (_sp > XB_SPIN_CAP) { atomicAdd(&(bar)[XB_TMO], 1u); break; } } } } while (0)

struct XcdBarrier {
    unsigned* bar; unsigned x;
    volatile LAS unsigned* st;
};

__device__ __forceinline__ XcdBarrier xcd_barrier_post(unsigned* bar, volatile LAS unsigned* st) {
    XcdBarrier b; b.bar = bar; b.x = xb_xcc_id(); b.st = st;
    if (threadIdx.x == 0) (void)xb_add(&bar[XB_XCNT(b.x)], 1u);
    return b;
}
__device__ __forceinline__ void xcd_barrier_complete(unsigned* bar, unsigned x, unsigned& nloc, unsigned& nx) {
    const unsigned G = gridDim.x * gridDim.y * gridDim.z;
    unsigned sum, cnt, mine, sp = 0u;
    for (;;) {
        sum = 0u; cnt = 0u; mine = 0u;
#pragma unroll
        for (unsigned j = 0; j < 16; ++j) { const unsigned c = xb_ld(&bar[XB_XCNT(j)]); sum += c; cnt += (c > 0u) ? 1u : 0u; mine = (j == x) ? c : mine; }
        if (sum == G) break;
        __builtin_amdgcn_s_sleep(1);
        if ((++sp & 255u) == 0u) { if (xb_ld(&bar[XB_TMO])) break; if (sp > XB_SPIN_CAP) { atomicAdd(&bar[XB_TMO], 1u); break; } }
    }
    nloc = mine > 0u ? mine : 1u; nx = cnt > 0u ? cnt : 1u;
}

__device__ __forceinline__ void xcd_barrier(const XcdBarrier& b) {
    asm volatile("s_waitcnt vmcnt(0)" ::: "memory");
    __syncthreads();
    if (threadIdx.x == 0) {
        unsigned* bar = b.bar;
        __builtin_amdgcn_s_waitcnt(0);
        unsigned nloc = b.st[0], nx = b.st[1];
        if (nloc == 0u) { xcd_barrier_complete(bar, b.x, nloc, nx); b.st[0] = nloc; b.st[1] = nx; }
        const unsigned old = xb_add(&bar[XB_XSUB(b.x)], 1u);
        const unsigned gen = old / nloc;
        if (old + 1u == (gen + 1u) * nloc) {
            __builtin_amdgcn_fence(__ATOMIC_RELEASE, "agent");
            asm volatile("s_waitcnt vmcnt(0)" ::: "memory");
            const unsigned og = xb_add(&bar[XB_TOP], 1u);
            const unsigned tg = og / nx;
            if (og + 1u == (tg + 1u) * nx) xb_add(&bar[XB_TOPGEN], 1u);
            else XB_SPIN(xb_ld(&bar[XB_TOPGEN]) == tg, bar);
            __builtin_amdgcn_fence(__ATOMIC_ACQUIRE, "agent");
            xb_add(&bar[XB_XGEN(b.x)], 1u);
            asm volatile("s_waitcnt vmcnt(0)" ::: "memory");
        } else {
            XB_SPIN(xb_ld(&bar[XB_XGEN(b.x)]) == gen, bar);
            __builtin_amdgcn_fence(__ATOMIC_ACQUIRE, "agent");
            asm volatile("s_waitcnt vmcnt(0)" ::: "memory");
        }
    }
    __syncthreads();
}

typedef short bf16x8_t __attribute__((ext_vector_type(8)));
typedef unsigned u32x4_t __attribute__((ext_vector_type(4)));
typedef unsigned u32x2_t __attribute__((ext_vector_type(2)));
typedef short s16x4_t __attribute__((ext_vector_type(4)));
typedef float f32x16_t __attribute__((ext_vector_type(16)));
typedef float f32x4_t __attribute__((ext_vector_type(4)));
typedef float f32x2_t __attribute__((ext_vector_type(2)));
typedef __bf16 bf16x2_t __attribute__((ext_vector_type(2)));
#define MFMA32(a, b, c) __builtin_amdgcn_mfma_f32_32x32x16_bf16((a), (b), (c), 0, 0, 0)
constexpr float LOG2E = 1.4426950408889634f;

__device__ __forceinline__ float vmax2(float a, float b) { float r; asm("v_max_f32 %0, %1, %2" : "=v"(r) : "v"(a), "v"(b)); return r; }
__device__ __forceinline__ float vmax3(float a, float b, float c) { float r; asm("v_max3_f32 %0, %1, %2, %3" : "=v"(r) : "v"(a), "v"(b), "v"(c)); return r; }
__device__ __forceinline__ int crow(int r, int hi) { return (r & 3) + 8 * (r >> 2) + 4 * hi; }
__device__ __forceinline__ unsigned cvtpk(float lo, float hi) { f32x2_t v = {lo, hi}; bf16x2_t b = __builtin_convertvector(v, bf16x2_t); return __builtin_bit_cast(unsigned, b); }
__device__ __forceinline__ s16x4_t vtr(const LAS unsigned char* p) { return __builtin_bit_cast(s16x4_t, __builtin_amdgcn_ds_read_tr16_b64_v4i16((LAS s16x4_t*)p)); }
__device__ __forceinline__ float xhalf_max(float m) { auto rr = __builtin_amdgcn_permlane32_swap(__float_as_uint(m), __float_as_uint(m), false, false); return fmaxf(__uint_as_float(rr[0]), __uint_as_float(rr[1])); }
__device__ __forceinline__ float xhalf_sum(float m) { auto rr = __builtin_amdgcn_permlane32_swap(__float_as_uint(m), __float_as_uint(m), false, false); return __uint_as_float(rr[0]) + __uint_as_float(rr[1]); }
__device__ __forceinline__ bf16x8_t pack8(const f32x16_t& p, int s) {
    u32x4_t u; u.x = cvtpk(p[8 * s + 0], p[8 * s + 1]); u.y = cvtpk(p[8 * s + 2], p[8 * s + 3]); u.z = cvtpk(p[8 * s + 4], p[8 * s + 5]); u.w = cvtpk(p[8 * s + 6], p[8 * s + 7]);
    return __builtin_bit_cast(bf16x8_t, u);
}

__device__ __forceinline__ void glds16(const void* sbase, unsigned voff, unsigned lds_base) {
    unsigned sv; asm volatile("s_mov_b32 %0, m0\n\ts_mov_b32 m0, %3\n\ts_nop 0\n\tglobal_load_lds_dwordx4 %1, %2\n\ts_mov_b32 m0, %0" : "=&s"(sv) : "v"(voff), "s"(sbase), "s"(lds_base) : "memory"); }
#define ATT_WAIT_BAR(N) asm volatile("s_waitcnt vmcnt(" #N ") lgkmcnt(0)\n\ts_barrier" ::: "memory")
constexpr int DA_SLOT = 32768, DA_BIAS = 133120, DA_LDS = 133120 + 1024;
__device__ __forceinline__ void diff_unit(const bf16_t* __restrict__ proj, bf16_t* __restrict__ mixin, const float* __restrict__ rel_bias, const float lam, const float* __restrict__ g_subln,
                                          LAS unsigned char* lds, int b, int h, int qt, int tid, int lane, int wave) {
    const int rg = wave >> 1, map = wave & 1, r32 = lane & 31, hh = lane >> 5;
    const int t0 = 128 * qt + 32 * rg;
    const int ntb = 2 * qt + 2;
    const int ntw = (t0 + 31) / 64 + 1;
    const size_t rowbase = (size_t)b * S;
    LAS float* biasT = (LAS float*)(lds + DA_BIAS);
    if (tid < 256) biasT[tid] = rel_bias[rel_bucket(tid) * 8 + h] * LOG2E;
    const float c31 = rel_bias[31 * 8 + h] * LOG2E;
    bf16x8_t qf[4];
    { const bf16_t* qrow = proj + (rowbase + t0 + r32) * NPP + C_DQ + h * 128 + map * 64 + 8 * hh;
#pragma unroll
      for (int ks = 0; ks < 4; ++ks) qf[ks] = *(const bf16x8_t*)(qrow + 16 * ks); }
    unsigned ko0, ko1, vo0, vo1;
    { const int pa = wave, pb = wave + 8;
      const int ra = 4 * pa + (lane >> 4), rb = 4 * pb + (lane >> 4), pc = lane & 15;
      ko0 = (unsigned)(ra * NPP + C_DK + h * 128 + 8 * (pc ^ (ra & 15))) * 2u;
      ko1 = (unsigned)(rb * NPP + C_DK + h * 128 + 8 * (pc ^ (rb & 15))) * 2u;
      const int ka = 16 * (pa & 3) + (lane >> 2), kb2 = 16 * (pb & 3) + (lane >> 2), cc = lane & 3;
      vo0 = (unsigned)(ka * NPP + C_DV + h * 128 + 8 * (4 * (pa >> 2) + cc)) * 2u;
      vo1 = (unsigned)(kb2 * NPP + C_DV + h * 128 + 8 * (4 * (pb >> 2) + cc)) * 2u; }
    const bf16_t* pbase = proj + rowbase * NPP;
    const unsigned lds0 = (unsigned)(size_t)lds;
    const unsigned dsta = (unsigned)__builtin_amdgcn_readfirstlane((int)(lds0 + wave * 1024)), dstb = dsta + 8192;
#define DA_DMA(j) do { const bf16_t* sb_ = pbase + (size_t)(64 * (j)) * NPP; const unsigned sl_ = (unsigned)(((j) & 3) * DA_SLOT); \
        glds16(sb_, ko0, dsta + sl_); glds16(sb_, ko1, dstb + sl_); glds16(sb_, vo0, dsta + sl_ + 16384); glds16(sb_, vo1, dstb + sl_ + 16384); } while (0)
    DA_DMA(0);
    if (ntb > 1) { DA_DMA(1); ATT_WAIT_BAR(4); } else ATT_WAIT_BAR(0);
    f32x16_t O[4];
#pragma unroll
    for (int i = 0; i < 4; ++i)
#pragma unroll
        for (int r = 0; r < 16; ++r) O[i][r] = 0.f;
    float m = -INFINITY, l = 0.f;
    const int t = t0 + r32;
    const float SC = 0.125f * LOG2E;
    const int i16 = lane & 15, tq = i16 >> 2, tp = i16 & 3, g1 = (lane >> 4) & 1;
    const unsigned vrd = (4 * hh + tq) * 64 + g1 * 32 + tp * 8;
    const unsigned krd = r32 * 256;
    bf16x8_t pb[2][2];
#define DA_QKSM(j) do { \
        const LAS unsigned char* kb = lds + (j & 3) * DA_SLOT; \
        f32x16_t s0, s1; \
        _Pragma("unroll") \
        for (int r = 0; r < 16; ++r) { s0[r] = 0.f; s1[r] = 0.f; } \
        _Pragma("unroll") \
        for (int ks = 0; ks < 4; ++ks) { \
            const int chunk = map * 8 + 2 * ks + hh; \
            const unsigned co = (unsigned)((chunk ^ (r32 & 15)) * 16); \
            const bf16x8_t a0 = *(const LAS bf16x8_t*)(kb + krd + co), a1 = *(const LAS bf16x8_t*)(kb + krd + 32 * 256 + co); \
            s0 = MFMA32(a0, qf[ks], s0); s1 = MFMA32(a1, qf[ks], s1); \
        } \
        const int kbase = 64 * j + 4 * hh; \
        const bool nearb = (t0 - (64 * j + 63)) < 113; \
        const bool diag = (64 * j + 63) > t0; \
        float alpha, ps = 0.f; \
        if (nearb) { \
        _Pragma("unroll") \
            for (int r = 0; r < 16; ++r) { const int key = kbase + (r & 3) + 8 * (r >> 2); \
                int d0 = t - key, d1 = d0 - 32; d0 = d0 < 0 ? 0 : d0; d1 = d1 < 0 ? 0 : d1; \
                s0[r] = s0[r] * SC + biasT[d0]; s1[r] = s1[r] * SC + biasT[d1]; \
                if (diag) { if (key > t) s0[r] = -INFINITY; if (key + 32 > t) s1[r] = -INFINITY; } } \
            float mt = vmax3(s0[0], s1[0], s0[1]); \
        _Pragma("unroll") \
            for (int r = 1; r < 16; ++r) mt = r < 15 ? vmax3(mt, s1[r], s0[r + 1]) : vmax2(mt, s1[r]); \
            mt = xhalf_max(mt); \
            const float mn = vmax2(m, mt); \
            alpha = __builtin_amdgcn_exp2f(m - mn); \
            m = mn; \
        _Pragma("unroll") \
            for (int r = 0; r < 16; ++r) { s0[r] = __builtin_amdgcn_exp2f(s0[r] - mn); s1[r] = __builtin_amdgcn_exp2f(s1[r] - mn); ps += s0[r] + s1[r]; } \
        } else { \
             \
            float mr = vmax3(s0[0], s1[0], s0[1]); \
        _Pragma("unroll") \
            for (int r = 1; r < 16; ++r) mr = r < 15 ? vmax3(mr, s1[r], s0[r + 1]) : vmax2(mr, s1[r]); \
            mr = xhalf_max(mr); \
            const float mn = vmax2(m, mr * SC + c31); \
            alpha = __builtin_amdgcn_exp2f(m - mn); \
            m = mn; \
            const float off = c31 - mn; \
        _Pragma("unroll") \
            for (int r = 0; r < 16; ++r) { s0[r] = __builtin_amdgcn_exp2f(s0[r] * SC + off); s1[r] = __builtin_amdgcn_exp2f(s1[r] * SC + off); ps += s0[r] + s1[r]; } \
        } \
        l = l * alpha + ps; \
        if (__any(alpha != 1.f)) { \
        _Pragma("unroll") \
            for (int i = 0; i < 4; ++i) \
        _Pragma("unroll") \
                for (int r = 0; r < 16; ++r) O[i][r] *= alpha; \
        } \
        pb[0][0] = pack8(s0, 0); pb[0][1] = pack8(s0, 1); pb[1][0] = pack8(s1, 0); pb[1][1] = pack8(s1, 1); \
    } while (0)
#define DA_PV(jt) do { \
        const LAS unsigned char* vb = lds + (jt & 3) * DA_SLOT + 16384; \
        _Pragma("unroll") \
        for (int sub = 0; sub < 2; ++sub) \
        _Pragma("unroll") \
            for (int s = 0; s < 2; ++s) \
        _Pragma("unroll") \
                for (int dblk = 0; dblk < 4; ++dblk) { \
                    const LAS unsigned char* vp = vb + dblk * 4096 + (32 * sub + 16 * s) * 64 + vrd; \
                    const s16x4_t lo = vtr(vp), hi = vtr(vp + 8 * 64); \
                    const bf16x8_t va = __builtin_shufflevector(lo, hi, 0, 1, 2, 3, 4, 5, 6, 7); \
                    O[dblk] = MFMA32(va, pb[sub][s], O[dblk]); \
                } \
    } while (0)
    const int grp = wave >> 2;
    int jp = -1;
    for (int j = 0; j < ntb; ++j) {
        const bool pf = j + 2 < ntb;
        if (pf) DA_DMA(j + 2);
        if (jp >= 0) { DA_PV(jp); jp = -1; }
        if (j < ntw) { DA_QKSM(j); if (grp == 0) DA_PV(j); else jp = j; }
        if (pf) ATT_WAIT_BAR(4); else ATT_WAIT_BAR(0);
    }
    if (jp >= 0) DA_PV(jp);
#undef DA_QKSM
#undef DA_PV
    __syncthreads();
#undef DA_DMA
    l = xhalf_sum(l);
    const float inv = (map ? lam : 1.f) / l;
    LAS float* ex = (LAS float*)(lds + rg * 16384);
    if (map == 1) {
#pragma unroll
        for (int i = 0; i < 4; ++i)
#pragma unroll
            for (int r = 0; r < 16; ++r) ex[(i * 16 + r) * 64 + lane] = O[i][r] * inv;
    }
    __syncthreads();
    if (map == 0) {
        float ss = 0.f;
#pragma unroll
        for (int i = 0; i < 4; ++i)
#pragma unroll
            for (int r = 0; r < 16; ++r) { const float o = O[i][r] * inv - ex[(i * 16 + r) * 64 + lane]; O[i][r] = o; ss += o * o; }
        ss = xhalf_sum(ss);
        const float rn = rsqrtf(ss * (1.f / 128.f) + EPS) * 0.8f;
        bf16_t* orow = mixin + (rowbase + t) * D + h * 128;
#pragma unroll
        for (int i = 0; i < 4; ++i)
#pragma unroll
            for (int g = 0; g < 4; ++g) { const int d0 = 32 * i + 8 * g + 4 * hh; const float4 gs = *(const float4*)(g_subln + d0);
                uint2 o; o.x = cvtpk(O[i][4 * g + 0] * rn * gs.x, O[i][4 * g + 1] * rn * gs.y); o.y = cvtpk(O[i][4 * g + 2] * rn * gs.z, O[i][4 * g + 3] * rn * gs.w);
                *(uint2*)(orow + d0) = o; }
    }
    __syncthreads();
}

__device__ __forceinline__ unsigned fkey(float f) { f = f + 0.0f; const unsigned u = __float_as_uint(f); return (u & 0x80000000u) ? ~u : (u | 0x80000000u); }
__device__ __forceinline__ int wave_sum_dpp(int v) {
    v += __builtin_amdgcn_update_dpp(0, v, 0x111, 0xf, 0xf, true);
    v += __builtin_amdgcn_update_dpp(0, v, 0x112, 0xf, 0xf, true);
    v += __builtin_amdgcn_update_dpp(0, v, 0x114, 0xf, 0xf, true);
    v += __builtin_amdgcn_update_dpp(0, v, 0x118, 0xf, 0xf, true);
    v += __builtin_amdgcn_update_dpp(0, v, 0x142, 0xa, 0xf, true);
    v += __builtin_amdgcn_update_dpp(0, v, 0x143, 0xc, 0xf, true);
    return __builtin_amdgcn_readlane(v, 63);
}
__device__ __forceinline__ void bit_transpose32(unsigned (&A)[32]) {
#pragma unroll
    for (int s = 0; s < 5; ++s) { const int j = 16 >> s; const unsigned m = s == 0 ? 0x0000FFFFu : s == 1 ? 0x00FF00FFu : s == 2 ? 0x0F0F0F0Fu : s == 3 ? 0x33333333u : 0x55555555u;
#pragma unroll
        for (int k = 0; k < 32; ++k) if (!(k & j)) { const unsigned a = A[k], b = A[k + j]; A[k] = (a & m) | ((b << j) & ~m); A[k + j] = ((a >> j) & m) | (b & ~m); } }
}
template <int NI>
__device__ __forceinline__ void dsa_select_pair(const LAS float* sc, unsigned* __restrict__ maskw, size_t rowbase, int t_base, int lane, int wave) {
    {
        const int tlA = 2 * wave, tA = t_base + tlA, tB = tA + 1, nkA = tA + 1, nkB = tB + 1;
        unsigned* mrowA = maskw + (rowbase + tA) * 64; unsigned* mrowB = mrowA + 64;
        const bool smallA = nkA <= 256, smallB = nkB <= 256;
        unsigned PA[32], PB[32];
#pragma unroll
        for (int i = 0; i < 32; ++i) {
            if (i < NI) { const int idx = lane + 64 * i;
                const float vA = sc[tlA * 2048 + (idx < nkA ? idx : 0)], vB = sc[(tlA + 1) * 2048 + (idx < nkB ? idx : 0)];
                PA[i] = idx < nkA ? fkey(vA) : 0u; PB[i] = idx < nkB ? fkey(vB) : 0u; }
            else { PA[i] = 0u; PB[i] = 0u; } }
        bit_transpose32(PA); bit_transpose32(PB);
        unsigned gtA = 0u, eqA = 0xFFFFFFFFu, gtB = 0u, eqB = 0xFFFFFFFFu, selA = 0u, selB = 0u;
        bool doneA = smallA, doneB = smallB, exactA = false, exactB = false;
#pragma unroll
        for (int bit = 31; bit >= 0; --bit) if (!(doneA && doneB)) {
            const unsigned geA = gtA | (eqA & PA[bit]), geB = gtB | (eqB & PB[bit]);
            const int tot2 = wave_sum_dpp(__builtin_popcount(geA) | (__builtin_popcount(geB) << 16));
            const int totA = tot2 & 0xffff, totB = tot2 >> 16;
            if (!doneA) { if (totA >= 256) { eqA &= PA[bit]; if (totA == 256) { selA = geA; exactA = true; doneA = true; } } else { gtA = geA; eqA &= ~PA[bit]; } }
            if (!doneB) { if (totB >= 256) { eqB &= PB[bit]; if (totB == 256) { selB = geB; exactB = true; doneB = true; } } else { gtB = geB; eqB &= ~PB[bit]; } }
        }
#pragma unroll 1
        for (int tt = 0; tt < 2; ++tt) {
            const int t = tt ? tB : tA; unsigned* mrow = tt ? mrowB : mrowA; const bool small = tt ? smallB : smallA, exact = tt ? exactB : exactA;
            if (small) {
                const int w0 = 32 * lane;
                unsigned v = 0u;
                if (w0 + 31 <= t) v = 0xFFFFFFFFu; else if (w0 <= t) v = (1u << (t - w0 + 1)) - 1u;
                mrow[lane] = v;
            } else {
                unsigned sel = tt ? selB : selA;
                if (!exact) {
                    const unsigned gt = tt ? gtB : gtA, eq = tt ? eqB : eqA;
                    const int need = 256 - wave_sum_dpp(__builtin_popcount(gt)); int running = 0;
                    const unsigned long long lt = (1ull << lane) - 1ull;
                    sel = gt;
#pragma unroll
                    for (int i = 0; i < NI; ++i) {
                        const bool e = (eq >> i) & 1u; const unsigned long long be = __ballot(e);
                        const int rank = running + __builtin_popcountll(be & lt);
                        if (e && rank < need) sel |= 1u << i;
                        running += __builtin_popcountll(be);
                    }
                }
                unsigned long long mine = 0ull;
#pragma unroll
                for (int i = 0; i < NI; ++i) { const unsigned long long bal = __ballot(((sel >> i) & 1u) != 0u); if (lane == i) mine = bal; }
                if (lane < 32) *(unsigned long long*)(mrow + 2 * lane) = lane < NI ? mine : 0ull;
            }
        }
    }
}
__device__ __forceinline__ void dsa_index_unit(const bf16_t* __restrict__ proj, unsigned* __restrict__ maskw, LAS unsigned char* lds, int b, int u16, int tid, int lane, int wave) {
    const int t_base = 16 * u16, ntile = ((t_base + 15) >> 5) + 1;
    const size_t rowbase = (size_t)b * S;
    LAS float* sc = (LAS float*)lds;
    const int r32 = lane & 31, hh = lane >> 5;
    {
        LAS float* wl = (LAS float*)(lds + 132096);
        if (tid < 128) wl[tid] = bf2f(proj[(rowbase + t_base + (tid >> 3)) * NPP + C_IW + (tid & 7)]) * (0.35355339059327373f * 0.125f);
        const int hsel = (r32 >> 2) & 1, q = (r32 & 3) + 4 * (r32 >> 3), tokl = 2 * hsel + (q >> 3), head = q & 7;
        LAS unsigned char* afi = lds + 133120;
#pragma unroll
        for (int cc = 0; cc < 2; ++cc) { const int c = tid + 512 * cc, crt = c >> 8, cks = (c >> 6) & 3, chh = (c >> 5) & 1, cr = c & 31;
            const int chs = (cr >> 2) & 1, cq = (cr & 3) + 4 * (cr >> 3), ctok = 2 * chs + (cq >> 3), chead = cq & 7;
            const bf16x8_t cv = *(const bf16x8_t*)(proj + (rowbase + t_base + 4 * crt + ctok) * NPP + C_IQ + chead * 64 + 8 * chh + 16 * cks);
            *(LAS bf16x8_t*)(afi + c * 16) = cv; }
        bf16x8_t bfr[4], bnx[4];
        const bf16_t* bp0 = proj + (rowbase + r32) * NPP + C_IK + 8 * hh;
        if (wave < ntile) {
#pragma unroll
            for (int ks = 0; ks < 4; ++ks) bnx[ks] = *(const bf16x8_t*)(bp0 + (size_t)(32 * wave) * NPP + 16 * ks);
        }
        __syncthreads();
        bf16x8_t af[4][4];
#pragma unroll
        for (int rt = 0; rt < 4; ++rt)
#pragma unroll
            for (int ks = 0; ks < 4; ++ks) af[rt][ks] = *(const LAS bf16x8_t*)(afi + ((((rt * 4 + ks) * 2 + hh) * 32 + r32) * 16));
        (void)tokl; (void)head;
        for (int tile = wave; tile < ntile; tile += 8) {
#pragma unroll
            for (int ks = 0; ks < 4; ++ks) bfr[ks] = bnx[ks];
            if (tile + 8 < ntile) {
#pragma unroll
                for (int ks = 0; ks < 4; ++ks) bnx[ks] = *(const bf16x8_t*)(bp0 + (size_t)(32 * (tile + 8)) * NPP + 16 * ks);
            }
            const int key = 32 * tile + r32;
#pragma unroll
            for (int rt = 0; rt < 4; ++rt) {
                f32x16_t acc;
#pragma unroll
                for (int r = 0; r < 16; ++r) acc[r] = 0.f;
#pragma unroll
                for (int ks = 0; ks < 4; ++ks) acc = MFMA32(af[rt][ks], bfr[ks], acc);
                const int tl = 4 * rt + 2 * hh;
                const LAS f32x4_t* w4 = (const LAS f32x4_t*)(wl + tl * 8);
                const f32x4_t wa0 = w4[0], wa1 = w4[1], wb0 = w4[2], wb1 = w4[3];
                float sA = wa0.x * fmaxf(acc[0], 0.f) + wa0.y * fmaxf(acc[1], 0.f) + wa0.z * fmaxf(acc[2], 0.f) + wa0.w * fmaxf(acc[3], 0.f)
                         + wa1.x * fmaxf(acc[4], 0.f) + wa1.y * fmaxf(acc[5], 0.f) + wa1.z * fmaxf(acc[6], 0.f) + wa1.w * fmaxf(acc[7], 0.f);
                float sB = wb0.x * fmaxf(acc[8], 0.f) + wb0.y * fmaxf(acc[9], 0.f) + wb0.z * fmaxf(acc[10], 0.f) + wb0.w * fmaxf(acc[11], 0.f)
                         + wb1.x * fmaxf(acc[12], 0.f) + wb1.y * fmaxf(acc[13], 0.f) + wb1.z * fmaxf(acc[14], 0.f) + wb1.w * fmaxf(acc[15], 0.f);
                const int tA = t_base + tl;
                sc[tl * 2048 + key] = key <= tA ? sA : -INFINITY;
                sc[(tl + 1) * 2048 + key] = key <= tA + 1 ? sB : -INFINITY;
            }
        }
    }
    __syncthreads();
    {
        const int ni = (t_base + 16 + 63) >> 6;
        if (ni <= 8) dsa_select_pair<8>(sc, maskw, rowbase, t_base, lane, wave);
        else if (ni <= 16) dsa_select_pair<16>(sc, maskw, rowbase, t_base, lane, wave);
        else if (ni <= 24) dsa_select_pair<24>(sc, maskw, rowbase, t_base, lane, wave);
        else dsa_select_pair<32>(sc, maskw, rowbase, t_base, lane, wave);
    }
    __syncthreads();
}

constexpr int DB_KV = 0, DB_BIAS = 32768, DB_Q = 36864, DB_LDS = 36864 + 65536;
__device__ __forceinline__ void dsa_attn_unit(const bf16_t* __restrict__ proj, const unsigned* __restrict__ maskw, const bf16_t* __restrict__ wuvF, const float* __restrict__ rel_bias, const float* __restrict__ g_kv,
                                              bf16_t* __restrict__ mixin, LAS unsigned char* lds, int b, int u64, int tid, int lane, int wave) {
    const int head = wave & 3, tgrp = wave >> 2, r32 = lane & 31, hh = lane >> 5;
    const int t0 = 64 * u64 + 32 * tgrp, t = t0 + r32;
    const int ntb = u64 + 1;
    const size_t rowbase = (size_t)b * S;
    LAS float* biasT = (LAS float*)(lds + DB_BIAS);
    for (int i = tid; i < 1024; i += NTHREADS) biasT[i] = rel_bias[rel_bucket(i & 255) * 8 + 4 + (i >> 8)] * LOG2E;
    const float c31 = rel_bias[31 * 8 + 4 + head] * LOG2E;
    bf16x8_t qreg[8];
    { const bf16_t* qrow = proj + (rowbase + t) * NPP + C_SQ + head * 128 + 8 * hh;
#pragma unroll
      for (int ks = 0; ks < 8; ++ks) qreg[ks] = *(const bf16x8_t*)(qrow + 16 * ks); }
    const int skey = tid >> 4, sc = tid & 15;
    const bf16_t* sg = proj + (rowbase + skey) * NPP + C_SKV + 8 * sc;
    const unsigned soff0 = (sc >> 2) * 4096 + skey * 64 + (((sc & 3) ^ ((skey >> 2) & 3)) * 16), soff1 = soff0 + 32 * 64;
    u32x4_t raw0, raw1; u32x2_t mw, mwn;
    const unsigned* mrow = maskw + (rowbase + t) * 64;
#define DB_LOAD(j) do { const size_t o_ = (size_t)(64 * (j)) * NPP; raw0 = *(const u32x4_t*)(sg + o_); raw1 = *(const u32x4_t*)(sg + o_ + (size_t)32 * NPP); mwn = *(const u32x2_t*)(mrow + 2 * (j)); } while (0)
#define DB_NORM1(raw, off) do { float f_[8]; float ss_ = 0.f; \
        _Pragma("unroll") for (int jj = 0; jj < 4; ++jj) { f_[2 * jj] = __uint_as_float(raw[jj] << 16); f_[2 * jj + 1] = __uint_as_float(raw[jj] & 0xffff0000u); ss_ += f_[2 * jj] * f_[2 * jj] + f_[2 * jj + 1] * f_[2 * jj + 1]; } \
        ss_ += __shfl_xor(ss_, 1); ss_ += __shfl_xor(ss_, 2); ss_ += __shfl_xor(ss_, 4); ss_ += __shfl_xor(ss_, 8); \
        const float rr_ = rsqrtf(ss_ * (1.f / 128.f) + EPS); u32x4_t o_; const float4 ga_ = *(const float4*)(g_kv + 8 * sc), gb_ = *(const float4*)(g_kv + 8 * sc + 4); const float gk[8] = {ga_.x, ga_.y, ga_.z, ga_.w, gb_.x, gb_.y, gb_.z, gb_.w}; \
        _Pragma("unroll") for (int jj = 0; jj < 4; ++jj) o_[jj] = cvtpk(f_[2 * jj] * rr_ * gk[2 * jj], f_[2 * jj + 1] * rr_ * gk[2 * jj + 1]); \
        *(LAS u32x4_t*)(kvb_ + (off)) = o_; } while (0)
#define DB_WRITE(bf) do { LAS unsigned char* kvb_ = lds + DB_KV + (bf) * 16384; DB_NORM1(raw0, soff0); DB_NORM1(raw1, soff1); } while (0)
    DB_LOAD(0); DB_WRITE(0); mw = mwn;
    __syncthreads();
    f32x16_t O[4];
#pragma unroll
    for (int i = 0; i < 4; ++i)
#pragma unroll
        for (int r = 0; r < 16; ++r) O[i][r] = 0.f;
    float m = -1e30f, l = 0.f;
    const float SC = 0.08838834764831845f * LOG2E;
    const int i16 = lane & 15, tq = i16 >> 2, tp = i16 & 3, g1 = (lane >> 4) & 1;
    const unsigned vrd_lo = (4 * hh + tq) * 64 + (((2 * g1 + (tp >> 1)) ^ (hh & 3)) * 16) + 8 * (tp & 1);
    const unsigned vrd_hi = (4 * hh + 8 + tq) * 64 + (((2 * g1 + (tp >> 1)) ^ ((hh + 2) & 3)) * 16) + 8 * (tp & 1);
    const unsigned kx = (unsigned)((r32 >> 2) & 3);
    const LAS float* bT = biasT + head * 256;
    for (int j = 0; j < ntb; ++j) {
        if (j + 1 < ntb) DB_LOAD(j + 1);
        {
            const LAS unsigned char* kvb = lds + DB_KV + (j & 1) * 16384;
            const bool nearb = (t0 - (64 * j + 63)) < 113;
#pragma unroll
            for (int sub = 0; sub < 2; ++sub) {
                f32x16_t s0;
#pragma unroll
                for (int r = 0; r < 16; ++r) s0[r] = 0.f;
                const LAS unsigned char* kvs = kvb + sub * (32 * 64);
#pragma unroll
                for (int ks = 0; ks < 8; ++ks) {
                    const int c16 = 2 * ks + hh;
                    const unsigned ao = (unsigned)((c16 >> 2) * 4096 + r32 * 64) + (((unsigned)(c16 & 3) ^ kx) * 16u);
                    const bf16x8_t a0 = *(const LAS bf16x8_t*)(kvs + ao);
                    const bf16x8_t qk = qreg[ks];
                    s0 = MFMA32(a0, qk, s0);
                }
                const int kbase = 64 * j + 32 * sub + 4 * hh;
                const unsigned w0 = (sub ? mw.y : mw.x) >> (4 * hh);
                float alpha, ps = 0.f;
                if (nearb) {
#pragma unroll
                    for (int r = 0; r < 16; ++r) { const int key = kbase + (r & 3) + 8 * (r >> 2);
                        int d0 = t - key; d0 = d0 < 0 ? 0 : d0;
                        s0[r] = s0[r] * SC + bT[d0]; }
#pragma unroll
                    for (int r = 0; r < 16; ++r) { const int bp = (r & 3) + 8 * (r >> 2); if (!((w0 >> bp) & 1u)) s0[r] = -INFINITY; }
                    float mt = vmax3(s0[0], s0[1], s0[2]);
#pragma unroll
                    for (int r = 3; r < 15; r += 2) mt = vmax3(mt, s0[r], s0[r + 1]);
                    mt = vmax2(mt, s0[15]);
                    mt = xhalf_max(mt);
                    const float mn = vmax2(m, mt);
                    alpha = __builtin_amdgcn_exp2f(m - mn);
                    m = mn;
#pragma unroll
                    for (int r = 0; r < 16; ++r) { s0[r] = __builtin_amdgcn_exp2f(s0[r] - mn); ps += s0[r]; }
                } else {
#pragma unroll
                    for (int r = 0; r < 16; ++r) { const int bp = (r & 3) + 8 * (r >> 2); if (!((w0 >> bp) & 1u)) s0[r] = -INFINITY; }
                    float mr = vmax3(s0[0], s0[1], s0[2]);
#pragma unroll
                    for (int r = 3; r < 15; r += 2) mr = vmax3(mr, s0[r], s0[r + 1]);
                    mr = vmax2(mr, s0[15]);
                    mr = xhalf_max(mr);
                    const float mn = vmax2(m, mr * SC + c31);
                    alpha = __builtin_amdgcn_exp2f(m - mn);
                    m = mn;
                    const float off = c31 - mn;
#pragma unroll
                    for (int r = 0; r < 16; ++r) { s0[r] = __builtin_amdgcn_exp2f(s0[r] * SC + off); ps += s0[r]; }
                }
                l = l * alpha + ps;
                if (__any(alpha != 1.f)) {
#pragma unroll
                    for (int i = 0; i < 4; ++i)
#pragma unroll
                        for (int r = 0; r < 16; ++r) O[i][r] *= alpha;
                }
                bf16x8_t pb[2];
                pb[0] = pack8(s0, 0); pb[1] = pack8(s0, 1);
#pragma unroll
                for (int s = 0; s < 2; ++s)
#pragma unroll
                    for (int dblk = 0; dblk < 4; ++dblk) {
                        const LAS unsigned char* vp = kvs + dblk * 4096 + (16 * s) * 64;
                        const s16x4_t lo = vtr(vp + vrd_lo), hi = vtr(vp + vrd_hi);
                        const bf16x8_t va = __builtin_shufflevector(lo, hi, 0, 1, 2, 3, 4, 5, 6, 7);
                        O[dblk] = MFMA32(va, pb[s], O[dblk]);
                    }
            }
        }
        if (j + 1 < ntb) { DB_WRITE((j + 1) & 1); mw = mwn; }
        __syncthreads();
    }
#undef DB_LOAD
#undef DB_NORM1
#undef DB_WRITE
    l = xhalf_sum(l);
    const float inv = 1.f / l;
#pragma unroll
    for (int i = 0; i < 4; ++i)
#pragma unroll
        for (int r = 0; r < 16; ++r) O[i][r] *= inv;
    bf16x8_t ob[4][2];
#pragma unroll
    for (int i = 0; i < 4; ++i) { ob[i][0] = pack8(O[i], 0); ob[i][1] = pack8(O[i], 1); }
    bf16_t* orow = mixin + (rowbase + t) * D + 512 + head * 128;
    u32x2_t po[4][4];
#pragma unroll 1
    for (int e2 = 0; e2 < 2; ++e2) {
        bf16x8_t wa[2][8];
#pragma unroll
        for (int q = 0; q < 2; ++q)
#pragma unroll
            for (int i = 0; i < 4; ++i)
#pragma unroll
                for (int s = 0; s < 2; ++s) wa[q][2 * i + s] = *(const bf16x8_t*)(wuvF + ((((size_t)(head * 4 + 2 * e2 + q) * 4 + i) * 2 + s) * 64 + lane) * 8);
#pragma unroll
        for (int q = 0; q < 2; ++q) {
            f32x16_t acc;
#pragma unroll
            for (int r = 0; r < 16; ++r) acc[r] = 0.f;
#pragma unroll
            for (int i = 0; i < 4; ++i)
#pragma unroll
                for (int s = 0; s < 2; ++s) acc = MFMA32(wa[q][2 * i + s], ob[i][s], acc);
#pragma unroll
            for (int g = 0; g < 4; ++g) { u32x2_t o; o.x = cvtpk(acc[4 * g + 0], acc[4 * g + 1]); o.y = cvtpk(acc[4 * g + 2], acc[4 * g + 3]);
                if (e2 == 0) po[q][g] = o; else po[2 + q][g] = o; }
        }
    }
#pragma unroll
    for (int eb = 0; eb < 4; ++eb)
#pragma unroll
        for (int g = 0; g < 4; ++g) *(u32x2_t*)(orow + 32 * eb + 8 * g + 4 * hh) = po[eb][g];
}

__device__ __forceinline__ unsigned fkey_raw(float f) { const unsigned u = __float_as_uint(f); return (u & 0x80000000u) ? ~u : (u | 0x80000000u); }
__device__ __forceinline__ float fkey_inv(unsigned k) { const unsigned u = (k & 0x80000000u) ? (k & 0x7fffffffu) : ~k; return __uint_as_float(u); }
__device__ __forceinline__ unsigned ps_fmax(unsigned a, unsigned b) { unsigned r; asm("v_max_f32 %0, %1, %2" : "=v"(r) : "v"(a), "v"(b)); return r; }
__device__ __forceinline__ unsigned ps_fmin(unsigned a, unsigned b) { unsigned r; asm("v_min_f32 %0, %1, %2" : "=v"(r) : "v"(a), "v"(b)); return r; }
#define PS_CE(a, b) do { const unsigned hi_ = ps_fmax((a), (b)); const unsigned lo_ = ps_fmin((a), (b)); (a) = hi_; (b) = lo_; } while (0)
__device__ __forceinline__ void sort16_desc(unsigned (&k)[16]) {
    PS_CE(k[0], k[1]); PS_CE(k[2], k[3]); PS_CE(k[0], k[2]); PS_CE(k[1], k[3]); PS_CE(k[1], k[2]); PS_CE(k[4], k[5]); PS_CE(k[6], k[7]); PS_CE(k[4], k[6]); PS_CE(k[5], k[7]); PS_CE(k[5], k[6]); PS_CE(k[0], k[4]); PS_CE(k[2], k[6]); PS_CE(k[2], k[4]); PS_CE(k[1], k[5]); PS_CE(k[3], k[7]); PS_CE(k[3], k[5]); PS_CE(k[1], k[2]); PS_CE(k[3], k[4]); PS_CE(k[5], k[6]); PS_CE(k[8], k[9]); PS_CE(k[10], k[11]); PS_CE(k[8], k[10]); PS_CE(k[9], k[11]); PS_CE(k[9], k[10]); PS_CE(k[12], k[13]); PS_CE(k[14], k[15]); PS_CE(k[12], k[14]); PS_CE(k[13], k[15]); PS_CE(k[13], k[14]); PS_CE(k[8], k[12]); PS_CE(k[10], k[14]); PS_CE(k[10], k[12]); PS_CE(k[9], k[13]); PS_CE(k[11], k[15]); PS_CE(k[11], k[13]); PS_CE(k[9], k[10]); PS_CE(k[11], k[12]); PS_CE(k[13], k[14]); PS_CE(k[0], k[8]); PS_CE(k[4], k[12]); PS_CE(k[4], k[8]); PS_CE(k[2], k[10]); PS_CE(k[6], k[14]); PS_CE(k[6], k[10]); PS_CE(k[2], k[4]); PS_CE(k[6], k[8]); PS_CE(k[10], k[12]); PS_CE(k[1], k[9]); PS_CE(k[5], k[13]); PS_CE(k[5], k[9]); PS_CE(k[3], k[11]); PS_CE(k[7], k[15]); PS_CE(k[7], k[11]); PS_CE(k[3], k[5]); PS_CE(k[7], k[9]); PS_CE(k[11], k[13]); PS_CE(k[1], k[2]); PS_CE(k[3], k[4]); PS_CE(k[5], k[6]); PS_CE(k[7], k[8]); PS_CE(k[9], k[10]); PS_CE(k[11], k[12]); PS_CE(k[13], k[14]);
}
__device__ __forceinline__ void sort9_desc(unsigned (&k)[9]) {
    PS_CE(k[0], k[1]); PS_CE(k[2], k[3]); PS_CE(k[0], k[2]); PS_CE(k[1], k[3]); PS_CE(k[1], k[2]); PS_CE(k[4], k[5]); PS_CE(k[6], k[7]); PS_CE(k[4], k[6]); PS_CE(k[5], k[7]); PS_CE(k[5], k[6]); PS_CE(k[0], k[4]); PS_CE(k[2], k[6]); PS_CE(k[2], k[4]); PS_CE(k[1], k[5]); PS_CE(k[3], k[7]); PS_CE(k[3], k[5]); PS_CE(k[1], k[2]); PS_CE(k[3], k[4]); PS_CE(k[5], k[6]); PS_CE(k[0], k[8]); PS_CE(k[4], k[8]); PS_CE(k[2], k[4]); PS_CE(k[6], k[8]); PS_CE(k[3], k[5]); PS_CE(k[1], k[2]); PS_CE(k[3], k[4]); PS_CE(k[5], k[6]); PS_CE(k[7], k[8]);
}
__device__ __forceinline__ void merge16_top9(unsigned (&a)[16], const unsigned (&b)[9]) {
#pragma unroll
    for (int i = 7; i < 16; ++i) a[i] = ps_fmax(a[i], b[15 - i]);
#pragma unroll
    for (int j = 8; j > 0; j >>= 1)
#pragma unroll
        for (int i = 0; i < 16; ++i) { const int l = i ^ j; if (l > i) PS_CE(a[i], a[l]); }
}
__device__ __forceinline__ void merge16_top(unsigned (&a)[16], const unsigned (&b)[16]) {
#pragma unroll
    for (int i = 0; i < 16; ++i) a[i] = ps_fmax(a[i], b[15 - i]);
#pragma unroll
    for (int j = 8; j > 0; j >>= 1)
#pragma unroll
        for (int i = 0; i < 16; ++i) { const int l = i ^ j; if (l > i) PS_CE(a[i], a[l]); }
}
__device__ __forceinline__ unsigned xhalf_get(unsigned x, int hh) { auto rr = __builtin_amdgcn_permlane32_swap(x, x, false, false); return hh ? rr[0] : rr[1]; }
__device__ __forceinline__ void top16_of_pair(unsigned (&g0)[16], unsigned (&g1)[16], unsigned (&g2)[16], unsigned (&g3)[16], int hh) {
    sort16_desc(g0); sort16_desc(g1); sort16_desc(g2); sort16_desc(g3);
    merge16_top(g0, g1); merge16_top(g2, g3); merge16_top(g0, g2);
#pragma unroll
    for (int i = 0; i < 16; ++i) g1[i] = xhalf_get(g0[i], hh);
    merge16_top(g0, g1);
}
__device__ __forceinline__ void peer_select_wave(int tile, const bf16_t* __restrict__ qb, const bf16_t* __restrict__ keysb, unsigned short* __restrict__ eidx, float* __restrict__ gate, LAS unsigned char* kimg, int tid, int lane) {
    const int r32 = lane & 31, hh = lane >> 5;
    const int tok = tile * 32 + r32;
    const bf16_t* qrow0 = qb + (size_t)tok * D + 8 * hh;
    int kofs = 0; asm volatile("" : "+s"(kofs));
    const bf16_t* kch0; const bf16_t* kch1;
    { const int c0 = tid, c1 = tid + 512;
      kch0 = keysb + kofs + (size_t)(32 * (c0 >> 8) + (c0 & 31)) * 64 + 8 * ((c0 >> 5) & 1) + 16 * ((c0 >> 6) & 3);
      kch1 = keysb + kofs + (size_t)(32 * (c1 >> 8) + (c1 & 31)) * 64 + 8 * ((c1 >> 5) & 1) + 16 * ((c1 >> 6) & 3); }
    const LAS unsigned char* krd = kimg + (hh * 32 + r32) * 16;
    unsigned L1[16], L2[16];
#pragma unroll
    for (int i = 0; i < 16; ++i) { L1[i] = 0u; L2[i] = 0u; }
    bf16x8_t qfr[4], ka[4];
    unsigned tneg = 4u * hh, tpos = tneg ^ 127u;
    asm volatile("" : "+v"(tneg), "+v"(tpos));
#define PSW_LOADQ(HP) do { _Pragma("unroll") for (int ks = 0; ks < 4; ++ks) qfr[ks] = *(const bf16x8_t*)(qrow0 + (HP) * 64 + 16 * ks); } while (0)
#define PSW_LOADK(HP, KT) do { _Pragma("unroll") for (int ks = 0; ks < 4; ++ks) ka[ks] = *(const LAS bf16x8_t*)(krd + ((HP) & 1) * 16384 + ((KT) * 4 + ks) * 1024); } while (0)
#define PSW_FETCH(HP) do { kf0 = *(const bf16x8_t*)(kch0 + (size_t)(HP) * 128 * 64); kf1 = *(const bf16x8_t*)(kch1 + (size_t)(HP) * 128 * 64); } while (0)
#define PSW_PUT(HP) do { *(LAS bf16x8_t*)(kimg + ((HP) & 1) * 16384 + tid * 16) = kf0; *(LAS bf16x8_t*)(kimg + ((HP) & 1) * 16384 + (tid + 512) * 16) = kf1; } while (0)
#define PSW_MFMA() do { _Pragma("unroll") for (int r = 0; r < 16; ++r) acc[r] = 0.f; \
        _Pragma("unroll") for (int ks = 0; ks < 4; ++ks) acc = MFMA32(ka[ks], qfr[ks], acc); } while (0)
#define PSW_KEYS(KT) do { _Pragma("unroll") for (int r = 0; r < 16; ++r) { const unsigned C_ = 32 * (KT) + (r & 3) + 8 * (r >> 2); const unsigned ub = __float_as_uint(acc[r]); g[KT][r] = (ub & ~127u) | (((int)ub < 0 ? tneg : tpos) ^ C_); } } while (0)
    bf16x8_t kf0, kf1;
    PSW_LOADQ(0); PSW_FETCH(0);
    __syncthreads();
    PSW_PUT(0);
    __syncthreads();
    PSW_LOADK(0, 0);
#pragma unroll 1
    for (int hp = 0; hp < 16; ++hp) {
        const int h = hp >> 1, p = hp & 1, hn = hp + 1 < 16 ? hp + 1 : 15;
        unsigned g[4][16]; f32x16_t acc;
        PSW_FETCH(hn);
        PSW_MFMA(); PSW_LOADK(hp, 1);
        __builtin_amdgcn_sched_barrier(0);
        PSW_KEYS(0);
        PSW_MFMA(); PSW_LOADK(hp, 2);
        __builtin_amdgcn_sched_barrier(0);
        PSW_KEYS(1);
        PSW_MFMA(); PSW_LOADK(hp, 3);
        __builtin_amdgcn_sched_barrier(0);
        PSW_KEYS(2);
        PSW_MFMA(); PSW_LOADQ(hn);
        PSW_PUT(hp + 1);
        __builtin_amdgcn_sched_barrier(0);
        PSW_KEYS(3);
        top16_of_pair(g[0], g[1], g[2], g[3], hh);
#pragma unroll
        for (int i = 0; i < 16; ++i) { L1[i] = p == 0 ? g[0][i] : L1[i]; L2[i] = p == 0 ? L2[i] : g[0][i]; }
        if (p == 1) {
            float s1[16], s2[16];
#pragma unroll
            for (int i = 0; i < 16; ++i) { s1[i] = __uint_as_float(L1[i] & ~127u); s2[i] = __uint_as_float(L2[i] & ~127u); }
            unsigned c0[16], c1[16], c9[9];
#pragma unroll
            for (int i = 0; i < 16; ++i) c0[i] = 0xff800000u;
#pragma unroll
            for (int i = 0; i < 9; ++i) c9[i] = 0xff800000u;
            {
                int n = 0;
#pragma unroll
                for (int i = 0; i < 16; ++i)
#pragma unroll
                    for (int j = 0; j < 16; ++j) if ((i + 1) * (j + 1) <= 16) {
                        const unsigned sb = __float_as_uint(s1[i] + s2[j]); const unsigned ck = (sb & ~255u) | (unsigned)((sb >> 31) ? (i * 16 + j) : 255 - (i * 16 + j));
                        const int slot = n >> 1;
                        if (slot < 16) c0[slot] = ((n & 1) == hh) ? ck : c0[slot]; else c9[slot - 16] = ((n & 1) == hh) ? ck : c9[slot - 16];
                        ++n;
                    }
            }
            sort16_desc(c0); sort9_desc(c9); merge16_top9(c0, c9);
#pragma unroll
            for (int i = 0; i < 16; ++i) c1[i] = xhalf_get(c0[i], hh);
            merge16_top(c0, c1);
            float ev[16]; float su = 0.f;
            const float tmax = __uint_as_float(c0[0] & ~255u);
#pragma unroll
            for (int r = 0; r < 16; ++r) { ev[r] = __expf(__uint_as_float(c0[r] & ~255u) - tmax); su += ev[r]; }
            const float inv = 1.f / su;
            unsigned short* eo = eidx + (size_t)tok * 128 + h * 16 + 8 * hh; float* go = gate + (size_t)tok * 128 + h * 16 + 8 * hh;
            unsigned T1[4], T2[4];
#pragma unroll
            for (int w = 0; w < 4; ++w) { unsigned d1 = 0u, d2 = 0u;
#pragma unroll
                for (int bq = 0; bq < 4; ++bq) { const unsigned ka_ = L1[4 * w + bq], kb_ = L2[4 * w + bq];
                    const unsigned ia = ~(ka_ ^ (unsigned)((int)ka_ >> 31)) & 127u, ib = ~(kb_ ^ (unsigned)((int)kb_ >> 31)) & 127u;
                    d1 |= ia << (8 * bq); d2 |= ib << (8 * bq); }
                T1[w] = d1; T2[w] = d2; }
            int ei[8]; float gv[8];
#pragma unroll
            for (int r = 0; r < 8; ++r) {
                const unsigned ck = hh ? c0[8 + r] : c0[r]; const float e = hh ? ev[8 + r] : ev[r];
                const int pos = (ck >> 31) ? (int)(ck & 255u) : 255 - (int)(ck & 255u), pi = pos >> 4, pj = pos & 15;
                const unsigned s1_ = ((unsigned)pi & 7u) | 0x0c0c0c00u, s2_ = ((unsigned)pj & 7u) | 0x0c0c0c00u;
                const unsigned a1 = __builtin_amdgcn_perm(T1[1], T1[0], s1_), b1 = __builtin_amdgcn_perm(T1[3], T1[2], s1_);
                const unsigned a2 = __builtin_amdgcn_perm(T2[1], T2[0], s2_), b2 = __builtin_amdgcn_perm(T2[3], T2[2], s2_);
                const int i1 = (int)(pi >= 8 ? b1 : a1), i2 = (int)(pj >= 8 ? b2 : a2);
                ei[r] = i1 * 128 + i2; gv[r] = e * inv;
            }
            __builtin_amdgcn_s_waitcnt(0x0F70);
            *(uint4*)(eo) = make_uint4((unsigned)ei[0] | ((unsigned)ei[1] << 16), (unsigned)ei[2] | ((unsigned)ei[3] << 16), (unsigned)ei[4] | ((unsigned)ei[5] << 16), (unsigned)ei[6] | ((unsigned)ei[7] << 16));
            *(float4*)(go) = make_float4(gv[0], gv[1], gv[2], gv[3]); *(float4*)(go + 4) = make_float4(gv[4], gv[5], gv[6], gv[7]);
        }
        __syncthreads();
        PSW_LOADK(hp + 1, 0);
    }
#undef PSW_FETCH
#undef PSW_PUT
#undef PSW_LOADQ
#undef PSW_LOADK
#undef PSW_MFMA
#undef PSW_KEYS
}

__device__ __forceinline__ float gelu_erf(float a) { return 0.5f * a * (1.f + erff(a * 0.70710678118654752f)); }
template <int CTRL> __device__ __forceinline__ int dpp_i(int v) { return __builtin_amdgcn_update_dpp(0, v, CTRL, 0xf, 0xf, false); }
template <int CTRL> __device__ __forceinline__ float dpp_f(float v) { return __int_as_float(__builtin_amdgcn_update_dpp(0, __float_as_int(v), CTRL, 0xf, 0xf, false)); }
constexpr int DPP_XOR1 = 0xB1, DPP_XOR2 = 0x4E, DPP_HMIRROR = 0x141, DPP_ROR8 = 0x128;

__device__ __forceinline__ void peer_gather_tile(int tile, const unsigned char* __restrict__ xq, const float* __restrict__ sxs, const unsigned short* __restrict__ eidx, const float* __restrict__ gate,
                                                 const unsigned char* __restrict__ uq, const unsigned char* __restrict__ vq, const float* __restrict__ su, const float* __restrict__ sv,
                                                 const float* __restrict__ mod, const float* __restrict__ g_final, const bf16_t* xin, bf16_t* ybuf, float* outp,
                                                 LAS unsigned char* wlds, LAS unsigned char* wsc, int lane) {
    const int tok0 = tile * 32, e_sub = lane >> 3, part = lane & 7;
    const int b0 = lane & 1, b1 = (lane >> 1) & 1, b2 = (lane >> 2) & 1, b3 = (lane >> 3) & 1, b4 = (lane >> 4) & 1, b5 = (lane >> 5) & 1;
    unsigned idr[32];
#pragma unroll
    for (int t = 0; t < 32; ++t) idr[t] = ((const unsigned*)(eidx + (size_t)(tok0 + t) * 128))[lane];
    int c128 = 128, part16 = 16 * part;
    asm volatile("" : "+v"(c128), "+v"(part16));
    LAS int* accl = (LAS int*)wlds;
    const __amdgpu_buffer_rsrc_t urs = __builtin_amdgcn_make_buffer_rsrc((void*)uq, 0, 16384 * 1024, 0x00020000);
    const __amdgpu_buffer_rsrc_t vrs = __builtin_amdgcn_make_buffer_rsrc((void*)vq, 0, 16384 * 1024, 0x00020000);
#pragma unroll
    for (int i = 0; i < 16; ++i) *(LAS u32x4_t*)(wlds + i * 1024 + lane * 16) = (u32x4_t){0u, 0u, 0u, 0u};
#define PG_LOADIDXRAW(q_, tl_) do { q_ = idr[(tl_)]; } while (0)
#define PG_UNPACKIDX(dst, q_) do { ((LAS unsigned*)wsc)[lane] = q_; const u32x4_t q0_ = *(const LAS u32x4_t*)(wsc + 32 * e_sub), q1_ = *(const LAS u32x4_t*)(wsc + 32 * e_sub + 16); \
        dst[0] = q0_.x; dst[1] = q0_.y; dst[2] = q0_.z; dst[3] = q0_.w; dst[4] = q1_.x; dst[5] = q1_.y; dst[6] = q1_.z; dst[7] = q1_.w; } while (0)
#define PG_ROWOFF(vo_, w_, hi_) do { if (hi_) asm("v_mad_u32_u16 %0, %1, %2, %3 op_sel:[1,0,0,0]" : "=v"(vo_) : "v"(w_), "v"(c128), "v"(part16)); \
                                     else asm("v_mad_u32_u16 %0, %1, %2, %3 op_sel:[0,0,0,0]" : "=v"(vo_) : "v"(w_), "v"(c128), "v"(part16)); } while (0)
#define PG_LOADROWS8(dst, idx_, h_, rs_) do { _Pragma("unroll") for (int i_ = 0; i_ < 8; ++i_) { int vo_; PG_ROWOFF(vo_, idx_[(8 * (h_) + i_) >> 1], (i_ & 1)); dst[i_] = __builtin_amdgcn_raw_buffer_load_b128(rs_, vo_, soff, 0); } } while (0)
#define PG_LOADROWS8_AFTER(dst, idx_, h_, rs_, dep_) do { _Pragma("unroll") for (int i_ = 0; i_ < 8; ++i_) { int vo_; PG_ROWOFF(vo_, idx_[(8 * (h_) + i_) >> 1], (i_ & 1)); asm volatile("" : "+v"(vo_) : "v"(dep_)); \
        dst[i_] = __builtin_amdgcn_raw_buffer_load_b128(rs_, vo_, soff, 0); } } while (0)
#define PG_UDOT8(r_, xs_, h_) do { _Pragma("unroll") for (int i = 0; i < 8; ++i) { int a_ = __builtin_amdgcn_sdot4((int)r_[i][0], (int)xs_.x, 0, false); a_ = __builtin_amdgcn_sdot4((int)r_[i][1], (int)xs_.y, a_, false); \
            a_ = __builtin_amdgcn_sdot4((int)r_[i][2], (int)xs_.z, a_, false); d[8 * (h_) + i] = __builtin_amdgcn_sdot4((int)r_[i][3], (int)xs_.w, a_, false); } } while (0)
#pragma unroll 1
    for (int s = 0; s < 8; ++s) {
        const int loff = 128 * s + 16 * part; const int soff = s * (16384 * 128);
        unsigned idxN[8]; u32x4_t rP[8], rQ[8]; unsigned iqw;
        LAS unsigned char* xbuf = wsc + 512;
        const unsigned char* xsrc = xq + (size_t)(tok0 + (lane >> 3)) * 1024 + loff;
        u32x4_t xh0 = __builtin_nontemporal_load((const u32x4_t*)(xsrc)), xh1 = __builtin_nontemporal_load((const u32x4_t*)(xsrc + 8 * 1024));
        PG_LOADIDXRAW(iqw, 0); PG_UNPACKIDX(idxN, iqw);
        PG_LOADROWS8(rP, idxN, 0, urs); PG_LOADROWS8(rQ, idxN, 1, urs);
        PG_LOADIDXRAW(iqw, 1);
        *(LAS u32x4_t*)(xbuf + lane * 16) = xh0; *(LAS u32x4_t*)(xbuf + 1024 + lane * 16) = xh1;
#pragma unroll 1
        for (int tl = 0; tl < 32; ++tl) {
            int d[16];
            const int tn2 = tl + 2 < 32 ? tl + 2 : 31;
            PG_UNPACKIDX(idxN, iqw);
            PG_LOADIDXRAW(iqw, tn2);
            if (tl == 8) { xh0 = __builtin_nontemporal_load((const u32x4_t*)(xsrc + 16 * 1024)); xh1 = __builtin_nontemporal_load((const u32x4_t*)(xsrc + 24 * 1024)); }
            if (tl == 16) { *(LAS u32x4_t*)(xbuf + lane * 16) = xh0; *(LAS u32x4_t*)(xbuf + 1024 + lane * 16) = xh1; }
            const u32x4_t xsC = *(const LAS u32x4_t*)(xbuf + (tl & 15) * 128 + part * 16);
            __builtin_amdgcn_sched_barrier(0);
            PG_UDOT8(rP, xsC, 0);
            PG_LOADROWS8_AFTER(rP, idxN, 0, urs, d[7]);
            __builtin_amdgcn_sched_barrier(0);
            PG_UDOT8(rQ, xsC, 1);
            PG_LOADROWS8_AFTER(rQ, idxN, 1, urs, d[15]);
            __builtin_amdgcn_sched_barrier(0);
#pragma unroll
            for (int j = 0; j < 8; ++j) { const int keep = b2 ? d[j + 8] : d[j], send = b2 ? d[j] : d[j + 8]; d[j] = keep + dpp_i<DPP_HMIRROR>(send); }
#pragma unroll
            for (int j = 0; j < 4; ++j) { const int keep = b0 ? d[j + 4] : d[j], send = b0 ? d[j] : d[j + 4]; d[j] = keep + dpp_i<DPP_XOR1>(send); }
#pragma unroll
            for (int j = 0; j < 2; ++j) { const int keep = b1 ? d[j + 2] : d[j], send = b1 ? d[j] : d[j + 2]; d[j] = keep + dpp_i<DPP_XOR2>(send); }
            LAS int* ap = accl + tl * 128 + 16 * e_sub + 8 * b2 + 4 * b0 + 2 * b1; ap[0] += d[0]; ap[1] += d[1];
        }
    }
#pragma unroll 1
    for (int t4 = 0; t4 < 32; t4 += 4) {
        int e_[4][2]; float g_[4][2], sx_[4], su_[4][2], sv_[4][2];
#pragma unroll
        for (int r = 0; r < 4; ++r) { const int tok = tok0 + t4 + r; sx_[r] = sxs[tok];
#pragma unroll
            for (int hf = 0; hf < 2; ++hf) { e_[r][hf] = (int)eidx[(size_t)tok * 128 + lane + 64 * hf]; g_[r][hf] = __builtin_nontemporal_load(gate + (size_t)tok * 128 + lane + 64 * hf); } }
        __builtin_amdgcn_sched_barrier(0);
#pragma unroll
        for (int r = 0; r < 4; ++r)
#pragma unroll
            for (int hf = 0; hf < 2; ++hf) { su_[r][hf] = su[e_[r][hf]]; sv_[r][hf] = sv[e_[r][hf]]; }
        __builtin_amdgcn_sched_barrier(0);
#pragma unroll
        for (int r = 0; r < 4; ++r) { const int tl = t4 + r;
            float wf[2];
#pragma unroll
            for (int hf = 0; hf < 2; ++hf) { const float a = (float)accl[tl * 128 + lane + 64 * hf] * sx_[r] * su_[r][hf]; wf[hf] = g_[r][hf] * gelu_erf(a) * sv_[r][hf]; }
            const float wm = wave_max(fmaxf(fabsf(wf[0]), fabsf(wf[1])));
            const float sw = wm > 0.f ? wm * (1.f / 127.f) : 1.f, inv = wm > 0.f ? 127.f / wm : 0.f;
            LAS signed char* wb = (LAS signed char*)(accl + tl * 128);
            wb[lane] = (signed char)(int)rintf(wf[0] * inv); wb[lane + 64] = (signed char)(int)rintf(wf[1] * inv);
            if (lane == 0) ((LAS float*)accl)[tl * 128 + 32] = sw;
        }
    }
#define PG_VACC8(r_, h_) do { _Pragma("unroll") for (int g_ = 0; g_ < 2; ++g_) { const int wq_ = (int)wq4[2 * (h_) + g_]; \
            _Pragma("unroll") for (int q = 0; q < 4; ++q) { const unsigned R0 = r_[4 * g_][q], R1 = r_[4 * g_ + 1][q], R2 = r_[4 * g_ + 2][q], R3 = r_[4 * g_ + 3][q]; \
                const unsigned A_ = __builtin_amdgcn_perm(R1, R0, 0x05010400u), B_ = __builtin_amdgcn_perm(R1, R0, 0x07030602u), C_ = __builtin_amdgcn_perm(R3, R2, 0x05010400u), D_ = __builtin_amdgcn_perm(R3, R2, 0x07030602u); \
                acc[4 * q + 0] = __builtin_amdgcn_sdot4((int)__builtin_amdgcn_perm(C_, A_, 0x05040100u), wq_, acc[4 * q + 0], false); \
                acc[4 * q + 1] = __builtin_amdgcn_sdot4((int)__builtin_amdgcn_perm(C_, A_, 0x07060302u), wq_, acc[4 * q + 1], false); \
                acc[4 * q + 2] = __builtin_amdgcn_sdot4((int)__builtin_amdgcn_perm(D_, B_, 0x05040100u), wq_, acc[4 * q + 2], false); \
                acc[4 * q + 3] = __builtin_amdgcn_sdot4((int)__builtin_amdgcn_perm(D_, B_, 0x07060302u), wq_, acc[4 * q + 3], false); } } } while (0)
#define PG_FLUSH(S_) do { _Pragma("unroll") for (int k = 0; k < 8; ++k) { const int f = 64 * k + lane, tkn = f >> 4, c = f & 15; \
            const u32x4_t yv = *(const LAS u32x4_t*)(wlds + tkn * 512 + 256 + 16 * c); \
            __builtin_nontemporal_store(yv, (u32x4_t*)(ybuf + (size_t)(tok0 + tkn) * D + 256 * (c >> 2) + 32 * (S_) + 8 * (c & 3))); } } while (0)
#pragma unroll 1
    for (int s = 0; s < 8; ++s) {
        const int soff = s * (16384 * 128);
        const int col = 256 * (2 * b3 + b5) + 32 * s + 4 * part + 2 * b4;
        LAS unsigned* ystage = (LAS unsigned*)(wlds + 256 + 64 * (2 * b3 + b5) + 8 * part + 4 * b4);
        const float2 gf = *(const float2*)(mod + (size_t)(tok0 / S) * 6144 + MOD_GATE_F + col);
        unsigned idxN[8]; u32x4_t rP[8], rQ[8]; unsigned iqw; unsigned x1pC, x1pN;
        PG_LOADIDXRAW(iqw, 0); PG_UNPACKIDX(idxN, iqw);
        x1pC = *(const unsigned*)(xin + (size_t)tok0 * D + col);
        PG_LOADROWS8(rP, idxN, 0, vrs); PG_LOADROWS8(rQ, idxN, 1, vrs);
        PG_LOADIDXRAW(iqw, 1);
        __builtin_amdgcn_sched_barrier(0);
        if (s > 0) PG_FLUSH(s - 1);
        __builtin_amdgcn_s_waitcnt(0x0F70);
#pragma unroll 1
        for (int tl = 0; tl < 32; ++tl) {
            const int tn = tl + 1 < 32 ? tl + 1 : 31, tn2 = tl + 2 < 32 ? tl + 2 : 31;
            PG_UNPACKIDX(idxN, iqw);
            PG_LOADIDXRAW(iqw, tn2);
            x1pN = *(const unsigned*)(xin + (size_t)(tok0 + tn) * D + col);
            const u32x4_t wq4 = *(const LAS u32x4_t*)((const LAS unsigned char*)(accl + tl * 128) + 16 * e_sub);
            const float sw = ((const LAS float*)accl)[tl * 128 + 32];
            int acc[16];
#pragma unroll
            for (int c = 0; c < 16; ++c) acc[c] = 0;
            __builtin_amdgcn_sched_barrier(0);
            PG_VACC8(rP, 0);
            PG_LOADROWS8_AFTER(rP, idxN, 0, vrs, acc[15]);
            __builtin_amdgcn_sched_barrier(0);
            PG_VACC8(rQ, 1);
            PG_LOADROWS8_AFTER(rQ, idxN, 1, vrs, acc[15]);
            __builtin_amdgcn_sched_barrier(0);
#pragma unroll
            for (int j = 0; j < 8; ++j) { const int keep = b3 ? acc[j + 8] : acc[j], send = b3 ? acc[j] : acc[j + 8]; acc[j] = keep + dpp_i<DPP_ROR8>(send); }
#pragma unroll
            for (int j = 0; j < 4; ++j) { auto rr = __builtin_amdgcn_permlane32_swap((unsigned)acc[j], (unsigned)acc[j + 4], false, false); acc[j] = (int)rr[0] + (int)rr[1]; }
#pragma unroll
            for (int j = 0; j < 2; ++j) { const int keep = b4 ? acc[j + 2] : acc[j], send = b4 ? acc[j] : acc[j + 2]; acc[j] = keep + __shfl_xor(send, 16); }
            float2 x1; x1.x = __uint_as_float(x1pC << 16); x1.y = __uint_as_float(x1pC & 0xffff0000u);
            ystage[tl * 128] = pk2(x1.x + gf.x * ((float)acc[0] * sw), x1.y + gf.y * ((float)acc[1] * sw));
            x1pC = x1pN;
        }
    }
    PG_FLUSH(7);
    __builtin_amdgcn_s_waitcnt(0x0F70);
#undef PG_FLUSH
#undef PG_LOADIDXRAW
#undef PG_UNPACKIDX
#undef PG_ROWOFF
#undef PG_LOADROWS8
#undef PG_LOADROWS8_AFTER
#undef PG_UDOT8
#undef PG_VACC8
    float4 gg[4];
#pragma unroll
    for (int i = 0; i < 4; ++i) gg[i] = *(const float4*)(g_final + 256 * i + 4 * lane);
#pragma unroll 1
    for (int tl = 0; tl < 32; tl += 4) {
        float4 y[4][4]; float ss[4];
#pragma unroll
        for (int r = 0; r < 4; ++r) { ss[r] = 0.f;
#pragma unroll
            for (int i = 0; i < 4; ++i) { const u32x2_t yb = __builtin_nontemporal_load((const u32x2_t*)(ybuf + (size_t)(tok0 + tl + r) * D + 256 * i + 4 * lane));
                y[r][i].x = __uint_as_float(yb.x << 16); y[r][i].y = __uint_as_float(yb.x & 0xffff0000u); y[r][i].z = __uint_as_float(yb.y << 16); y[r][i].w = __uint_as_float(yb.y & 0xffff0000u); } }
#pragma unroll
        for (int r = 0; r < 4; ++r)
#pragma unroll
            for (int i = 0; i < 4; ++i) ss[r] += y[r][i].x * y[r][i].x + y[r][i].y * y[r][i].y + y[r][i].z * y[r][i].z + y[r][i].w * y[r][i].w;
#pragma unroll
        for (int o = 32; o >= 1; o >>= 1)
#pragma unroll
            for (int r = 0; r < 4; ++r) ss[r] += __shfl_xor(ss[r], o);
#pragma unroll
        for (int r = 0; r < 4; ++r) { const float rn = rsqrtf(ss[r] * (1.f / D) + EPS);
#pragma unroll
            for (int i = 0; i < 4; ++i) { float4 o; o.x = y[r][i].x * rn * gg[i].x; o.y = y[r][i].y * rn * gg[i].y; o.z = y[r][i].z * rn * gg[i].z; o.w = y[r][i].w * rn * gg[i].w;
                __builtin_nontemporal_store((f32x4_t){o.x, o.y, o.z, o.w}, (f32x4_t*)(outp + (size_t)(tok0 + tl + r) * D + 256 * i + 4 * lane)); } }
    }
}

constexpr size_t MiB = 1u << 20;
constexpr size_t WS_CTL = 0, CTL_ZERO_BYTES = 1 * MiB;
constexpr size_t WS_MOD = 1 * MiB;
constexpr size_t WS_LAM = 1 * MiB + 800 * 1024;
constexpr size_t WS_WIN_T = 2 * MiB;
constexpr size_t WS_WO_T = 8 * MiB;
constexpr size_t WS_WQ_T = 10 * MiB;
constexpr size_t WS_HBUF = 16 * MiB;
constexpr size_t WS_MIXIN = 144 * MiB;
constexpr size_t WS_MASK = 272 * MiB;
constexpr size_t WS_KEYSB = 13 * MiB;
constexpr size_t WS_WUVF = 12 * MiB;
constexpr size_t WS_EIDX = 288 * MiB;
constexpr size_t WS_GATE = 320 * MiB;
constexpr size_t WS_BIG = 352 * MiB;
constexpr size_t WS_UQ = 704 * MiB;
constexpr size_t WS_VQ = 720 * MiB;
constexpr size_t WS_SU = 736 * MiB;
constexpr size_t WS_SV = 736 * MiB + 65536;
constexpr size_t WS_XQ = 737 * MiB;
constexpr size_t WS_SX = 801 * MiB;
constexpr size_t WS_END = 802 * MiB;
constexpr int CW_BAR = 4096;
constexpr int MAX_FWD_LAUNCHES = 8;
static_assert((CW_BAR + MAX_FWD_LAUNCHES * XCD_BAR_WORDS) * 4 <= (int)CTL_ZERO_BYTES, "barrier words inside the memset region");

constexpr int RING_OFF = 0, RING_BYTES = 131072;
constexpr int LDSCTL_OFF = RING_BYTES, MISC_OFF = LDSCTL_OFF + 320;
constexpr int LDS_BYTES = 163840;

constexpr int REPS[11] = {1, 1, 1, 1, 1, 1, 1, 1, 1, 1, 1};
struct Args { const float* in[21]; float* out; unsigned char* ws; int ph_lo, ph_hi, li, pad; };

__device__ __forceinline__ void p0_transpose_item(const float* W, int K, int N, int Npad, bf16_t* WT, LAS float* scr, int item, int lane) {
    const int nblk = Npad / 32, kb = item / nblk, nb = item % nblk, k0 = 64 * kb, n0 = 32 * nb;
    const int n_in = n0 + (lane & 31);
#pragma unroll 8
    for (int i = 0; i < 32; ++i) { const int kk = 2 * i + (lane >> 5); scr[kk * 33 + (lane & 31)] = n_in < N ? W[(size_t)(k0 + kk) * N + n_in] : 0.f; }
    asm volatile("s_waitcnt lgkmcnt(0)" ::: "memory");
    const int c = lane & 7;
#pragma unroll
    for (int j = 0; j < 4; ++j) { const int n = (lane >> 3) + 8 * j; const LAS float* s = scr + (8 * c) * 33 + n;
        uint4 o; o.x = pk2(s[0 * 33], s[1 * 33]); o.y = pk2(s[2 * 33], s[3 * 33]); o.z = pk2(s[4 * 33], s[5 * 33]); o.w = pk2(s[6 * 33], s[7 * 33]);
        *(uint4*)(WT + (size_t)(n0 + n) * K + k0 + 8 * c) = o; }
    asm volatile("s_waitcnt lgkmcnt(0)" ::: "memory");
}

template <int OFFS, bool SLICED = false> __device__ __forceinline__ void quant_row(const float4 (&v)[4], unsigned char* qrow, float* scale_out, int lane);
template <int OFFS, bool SLICED> __device__ __forceinline__ void quant_row(const float4 (&v)[4], unsigned char* qrow, float* scale_out, int lane);
template <bool QUANT, int NR, bool BF16IN>
__device__ __forceinline__ void norm_mod_rows(const void* xrows_v, const float* g, const float* mb, int shift_off, int scale_off, bf16_t* orows, int lane, unsigned char* qrows, float* qscale) {
    float4 v[NR][4]; float ss[NR];
#pragma unroll
    for (int r = 0; r < NR; ++r)
#pragma unroll
        for (int i = 0; i < 4; ++i) {
            if (BF16IN) { const uint2 b2 = ((const uint2*)((const bf16_t*)xrows_v + (size_t)r * D))[lane + 64 * i];
                v[r][i].x = __uint_as_float(b2.x << 16); v[r][i].y = __uint_as_float(b2.x & 0xffff0000u); v[r][i].z = __uint_as_float(b2.y << 16); v[r][i].w = __uint_as_float(b2.y & 0xffff0000u); }
            else v[r][i] = ((const float4*)((const float*)xrows_v + (size_t)r * D))[lane + 64 * i];
        }
#pragma unroll
    for (int r = 0; r < NR; ++r) { ss[r] = 0.f;
#pragma unroll
        for (int i = 0; i < 4; ++i) ss[r] += v[r][i].x * v[r][i].x + v[r][i].y * v[r][i].y + v[r][i].z * v[r][i].z + v[r][i].w * v[r][i].w; }
#pragma unroll
    for (int o = 32; o >= 1; o >>= 1)
#pragma unroll
        for (int r = 0; r < NR; ++r) ss[r] += __shfl_xor(ss[r], o);
#pragma unroll
    for (int i = 0; i < 4; ++i) {
        const int col = (lane + 64 * i) * 4;
        const float4 gg = *(const float4*)(g + col), sc = *(const float4*)(mb + scale_off + col), sh = *(const float4*)(mb + shift_off + col);
        const float mx = gg.x * (1.f + sc.x), my = gg.y * (1.f + sc.y), mz = gg.z * (1.f + sc.z), mw = gg.w * (1.f + sc.w);
#pragma unroll
        for (int r = 0; r < NR; ++r) {
            const float rn = rsqrtf(ss[r] * (1.f / D) + EPS);
            v[r][i].x = v[r][i].x * rn * mx + sh.x; v[r][i].y = v[r][i].y * rn * my + sh.y; v[r][i].z = v[r][i].z * rn * mz + sh.z; v[r][i].w = v[r][i].w * rn * mw + sh.w;
            uint2 o; o.x = pk2(v[r][i].x, v[r][i].y); o.y = pk2(v[r][i].z, v[r][i].w);
            *(uint2*)(orows + (size_t)r * D + col) = o;
        }
    }
    if (QUANT) {
#pragma unroll
        for (int r = 0; r < NR; ++r) quant_row<0>(v[r], qrows + (size_t)r * 1024, qscale + r, lane);
    }
}

template <int OFFS, bool SLICED>
__device__ __forceinline__ void quant_row(const float4 (&v)[4], unsigned char* qrow, float* scale_out, int lane) {
    float am = 0.f;
#pragma unroll
    for (int i = 0; i < 4; ++i) am = fmaxf(am, fmaxf(fmaxf(fabsf(v[i].x), fabsf(v[i].y)), fmaxf(fabsf(v[i].z), fabsf(v[i].w))));
    am = wave_max(am);
    const float sc = am > 0.f ? am * (1.f / 127.f) : 1.f, inv = am > 0.f ? 127.f / am : 0.f;
    uint4 o; unsigned w[4];
#pragma unroll
    for (int i = 0; i < 4; ++i) {
        const int q0 = (int)rintf(v[i].x * inv) + OFFS, q1 = (int)rintf(v[i].y * inv) + OFFS, q2 = (int)rintf(v[i].z * inv) + OFFS, q3 = (int)rintf(v[i].w * inv) + OFFS;
        w[i] = (unsigned)(q0 & 255) | ((unsigned)(q1 & 255) << 8) | ((unsigned)(q2 & 255) << 16) | ((unsigned)(q3 & 255) << 24);
    }
    o.x = w[0]; o.y = w[1]; o.z = w[2]; o.w = w[3];
    *(uint4*)(qrow + (SLICED ? (size_t)(lane >> 3) * (16384 * 128) + 16 * (lane & 7) : (size_t)16 * lane)) = o;
    if (lane == 0) *scale_out = sc;
}
__device__ __forceinline__ void quant_table_row(const float* row, unsigned char* qrow, float* scale_out, int lane, bool offs) {
    float4 v[4];
#pragma unroll
    for (int i = 0; i < 4; ++i) v[i] = ((const float4*)row)[lane + 64 * i];
    (void)offs; quant_row<0, true>(v, qrow, scale_out, lane);
}

__device__ __forceinline__ int treduce16(int (&v)[16], int lane) {
#pragma unroll
    for (int o = 8, n = 16; o >= 1; o >>= 1, n >>= 1) {
        const bool upper = (lane & o) != 0;
#pragma unroll
        for (int j = 0; j < n / 2; ++j) {
            const int keep = upper ? v[j + n / 2] : v[j];
            const int send = upper ? v[j] : v[j + n / 2];
            v[j] = keep + __shfl_xor(send, o);
        }
    }
    int t = v[0];
    t += __shfl_xor(t, 16); t += __shfl_xor(t, 32);
    return t;
}

typedef float f32x16m __attribute__((ext_vector_type(16)));
__device__ __forceinline__ void mod_block(const float* __restrict__ c, const float* __restrict__ w_ada, const float* __restrict__ b_ada, float* __restrict__ mod, LAS float* red, int blk, int tid, int lane, int wave) {
    const int r32 = lane & 31, hh = lane >> 5, j0 = 24 * blk;
    f32x16m acc;
#pragma unroll
    for (int r = 0; r < 16; ++r) acc[r] = 0.f;
    const int kb = 128 * wave;
#pragma unroll 8
    for (int s2 = 0; s2 < 64; ++s2) {
        const int k = kb + 2 * s2 + hh;
        const float cv = c[r32 * D + k];
        const float a = cv / (1.f + __expf(-cv));
        const float bw = r32 < 24 ? w_ada[(size_t)k * 6144 + j0 + r32] : 0.f;
        acc = __builtin_amdgcn_mfma_f32_32x32x2f32(a, bw, acc, 0, 0, 0);
    }
#pragma unroll
    for (int r = 0; r < 16; ++r) red[wave * 1024 + ((r & 3) + 8 * (r >> 2) + 4 * hh) * 32 + r32] = acc[r];
    __syncthreads();
    for (int o = tid; o < 32 * 24; o += NTHREADS) {
        const int b = o / 24, j = o - 24 * b; float sum = b_ada[j0 + j];
#pragma unroll
        for (int w = 0; w < 8; ++w) sum += red[w * 1024 + b * 32 + j];
        mod[b * 6144 + j0 + j] = sum;
    }
    __syncthreads();
}

__global__ void __launch_bounds__(NTHREADS, 2) fwd(Args args) {
    extern __shared__ __attribute__((aligned(16))) unsigned char lds_raw[];
    LAS unsigned char* lds = (LAS unsigned char*)lds_raw;
    volatile LAS unsigned* MISC = (volatile LAS unsigned*)(lds + MISC_OFF);
    const int wave = __builtin_amdgcn_readfirstlane(threadIdx.x >> 6);
#define LANE_ID() ((int)__builtin_amdgcn_mbcnt_hi(~0u, __builtin_amdgcn_mbcnt_lo(~0u, 0u)))
    const int G = gridDim.x;
    unsigned char* ws = args.ws;
    unsigned* ctl = (unsigned*)(ws + WS_CTL);
    for (int u = threadIdx.x; u < (LDS_BYTES - LDSCTL_OFF) / 4; u += NTHREADS) ((LAS unsigned*)(lds + LDSCTL_OFF))[u] = 0u;
    __syncthreads();
    XcdBarrier bar = xcd_barrier_post(ctl + CW_BAR + args.li * XCD_BAR_WORDS, MISC + 8);
    const int lo = args.ph_lo, hi = args.ph_hi;
#define IN(k) (lo <= (k) && (k) < hi)
#define BOTH(k) (IN(k) && IN((k) + 1))
    const float* x = args.in[0];
    const float* g_norm_mix = args.in[4];
    const float* w_in = args.in[5];
    const float* w_out = args.in[13];
    const float* g_norm_ffn = args.in[14];
    const float* w_peer_q = args.in[15];
    float* out = args.out;
    float* mod = (float*)(ws + WS_MOD);
    bf16_t* Win_t = (bf16_t*)(ws + WS_WIN_T); bf16_t* Wo_t = (bf16_t*)(ws + WS_WO_T); bf16_t* Wq_t = (bf16_t*)(ws + WS_WQ_T);
    bf16_t* hbuf = (bf16_t*)(ws + WS_HBUF); bf16_t* mixin = (bf16_t*)(ws + WS_MIXIN);
    bf16_t* proj = (bf16_t*)(ws + WS_BIG); bf16_t* qb = (bf16_t*)(ws + WS_BIG); bf16_t* keysb = (bf16_t*)(ws + WS_KEYSB);
    bf16_t* x1b = (bf16_t*)(ws + WS_BIG + 128 * MiB);
    unsigned* maskw = (unsigned*)(ws + WS_MASK); bf16_t* wuvF = (bf16_t*)(ws + WS_WUVF);
    unsigned char* uq = ws + WS_UQ; unsigned char* vq = ws + WS_VQ; float* su = (float*)(ws + WS_SU); float* sv = (float*)(ws + WS_SV);
    unsigned char* xq = ws + WS_XQ; float* sxs = (float*)(ws + WS_SX);
    const int gw = blockIdx.x * NWAVES + wave, NGW = G * NWAVES;
    const int vcu = (G % 8 == 0) ? ((int)blockIdx.x % 8) * (G / 8) + (int)blockIdx.x / 8 : (int)blockIdx.x;

    if (IN(0)) for (int rep_ = 0; rep_ < REPS[0]; ++rep_) {
        const int lane = LANE_ID(), tid = wave * 64 + lane; (void)tid;
        for (int blk = blockIdx.x; blk < 256; blk += G) mod_block(args.in[1], args.in[2], args.in[3], mod, (LAS float*)(lds + RING_OFF), blk, tid, lane, wave);
        if (blockIdx.x == 0 && tid == 0) {
            float s1 = 0.f, s2 = 0.f;
            for (int i = 0; i < 64; ++i) { s1 += args.in[6][i] * args.in[7][i]; s2 += args.in[8][i] * args.in[9][i]; }
            *(float*)(ws + WS_LAM) = expf(s1) - expf(s2) + 0.2f;
        }
        LAS float* scr = (LAS float*)(lds + RING_OFF + wave * 16384);
        constexpr int I_IN = 16 * (NPP / 32), I_O = 16 * 32, I_Q = 16 * 32;
        for (int it = gw; it < I_IN + I_O + I_Q; it += NGW) {
            int r = it;
            if (r < I_IN) { p0_transpose_item(w_in, D, NP, NPP, Win_t, scr, r, lane); continue; } r -= I_IN;
            if (r < I_O) { p0_transpose_item(w_out, D, D, D, Wo_t, scr, r, lane); continue; } r -= I_O;
            p0_transpose_item(w_peer_q, D, D, D, Wq_t, scr, r, lane);
        }
        for (int i = blockIdx.x * NTHREADS + tid; i < 4 * 4 * 4 * 2 * 64 * 8; i += G * NTHREADS) {
            const int j = i & 7, ln = (i >> 3) & 63, s2 = (i >> 9) & 1, db = (i >> 10) & 3, eb = (i >> 12) & 3, hd = i >> 14;
            const int cc = 32 * db + 16 * s2 + 8 * (j >> 2) + 4 * (ln >> 5) + (j & 3), e = 32 * eb + (ln & 31);
            wuvF[i] = f2bf(args.in[12][((size_t)hd * 128 + cc) * 128 + e]);
        }
        for (int i = blockIdx.x * NTHREADS + tid; i < 8 * 2 * 128 * 64; i += G * NTHREADS) keysb[i] = f2bf(args.in[16][i]);
        for (int r = gw; r < 2 * 16384; r += NGW) {
            if (r < 16384) quant_table_row(args.in[17] + (size_t)r * D, uq + (size_t)r * 128, su + r, lane, false);
            else quant_table_row(args.in[18] + (size_t)(r - 16384) * D, vq + (size_t)(r - 16384) * 128, sv + (r - 16384), lane, false);
        }
        if (BOTH(0)) xcd_barrier(bar);
    }
    if (IN(1)) for (int rep_ = 0; rep_ < REPS[1]; ++rep_) {
        const int lane = LANE_ID(), tid = wave * 64 + lane; (void)tid;
        for (int m = 4 * gw; m < T; m += 4 * NGW) norm_mod_rows<false, 4, false>(x + (size_t)m * D, g_norm_mix, mod + (size_t)(m / S) * 6144, MOD_SHIFT_A, MOD_SCALE_A, hbuf + (size_t)m * D, lane, nullptr, nullptr);
        if (BOTH(1)) xcd_barrier(bar);
    }
    if (IN(2)) for (int rep_ = 0; rep_ < REPS[2]; ++rep_) {
        pg8::Gemm g{hbuf, Win_t, T, NPP, D}; pg8::StaticOrder So; So.init(T, NPP, G, (int)blockIdx.x);
        pg8::EpiBf16Plain E{proj, NPP};
        pg8::gemm_phase<pg8::EpiBf16Plain, pg8::StaticOrder, true, true>(lds + RING_OFF, g, So, E);
        if (BOTH(2)) xcd_barrier(bar);
    }
    if (IN(3)) for (int rep_ = 0; rep_ < REPS[3]; ++rep_) {
        const int lane = LANE_ID(), tid = wave * 64 + lane; (void)tid;
        const float lam = *(const float*)(ws + WS_LAM);
        for (int it = vcu; it < 1024; it += G) {
            const int b = it >> 5, h = (it >> 3) & 3, qp = it & 7;
            diff_unit(proj, mixin, args.in[19], lam, args.in[10], lds, b, h, 15 - qp, tid, lane, wave);
            diff_unit(proj, mixin, args.in[19], lam, args.in[10], lds, b, h, qp, tid, lane, wave);
        }
    }
    if (IN(4)) for (int rep_ = 0; rep_ < REPS[4]; ++rep_) {
        const int lane = LANE_ID(), tid = wave * 64 + lane; (void)tid;
        for (int it = vcu; it < 512; it += G) {
            const int b = it >> 4, up = it & 15;
#pragma unroll 1
            for (int k8 = 0; k8 < 8; ++k8) dsa_index_unit(proj, maskw, lds, b, 4 * (k8 < 4 ? 31 - up : up) + (k8 & 3), tid, lane, wave);
        }
        asm volatile("s_waitcnt vmcnt(0)" ::: "memory");
        __syncthreads();
    }
    if (IN(5)) for (int rep_ = 0; rep_ < REPS[5]; ++rep_) {
        const int lane = LANE_ID(), tid = wave * 64 + lane; (void)tid;
        for (int it = vcu; it < 512; it += G) {
            const int b = it >> 4, up = it & 15;
            dsa_attn_unit(proj, maskw, wuvF, args.in[19], args.in[11], mixin, lds, b, 31 - up, tid, lane, wave);
            dsa_attn_unit(proj, maskw, wuvF, args.in[19], args.in[11], mixin, lds, b, up, tid, lane, wave);
        }
        if (BOTH(5)) xcd_barrier(bar);
    }
    if (IN(6)) for (int rep_ = 0; rep_ < REPS[6]; ++rep_) {
        pg8::Gemm g{mixin, Wo_t, T, D, D}; pg8::StaticOrder So; So.init(T, D, G, (int)blockIdx.x);
        pg8::EpiBf16ResB E{x1b, x, mod + MOD_GATE_A};
        pg8::gemm_phase<pg8::EpiBf16ResB, pg8::StaticOrder, true, false>(lds + RING_OFF, g, So, E);
        if (BOTH(6)) xcd_barrier(bar);
    }
    if (IN(7)) for (int rep_ = 0; rep_ < REPS[7]; ++rep_) {
        const int lane = LANE_ID(), tid = wave * 64 + lane; (void)tid;
        for (int m = 4 * gw; m < T; m += 4 * NGW) norm_mod_rows<true, 4, true>(x1b + (size_t)m * D, g_norm_ffn, mod + (size_t)(m / S) * 6144, MOD_SHIFT_F, MOD_SCALE_F, hbuf + (size_t)m * D, lane, xq + (size_t)m * 1024, sxs + m);
        if (BOTH(7)) xcd_barrier(bar);
    }
    if (IN(8)) for (int rep_ = 0; rep_ < REPS[8]; ++rep_) {
        pg8::Gemm g{hbuf, Wq_t, T, D, D}; pg8::StaticOrder So; So.init(T, D, G, (int)blockIdx.x);
        pg8::EpiBf16Plain E{qb, D};
        pg8::gemm_phase<pg8::EpiBf16Plain, pg8::StaticOrder, true, true>(lds + RING_OFF, g, So, E);
        if (BOTH(8)) xcd_barrier(bar);
    }
    if (IN(9)) for (int rep_ = 0; rep_ < REPS[9]; ++rep_) {
        const int lane = LANE_ID();
        for (int base = blockIdx.x * NWAVES; base < T / 32; base += NGW)
            peer_select_wave(base + wave, qb, keysb, (unsigned short*)(ws + WS_EIDX), (float*)(ws + WS_GATE), lds + RING_OFF, wave * 64 + lane, lane);
        asm volatile("s_waitcnt vmcnt(0)" ::: "memory");
    }
    if (IN(10)) for (int rep_ = 0; rep_ < REPS[10]; ++rep_) {
        const int lane = LANE_ID();
        const unsigned short* eidx = (const unsigned short*)(ws + WS_EIDX); const float* gate = (const float*)(ws + WS_GATE);
        bf16_t* ybuf = (bf16_t*)(ws + WS_BIG);
        for (int tile = gw; tile < T / 32; tile += NGW)
            peer_gather_tile(tile, xq, sxs, eidx, gate, uq, vq, su, sv, mod, args.in[20], x1b, ybuf, out, lds + RING_OFF + wave * 16384, lds + 133120 + wave * 3584, lane);
    }
#undef IN
#undef BOTH
}
#ifndef PROBE_PREFIX_N
#define PROBE_PREFIX_N 0
#endif
constexpr int PROBE_PREFIX = PROBE_PREFIX_N;
extern "C" void kernel_launch(void* const* d_in, const int* in_sizes, int n_in, void* d_out, int out_size, void* d_ws, size_t ws_size, hipStream_t stream) {
    static int grid = 0;
    if (grid == 0) {
        if (n_in != 21 || out_size != T * D || ws_size < WS_END) { fprintf(stderr, "kernel_launch: unexpected shapes (n_in %d out %d ws %zu)\n", n_in, out_size, ws_size); grid = -1; return; }
        int dev = 0, cus = 0, per_cu = 0;
        if (hipGetDevice(&dev) != hipSuccess || hipDeviceGetAttribute(&cus, hipDeviceAttributeMultiprocessorCount, dev) != hipSuccess) { grid = -1; return; }
        if (hipFuncSetAttribute((const void*)fwd, hipFuncAttributeMaxDynamicSharedMemorySize, LDS_BYTES) != hipSuccess) { fprintf(stderr, "kernel_launch: hipFuncSetAttribute failed\n"); grid = -1; return; }
        if (hipOccupancyMaxActiveBlocksPerMultiprocessor(&per_cu, (const void*)fwd, NTHREADS, LDS_BYTES) != hipSuccess || per_cu < 1)
            fprintf(stderr, "kernel_launch: occupancy query reports %d workgroups per CU\n", per_cu);
        (void)hipGetLastError();
        grid = cus;
        if (grid != 256) fprintf(stderr, "kernel_launch: %d CUs (expected 256)\n", grid);
    }
    if (grid < 0) return;
    float* out = (float*)d_out;
    unsigned char* ws = (unsigned char*)d_ws;
    (void)hipMemsetAsync(ws + WS_CTL, 0, CTL_ZERO_BYTES, stream);
    Args a{};
    for (int i = 0; i < 21; ++i) a.in[i] = (const float*)d_in[i];
    a.out = out; a.ws = ws;

    if (PROBE_PREFIX > 0) {
        a.ph_lo = 0; a.ph_hi = PROBE_PREFIX; a.li = 1;
        hipLaunchKernelGGL(fwd, dim3(grid), dim3(NTHREADS), LDS_BYTES, stream, a);
    }
    a.ph_lo = 0; a.ph_hi = 11; a.li = 0;
    hipLaunchKernelGGL(fwd, dim3(grid), dim3(NTHREADS), LDS_BYTES, stream, a);
}
```

```cpp
#include <hip/hip_runtime.h>
#include <stdint.h>
#include <stdio.h>

typedef unsigned short bf16_t;
#define LAS __attribute__((address_space(3)))
#define GAS __attribute__((address_space(1)))

constexpr int D = 1024, NB = 32, S = 2048, T = NB * S;
constexpr int NP = 2760, NPP = 2816;
constexpr int C_DQ = 0, C_DK = 512, C_DV = 1024, C_SQ = 1536, C_SKV = 2048, C_IQ = 2176, C_IK = 2688, C_IW = 2752;
constexpr int MOD_SHIFT_A = 0, MOD_SCALE_A = 1024, MOD_GATE_A = 2048, MOD_SHIFT_F = 3072, MOD_SCALE_F = 4096, MOD_GATE_F = 5120;
constexpr float EPS = 1e-6f;
constexpr int NWAVES = 8, NTHREADS = 512;

__device__ __forceinline__ float bf2f(bf16_t v) { return __uint_as_float(((unsigned)v) << 16); }
__device__ __forceinline__ bf16_t f2bf(float f) { unsigned u = __float_as_uint(f); u += 0x7fffu + ((u >> 16) & 1u); return (bf16_t)(u >> 16); }
__device__ __forceinline__ unsigned pk2(float lo, float hi) { return (unsigned)f2bf(lo) | ((unsigned)f2bf(hi) << 16); }

__device__ __forceinline__ int rel_bucket(int n) {
    if (n < 16) return n < 0 ? 0 : n;
    int b = 16;
    b += (n >= 19); b += (n >= 21); b += (n >= 24); b += (n >= 27); b += (n >= 31); b += (n >= 35); b += (n >= 40); b += (n >= 46);
    b += (n >= 52); b += (n >= 59); b += (n >= 67); b += (n >= 77); b += (n >= 87); b += (n >= 99); b += (n >= 113);
    return b;
}

__device__ __forceinline__ float wave_sum(float v) {
#pragma unroll
    for (int o = 32; o >= 1; o >>= 1) v += __shfl_xor(v, o);
    return v;
}
__device__ __forceinline__ float wave_max(float v) {
#pragma unroll
    for (int o = 32; o >= 1; o >>= 1) v = fmaxf(v, __shfl_xor(v, o));
    return v;
}
__device__ __forceinline__ float block_sum(float v, float* red) {
    v = wave_sum(v);
    __syncthreads();
    if ((threadIdx.x & 63) == 0) red[threadIdx.x >> 6] = v;
    __syncthreads();
    return red[0] + red[1] + red[2] + red[3];
}
__device__ __forceinline__ float block_max(float v, float* red) {
    v = wave_max(v);
    __syncthreads();
    if ((threadIdx.x & 63) == 0) red[threadIdx.x >> 6] = v;
    __syncthreads();
    return fmaxf(fmaxf(red[0], red[1]), fmaxf(red[2], red[3]));
}
__device__ __forceinline__ int block_sum_i(int v, int* red) {
#pragma unroll
    for (int o = 32; o >= 1; o >>= 1) v += __shfl_xor(v, o);
    __syncthreads();
    if ((threadIdx.x & 63) == 0) red[threadIdx.x >> 6] = v;
    __syncthreads();
    return red[0] + red[1] + red[2] + red[3];
}

namespace pg8 {
#define PG8_LAS __attribute__((address_space(3)))
typedef unsigned short bf16_t;
typedef short bf16x8 __attribute__((ext_vector_type(8)));
typedef float f32x4 __attribute__((ext_vector_type(4)));
typedef unsigned u32x4 __attribute__((ext_vector_type(4)));
constexpr int BM = 256, BK = 64, HALF = 128, HTB = HALF * BK * 2  , STAGE_BYTES = 8 * HTB, NXCD = 8, WGM = 8;

__host__ __device__ __forceinline__ int lds_byte(int r, int c) { const int st = (r >> 4) * 2 + (c >> 5), rr = r & 15, cc = c & 31, ob = rr * 64 + cc * 2; return st * 1024 + (ob ^ (((ob >> 9) & 1) << 5)); }
__host__ __device__ __forceinline__ void stage_rc(int b, int& R, int& C) { const int st = b / 1024, sb = b % 1024, swz = sb ^ (((sb >> 9) & 1) << 5); R = (st >> 1) * 16 + swz / 64; C = (st & 1) * 32 + (swz % 64) / 2; }
__host__ __device__ __forceinline__ int perm32(int rho) { const int n = rho >> 4, i = rho & 15; return 8 * (i >> 2) + 4 * n + (i & 3); }

struct Unit { int pm, pn; };
struct Gemm { const bf16_t* A; const bf16_t* Bt; int M, N, K; };

struct StaticOrder {
    int nM, nN, nwg, G, c;
    __host__ __device__ void init(int M, int N, int G_, int c_) { nM = M / BM; nN = N / BM; nwg = nM * nN; G = G_; c = c_; }
    __host__ __device__ bool next(int i, Unit& u) const {
        const long L = (long)i * G + c; if (L >= nwg) return false;
        int wgid = (int)L; { const int q = nwg / NXCD, r = nwg % NXCD, xcd = wgid % NXCD, off = wgid / NXCD; wgid = (xcd < r ? xcd * (q + 1) : r * (q + 1) + (xcd - r) * q) + off; }
        const int nig = WGM * nN, gid = wgid / nig, fm = gid * WGM, gsz = (nM - fm) < WGM ? (nM - fm) : WGM;
        u.pm = fm + ((wgid % nig) % gsz); u.pn = (wgid % nig) / gsz; return true;
    }
    __device__ __forceinline__ void a_ready(const Unit&) const {}
    __device__ __forceinline__ void done(const Unit&) const {}
};
__device__ __forceinline__ unsigned cvt_pk_bf16(float lo, float hi) { unsigned r; asm volatile("v_cvt_pk_bf16_f32 %0, %1, %2" : "=v"(r) : "v"(lo), "v"(hi)); return r; }
typedef float f32x2 __attribute__((ext_vector_type(2)));
struct EpiBf16Plain {
    static constexpr bool PERM = true, AFTER_DRAIN = false;
    bf16_t* O; int ldc;
    __device__ __forceinline__ void operator()(const f32x4 (&acc)[2][2][4][2], const Unit& u, int wr, int wc, int fr, int fq) const {
        const int row0 = u.pm * BM + wr * 64 + fr, col0 = u.pn * BM + wc * 32 + 8 * fq;
#pragma unroll
        for (int ai = 0; ai < 2; ++ai)
#pragma unroll
            for (int m = 0; m < 4; ++m) { bf16_t* rowp = O + (size_t)(row0 + ai * HALF + m * 16) * ldc + col0;
#pragma unroll
                for (int bj = 0; bj < 2; ++bj) { const f32x4 v0 = acc[ai][bj][m][0], v1 = acc[ai][bj][m][1];
                    u32x4 w; w.x = cvt_pk_bf16(v0[0], v0[1]); w.y = cvt_pk_bf16(v0[2], v0[3]); w.z = cvt_pk_bf16(v1[0], v1[1]); w.w = cvt_pk_bf16(v1[2], v1[3]);
                    *(u32x4*)(rowp + bj * HALF) = w; } }
    }
};
struct EpiF32Res {
    static constexpr bool PERM = false, AFTER_DRAIN = false;
    float* C; const float* res; const float* gate;
    __device__ __forceinline__ void operator()(const f32x4 (&acc)[2][2][4][2], const Unit& u, int wr, int wc, int fr, int fq) const {
        const int row0 = u.pm * BM + wr * 64 + fr, col0 = u.pn * BM + wc * 32 + 4 * fq;
        f32x4 gv[2][2];
#pragma unroll
        for (int bj = 0; bj < 2; ++bj)
#pragma unroll
            for (int n = 0; n < 2; ++n) gv[bj][n] = res ? *(const f32x4*)(gate + (size_t)(u.pm >> 3) * 6144 + col0 + bj * HALF + n * 16) : (f32x4){1.f, 1.f, 1.f, 1.f};
#pragma unroll
        for (int ai = 0; ai < 2; ++ai)
#pragma unroll
            for (int m = 0; m < 4; ++m) { const size_t off = (size_t)(row0 + ai * HALF + m * 16) * 1024 + col0;
#pragma unroll
                for (int bj = 0; bj < 2; ++bj)
#pragma unroll
                    for (int n = 0; n < 2; ++n) { f32x4 o = acc[ai][bj][m][n] * gv[bj][n];
                        if (res) o = o + *(const f32x4*)(res + off + bj * HALF + n * 16);
                        *(f32x4*)(C + off + bj * HALF + n * 16) = o; } }
    }
};

struct EpiBf16Res {
    static constexpr bool PERM = true, AFTER_DRAIN = false;
    bf16_t* O; const float* res; const float* gate;
    __device__ __forceinline__ void operator()(const f32x4 (&acc)[2][2][4][2], const Unit& u, int wr, int wc, int fr, int fq) const {
        const int row0 = u.pm * BM + wr * 64 + fr, col0 = u.pn * BM + wc * 32 + 8 * fq;
        f32x4 gv[2][2];
#pragma unroll
        for (int bj = 0; bj < 2; ++bj)
#pragma unroll
            for (int n = 0; n < 2; ++n) gv[bj][n] = *(const f32x4*)(gate + (size_t)(u.pm >> 3) * 6144 + col0 + bj * HALF + 4 * n);
#pragma unroll
        for (int ai = 0; ai < 2; ++ai)
#pragma unroll
            for (int m = 0; m < 4; ++m) { const size_t off = (size_t)(row0 + ai * HALF + m * 16) * 1024 + col0;
#pragma unroll
                for (int bj = 0; bj < 2; ++bj) { const f32x4 r0 = *(const f32x4*)(res + off + bj * HALF), r1 = *(const f32x4*)(res + off + bj * HALF + 4);
                    const f32x4 v0 = r0 + acc[ai][bj][m][0] * gv[bj][0], v1 = r1 + acc[ai][bj][m][1] * gv[bj][1];
                    u32x4 w; w.x = cvt_pk_bf16(v0[0], v0[1]); w.y = cvt_pk_bf16(v0[2], v0[3]); w.z = cvt_pk_bf16(v1[0], v1[1]); w.w = cvt_pk_bf16(v1[2], v1[3]);
                    *(u32x4*)(O + off + bj * HALF) = w; } }
    }
};

struct EpiBf16ResB {
    static constexpr bool PERM = true, AFTER_DRAIN = false;
    bf16_t* O; const float* res; const float* gate;
    __device__ __forceinline__ void operator()(const f32x4 (&acc)[2][2][4][2], const Unit& u, int wr, int wc, int fr, int fq) const {
        const int row0 = u.pm * BM + wr * 64 + fr, col0 = u.pn * BM + wc * 32 + 8 * fq;
        f32x4 gv[2][2];
#pragma unroll
        for (int bj = 0; bj < 2; ++bj)
#pragma unroll
            for (int n = 0; n < 2; ++n) gv[bj][n] = *(const f32x4*)(gate + (size_t)(u.pm >> 3) * 6144 + col0 + bj * HALF + 4 * n);
#pragma unroll
        for (int ai = 0; ai < 2; ++ai) {
            f32x4 rr[4][2][2];
#pragma unroll
            for (int m = 0; m < 4; ++m) { const size_t off = (size_t)(row0 + ai * HALF + m * 16) * 1024 + col0;
#pragma unroll
                for (int bj = 0; bj < 2; ++bj) { rr[m][bj][0] = __builtin_nontemporal_load((const f32x4*)(res + off + bj * HALF)); rr[m][bj][1] = __builtin_nontemporal_load((const f32x4*)(res + off + bj * HALF + 4)); } }
            __builtin_amdgcn_sched_barrier(0);
#pragma unroll
            for (int m = 0; m < 4; ++m) { const size_t off = (size_t)(row0 + ai * HALF + m * 16) * 1024 + col0;
#pragma unroll
                for (int bj = 0; bj < 2; ++bj) { const f32x4 v0 = rr[m][bj][0] + acc[ai][bj][m][0] * gv[bj][0], v1 = rr[m][bj][1] + acc[ai][bj][m][1] * gv[bj][1];
                    u32x4 w; w.x = cvt_pk_bf16(v0[0], v0[1]); w.y = cvt_pk_bf16(v0[2], v0[3]); w.z = cvt_pk_bf16(v1[0], v1[1]); w.w = cvt_pk_bf16(v1[2], v1[3]);
                    *(u32x4*)(O + off + bj * HALF) = w; } }
            __builtin_amdgcn_sched_barrier(0);
        }
    }
};

template <class Epi, class Sched, bool ALIGN_EPI = false, bool SP2 = false>
__device__ __forceinline__ void gemm_phase(PG8_LAS unsigned char* lds, const Gemm g, const Sched& S, const Epi& E) {
    const int tid = threadIdx.x, wid = __builtin_amdgcn_readfirstlane(tid >> 6), lane = tid & 63, wr = wid >> 2, wc = wid & 3, fr = lane & 15, fq = lane >> 4;
    const int K = g.K, nt = K / BK;
    unsigned voffA[2], voffB[2];
#pragma unroll
    for (int i = 0; i < 2; ++i) { int R, C; stage_rc(tid * 16 + i * 8192, R, C); const int Rb = Epi::PERM ? ((R & ~31) + perm32(R & 31)) : R;
        voffA[i] = (unsigned)(R * K + C) * 2u; voffB[i] = (unsigned)(Rb * K + C) * 2u; }
    const size_t kstep = (size_t)(BK * 2);
    const size_t hstep = (size_t)HALF * K * 2;
    const size_t tstep = 2 * hstep;
    const unsigned ldsw = (unsigned)wid * 1024u;
    const int aoff = lds_byte(wr * 64 + fr, fq * 8), boff = lds_byte(wc * 32 + fr, fq * 8);
#define PG8_SA(b, h) (((b) * 2 + (h)) * HTB)
#define PG8_SB(b, h) ((4 + (b) * 2 + (h)) * HTB)
#define PG8_STAGE(bufoff, gbase, voff) do { _Pragma("unroll") for (int _i = 0; _i < 2; ++_i) \
        __builtin_amdgcn_global_load_lds((const unsigned*)((const char*)(gbase) + (voff)[_i]), (PG8_LAS unsigned*)(lds + (bufoff) + ldsw + _i * 8192), 16, 0, 0); } while (0)
#define PG8_LDA(dst, b, h) do { _Pragma("unroll") for (int m = 0; m < 4; ++m) _Pragma("unroll") for (int k = 0; k < 2; ++k) dst[m][k] = *(const PG8_LAS bf16x8*)(lds + PG8_SA(b, h) + aoff + m * 2048 + k * 1024); } while (0)
#define PG8_LDB(dst, b, h) do { _Pragma("unroll") for (int n = 0; n < 2; ++n) _Pragma("unroll") for (int k = 0; k < 2; ++k) dst[n][k] = *(const PG8_LAS bf16x8*)(lds + PG8_SB(b, h) + boff + n * 2048 + k * 1024); } while (0)
#define PG8_MMA(ai, bj, At, Bt) do { __builtin_amdgcn_s_setprio(1); _Pragma("unroll") for (int m = 0; m < 4; ++m) _Pragma("unroll") for (int n = 0; n < 2; ++n) _Pragma("unroll") for (int k = 0; k < 2; ++k) \
        acc[ai][bj][m][n] = __builtin_amdgcn_mfma_f32_16x16x32_bf16(Bt[n][k], At[m][k], acc[ai][bj][m][n], 0, 0, 0); __builtin_amdgcn_s_setprio(0); } while (0)
#define PG8_WAIT_V(n) asm volatile("s_waitcnt vmcnt(" #n ")" ::: "memory")
#define PG8_WAIT_L(n) asm volatile("s_waitcnt lgkmcnt(" #n ")" ::: "memory")
#define PG8_BAR __builtin_amdgcn_s_barrier()
#define PG8_SCHED __builtin_amdgcn_sched_barrier(0)
    Unit cur, nxt; int ui = 0;
    if (!S.next(0, cur)) return;
    f32x4 acc[2][2][4][2];
#pragma unroll
    for (int a = 0; a < 2; ++a)
#pragma unroll
        for (int b = 0; b < 2; ++b)
#pragma unroll
            for (int m = 0; m < 4; ++m)
#pragma unroll
                for (int n = 0; n < 2; ++n) acc[a][b][m][n] = (f32x4){0.f, 0.f, 0.f, 0.f};
    bf16x8 At[4][2], B0[2][2], B1[2][2];
    const char* cA = (const char*)g.A + (size_t)cur.pm * tstep; const char* cB = (const char*)g.Bt + (size_t)cur.pn * tstep;
    S.a_ready(cur);
    if constexpr (SP2) {
        PG8_STAGE(PG8_SB(0, 0), cB, voffB); PG8_STAGE(PG8_SB(0, 1), cB + hstep, voffB); PG8_STAGE(PG8_SA(0, 0), cA, voffA); PG8_STAGE(PG8_SA(0, 1), cA + hstep, voffA);
        if (wr == 1) PG8_BAR;
        PG8_WAIT_V(2); PG8_BAR;
        PG8_STAGE(PG8_SB(1, 0), cB + kstep, voffB); PG8_STAGE(PG8_SA(1, 0), cA + kstep, voffA); PG8_STAGE(PG8_SB(1, 1), cB + hstep + kstep, voffB);
        PG8_WAIT_V(6); PG8_BAR;
    } else {
        PG8_STAGE(PG8_SB(0, 0), cB, voffB); PG8_STAGE(PG8_SA(0, 0), cA, voffA); PG8_STAGE(PG8_SB(0, 1), cB + hstep, voffB); PG8_STAGE(PG8_SA(0, 1), cA + hstep, voffA);
        if (wr == 1) PG8_BAR;
        PG8_WAIT_V(4); PG8_BAR;
        PG8_STAGE(PG8_SB(1, 0), cB + kstep, voffB); PG8_STAGE(PG8_SA(1, 0), cA + kstep, voffA); PG8_STAGE(PG8_SB(1, 1), cB + hstep + kstep, voffB);
        PG8_WAIT_V(6); PG8_BAR;
    }
    for (;;) {
        const bool has_next = S.next(ui + 1, nxt);
        const char* nA = has_next ? (const char*)g.A + (size_t)nxt.pm * tstep : cA; const char* nB = has_next ? (const char*)g.Bt + (size_t)nxt.pn * tstep : cB;
        for (int t = 0; t < nt; t += 2) {
            const bool last = (t == nt - 2);
            const char* a1 = cA + (size_t)(t + 1) * kstep;
            const char* a2 = last ? nA : cA + (size_t)(t + 2) * kstep; const char* b2 = last ? nB : cB + (size_t)(t + 2) * kstep;
            const char* a3 = a2 + kstep; const char* b3 = b2 + kstep;
            if (last && has_next) S.a_ready(nxt);
            if constexpr (SP2) {
            PG8_LDB(B0, 0, 0); PG8_LDB(B1, 0, 1); PG8_SCHED; PG8_LDA(At, 0, 0); PG8_STAGE(PG8_SA(1, 1), a1 + hstep, voffA);
            PG8_WAIT_V(8); PG8_WAIT_L(0); PG8_BAR; PG8_MMA(0, 0, At, B0); PG8_MMA(0, 1, At, B1); PG8_BAR; PG8_SCHED;
            PG8_LDA(At, 0, 1); PG8_STAGE(PG8_SB(0, 0), b2, voffB); PG8_STAGE(PG8_SB(0, 1), b2 + hstep, voffB); PG8_STAGE(PG8_SA(0, 0), a2, voffA);
            PG8_WAIT_V(8); PG8_WAIT_L(0); PG8_BAR; PG8_MMA(1, 0, At, B0); PG8_MMA(1, 1, At, B1); PG8_BAR; PG8_SCHED;
            PG8_LDB(B0, 1, 0); PG8_LDB(B1, 1, 1); PG8_SCHED; PG8_LDA(At, 1, 0); PG8_STAGE(PG8_SA(0, 1), a2 + hstep, voffA);
            PG8_WAIT_V(8); PG8_WAIT_L(0); PG8_BAR; PG8_MMA(0, 0, At, B0); PG8_MMA(0, 1, At, B1); PG8_BAR; PG8_SCHED;
            PG8_LDA(At, 1, 1); PG8_STAGE(PG8_SB(1, 0), b3, voffB); PG8_STAGE(PG8_SB(1, 1), b3 + hstep, voffB); PG8_STAGE(PG8_SA(1, 0), a3, voffA);
            PG8_WAIT_V(8); PG8_WAIT_L(0); PG8_BAR; PG8_MMA(1, 0, At, B0); PG8_MMA(1, 1, At, B1); PG8_BAR; PG8_SCHED;
            } else {
            PG8_LDB(B0, 0, 0); PG8_SCHED; PG8_LDA(At, 0, 0); PG8_STAGE(PG8_SA(1, 1), a1 + hstep, voffA);
            PG8_WAIT_L(8); PG8_BAR; PG8_WAIT_L(0); PG8_MMA(0, 0, At, B0); PG8_BAR; PG8_SCHED;
            PG8_LDB(B1, 0, 1); PG8_STAGE(PG8_SB(0, 0), b2, voffB);
            PG8_BAR; PG8_WAIT_L(0); PG8_MMA(0, 1, At, B1); PG8_BAR;
            PG8_LDA(At, 0, 1); PG8_STAGE(PG8_SA(0, 0), a2, voffA);
            PG8_BAR; PG8_WAIT_L(0); PG8_MMA(1, 0, At, B0); PG8_BAR; PG8_SCHED;
            PG8_STAGE(PG8_SB(0, 1), b2 + hstep, voffB);
            PG8_WAIT_V(6); PG8_BAR; PG8_MMA(1, 1, At, B1); PG8_BAR;
            PG8_LDB(B0, 1, 0); PG8_SCHED; PG8_LDA(At, 1, 0); PG8_STAGE(PG8_SA(0, 1), a2 + hstep, voffA);
            PG8_WAIT_L(8); PG8_BAR; PG8_WAIT_L(0); PG8_MMA(0, 0, At, B0); PG8_BAR; PG8_SCHED;
            PG8_LDB(B1, 1, 1); PG8_STAGE(PG8_SB(1, 0), b3, voffB);
            PG8_BAR; PG8_WAIT_L(0); PG8_MMA(0, 1, At, B1); PG8_BAR;
            PG8_LDA(At, 1, 1); PG8_STAGE(PG8_SA(1, 0), a3, voffA);
            PG8_BAR; PG8_WAIT_L(0); PG8_MMA(1, 0, At, B0); PG8_BAR; PG8_SCHED;
            PG8_STAGE(PG8_SB(1, 1), b3 + hstep, voffB);
            PG8_WAIT_V(6); PG8_BAR; PG8_MMA(1, 1, At, B1); PG8_BAR;
            }
        }
        if constexpr (ALIGN_EPI) { if (wr == 0) PG8_BAR; }
        if constexpr (!Epi::AFTER_DRAIN) { E(acc, cur, wr, wc, fr, fq); S.done(cur); }
        if (!has_next) break;
#pragma unroll
        for (int a = 0; a < 2; ++a)
#pragma unroll
            for (int b = 0; b < 2; ++b)
#pragma unroll
                for (int m = 0; m < 4; ++m)
#pragma unroll
                    for (int n = 0; n < 2; ++n) acc[a][b][m][n] = (f32x4){0.f, 0.f, 0.f, 0.f};
        cur = nxt; cA = nA; cB = nB; ++ui;
        if constexpr (ALIGN_EPI) { if (wr == 1) PG8_BAR; }
    }
    PG8_WAIT_V(0);
    if constexpr (!ALIGN_EPI) { if (wr == 0) PG8_BAR; }
    PG8_BAR;
    if constexpr (Epi::AFTER_DRAIN) { E.fused(acc, cur, wr, wc, fr, fq, lds, wid, lane); S.done(cur); }
#undef PG8_SA
#undef PG8_SB
#undef PG8_STAGE
#undef PG8_LDA
#undef PG8_LDB
#undef PG8_MMA
#undef PG8_WAIT_V
#undef PG8_WAIT_L
#undef PG8_BAR
#undef PG8_SCHED
}
}
#define XB_TMO      128
#define XB_XCNT(j)  (256  + 64 * (j))
#define XB_XSUB(j)  (1280 + 64 * (j))
#define XB_XGEN(j)  (2304 + 64 * (j))
#define XB_TOP      3328
#define XB_TOPGEN   3392
#define XCD_BAR_WORDS 3456
#define XB_SPIN_CAP (1u << 18)

__device__ __forceinline__ unsigned xb_ld(unsigned* p)              { return __hip_atomic_load(p, __ATOMIC_RELAXED, __HIP_MEMORY_SCOPE_AGENT); }
__device__ __forceinline__ unsigned xb_add(unsigned* p, unsigned v) { return __hip_atomic_fetch_add(p, v, __ATOMIC_RELAXED, __HIP_MEMORY_SCOPE_AGENT); }
__device__ __forceinline__ unsigned xb_xcc_id() { return (unsigned)__builtin_amdgcn_s_getreg((3 << 11) | 20) & 0xFu; }
#define XB_SPIN(cond, bar) do { unsigned _sp = 0; while (cond) { __builtin_amdgcn_s_sleep(1); \
    if ((++_sp & 255u) == 0u) { if (xb_ld(&(bar)[XB_TMO])) break; if (_sp > XB_SPIN_CAP) { atomicAdd(&(bar)[XB_TMO], 1u); break; } } } } while (0)

struct XcdBarrier {
    unsigned* bar; unsigned x;
    volatile LAS unsigned* st;
};

__device__ __forceinline__ XcdBarrier xcd_barrier_post(unsigned* bar, volatile LAS unsigned* st) {
    XcdBarrier b; b.bar = bar; b.x = xb_xcc_id(); b.st = st;
    if (threadIdx.x == 0) (void)xb_add(&bar[XB_XCNT(b.x)], 1u);
    return b;
}
__device__ __forceinline__ void xcd_barrier_complete(unsigned* bar, unsigned x, unsigned& nloc, unsigned& nx) {
    const unsigned G = gridDim.x * gridDim.y * gridDim.z;
    unsigned sum, cnt, mine, sp = 0u;
    for (;;) {
        sum = 0u; cnt = 0u; mine = 0u;
#pragma unroll
        for (unsigned j = 0; j < 16; ++j) { const unsigned c = xb_ld(&bar[XB_XCNT(j)]); sum += c; cnt += (c > 0u) ? 1u : 0u; mine = (j == x) ? c : mine; }
        if (sum == G) break;
        __builtin_amdgcn_s_sleep(1);
        if ((++sp & 255u) == 0u) { if (xb_ld(&bar[XB_TMO])) break; if (sp > XB_SPIN_CAP) { atomicAdd(&bar[XB_TMO], 1u); break; } }
    }
    nloc = mine > 0u ? mine : 1u; nx = cnt > 0u ? cnt : 1u;
}

__device__ __forceinline__ void xcd_barrier(const XcdBarrier& b) {
    asm volatile("s_waitcnt vmcnt(0)" ::: "memory");
    __syncthreads();
    if (threadIdx.x == 0) {
        unsigned* bar = b.bar;
        __builtin_amdgcn_s_waitcnt(0);
        unsigned nloc = b.st[0], nx = b.st[1];
        if (nloc == 0u) { xcd_barrier_complete(bar, b.x, nloc, nx); b.st[0] = nloc; b.st[1] = nx; }
        const unsigned old = xb_add(&bar[XB_XSUB(b.x)], 1u);
        const unsigned gen = old / nloc;
        if (old + 1u == (gen + 1u) * nloc) {
            __builtin_amdgcn_fence(__ATOMIC_RELEASE, "agent");
            asm volatile("s_waitcnt vmcnt(0)" ::: "memory");
            const unsigned og = xb_add(&bar[XB_TOP], 1u);
            const unsigned tg = og / nx;
            if (og + 1u == (tg + 1u) * nx) xb_add(&bar[XB_TOPGEN], 1u);
            else XB_SPIN(xb_ld(&bar[XB_TOPGEN]) == tg, bar);
            __builtin_amdgcn_fence(__ATOMIC_ACQUIRE, "agent");
            xb_add(&bar[XB_XGEN(b.x)], 1u);
            asm volatile("s_waitcnt vmcnt(0)" ::: "memory");
        } else {
            XB_SPIN(xb_ld(&bar[XB_XGEN(b.x)]) == gen, bar);
            __builtin_amdgcn_fence(__ATOMIC_ACQUIRE, "agent");
            asm volatile("s_waitcnt vmcnt(0)" ::: "memory");
        }
    }
    __syncthreads();
}

typedef short bf16x8_t __attribute__((ext_vector_type(8)));
typedef unsigned u32x4_t __attribute__((ext_vector_type(4)));
typedef unsigned u32x2_t __attribute__((ext_vector_type(2)));
typedef short s16x4_t __attribute__((ext_vector_type(4)));
typedef float f32x16_t __attribute__((ext_vector_type(16)));
typedef float f32x4_t __attribute__((ext_vector_type(4)));
typedef float f32x2_t __attribute__((ext_vector_type(2)));
typedef __bf16 bf16x2_t __attribute__((ext_vector_type(2)));
#define MFMA32(a, b, c) __builtin_amdgcn_mfma_f32_32x32x16_bf16((a), (b), (c), 0, 0, 0)
constexpr float LOG2E = 1.4426950408889634f;

__device__ __forceinline__ float vmax2(float a, float b) { float r; asm("v_max_f32 %0, %1, %2" : "=v"(r) : "v"(a), "v"(b)); return r; }
__device__ __forceinline__ float vmax3(float a, float b, float c) { float r; asm("v_max3_f32 %0, %1, %2, %3" : "=v"(r) : "v"(a), "v"(b), "v"(c)); return r; }
__device__ __forceinline__ int crow(int r, int hi) { return (r & 3) + 8 * (r >> 2) + 4 * hi; }
__device__ __forceinline__ unsigned cvtpk(float lo, float hi) { f32x2_t v = {lo, hi}; bf16x2_t b = __builtin_convertvector(v, bf16x2_t); return __builtin_bit_cast(unsigned, b); }
__device__ __forceinline__ s16x4_t vtr(const LAS unsigned char* p) { return __builtin_bit_cast(s16x4_t, __builtin_amdgcn_ds_read_tr16_b64_v4i16((LAS s16x4_t*)p)); }
__device__ __forceinline__ float xhalf_max(float m) { auto rr = __builtin_amdgcn_permlane32_swap(__float_as_uint(m), __float_as_uint(m), false, false); return fmaxf(__uint_as_float(rr[0]), __uint_as_float(rr[1])); }
__device__ __forceinline__ float xhalf_sum(float m) { auto rr = __builtin_amdgcn_permlane32_swap(__float_as_uint(m), __float_as_uint(m), false, false); return __uint_as_float(rr[0]) + __uint_as_float(rr[1]); }
__device__ __forceinline__ bf16x8_t pack8(const f32x16_t& p, int s) {
    u32x4_t u; u.x = cvtpk(p[8 * s + 0], p[8 * s + 1]); u.y = cvtpk(p[8 * s + 2], p[8 * s + 3]); u.z = cvtpk(p[8 * s + 4], p[8 * s + 5]); u.w = cvtpk(p[8 * s + 6], p[8 * s + 7]);
    return __builtin_bit_cast(bf16x8_t, u);
}

__device__ __forceinline__ void glds16(const void* sbase, unsigned voff, unsigned lds_base) {
    unsigned sv; asm volatile("s_mov_b32 %0, m0\n\ts_mov_b32 m0, %3\n\ts_nop 0\n\tglobal_load_lds_dwordx4 %1, %2\n\ts_mov_b32 m0, %0" : "=&s"(sv) : "v"(voff), "s"(sbase), "s"(lds_base) : "memory"); }
#define ATT_WAIT_BAR(N) asm volatile("s_waitcnt vmcnt(" #N ") lgkmcnt(0)\n\ts_barrier" ::: "memory")
constexpr int DA_SLOT = 32768, DA_BIAS = 133120, DA_LDS = 133120 + 1024;
__device__ __forceinline__ void diff_unit(const bf16_t* __restrict__ proj, bf16_t* __restrict__ mixin, const float* __restrict__ rel_bias, const float lam, const float* __restrict__ g_subln,
                                          LAS unsigned char* lds, int b, int h, int qt, int tid, int lane, int wave) {
    const int rg = wave >> 1, map = wave & 1, r32 = lane & 31, hh = lane >> 5;
    const int t0 = 128 * qt + 32 * rg;
    const int ntb = 2 * qt + 2;
    const int ntw = (t0 + 31) / 64 + 1;
    const size_t rowbase = (size_t)b * S;
    LAS float* biasT = (LAS float*)(lds + DA_BIAS);
    if (tid < 256) biasT[tid] = rel_bias[rel_bucket(tid) * 8 + h] * LOG2E;
    const float c31 = rel_bias[31 * 8 + h] * LOG2E;
    bf16x8_t qf[4];
    { const bf16_t* qrow = proj + (rowbase + t0 + r32) * NPP + C_DQ + h * 128 + map * 64 + 8 * hh;
#pragma unroll
      for (int ks = 0; ks < 4; ++ks) qf[ks] = *(const bf16x8_t*)(qrow + 16 * ks); }
    unsigned ko0, ko1, vo0, vo1;
    { const int pa = wave, pb = wave + 8;
      const int ra = 4 * pa + (lane >> 4), rb = 4 * pb + (lane >> 4), pc = lane & 15;
      ko0 = (unsigned)(ra * NPP + C_DK + h * 128 + 8 * (pc ^ (ra & 15))) * 2u;
      ko1 = (unsigned)(rb * NPP + C_DK + h * 128 + 8 * (pc ^ (rb & 15))) * 2u;
      const int ka = 16 * (pa & 3) + (lane >> 2), kb2 = 16 * (pb & 3) + (lane >> 2), cc = lane & 3;
      vo0 = (unsigned)(ka * NPP + C_DV + h * 128 + 8 * (4 * (pa >> 2) + cc)) * 2u;
      vo1 = (unsigned)(kb2 * NPP + C_DV + h * 128 + 8 * (4 * (pb >> 2) + cc)) * 2u; }
    const bf16_t* pbase = proj + rowbase * NPP;
    const unsigned lds0 = (unsigned)(size_t)lds;
    const unsigned dsta = (unsigned)__builtin_amdgcn_readfirstlane((int)(lds0 + wave * 1024)), dstb = dsta + 8192;
#define DA_DMA(j) do { const bf16_t* sb_ = pbase + (size_t)(64 * (j)) * NPP; const unsigned sl_ = (unsigned)(((j) & 3) * DA_SLOT); \
        glds16(sb_, ko0, dsta + sl_); glds16(sb_, ko1, dstb + sl_); glds16(sb_, vo0, dsta + sl_ + 16384); glds16(sb_, vo1, dstb + sl_ + 16384); } while (0)
    DA_DMA(0);
    if (ntb > 1) { DA_DMA(1); ATT_WAIT_BAR(4); } else ATT_WAIT_BAR(0);
    f32x16_t O[4];
#pragma unroll
    for (int i = 0; i < 4; ++i)
#pragma unroll
        for (int r = 0; r < 16; ++r) O[i][r] = 0.f;
    float m = -INFINITY, l = 0.f;
    const int t = t0 + r32;
    const float SC = 0.125f * LOG2E;
    const int i16 = lane & 15, tq = i16 >> 2, tp = i16 & 3, g1 = (lane >> 4) & 1;
    const unsigned vrd = (4 * hh + tq) * 64 + g1 * 32 + tp * 8;
    const unsigned krd = r32 * 256;
    bf16x8_t pb[2][2];
#define DA_QKSM(j) do { \
        const LAS unsigned char* kb = lds + (j & 3) * DA_SLOT; \
        f32x16_t s0, s1; \
        _Pragma("unroll") \
        for (int r = 0; r < 16; ++r) { s0[r] = 0.f; s1[r] = 0.f; } \
        _Pragma("unroll") \
        for (int ks = 0; ks < 4; ++ks) { \
            const int chunk = map * 8 + 2 * ks + hh; \
            const unsigned co = (unsigned)((chunk ^ (r32 & 15)) * 16); \
            const bf16x8_t a0 = *(const LAS bf16x8_t*)(kb + krd + co), a1 = *(const LAS bf16x8_t*)(kb + krd + 32 * 256 + co); \
            s0 = MFMA32(a0, qf[ks], s0); s1 = MFMA32(a1, qf[ks], s1); \
        } \
        const int kbase = 64 * j + 4 * hh; \
        const bool nearb = (t0 - (64 * j + 63)) < 113; \
        const bool diag = (64 * j + 63) > t0; \
        float alpha, ps = 0.f; \
        if (nearb) { \
        _Pragma("unroll") \
            for (int r = 0; r < 16; ++r) { const int key = kbase + (r & 3) + 8 * (r >> 2); \
                int d0 = t - key, d1 = d0 - 32; d0 = d0 < 0 ? 0 : d0; d1 = d1 < 0 ? 0 : d1; \
                s0[r] = s0[r] * SC + biasT[d0]; s1[r] = s1[r] * SC + biasT[d1]; \
                if (diag) { if (key > t) s0[r] = -INFINITY; if (key + 32 > t) s1[r] = -INFINITY; } } \
            float mt = vmax3(s0[0], s1[0], s0[1]); \
        _Pragma("unroll") \
            for (int r = 1; r < 16; ++r) mt = r < 15 ? vmax3(mt, s1[r], s0[r + 1]) : vmax2(mt, s1[r]); \
            mt = xhalf_max(mt); \
            const float mn = vmax2(m, mt); \
            alpha = __builtin_amdgcn_exp2f(m - mn); \
            m = mn; \
        _Pragma("unroll") \
            for (int r = 0; r < 16; ++r) { s0[r] = __builtin_amdgcn_exp2f(s0[r] - mn); s1[r] = __builtin_amdgcn_exp2f(s1[r] - mn); ps += s0[r] + s1[r]; } \
        } else { \
             \
            float mr = vmax3(s0[0], s1[0], s0[1]); \
        _Pragma("unroll") \
            for (int r = 1; r < 16; ++r) mr = r < 15 ? vmax3(mr, s1[r], s0[r + 1]) : vmax2(mr, s1[r]); \
            mr = xhalf_max(mr); \
            const float mn = vmax2(m, mr * SC + c31); \
            alpha = __builtin_amdgcn_exp2f(m - mn); \
            m = mn; \
            const float off = c31 - mn; \
        _Pragma("unroll") \
            for (int r = 0; r < 16; ++r) { s0[r] = __builtin_amdgcn_exp2f(s0[r] * SC + off); s1[r] = __builtin_amdgcn_exp2f(s1[r] * SC + off); ps += s0[r] + s1[r]; } \
        } \
        l = l * alpha + ps; \
        if (__any(alpha != 1.f)) { \
        _Pragma("unroll") \
            for (int i = 0; i < 4; ++i) \
        _Pragma("unroll") \
                for (int r = 0; r < 16; ++r) O[i][r] *= alpha; \
        } \
        pb[0][0] = pack8(s0, 0); pb[0][1] = pack8(s0, 1); pb[1][0] = pack8(s1, 0); pb[1][1] = pack8(s1, 1); \
    } while (0)
#define DA_PV(jt) do { \
        const LAS unsigned char* vb = lds + (jt & 3) * DA_SLOT + 16384; \
        _Pragma("unroll") \
        for (int sub = 0; sub < 2; ++sub) \
        _Pragma("unroll") \
            for (int s = 0; s < 2; ++s) \
        _Pragma("unroll") \
                for (int dblk = 0; dblk < 4; ++dblk) { \
                    const LAS unsigned char* vp = vb + dblk * 4096 + (32 * sub + 16 * s) * 64 + vrd; \
                    const s16x4_t lo = vtr(vp), hi = vtr(vp + 8 * 64); \
                    const bf16x8_t va = __builtin_shufflevector(lo, hi, 0, 1, 2, 3, 4, 5, 6, 7); \
                    O[dblk] = MFMA32(va, pb[sub][s], O[dblk]); \
                } \
    } while (0)
    const int grp = wave >> 2;
    int jp = -1;
    for (int j = 0; j < ntb; ++j) {
        const bool pf = j + 2 < ntb;
        if (pf) DA_DMA(j + 2);
        if (jp >= 0) { DA_PV(jp); jp = -1; }
        if (j < ntw) { DA_QKSM(j); if (grp == 0) DA_PV(j); else jp = j; }
        if (pf) ATT_WAIT_BAR(4); else ATT_WAIT_BAR(0);
    }
    if (jp >= 0) DA_PV(jp);
#undef DA_QKSM
#undef DA_PV
    __syncthreads();
#undef DA_DMA
    l = xhalf_sum(l);
    const float inv = (map ? lam : 1.f) / l;
    LAS float* ex = (LAS float*)(lds + rg * 16384);
    if (map == 1) {
#pragma unroll
        for (int i = 0; i < 4; ++i)
#pragma unroll
            for (int r = 0; r < 16; ++r) ex[(i * 16 + r) * 64 + lane] = O[i][r] * inv;
    }
    __syncthreads();
    if (map == 0) {
        float ss = 0.f;
#pragma unroll
        for (int i = 0; i < 4; ++i)
#pragma unroll
            for (int r = 0; r < 16; ++r) { const float o = O[i][r] * inv - ex[(i * 16 + r) * 64 + lane]; O[i][r] = o; ss += o * o; }
        ss = xhalf_sum(ss);
        const float rn = rsqrtf(ss * (1.f / 128.f) + EPS) * 0.8f;
        bf16_t* orow = mixin + (rowbase + t) * D + h * 128;
#pragma unroll
        for (int i = 0; i < 4; ++i)
#pragma unroll
            for (int g = 0; g < 4; ++g) { const int d0 = 32 * i + 8 * g + 4 * hh; const float4 gs = *(const float4*)(g_subln + d0);
                uint2 o; o.x = cvtpk(O[i][4 * g + 0] * rn * gs.x, O[i][4 * g + 1] * rn * gs.y); o.y = cvtpk(O[i][4 * g + 2] * rn * gs.z, O[i][4 * g + 3] * rn * gs.w);
                *(uint2*)(orow + d0) = o; }
    }
    __syncthreads();
}

__device__ __forceinline__ unsigned fkey(float f) { f = f + 0.0f; const unsigned u = __float_as_uint(f); return (u & 0x80000000u) ? ~u : (u | 0x80000000u); }
__device__ __forceinline__ int wave_sum_dpp(int v) {
    v += __builtin_amdgcn_update_dpp(0, v, 0x111, 0xf, 0xf, true);
    v += __builtin_amdgcn_update_dpp(0, v, 0x112, 0xf, 0xf, true);
    v += __builtin_amdgcn_update_dpp(0, v, 0x114, 0xf, 0xf, true);
    v += __builtin_amdgcn_update_dpp(0, v, 0x118, 0xf, 0xf, true);
    v += __builtin_amdgcn_update_dpp(0, v, 0x142, 0xa, 0xf, true);
    v += __builtin_amdgcn_update_dpp(0, v, 0x143, 0xc, 0xf, true);
    return __builtin_amdgcn_readlane(v, 63);
}
__device__ __forceinline__ void bit_transpose32(unsigned (&A)[32]) {
#pragma unroll
    for (int s = 0; s < 5; ++s) { const int j = 16 >> s; const unsigned m = s == 0 ? 0x0000FFFFu : s == 1 ? 0x00FF00FFu : s == 2 ? 0x0F0F0F0Fu : s == 3 ? 0x33333333u : 0x55555555u;
#pragma unroll
        for (int k = 0; k < 32; ++k) if (!(k & j)) { const unsigned a = A[k], b = A[k + j]; A[k] = (a & m) | ((b << j) & ~m); A[k + j] = ((a >> j) & m) | (b & ~m); } }
}
template <int NI>
__device__ __forceinline__ void dsa_select_pair(const LAS float* sc, unsigned* __restrict__ maskw, size_t rowbase, int t_base, int lane, int wave) {
    {
        const int tlA = 2 * wave, tA = t_base + tlA, tB = tA + 1, nkA = tA + 1, nkB = tB + 1;
        unsigned* mrowA = maskw + (rowbase + tA) * 64; unsigned* mrowB = mrowA + 64;
        const bool smallA = nkA <= 256, smallB = nkB <= 256;
        unsigned PA[32], PB[32];
#pragma unroll
        for (int i = 0; i < 32; ++i) {
            if (i < NI) { const int idx = lane + 64 * i;
                const float vA = sc[tlA * 2048 + (idx < nkA ? idx : 0)], vB = sc[(tlA + 1) * 2048 + (idx < nkB ? idx : 0)];
                PA[i] = idx < nkA ? fkey(vA) : 0u; PB[i] = idx < nkB ? fkey(vB) : 0u; }
            else { PA[i] = 0u; PB[i] = 0u; } }
        bit_transpose32(PA); bit_transpose32(PB);
        unsigned gtA = 0u, eqA = 0xFFFFFFFFu, gtB = 0u, eqB = 0xFFFFFFFFu, selA = 0u, selB = 0u;
        bool doneA = smallA, doneB = smallB, exactA = false, exactB = false;
#pragma unroll
        for (int bit = 31; bit >= 0; --bit) if (!(doneA && doneB)) {
            const unsigned geA = gtA | (eqA & PA[bit]), geB = gtB | (eqB & PB[bit]);
            const int tot2 = wave_sum_dpp(__builtin_popcount(geA) | (__builtin_popcount(geB) << 16));
            const int totA = tot2 & 0xffff, totB = tot2 >> 16;
            if (!doneA) { if (totA >= 256) { eqA &= PA[bit]; if (totA == 256) { selA = geA; exactA = true; doneA = true; } } else { gtA = geA; eqA &= ~PA[bit]; } }
            if (!doneB) { if (totB >= 256) { eqB &= PB[bit]; if (totB == 256) { selB = geB; exactB = true; doneB = true; } } else { gtB = geB; eqB &= ~PB[bit]; } }
        }
#pragma unroll 1
        for (int tt = 0; tt < 2; ++tt) {
            const int t = tt ? tB : tA; unsigned* mrow = tt ? mrowB : mrowA; const bool small = tt ? smallB : smallA, exact = tt ? exactB : exactA;
            if (small) {
                const int w0 = 32 * lane;
                unsigned v = 0u;
                if (w0 + 31 <= t) v = 0xFFFFFFFFu; else if (w0 <= t) v = (1u << (t - w0 + 1)) - 1u;
                mrow[lane] = v;
            } else {
                unsigned sel = tt ? selB : selA;
                if (!exact) {
                    const unsigned gt = tt ? gtB : gtA, eq = tt ? eqB : eqA;
                    const int need = 256 - wave_sum_dpp(__builtin_popcount(gt)); int running = 0;
                    const unsigned long long lt = (1ull << lane) - 1ull;
                    sel = gt;
#pragma unroll
                    for (int i = 0; i < NI; ++i) {
                        const bool e = (eq >> i) & 1u; const unsigned long long be = __ballot(e);
                        const int rank = running + __builtin_popcountll(be & lt);
                        if (e && rank < need) sel |= 1u << i;
                        running += __builtin_popcountll(be);
                    }
                }
                unsigned long long mine = 0ull;
#pragma unroll
                for (int i = 0; i < NI; ++i) { const unsigned long long bal = __ballot(((sel >> i) & 1u) != 0u); if (lane == i) mine = bal; }
                if (lane < 32) *(unsigned long long*)(mrow + 2 * lane) = lane < NI ? mine : 0ull;
            }
        }
    }
}
__device__ __forceinline__ void dsa_index_unit(const bf16_t* __restrict__ proj, unsigned* __restrict__ maskw, LAS unsigned char* lds, int b, int u16, int tid, int lane, int wave) {
    const int t_base = 16 * u16, ntile = ((t_base + 15) >> 5) + 1;
    const size_t rowbase = (size_t)b * S;
    LAS float* sc = (LAS float*)lds;
    const int r32 = lane & 31, hh = lane >> 5;
    {
        LAS float* wl = (LAS float*)(lds + 132096);
        if (tid < 128) wl[tid] = bf2f(proj[(rowbase + t_base + (tid >> 3)) * NPP + C_IW + (tid & 7)]) * (0.35355339059327373f * 0.125f);
        const int hsel = (r32 >> 2) & 1, q = (r32 & 3) + 4 * (r32 >> 3), tokl = 2 * hsel + (q >> 3), head = q & 7;
        LAS unsigned char* afi = lds + 133120;
#pragma unroll
        for (int cc = 0; cc < 2; ++cc) { const int c = tid + 512 * cc, crt = c >> 8, cks = (c >> 6) & 3, chh = (c >> 5) & 1, cr = c & 31;
            const int chs = (cr >> 2) & 1, cq = (cr & 3) + 4 * (cr >> 3), ctok = 2 * chs + (cq >> 3), chead = cq & 7;
            const bf16x8_t cv = *(const bf16x8_t*)(proj + (rowbase + t_base + 4 * crt + ctok) * NPP + C_IQ + chead * 64 + 8 * chh + 16 * cks);
            *(LAS bf16x8_t*)(afi + c * 16) = cv; }
        bf16x8_t bfr[4], bnx[4];
        const bf16_t* bp0 = proj + (rowbase + r32) * NPP + C_IK + 8 * hh;
        if (wave < ntile) {
#pragma unroll
            for (int ks = 0; ks < 4; ++ks) bnx[ks] = *(const bf16x8_t*)(bp0 + (size_t)(32 * wave) * NPP + 16 * ks);
        }
        __syncthreads();
        bf16x8_t af[4][4];
#pragma unroll
        for (int rt = 0; rt < 4; ++rt)
#pragma unroll
            for (int ks = 0; ks < 4; ++ks) af[rt][ks] = *(const LAS bf16x8_t*)(afi + ((((rt * 4 + ks) * 2 + hh) * 32 + r32) * 16));
        (void)tokl; (void)head;
        for (int tile = wave; tile < ntile; tile += 8) {
#pragma unroll
            for (int ks = 0; ks < 4; ++ks) bfr[ks] = bnx[ks];
            if (tile + 8 < ntile) {
#pragma unroll
                for (int ks = 0; ks < 4; ++ks) bnx[ks] = *(const bf16x8_t*)(bp0 + (size_t)(32 * (tile + 8)) * NPP + 16 * ks);
            }
            const int key = 32 * tile + r32;
#pragma unroll
            for (int rt = 0; rt < 4; ++rt) {
                f32x16_t acc;
#pragma unroll
                for (int r = 0; r < 16; ++r) acc[r] = 0.f;
#pragma unroll
                for (int ks = 0; ks < 4; ++ks) acc = MFMA32(af[rt][ks], bfr[ks], acc);
                const int tl = 4 * rt + 2 * hh;
                const LAS f32x4_t* w4 = (const LAS f32x4_t*)(wl + tl * 8);
                const f32x4_t wa0 = w4[0], wa1 = w4[1], wb0 = w4[2], wb1 = w4[3];
                float sA = wa0.x * fmaxf(acc[0], 0.f) + wa0.y * fmaxf(acc[1], 0.f) + wa0.z * fmaxf(acc[2], 0.f) + wa0.w * fmaxf(acc[3], 0.f)
                         + wa1.x * fmaxf(acc[4], 0.f) + wa1.y * fmaxf(acc[5], 0.f) + wa1.z * fmaxf(acc[6], 0.f) + wa1.w * fmaxf(acc[7], 0.f);
                float sB = wb0.x * fmaxf(acc[8], 0.f) + wb0.y * fmaxf(acc[9], 0.f) + wb0.z * fmaxf(acc[10], 0.f) + wb0.w * fmaxf(acc[11], 0.f)
                         + wb1.x * fmaxf(acc[12], 0.f) + wb1.y * fmaxf(acc[13], 0.f) + wb1.z * fmaxf(acc[14], 0.f) + wb1.w * fmaxf(acc[15], 0.f);
                const int tA = t_base + tl;
                sc[tl * 2048 + key] = key <= tA ? sA : -INFINITY;
                sc[(tl + 1) * 2048 + key] = key <= tA + 1 ? sB : -INFINITY;
            }
        }
    }
    __syncthreads();
    {
        const int ni = (t_base + 16 + 63) >> 6;
        if (ni <= 8) dsa_select_pair<8>(sc, maskw, rowbase, t_base, lane, wave);
        else if (ni <= 16) dsa_select_pair<16>(sc, maskw, rowbase, t_base, lane, wave);
        else if (ni <= 24) dsa_select_pair<24>(sc, maskw, rowbase, t_base, lane, wave);
        else dsa_select_pair<32>(sc, maskw, rowbase, t_base, lane, wave);
    }
    __syncthreads();
}

constexpr int DB_KV = 0, DB_BIAS = 32768, DB_Q = 36864, DB_LDS = 36864 + 65536;
__device__ __forceinline__ void dsa_attn_unit(const bf16_t* __restrict__ proj, const unsigned* __restrict__ maskw, const bf16_t* __restrict__ wuvF, const float* __restrict__ rel_bias, const float* __restrict__ g_kv,
                                              bf16_t* __restrict__ mixin, LAS unsigned char* lds, int b, int u64, int tid, int lane, int wave) {
    const int head = wave & 3, tgrp = wave >> 2, r32 = lane & 31, hh = lane >> 5;
    const int t0 = 64 * u64 + 32 * tgrp, t = t0 + r32;
    const int ntb = u64 + 1;
    const size_t rowbase = (size_t)b * S;
    LAS float* biasT = (LAS float*)(lds + DB_BIAS);
    for (int i = tid; i < 1024; i += NTHREADS) biasT[i] = rel_bias[rel_bucket(i & 255) * 8 + 4 + (i >> 8)] * LOG2E;
    const float c31 = rel_bias[31 * 8 + 4 + head] * LOG2E;
    bf16x8_t qreg[8];
    { const bf16_t* qrow = proj + (rowbase + t) * NPP + C_SQ + head * 128 + 8 * hh;
#pragma unroll
      for (int ks = 0; ks < 8; ++ks) qreg[ks] = *(const bf16x8_t*)(qrow + 16 * ks); }
    const int skey = tid >> 4, sc = tid & 15;
    const bf16_t* sg = proj + (rowbase + skey) * NPP + C_SKV + 8 * sc;
    const unsigned soff0 = (sc >> 2) * 4096 + skey * 64 + (((sc & 3) ^ ((skey >> 2) & 3)) * 16), soff1 = soff0 + 32 * 64;
    u32x4_t raw0, raw1; u32x2_t mw, mwn;
    const unsigned* mrow = maskw + (rowbase + t) * 64;
#define DB_LOAD(j) do { const size_t o_ = (size_t)(64 * (j)) * NPP; raw0 = *(const u32x4_t*)(sg + o_); raw1 = *(const u32x4_t*)(sg + o_ + (size_t)32 * NPP); mwn = *(const u32x2_t*)(mrow + 2 * (j)); } while (0)
#define DB_NORM1(raw, off) do { float f_[8]; float ss_ = 0.f; \
        _Pragma("unroll") for (int jj = 0; jj < 4; ++jj) { f_[2 * jj] = __uint_as_float(raw[jj] << 16); f_[2 * jj + 1] = __uint_as_float(raw[jj] & 0xffff0000u); ss_ += f_[2 * jj] * f_[2 * jj] + f_[2 * jj + 1] * f_[2 * jj + 1]; } \
        ss_ += __shfl_xor(ss_, 1); ss_ += __shfl_xor(ss_, 2); ss_ += __shfl_xor(ss_, 4); ss_ += __shfl_xor(ss_, 8); \
        const float rr_ = rsqrtf(ss_ * (1.f / 128.f) + EPS); u32x4_t o_; const float4 ga_ = *(const float4*)(g_kv + 8 * sc), gb_ = *(const float4*)(g_kv + 8 * sc + 4); const float gk[8] = {ga_.x, ga_.y, ga_.z, ga_.w, gb_.x, gb_.y, gb_.z, gb_.w}; \
        _Pragma("unroll") for (int jj = 0; jj < 4; ++jj) o_[jj] = cvtpk(f_[2 * jj] * rr_ * gk[2 * jj], f_[2 * jj + 1] * rr_ * gk[2 * jj + 1]); \
        *(LAS u32x4_t*)(kvb_ + (off)) = o_; } while (0)
#define DB_WRITE(bf) do { LAS unsigned char* kvb_ = lds + DB_KV + (bf) * 16384; DB_NORM1(raw0, soff0); DB_NORM1(raw1, soff1); } while (0)
    DB_LOAD(0); DB_WRITE(0); mw = mwn;
    __syncthreads();
    f32x16_t O[4];
#pragma unroll
    for (int i = 0; i < 4; ++i)
#pragma unroll
        for (int r = 0; r < 16; ++r) O[i][r] = 0.f;
    float m = -1e30f, l = 0.f;
    const float SC = 0.08838834764831845f * LOG2E;
    const int i16 = lane & 15, tq = i16 >> 2, tp = i16 & 3, g1 = (lane >> 4) & 1;
    const unsigned vrd_lo = (4 * hh + tq) * 64 + (((2 * g1 + (tp >> 1)) ^ (hh & 3)) * 16) + 8 * (tp & 1);
    const unsigned vrd_hi = (4 * hh + 8 + tq) * 64 + (((2 * g1 + (tp >> 1)) ^ ((hh + 2) & 3)) * 16) + 8 * (tp & 1);
    const unsigned kx = (unsigned)((r32 >> 2) & 3);
    const LAS float* bT = biasT + head * 256;
    for (int j = 0; j < ntb; ++j) {
        if (j + 1 < ntb) DB_LOAD(j + 1);
        {
            const LAS unsigned char* kvb = lds + DB_KV + (j & 1) * 16384;
            const bool nearb = (t0 - (64 * j + 63)) < 113;
#pragma unroll
            for (int sub = 0; sub < 2; ++sub) {
                f32x16_t s0;
#pragma unroll
                for (int r = 0; r < 16; ++r) s0[r] = 0.f;
                const LAS unsigned char* kvs = kvb + sub * (32 * 64);
#pragma unroll
                for (int ks = 0; ks < 8; ++ks) {
                    const int c16 = 2 * ks + hh;
                    const unsigned ao = (unsigned)((c16 >> 2) * 4096 + r32 * 64) + (((unsigned)(c16 & 3) ^ kx) * 16u);
                    const bf16x8_t a0 = *(const LAS bf16x8_t*)(kvs + ao);
                    const bf16x8_t qk = qreg[ks];
                    s0 = MFMA32(a0, qk, s0);
                }
                const int kbase = 64 * j + 32 * sub + 4 * hh;
                const unsigned w0 = (sub ? mw.y : mw.x) >> (4 * hh);
                float alpha, ps = 0.f;
                if (nearb) {
#pragma unroll
                    for (int r = 0; r < 16; ++r) { const int key = kbase + (r & 3) + 8 * (r >> 2);
                        int d0 = t - key; d0 = d0 < 0 ? 0 : d0;
                        s0[r] = s0[r] * SC + bT[d0]; }
#pragma unroll
                    for (int r = 0; r < 16; ++r) { const int bp = (r & 3) + 8 * (r >> 2); if (!((w0 >> bp) & 1u)) s0[r] = -INFINITY; }
                    float mt = vmax3(s0[0], s0[1], s0[2]);
#pragma unroll
                    for (int r = 3; r < 15; r += 2) mt = vmax3(mt, s0[r], s0[r + 1]);
                    mt = vmax2(mt, s0[15]);
                    mt = xhalf_max(mt);
                    const float mn = vmax2(m, mt);
                    alpha = __builtin_amdgcn_exp2f(m - mn);
                    m = mn;
#pragma unroll
                    for (int r = 0; r < 16; ++r) { s0[r] = __builtin_amdgcn_exp2f(s0[r] - mn); ps += s0[r]; }
                } else {
#pragma unroll
                    for (int r = 0; r < 16; ++r) { const int bp = (r & 3) + 8 * (r >> 2); if (!((w0 >> bp) & 1u)) s0[r] = -INFINITY; }
                    float mr = vmax3(s0[0], s0[1], s0[2]);
#pragma unroll
                    for (int r = 3; r < 15; r += 2) mr = vmax3(mr, s0[r], s0[r + 1]);
                    mr = vmax2(mr, s0[15]);
                    mr = xhalf_max(mr);
                    const float mn = vmax2(m, mr * SC + c31);
                    alpha = __builtin_amdgcn_exp2f(m - mn);
                    m = mn;
                    const float off = c31 - mn;
#pragma unroll
                    for (int r = 0; r < 16; ++r) { s0[r] = __builtin_amdgcn_exp2f(s0[r] * SC + off); ps += s0[r]; }
                }
                l = l * alpha + ps;
                if (__any(alpha != 1.f)) {
#pragma unroll
                    for (int i = 0; i < 4; ++i)
#pragma unroll
                        for (int r = 0; r < 16; ++r) O[i][r] *= alpha;
                }
                bf16x8_t pb[2];
                pb[0] = pack8(s0, 0); pb[1] = pack8(s0, 1);
#pragma unroll
                for (int s = 0; s < 2; ++s)
#pragma unroll
                    for (int dblk = 0; dblk < 4; ++dblk) {
                        const LAS unsigned char* vp = kvs + dblk * 4096 + (16 * s) * 64;
                        const s16x4_t lo = vtr(vp + vrd_lo), hi = vtr(vp + vrd_hi);
                        const bf16x8_t va = __builtin_shufflevector(lo, hi, 0, 1, 2, 3, 4, 5, 6, 7);
                        O[dblk] = MFMA32(va, pb[s], O[dblk]);
                    }
            }
        }
        if (j + 1 < ntb) { DB_WRITE((j + 1) & 1); mw = mwn; }
        __syncthreads();
    }
#undef DB_LOAD
#undef DB_NORM1
#undef DB_WRITE
    l = xhalf_sum(l);
    const float inv = 1.f / l;
#pragma unroll
    for (int i = 0; i < 4; ++i)
#pragma unroll
        for (int r = 0; r < 16; ++r) O[i][r] *= inv;
    bf16x8_t ob[4][2];
#pragma unroll
    for (int i = 0; i < 4; ++i) { ob[i][0] = pack8(O[i], 0); ob[i][1] = pack8(O[i], 1); }
    bf16_t* orow = mixin + (rowbase + t) * D + 512 + head * 128;
    u32x2_t po[4][4];
#pragma unroll 1
    for (int e2 = 0; e2 < 2; ++e2) {
        bf16x8_t wa[2][8];
#pragma unroll
        for (int q = 0; q < 2; ++q)
#pragma unroll
            for (int i = 0; i < 4; ++i)
#pragma unroll
                for (int s = 0; s < 2; ++s) wa[q][2 * i + s] = *(const bf16x8_t*)(wuvF + ((((size_t)(head * 4 + 2 * e2 + q) * 4 + i) * 2 + s) * 64 + lane) * 8);
#pragma unroll
        for (int q = 0; q < 2; ++q) {
            f32x16_t acc;
#pragma unroll
            for (int r = 0; r < 16; ++r) acc[r] = 0.f;
#pragma unroll
            for (int i = 0; i < 4; ++i)
#pragma unroll
                for (int s = 0; s < 2; ++s) acc = MFMA32(wa[q][2 * i + s], ob[i][s], acc);
#pragma unroll
            for (int g = 0; g < 4; ++g) { u32x2_t o; o.x = cvtpk(acc[4 * g + 0], acc[4 * g + 1]); o.y = cvtpk(acc[4 * g + 2], acc[4 * g + 3]);
                if (e2 == 0) po[q][g] = o; else po[2 + q][g] = o; }
        }
    }
#pragma unroll
    for (int eb = 0; eb < 4; ++eb)
#pragma unroll
        for (int g = 0; g < 4; ++g) *(u32x2_t*)(orow + 32 * eb + 8 * g + 4 * hh) = po[eb][g];
}

__device__ __forceinline__ unsigned fkey_raw(float f) { const unsigned u = __float_as_uint(f); return (u & 0x80000000u) ? ~u : (u | 0x80000000u); }
__device__ __forceinline__ float fkey_inv(unsigned k) { const unsigned u = (k & 0x80000000u) ? (k & 0x7fffffffu) : ~k; return __uint_as_float(u); }
__device__ __forceinline__ unsigned ps_fmax(unsigned a, unsigned b) { unsigned r; asm("v_max_f32 %0, %1, %2" : "=v"(r) : "v"(a), "v"(b)); return r; }
__device__ __forceinline__ unsigned ps_fmin(unsigned a, unsigned b) { unsigned r; asm("v_min_f32 %0, %1, %2" : "=v"(r) : "v"(a), "v"(b)); return r; }
#define PS_CE(a, b) do { const unsigned hi_ = ps_fmax((a), (b)); const unsigned lo_ = ps_fmin((a), (b)); (a) = hi_; (b) = lo_; } while (0)
__device__ __forceinline__ void sort16_desc(unsigned (&k)[16]) {
    PS_CE(k[0], k[1]); PS_CE(k[2], k[3]); PS_CE(k[0], k[2]); PS_CE(k[1], k[3]); PS_CE(k[1], k[2]); PS_CE(k[4], k[5]); PS_CE(k[6], k[7]); PS_CE(k[4], k[6]); PS_CE(k[5], k[7]); PS_CE(k[5], k[6]); PS_CE(k[0], k[4]); PS_CE(k[2], k[6]); PS_CE(k[2], k[4]); PS_CE(k[1], k[5]); PS_CE(k[3], k[7]); PS_CE(k[3], k[5]); PS_CE(k[1], k[2]); PS_CE(k[3], k[4]); PS_CE(k[5], k[6]); PS_CE(k[8], k[9]); PS_CE(k[10], k[11]); PS_CE(k[8], k[10]); PS_CE(k[9], k[11]); PS_CE(k[9], k[10]); PS_CE(k[12], k[13]); PS_CE(k[14], k[15]); PS_CE(k[12], k[14]); PS_CE(k[13], k[15]); PS_CE(k[13], k[14]); PS_CE(k[8], k[12]); PS_CE(k[10], k[14]); PS_CE(k[10], k[12]); PS_CE(k[9], k[13]); PS_CE(k[11], k[15]); PS_CE(k[11], k[13]); PS_CE(k[9], k[10]); PS_CE(k[11], k[12]); PS_CE(k[13], k[14]); PS_CE(k[0], k[8]); PS_CE(k[4], k[12]); PS_CE(k[4], k[8]); PS_CE(k[2], k[10]); PS_CE(k[6], k[14]); PS_CE(k[6], k[10]); PS_CE(k[2], k[4]); PS_CE(k[6], k[8]); PS_CE(k[10], k[12]); PS_CE(k[1], k[9]); PS_CE(k[5], k[13]); PS_CE(k[5], k[9]); PS_CE(k[3], k[11]); PS_CE(k[7], k[15]); PS_CE(k[7], k[11]); PS_CE(k[3], k[5]); PS_CE(k[7], k[9]); PS_CE(k[11], k[13]); PS_CE(k[1], k[2]); PS_CE(k[3], k[4]); PS_CE(k[5], k[6]); PS_CE(k[7], k[8]); PS_CE(k[9], k[10]); PS_CE(k[11], k[12]); PS_CE(k[13], k[14]);
}
__device__ __forceinline__ void sort9_desc(unsigned (&k)[9]) {
    PS_CE(k[0], k[1]); PS_CE(k[2], k[3]); PS_CE(k[0], k[2]); PS_CE(k[1], k[3]); PS_CE(k[1], k[2]); PS_CE(k[4], k[5]); PS_CE(k[6], k[7]); PS_CE(k[4], k[6]); PS_CE(k[5], k[7]); PS_CE(k[5], k[6]); PS_CE(k[0], k[4]); PS_CE(k[2], k[6]); PS_CE(k[2], k[4]); PS_CE(k[1], k[5]); PS_CE(k[3], k[7]); PS_CE(k[3], k[5]); PS_CE(k[1], k[2]); PS_CE(k[3], k[4]); PS_CE(k[5], k[6]); PS_CE(k[0], k[8]); PS_CE(k[4], k[8]); PS_CE(k[2], k[4]); PS_CE(k[6], k[8]); PS_CE(k[3], k[5]); PS_CE(k[1], k[2]); PS_CE(k[3], k[4]); PS_CE(k[5], k[6]); PS_CE(k[7], k[8]);
}
__device__ __forceinline__ void merge16_top9(unsigned (&a)[16], const unsigned (&b)[9]) {
#pragma unroll
    for (int i = 7; i < 16; ++i) a[i] = ps_fmax(a[i], b[15 - i]);
#pragma unroll
    for (int j = 8; j > 0; j >>= 1)
#pragma unroll
        for (int i = 0; i < 16; ++i) { const int l = i ^ j; if (l > i) PS_CE(a[i], a[l]); }
}
__device__ __forceinline__ void merge16_top(unsigned (&a)[16], const unsigned (&b)[16]) {
#pragma unroll
    for (int i = 0; i < 16; ++i) a[i] = ps_fmax(a[i], b[15 - i]);
#pragma unroll
    for (int j = 8; j > 0; j >>= 1)
#pragma unroll
        for (int i = 0; i < 16; ++i) { const int l = i ^ j; if (l > i) PS_CE(a[i], a[l]); }
}
__device__ __forceinline__ unsigned xhalf_get(unsigned x, int hh) { auto rr = __builtin_amdgcn_permlane32_swap(x, x, false, false); return hh ? rr[0] : rr[1]; }
__device__ __forceinline__ void top16_of_pair(unsigned (&g0)[16], unsigned (&g1)[16], unsigned (&g2)[16], unsigned (&g3)[16], int hh) {
    sort16_desc(g0); sort16_desc(g1); sort16_desc(g2); sort16_desc(g3);
    merge16_top(g0, g1); merge16_top(g2, g3); merge16_top(g0, g2);
#pragma unroll
    for (int i = 0; i < 16; ++i) g1[i] = xhalf_get(g0[i], hh);
    merge16_top(g0, g1);
}
__device__ __forceinline__ void peer_select_wave(int tile, const bf16_t* __restrict__ qb, const bf16_t* __restrict__ keysb, unsigned short* __restrict__ eidx, float* __restrict__ gate, LAS unsigned char* kimg, int tid, int lane,
                                                 const float* __restrict__ rsu, const float* __restrict__ rsv, float* __restrict__ susel) {
    const int r32 = lane & 31, hh = lane >> 5;
    const int tok = tile * 32 + r32;
    const bf16_t* qrow0 = qb + (size_t)tok * D + 8 * hh;
    int kofs = 0; asm volatile("" : "+s"(kofs));
    const bf16_t* kch0; const bf16_t* kch1;
    { const int c0 = tid, c1 = tid + 512;
      kch0 = keysb + kofs + (size_t)(32 * (c0 >> 8) + (c0 & 31)) * 64 + 8 * ((c0 >> 5) & 1) + 16 * ((c0 >> 6) & 3);
      kch1 = keysb + kofs + (size_t)(32 * (c1 >> 8) + (c1 & 31)) * 64 + 8 * ((c1 >> 5) & 1) + 16 * ((c1 >> 6) & 3); }
    const LAS unsigned char* krd = kimg + (hh * 32 + r32) * 16;
    unsigned L1[16], L2[16];
#pragma unroll
    for (int i = 0; i < 16; ++i) { L1[i] = 0u; L2[i] = 0u; }
    bf16x8_t qfr[4], ka[4];
    unsigned tneg = 4u * hh, tpos = tneg ^ 127u;
    asm volatile("" : "+v"(tneg), "+v"(tpos));
#define PSW_LOADQ(HP) do { _Pragma("unroll") for (int ks = 0; ks < 4; ++ks) qfr[ks] = __builtin_nontemporal_load((const bf16x8_t*)(qrow0 + (HP) * 64 + 16 * ks)); } while (0)
#define PSW_LOADK(HP, KT) do { _Pragma("unroll") for (int ks = 0; ks < 4; ++ks) ka[ks] = *(const LAS bf16x8_t*)(krd + ((HP) & 1) * 16384 + ((KT) * 4 + ks) * 1024); } while (0)
#define PSW_FETCH(HP) do { kf0 = *(const bf16x8_t*)(kch0 + (size_t)(HP) * 128 * 64); kf1 = *(const bf16x8_t*)(kch1 + (size_t)(HP) * 128 * 64); } while (0)
#define PSW_PUT(HP) do { *(LAS bf16x8_t*)(kimg + ((HP) & 1) * 16384 + tid * 16) = kf0; *(LAS bf16x8_t*)(kimg + ((HP) & 1) * 16384 + (tid + 512) * 16) = kf1; } while (0)
#define PSW_MFMA() do { _Pragma("unroll") for (int r = 0; r < 16; ++r) acc[r] = 0.f; \
        _Pragma("unroll") for (int ks = 0; ks < 4; ++ks) acc = MFMA32(ka[ks], qfr[ks], acc); } while (0)
#define PSW_KEYS(KT) do { _Pragma("unroll") for (int r = 0; r < 16; ++r) { const unsigned C_ = 32 * (KT) + (r & 3) + 8 * (r >> 2); const unsigned ub = __float_as_uint(acc[r]); g[KT][r] = (ub & ~127u) | (((int)ub < 0 ? tneg : tpos) ^ C_); } } while (0)
    bf16x8_t kf0, kf1;
    PSW_LOADQ(0); PSW_FETCH(0);
    __syncthreads();
    PSW_PUT(0);
    __syncthreads();
    PSW_LOADK(0, 0);
#pragma unroll 1
    for (int hp = 0; hp < 16; ++hp) {
        const int h = hp >> 1, p = hp & 1, hn = hp + 1 < 16 ? hp + 1 : 15;
        unsigned g[4][16]; f32x16_t acc;
        PSW_FETCH(hn);
        PSW_MFMA(); PSW_LOADK(hp, 1);
        __builtin_amdgcn_sched_barrier(0);
        PSW_KEYS(0);
        PSW_MFMA(); PSW_LOADK(hp, 2);
        __builtin_amdgcn_sched_barrier(0);
        PSW_KEYS(1);
        PSW_MFMA(); PSW_LOADK(hp, 3);
        __builtin_amdgcn_sched_barrier(0);
        PSW_KEYS(2);
        PSW_MFMA(); PSW_LOADQ(hn);
        PSW_PUT(hp + 1);
        __builtin_amdgcn_sched_barrier(0);
        PSW_KEYS(3);
        top16_of_pair(g[0], g[1], g[2], g[3], hh);
#pragma unroll
        for (int i = 0; i < 16; ++i) { L1[i] = p == 0 ? g[0][i] : L1[i]; L2[i] = p == 0 ? L2[i] : g[0][i]; }
        if (p == 1) {
            float s1[16], s2[16];
#pragma unroll
            for (int i = 0; i < 16; ++i) { s1[i] = __uint_as_float(L1[i] & ~127u); s2[i] = __uint_as_float(L2[i] & ~127u); }
            unsigned c0[16], c1[16], c9[9];
#pragma unroll
            for (int i = 0; i < 16; ++i) c0[i] = 0xff800000u;
#pragma unroll
            for (int i = 0; i < 9; ++i) c9[i] = 0xff800000u;
            {
                int n = 0;
#pragma unroll
                for (int i = 0; i < 16; ++i)
#pragma unroll
                    for (int j = 0; j < 16; ++j) if ((i + 1) * (j + 1) <= 16) {
                        const unsigned sb = __float_as_uint(s1[i] + s2[j]); const unsigned ck = (sb & ~255u) | (unsigned)((sb >> 31) ? (i * 16 + j) : 255 - (i * 16 + j));
                        const int slot = n >> 1;
                        if (slot < 16) c0[slot] = ((n & 1) == hh) ? ck : c0[slot]; else c9[slot - 16] = ((n & 1) == hh) ? ck : c9[slot - 16];
                        ++n;
                    }
            }
            sort16_desc(c0); sort9_desc(c9); merge16_top9(c0, c9);
#pragma unroll
            for (int i = 0; i < 16; ++i) c1[i] = xhalf_get(c0[i], hh);
            merge16_top(c0, c1);
            float ev[16]; float su = 0.f;
            const float tmax = __uint_as_float(c0[0] & ~255u);
#pragma unroll
            for (int r = 0; r < 16; ++r) { ev[r] = __expf(__uint_as_float(c0[r] & ~255u) - tmax); su += ev[r]; }
            const float inv = 1.f / su;
            unsigned short* eo = eidx + (size_t)tok * 128 + h * 16 + 8 * hh; float* go = gate + (size_t)tok * 128 + h * 16 + 8 * hh;
            unsigned T1[4], T2[4];
#pragma unroll
            for (int w = 0; w < 4; ++w) { unsigned d1 = 0u, d2 = 0u;
#pragma unroll
                for (int bq = 0; bq < 4; ++bq) { const unsigned ka_ = L1[4 * w + bq], kb_ = L2[4 * w + bq];
                    const unsigned ia = ~(ka_ ^ (unsigned)((int)ka_ >> 31)) & 127u, ib = ~(kb_ ^ (unsigned)((int)kb_ >> 31)) & 127u;
                    d1 |= ia << (8 * bq); d2 |= ib << (8 * bq); }
                T1[w] = d1; T2[w] = d2; }
            int ei[8]; float gv[8];
#pragma unroll
            for (int r = 0; r < 8; ++r) {
                const unsigned ck = hh ? c0[8 + r] : c0[r]; const float e = hh ? ev[8 + r] : ev[r];
                const int pos = (ck >> 31) ? (int)(ck & 255u) : 255 - (int)(ck & 255u), pi = pos >> 4, pj = pos & 15;
                const unsigned s1_ = ((unsigned)pi & 7u) | 0x0c0c0c00u, s2_ = ((unsigned)pj & 7u) | 0x0c0c0c00u;
                const unsigned a1 = __builtin_amdgcn_perm(T1[1], T1[0], s1_), b1 = __builtin_amdgcn_perm(T1[3], T1[2], s1_);
                const unsigned a2 = __builtin_amdgcn_perm(T2[1], T2[0], s2_), b2 = __builtin_amdgcn_perm(T2[3], T2[2], s2_);
                const int i1 = (int)(pi >= 8 ? b1 : a1), i2 = (int)(pj >= 8 ? b2 : a2);
                ei[r] = i1 * 128 + i2; gv[r] = e * inv;
            }
            float sus[8];
#pragma unroll
            for (int r = 0; r < 8; ++r) { sus[r] = rsu[ei[r]]; gv[r] *= rsv[ei[r]]; }
            __builtin_amdgcn_s_waitcnt(0x0F70);
            *(uint4*)(eo) = make_uint4((unsigned)ei[0] | ((unsigned)ei[1] << 16), (unsigned)ei[2] | ((unsigned)ei[3] << 16), (unsigned)ei[4] | ((unsigned)ei[5] << 16), (unsigned)ei[6] | ((unsigned)ei[7] << 16));
            *(float4*)(go) = make_float4(gv[0], gv[1], gv[2], gv[3]); *(float4*)(go + 4) = make_float4(gv[4], gv[5], gv[6], gv[7]);
            { float* so = susel + (size_t)tok * 128 + h * 16 + 8 * hh; *(float4*)(so) = make_float4(sus[0], sus[1], sus[2], sus[3]); *(float4*)(so + 4) = make_float4(sus[4], sus[5], sus[6], sus[7]); }
        }
        __syncthreads();
        PSW_LOADK(hp + 1, 0);
    }
#undef PSW_FETCH
#undef PSW_PUT
#undef PSW_LOADQ
#undef PSW_LOADK
#undef PSW_MFMA
#undef PSW_KEYS
}

__device__ __forceinline__ float gelu_erf(float a) { return 0.5f * a * (1.f + erff(a * 0.70710678118654752f)); }
template <int CTRL> __device__ __forceinline__ int dpp_i(int v) { return __builtin_amdgcn_update_dpp(0, v, CTRL, 0xf, 0xf, false); }
template <int CTRL> __device__ __forceinline__ float dpp_f(float v) { return __int_as_float(__builtin_amdgcn_update_dpp(0, __float_as_int(v), CTRL, 0xf, 0xf, false)); }
constexpr int DPP_XOR1 = 0xB1, DPP_XOR2 = 0x4E, DPP_HMIRROR = 0x141, DPP_ROR8 = 0x128;

__device__ __forceinline__ void peer_gather_tile(int tile, const unsigned char* __restrict__ xq, const float* __restrict__ sxs, const unsigned short* __restrict__ eidx, const float* __restrict__ gate,
                                                 const unsigned char* __restrict__ uq, const unsigned char* __restrict__ vq, const float* __restrict__ su, const float* __restrict__ sv,
                                                 const float* __restrict__ mod, const float* __restrict__ g_final, const bf16_t* xin, bf16_t* ybuf, float* outp,
                                                 LAS unsigned char* wlds, LAS unsigned char* wsc, int lane) {
    const int tok0 = tile * 32, e_sub = lane >> 3, part = lane & 7;
    const int b0 = lane & 1, b1 = (lane >> 1) & 1, b2 = (lane >> 2) & 1, b3 = (lane >> 3) & 1, b4 = (lane >> 4) & 1, b5 = (lane >> 5) & 1;
    unsigned idr[32];
#pragma unroll
    for (int t = 0; t < 32; ++t) idr[t] = ((const unsigned*)(eidx + (size_t)(tok0 + t) * 128))[lane];
    int c128 = 128, part16 = 16 * part;
    asm volatile("" : "+v"(c128), "+v"(part16));
    LAS int* accl = (LAS int*)wlds;
    const __amdgpu_buffer_rsrc_t urs = __builtin_amdgcn_make_buffer_rsrc((void*)uq, 0, 16384 * 1024, 0x00020000);
    const __amdgpu_buffer_rsrc_t vrs = __builtin_amdgcn_make_buffer_rsrc((void*)vq, 0, 16384 * 1024, 0x00020000);
#pragma unroll
    for (int i = 0; i < 16; ++i) *(LAS u32x4_t*)(wlds + i * 1024 + lane * 16) = (u32x4_t){0u, 0u, 0u, 0u};
#define PG_LOADIDXRAW(q_, tl_) do { q_ = idr[(tl_)]; } while (0)
#define PG_UNPACKIDX(dst, q_) do { ((LAS unsigned*)wsc)[lane] = q_; const u32x4_t q0_ = *(const LAS u32x4_t*)(wsc + 32 * e_sub), q1_ = *(const LAS u32x4_t*)(wsc + 32 * e_sub + 16); \
        dst[0] = q0_.x; dst[1] = q0_.y; dst[2] = q0_.z; dst[3] = q0_.w; dst[4] = q1_.x; dst[5] = q1_.y; dst[6] = q1_.z; dst[7] = q1_.w; } while (0)
#define PG_ROWOFF(vo_, w_, hi_) do { if (hi_) asm("v_mad_u32_u16 %0, %1, %2, %3 op_sel:[1,0,0,0]" : "=v"(vo_) : "v"(w_), "v"(c128), "v"(part16)); \
                                     else asm("v_mad_u32_u16 %0, %1, %2, %3 op_sel:[0,0,0,0]" : "=v"(vo_) : "v"(w_), "v"(c128), "v"(part16)); } while (0)
#define PG_LOADROWS8(dst, idx_, h_, rs_) do { _Pragma("unroll") for (int i_ = 0; i_ < 8; ++i_) { int vo_; PG_ROWOFF(vo_, idx_[(8 * (h_) + i_) >> 1], (i_ & 1)); dst[i_] = __builtin_amdgcn_raw_buffer_load_b128(rs_, vo_, soff, 0); } } while (0)
#define PG_LOADROWS8_AFTER(dst, idx_, h_, rs_, dep_) do { _Pragma("unroll") for (int i_ = 0; i_ < 8; ++i_) { int vo_; PG_ROWOFF(vo_, idx_[(8 * (h_) + i_) >> 1], (i_ & 1)); asm volatile("" : "+v"(vo_) : "v"(dep_)); \
        dst[i_] = __builtin_amdgcn_raw_buffer_load_b128(rs_, vo_, soff, 0); } } while (0)
#define PG_UDOT8(r_, xs_, h_) do { _Pragma("unroll") for (int i = 0; i < 8; ++i) { int a_ = __builtin_amdgcn_sdot4((int)r_[i][0], (int)xs_.x, 0, false); a_ = __builtin_amdgcn_sdot4((int)r_[i][1], (int)xs_.y, a_, false); \
            a_ = __builtin_amdgcn_sdot4((int)r_[i][2], (int)xs_.z, a_, false); d[8 * (h_) + i] = __builtin_amdgcn_sdot4((int)r_[i][3], (int)xs_.w, a_, false); } } while (0)
#pragma unroll 1
    for (int s = 0; s < 8; ++s) {
        const int loff = 128 * s + 16 * part; const int soff = s * (16384 * 128);
        unsigned idxN[8]; u32x4_t rP[8], rQ[8]; unsigned iqw;
        LAS unsigned char* xbuf = wsc + 512;
        const unsigned char* xsrc = xq + (size_t)(tok0 + (lane >> 3)) * 1024 + loff;
        u32x4_t xh0 = __builtin_nontemporal_load((const u32x4_t*)(xsrc)), xh1 = __builtin_nontemporal_load((const u32x4_t*)(xsrc + 8 * 1024));
        PG_LOADIDXRAW(iqw, 0); PG_UNPACKIDX(idxN, iqw);
        PG_LOADROWS8(rP, idxN, 0, urs); PG_LOADROWS8(rQ, idxN, 1, urs);
        PG_LOADIDXRAW(iqw, 1);
        *(LAS u32x4_t*)(xbuf + lane * 16) = xh0; *(LAS u32x4_t*)(xbuf + 1024 + lane * 16) = xh1;
#pragma unroll 1
        for (int tl = 0; tl < 32; ++tl) {
            int d[16];
            const int tn2 = tl + 2 < 32 ? tl + 2 : 31;
            PG_UNPACKIDX(idxN, iqw);
            PG_LOADIDXRAW(iqw, tn2);
            if (tl == 8) { xh0 = __builtin_nontemporal_load((const u32x4_t*)(xsrc + 16 * 1024)); xh1 = __builtin_nontemporal_load((const u32x4_t*)(xsrc + 24 * 1024)); }
            if (tl == 16) { *(LAS u32x4_t*)(xbuf + lane * 16) = xh0; *(LAS u32x4_t*)(xbuf + 1024 + lane * 16) = xh1; }
            const u32x4_t xsC = *(const LAS u32x4_t*)(xbuf + (tl & 15) * 128 + part * 16);
            __builtin_amdgcn_sched_barrier(0);
            PG_UDOT8(rP, xsC, 0);
            PG_LOADROWS8_AFTER(rP, idxN, 0, urs, d[7]);
            __builtin_amdgcn_sched_barrier(0);
            PG_UDOT8(rQ, xsC, 1);
            PG_LOADROWS8_AFTER(rQ, idxN, 1, urs, d[15]);
            __builtin_amdgcn_sched_barrier(0);
#pragma unroll
            for (int j = 0; j < 8; ++j) { const int keep = b2 ? d[j + 8] : d[j], send = b2 ? d[j] : d[j + 8]; d[j] = keep + dpp_i<DPP_HMIRROR>(send); }
#pragma unroll
            for (int j = 0; j < 4; ++j) { const int keep = b0 ? d[j + 4] : d[j], send = b0 ? d[j] : d[j + 4]; d[j] = keep + dpp_i<DPP_XOR1>(send); }
#pragma unroll
            for (int j = 0; j < 2; ++j) { const int keep = b1 ? d[j + 2] : d[j], send = b1 ? d[j] : d[j + 2]; d[j] = keep + dpp_i<DPP_XOR2>(send); }
            LAS int* ap = accl + tl * 128 + 16 * e_sub + 8 * b2 + 4 * b0 + 2 * b1; ap[0] += d[0]; ap[1] += d[1];
        }
    }
#pragma unroll 1
    for (int t4 = 0; t4 < 32; t4 += 4) {
        float g_[4][2], sx_[4], su_[4][2];
#pragma unroll
        for (int r = 0; r < 4; ++r) { const int tok = tok0 + t4 + r; sx_[r] = sxs[tok];
#pragma unroll
            for (int hf = 0; hf < 2; ++hf) { g_[r][hf] = __builtin_nontemporal_load(gate + (size_t)tok * 128 + lane + 64 * hf); su_[r][hf] = __builtin_nontemporal_load(su + (size_t)tok * 128 + lane + 64 * hf); } }
        __builtin_amdgcn_sched_barrier(0);
#pragma unroll
        for (int r = 0; r < 4; ++r) { const int tl = t4 + r;
            float wf[2];
#pragma unroll
            for (int hf = 0; hf < 2; ++hf) { const float a = (float)accl[tl * 128 + lane + 64 * hf] * sx_[r] * su_[r][hf]; wf[hf] = g_[r][hf] * gelu_erf(a); }
            const float wm = wave_max(fmaxf(fabsf(wf[0]), fabsf(wf[1])));
            const float sw = wm > 0.f ? wm * (1.f / 127.f) : 1.f, inv = wm > 0.f ? 127.f / wm : 0.f;
            LAS signed char* wb = (LAS signed char*)(accl + tl * 128);
            wb[lane] = (signed char)(int)rintf(wf[0] * inv); wb[lane + 64] = (signed char)(int)rintf(wf[1] * inv);
            if (lane == 0) ((LAS float*)accl)[tl * 128 + 32] = sw;
        }
    }
#define PG_VACC8(r_, h_) do { _Pragma("unroll") for (int g_ = 0; g_ < 2; ++g_) { const int wq_ = (int)wq4[2 * (h_) + g_]; \
            _Pragma("unroll") for (int q = 0; q < 4; ++q) { const unsigned R0 = r_[4 * g_][q], R1 = r_[4 * g_ + 1][q], R2 = r_[4 * g_ + 2][q], R3 = r_[4 * g_ + 3][q]; \
                const unsigned A_ = __builtin_amdgcn_perm(R1, R0, 0x05010400u), B_ = __builtin_amdgcn_perm(R1, R0, 0x07030602u), C_ = __builtin_amdgcn_perm(R3, R2, 0x05010400u), D_ = __builtin_amdgcn_perm(R3, R2, 0x07030602u); \
                acc[4 * q + 0] = __builtin_amdgcn_sdot4((int)__builtin_amdgcn_perm(C_, A_, 0x05040100u), wq_, acc[4 * q + 0], false); \
                acc[4 * q + 1] = __builtin_amdgcn_sdot4((int)__builtin_amdgcn_perm(C_, A_, 0x07060302u), wq_, acc[4 * q + 1], false); \
                acc[4 * q + 2] = __builtin_amdgcn_sdot4((int)__builtin_amdgcn_perm(D_, B_, 0x05040100u), wq_, acc[4 * q + 2], false); \
                acc[4 * q + 3] = __builtin_amdgcn_sdot4((int)__builtin_amdgcn_perm(D_, B_, 0x07060302u), wq_, acc[4 * q + 3], false); } } } while (0)
#define PG_FLUSH(S_) do { _Pragma("unroll") for (int k = 0; k < 8; ++k) { const int f = 64 * k + lane, tkn = f >> 4, c = f & 15; \
            const u32x4_t yv = *(const LAS u32x4_t*)(wlds + tkn * 512 + 256 + 16 * c); \
            __builtin_nontemporal_store(yv, (u32x4_t*)(ybuf + (size_t)(tok0 + tkn) * D + 128 * (S_) + 8 * c)); } } while (0)
#pragma unroll 1
    for (int s = 0; s < 8; ++s) {
        const int soff = s * (16384 * 128);
        const int col = 256 * (2 * b3 + b5) + 32 * s + 4 * part + 2 * b4;
        LAS unsigned* ystage = (LAS unsigned*)(wlds + 256 + 64 * (2 * b3 + b5) + 8 * part + 4 * b4);
        unsigned idxN[8]; u32x4_t rP[8], rQ[8]; unsigned iqw;
        PG_LOADIDXRAW(iqw, 0); PG_UNPACKIDX(idxN, iqw);
        PG_LOADROWS8(rP, idxN, 0, vrs); PG_LOADROWS8(rQ, idxN, 1, vrs);
        PG_LOADIDXRAW(iqw, 1);
        __builtin_amdgcn_sched_barrier(0);
        if (s > 0) PG_FLUSH(s - 1);
        __builtin_amdgcn_s_waitcnt(0x0F70);
#pragma unroll 1
        for (int tl = 0; tl < 32; ++tl) {
            const int tn = tl + 1 < 32 ? tl + 1 : 31, tn2 = tl + 2 < 32 ? tl + 2 : 31;
            PG_UNPACKIDX(idxN, iqw);
            PG_LOADIDXRAW(iqw, tn2);
            const u32x4_t wq4 = *(const LAS u32x4_t*)((const LAS unsigned char*)(accl + tl * 128) + 16 * e_sub);
            const float sw = ((const LAS float*)accl)[tl * 128 + 32];
            int acc[16];
#pragma unroll
            for (int c = 0; c < 16; ++c) acc[c] = 0;
            __builtin_amdgcn_sched_barrier(0);
            PG_VACC8(rP, 0);
            PG_LOADROWS8_AFTER(rP, idxN, 0, vrs, acc[15]);
            __builtin_amdgcn_sched_barrier(0);
            PG_VACC8(rQ, 1);
            PG_LOADROWS8_AFTER(rQ, idxN, 1, vrs, acc[15]);
            __builtin_amdgcn_sched_barrier(0);
#pragma unroll
            for (int j = 0; j < 8; ++j) { const int keep = b3 ? acc[j + 8] : acc[j], send = b3 ? acc[j] : acc[j + 8]; acc[j] = keep + dpp_i<DPP_ROR8>(send); }
#pragma unroll
            for (int j = 0; j < 4; ++j) { auto rr = __builtin_amdgcn_permlane32_swap((unsigned)acc[j], (unsigned)acc[j + 4], false, false); acc[j] = (int)rr[0] + (int)rr[1]; }
#pragma unroll
            for (int j = 0; j < 2; ++j) { const int keep = b4 ? acc[j + 2] : acc[j], send = b4 ? acc[j] : acc[j + 2]; acc[j] = keep + __shfl_xor(send, 16); }
            ystage[tl * 128] = pk2((float)acc[0] * sw, (float)acc[1] * sw);
        }
    }
    PG_FLUSH(7);
    __builtin_amdgcn_s_waitcnt(0x0F70);
#undef PG_FLUSH
#undef PG_LOADIDXRAW
#undef PG_UNPACKIDX
#undef PG_ROWOFF
#undef PG_LOADROWS8
#undef PG_LOADROWS8_AFTER
#undef PG_UDOT8
#undef PG_VACC8
    float4 gg[4];
#pragma unroll
    for (int i = 0; i < 4; ++i) gg[i] = *(const float4*)(g_final + 256 * i + 4 * lane);
    float4 gfv[4];
#pragma unroll
    for (int i = 0; i < 4; ++i) gfv[i] = *(const float4*)(mod + (size_t)(tok0 / S) * 6144 + MOD_GATE_F + 256 * i + 4 * lane);
#pragma unroll 1
    for (int tl = 0; tl < 32; tl += 4) {
        float4 y[4][4]; float ss[4];
#pragma unroll
        for (int r = 0; r < 4; ++r) { ss[r] = 0.f;
#pragma unroll
            for (int i = 0; i < 4; ++i) { const u32x2_t yb = __builtin_nontemporal_load((const u32x2_t*)(ybuf + (size_t)(tok0 + tl + r) * D + 128 * (lane >> 3) + 32 * i + 4 * (lane & 7)));
                const u32x2_t xb = __builtin_nontemporal_load((const u32x2_t*)(xin + (size_t)(tok0 + tl + r) * D + 256 * i + 4 * lane));
                y[r][i].x = __uint_as_float(xb.x << 16) + gfv[i].x * __uint_as_float(yb.x << 16); y[r][i].y = __uint_as_float(xb.x & 0xffff0000u) + gfv[i].y * __uint_as_float(yb.x & 0xffff0000u);
                y[r][i].z = __uint_as_float(xb.y << 16) + gfv[i].z * __uint_as_float(yb.y << 16); y[r][i].w = __uint_as_float(xb.y & 0xffff0000u) + gfv[i].w * __uint_as_float(yb.y & 0xffff0000u); } }
#pragma unroll
        for (int r = 0; r < 4; ++r)
#pragma unroll
            for (int i = 0; i < 4; ++i) ss[r] += y[r][i].x * y[r][i].x + y[r][i].y * y[r][i].y + y[r][i].z * y[r][i].z + y[r][i].w * y[r][i].w;
#pragma unroll
        for (int o = 32; o >= 1; o >>= 1)
#pragma unroll
            for (int r = 0; r < 4; ++r) ss[r] += __shfl_xor(ss[r], o);
#pragma unroll
        for (int r = 0; r < 4; ++r) { const float rn = rsqrtf(ss[r] * (1.f / D) + EPS);
#pragma unroll
            for (int i = 0; i < 4; ++i) { float4 o; o.x = y[r][i].x * rn * gg[i].x; o.y = y[r][i].y * rn * gg[i].y; o.z = y[r][i].z * rn * gg[i].z; o.w = y[r][i].w * rn * gg[i].w;
                __builtin_nontemporal_store((f32x4_t){o.x, o.y, o.z, o.w}, (f32x4_t*)(outp + (size_t)(tok0 + tl + r) * D + 256 * i + 4 * lane)); } }
    }
}

constexpr size_t MiB = 1u << 20;
constexpr size_t WS_CTL = 0, CTL_ZERO_BYTES = 1 * MiB;
constexpr size_t WS_MOD = 1 * MiB;
constexpr size_t WS_LAM = 1 * MiB + 800 * 1024;
constexpr size_t WS_WIN_T = 2 * MiB;
constexpr size_t WS_WO_T = 8 * MiB;
constexpr size_t WS_WQ_T = 10 * MiB;
constexpr size_t WS_HBUF = 16 * MiB;
constexpr size_t WS_MIXIN = 144 * MiB;
constexpr size_t WS_MASK = 272 * MiB;
constexpr size_t WS_KEYSB = 13 * MiB;
constexpr size_t WS_WUVF = 12 * MiB;
constexpr size_t WS_EIDX = 288 * MiB;
constexpr size_t WS_GATE = 320 * MiB;
constexpr size_t WS_BIG = 352 * MiB;
constexpr size_t WS_UQ = 704 * MiB;
constexpr size_t WS_VQ = 720 * MiB;
constexpr size_t WS_SU = 736 * MiB;
constexpr size_t WS_SV = 736 * MiB + 65536;
constexpr size_t WS_XQ = 737 * MiB;
constexpr size_t WS_SX = 801 * MiB;
constexpr size_t WS_END = 802 * MiB;
constexpr int CW_BAR = 4096;
constexpr int MAX_FWD_LAUNCHES = 8;
static_assert((CW_BAR + MAX_FWD_LAUNCHES * XCD_BAR_WORDS) * 4 <= (int)CTL_ZERO_BYTES, "barrier words inside the memset region");

constexpr int RING_OFF = 0, RING_BYTES = 131072;
constexpr int LDSCTL_OFF = RING_BYTES, MISC_OFF = LDSCTL_OFF + 320;
constexpr int LDS_BYTES = 163840;

constexpr int REPS[11] = {1, 1, 1, 1, 1, 1, 1, 1, 1, 1, 1};
struct Args { const float* in[21]; float* out; unsigned char* ws; int ph_lo, ph_hi, li, pad; };

__device__ __forceinline__ void p0_transpose_item(const float* W, int K, int N, int Npad, bf16_t* WT, LAS float* scr, int item, int lane) {
    const int nblk = Npad / 32, kb = item / nblk, nb = item % nblk, k0 = 64 * kb, n0 = 32 * nb;
    const int n_in = n0 + (lane & 31);
#pragma unroll 8
    for (int i = 0; i < 32; ++i) { const int kk = 2 * i + (lane >> 5); scr[kk * 33 + (lane & 31)] = n_in < N ? W[(size_t)(k0 + kk) * N + n_in] : 0.f; }
    asm volatile("s_waitcnt lgkmcnt(0)" ::: "memory");
    const int c = lane & 7;
#pragma unroll
    for (int j = 0; j < 4; ++j) { const int n = (lane >> 3) + 8 * j; const LAS float* s = scr + (8 * c) * 33 + n;
        uint4 o; o.x = pk2(s[0 * 33], s[1 * 33]); o.y = pk2(s[2 * 33], s[3 * 33]); o.z = pk2(s[4 * 33], s[5 * 33]); o.w = pk2(s[6 * 33], s[7 * 33]);
        *(uint4*)(WT + (size_t)(n0 + n) * K + k0 + 8 * c) = o; }
    asm volatile("s_waitcnt lgkmcnt(0)" ::: "memory");
}

template <int OFFS, bool SLICED = false> __device__ __forceinline__ void quant_row(const float4 (&v)[4], unsigned char* qrow, float* scale_out, int lane);
template <int OFFS, bool SLICED> __device__ __forceinline__ void quant_row(const float4 (&v)[4], unsigned char* qrow, float* scale_out, int lane);
template <bool QUANT, int NR, bool BF16IN>
__device__ __forceinline__ void norm_mod_rows(const void* xrows_v, const float* g, const float* mb, int shift_off, int scale_off, bf16_t* orows, int lane, unsigned char* qrows, float* qscale) {
    float4 v[NR][4]; float ss[NR];
#pragma unroll
    for (int r = 0; r < NR; ++r)
#pragma unroll
        for (int i = 0; i < 4; ++i) {
            if (BF16IN) { const uint2 b2 = ((const uint2*)((const bf16_t*)xrows_v + (size_t)r * D))[lane + 64 * i];
                v[r][i].x = __uint_as_float(b2.x << 16); v[r][i].y = __uint_as_float(b2.x & 0xffff0000u); v[r][i].z = __uint_as_float(b2.y << 16); v[r][i].w = __uint_as_float(b2.y & 0xffff0000u); }
            else v[r][i] = ((const float4*)((const float*)xrows_v + (size_t)r * D))[lane + 64 * i];
        }
#pragma unroll
    for (int r = 0; r < NR; ++r) { ss[r] = 0.f;
#pragma unroll
        for (int i = 0; i < 4; ++i) ss[r] += v[r][i].x * v[r][i].x + v[r][i].y * v[r][i].y + v[r][i].z * v[r][i].z + v[r][i].w * v[r][i].w; }
#pragma unroll
    for (int o = 32; o >= 1; o >>= 1)
#pragma unroll
        for (int r = 0; r < NR; ++r) ss[r] += __shfl_xor(ss[r], o);
#pragma unroll
    for (int i = 0; i < 4; ++i) {
        const int col = (lane + 64 * i) * 4;
        const float4 gg = *(const float4*)(g + col), sc = *(const float4*)(mb + scale_off + col), sh = *(const float4*)(mb + shift_off + col);
        const float mx = gg.x * (1.f + sc.x), my = gg.y * (1.f + sc.y), mz = gg.z * (1.f + sc.z), mw = gg.w * (1.f + sc.w);
#pragma unroll
        for (int r = 0; r < NR; ++r) {
            const float rn = rsqrtf(ss[r] * (1.f / D) + EPS);
            v[r][i].x = v[r][i].x * rn * mx + sh.x; v[r][i].y = v[r][i].y * rn * my + sh.y; v[r][i].z = v[r][i].z * rn * mz + sh.z; v[r][i].w = v[r][i].w * rn * mw + sh.w;
            uint2 o; o.x = pk2(v[r][i].x, v[r][i].y); o.y = pk2(v[r][i].z, v[r][i].w);
            *(uint2*)(orows + (size_t)r * D + col) = o;
        }
    }
    if (QUANT) {
#pragma unroll
        for (int r = 0; r < NR; ++r) quant_row<0>(v[r], qrows + (size_t)r * 1024, qscale + r, lane);
    }
}

template <int OFFS, bool SLICED>
__device__ __forceinline__ void quant_row(const float4 (&v)[4], unsigned char* qrow, float* scale_out, int lane) {
    float am = 0.f;
#pragma unroll
    for (int i = 0; i < 4; ++i) am = fmaxf(am, fmaxf(fmaxf(fabsf(v[i].x), fabsf(v[i].y)), fmaxf(fabsf(v[i].z), fabsf(v[i].w))));
    am = wave_max(am);
    const float sc = am > 0.f ? am * (1.f / 127.f) : 1.f, inv = am > 0.f ? 127.f / am : 0.f;
    uint4 o; unsigned w[4];
#pragma unroll
    for (int i = 0; i < 4; ++i) {
        const int q0 = (int)rintf(v[i].x * inv) + OFFS, q1 = (int)rintf(v[i].y * inv) + OFFS, q2 = (int)rintf(v[i].z * inv) + OFFS, q3 = (int)rintf(v[i].w * inv) + OFFS;
        w[i] = (unsigned)(q0 & 255) | ((unsigned)(q1 & 255) << 8) | ((unsigned)(q2 & 255) << 16) | ((unsigned)(q3 & 255) << 24);
    }
    o.x = w[0]; o.y = w[1]; o.z = w[2]; o.w = w[3];
    *(uint4*)(qrow + (SLICED ? (size_t)(lane >> 3) * (16384 * 128) + 16 * (lane & 7) : (size_t)16 * lane)) = o;
    if (lane == 0) *scale_out = sc;
}
__device__ __forceinline__ void quant_table_row(const float* row, unsigned char* qrow, float* scale_out, int lane, bool offs) {
    float4 v[4];
#pragma unroll
    for (int i = 0; i < 4; ++i) v[i] = ((const float4*)row)[lane + 64 * i];
    (void)offs; quant_row<0, true>(v, qrow, scale_out, lane);
}

__device__ __forceinline__ int treduce16(int (&v)[16], int lane) {
#pragma unroll
    for (int o = 8, n = 16; o >= 1; o >>= 1, n >>= 1) {
        const bool upper = (lane & o) != 0;
#pragma unroll
        for (int j = 0; j < n / 2; ++j) {
            const int keep = upper ? v[j + n / 2] : v[j];
            const int send = upper ? v[j] : v[j + n / 2];
            v[j] = keep + __shfl_xor(send, o);
        }
    }
    int t = v[0];
    t += __shfl_xor(t, 16); t += __shfl_xor(t, 32);
    return t;
}

typedef float f32x16m __attribute__((ext_vector_type(16)));
__device__ __forceinline__ void mod_block(const float* __restrict__ c, const float* __restrict__ w_ada, const float* __restrict__ b_ada, float* __restrict__ mod, LAS float* red, int blk, int tid, int lane, int wave) {
    const int r32 = lane & 31, hh = lane >> 5, j0 = 24 * blk;
    f32x16m acc;
#pragma unroll
    for (int r = 0; r < 16; ++r) acc[r] = 0.f;
    const int kb = 128 * wave;
#pragma unroll 8
    for (int s2 = 0; s2 < 64; ++s2) {
        const int k = kb + 2 * s2 + hh;
        const float cv = c[r32 * D + k];
        const float a = cv / (1.f + __expf(-cv));
        const float bw = r32 < 24 ? w_ada[(size_t)k * 6144 + j0 + r32] : 0.f;
        acc = __builtin_amdgcn_mfma_f32_32x32x2f32(a, bw, acc, 0, 0, 0);
    }
#pragma unroll
    for (int r = 0; r < 16; ++r) red[wave * 1024 + ((r & 3) + 8 * (r >> 2) + 4 * hh) * 32 + r32] = acc[r];
    __syncthreads();
    for (int o = tid; o < 32 * 24; o += NTHREADS) {
        const int b = o / 24, j = o - 24 * b; float sum = b_ada[j0 + j];
#pragma unroll
        for (int w = 0; w < 8; ++w) sum += red[w * 1024 + b * 32 + j];
        mod[b * 6144 + j0 + j] = sum;
    }
    __syncthreads();
}

__global__ void __launch_bounds__(NTHREADS, 2) fwd(Args args) {
    extern __shared__ __attribute__((aligned(16))) unsigned char lds_raw[];
    LAS unsigned char* lds = (LAS unsigned char*)lds_raw;
    volatile LAS unsigned* MISC = (volatile LAS unsigned*)(lds + MISC_OFF);
    const int wave = __builtin_amdgcn_readfirstlane(threadIdx.x >> 6);
#define LANE_ID() ((int)__builtin_amdgcn_mbcnt_hi(~0u, __builtin_amdgcn_mbcnt_lo(~0u, 0u)))
    const int G = gridDim.x;
    unsigned char* ws = args.ws;
    unsigned* ctl = (unsigned*)(ws + WS_CTL);
    for (int u = threadIdx.x; u < (LDS_BYTES - LDSCTL_OFF) / 4; u += NTHREADS) ((LAS unsigned*)(lds + LDSCTL_OFF))[u] = 0u;
    __syncthreads();
    XcdBarrier bar = xcd_barrier_post(ctl + CW_BAR + args.li * XCD_BAR_WORDS, MISC + 8);
    const int lo = args.ph_lo, hi = args.ph_hi;
#define IN(k) (lo <= (k) && (k) < hi)
#define BOTH(k) (IN(k) && IN((k) + 1))
    const float* x = args.in[0];
    const float* g_norm_mix = args.in[4];
    const float* w_in = args.in[5];
    const float* w_out = args.in[13];
    const float* g_norm_ffn = args.in[14];
    const float* w_peer_q = args.in[15];
    float* out = args.out;
    float* mod = (float*)(ws + WS_MOD);
    bf16_t* Win_t = (bf16_t*)(ws + WS_WIN_T); bf16_t* Wo_t = (bf16_t*)(ws + WS_WO_T); bf16_t* Wq_t = (bf16_t*)(ws + WS_WQ_T);
    bf16_t* hbuf = (bf16_t*)(ws + WS_HBUF); bf16_t* mixin = (bf16_t*)(ws + WS_MIXIN);
    bf16_t* proj = (bf16_t*)(ws + WS_BIG); bf16_t* qb = (bf16_t*)(ws + WS_BIG); bf16_t* keysb = (bf16_t*)(ws + WS_KEYSB);
    bf16_t* x1b = (bf16_t*)(ws + WS_BIG + 128 * MiB);
    unsigned* maskw = (unsigned*)(ws + WS_MASK); bf16_t* wuvF = (bf16_t*)(ws + WS_WUVF);
    unsigned char* uq = ws + WS_UQ; unsigned char* vq = ws + WS_VQ; float* su = (float*)(ws + WS_SU); float* sv = (float*)(ws + WS_SV);
    unsigned char* xq = ws + WS_XQ; float* sxs = (float*)(ws + WS_SX);
    const int gw = blockIdx.x * NWAVES + wave, NGW = G * NWAVES;
    const int vcu = (G % 8 == 0) ? ((int)blockIdx.x % 8) * (G / 8) + (int)blockIdx.x / 8 : (int)blockIdx.x;

    if (IN(0)) for (int rep_ = 0; rep_ < REPS[0]; ++rep_) {
        const int lane = LANE_ID(), tid = wave * 64 + lane; (void)tid;
        for (int blk = blockIdx.x; blk < 256; blk += G) mod_block(args.in[1], args.in[2], args.in[3], mod, (LAS float*)(lds + RING_OFF), blk, tid, lane, wave);
        if (blockIdx.x == 0 && tid == 0) {
            float s1 = 0.f, s2 = 0.f;
            for (int i = 0; i < 64; ++i) { s1 += args.in[6][i] * args.in[7][i]; s2 += args.in[8][i] * args.in[9][i]; }
            *(float*)(ws + WS_LAM) = expf(s1) - expf(s2) + 0.2f;
        }
        LAS float* scr = (LAS float*)(lds + RING_OFF + wave * 16384);
        constexpr int I_IN = 16 * (NPP / 32), I_O = 16 * 32, I_Q = 16 * 32;
        for (int it = gw; it < I_IN + I_O + I_Q; it += NGW) {
            int r = it;
            if (r < I_IN) { p0_transpose_item(w_in, D, NP, NPP, Win_t, scr, r, lane); continue; } r -= I_IN;
            if (r < I_O) { p0_transpose_item(w_out, D, D, D, Wo_t, scr, r, lane); continue; } r -= I_O;
            p0_transpose_item(w_peer_q, D, D, D, Wq_t, scr, r, lane);
        }
        for (int i = blockIdx.x * NTHREADS + tid; i < 4 * 4 * 4 * 2 * 64 * 8; i += G * NTHREADS) {
            const int j = i & 7, ln = (i >> 3) & 63, s2 = (i >> 9) & 1, db = (i >> 10) & 3, eb = (i >> 12) & 3, hd = i >> 14;
            const int cc = 32 * db + 16 * s2 + 8 * (j >> 2) + 4 * (ln >> 5) + (j & 3), e = 32 * eb + (ln & 31);
            wuvF[i] = f2bf(args.in[12][((size_t)hd * 128 + cc) * 128 + e]);
        }
        for (int i = blockIdx.x * NTHREADS + tid; i < 8 * 2 * 128 * 64; i += G * NTHREADS) keysb[i] = f2bf(args.in[16][i]);
        for (int r = gw; r < 2 * 16384; r += NGW) {
            if (r < 16384) quant_table_row(args.in[17] + (size_t)r * D, uq + (size_t)r * 128, su + r, lane, false);
            else quant_table_row(args.in[18] + (size_t)(r - 16384) * D, vq + (size_t)(r - 16384) * 128, sv + (r - 16384), lane, false);
        }
        if (BOTH(0)) xcd_barrier(bar);
    }
    if (IN(1)) for (int rep_ = 0; rep_ < REPS[1]; ++rep_) {
        const int lane = LANE_ID(), tid = wave * 64 + lane; (void)tid;
        for (int m = 4 * gw; m < T; m += 4 * NGW) norm_mod_rows<false, 4, false>(x + (size_t)m * D, g_norm_mix, mod + (size_t)(m / S) * 6144, MOD_SHIFT_A, MOD_SCALE_A, hbuf + (size_t)m * D, lane, nullptr, nullptr);
        if (BOTH(1)) xcd_barrier(bar);
    }
    if (IN(2)) for (int rep_ = 0; rep_ < REPS[2]; ++rep_) {
        pg8::Gemm g{hbuf, Win_t, T, NPP, D}; pg8::StaticOrder So; So.init(T, NPP, G, (int)blockIdx.x);
        pg8::EpiBf16Plain E{proj, NPP};
        pg8::gemm_phase<pg8::EpiBf16Plain, pg8::StaticOrder, true, true>(lds + RING_OFF, g, So, E);
        if (BOTH(2)) xcd_barrier(bar);
    }
    if (IN(3)) for (int rep_ = 0; rep_ < REPS[3]; ++rep_) {
        const int lane = LANE_ID(), tid = wave * 64 + lane; (void)tid;
        const float lam = *(const float*)(ws + WS_LAM);
        for (int it = vcu; it < 1024; it += G) {
            const int b = it >> 5, h = (it >> 3) & 3, qp = it & 7;
            diff_unit(proj, mixin, args.in[19], lam, args.in[10], lds, b, h, 15 - qp, tid, lane, wave);
            diff_unit(proj, mixin, args.in[19], lam, args.in[10], lds, b, h, qp, tid, lane, wave);
        }
    }
    if (IN(4)) for (int rep_ = 0; rep_ < REPS[4]; ++rep_) {
        const int lane = LANE_ID(), tid = wave * 64 + lane; (void)tid;
        for (int it = vcu; it < 512; it += G) {
            const int b = it >> 4, up = it & 15;
#pragma unroll 1
            for (int k8 = 0; k8 < 8; ++k8) dsa_index_unit(proj, maskw, lds, b, 4 * (k8 < 4 ? 31 - up : up) + (k8 & 3), tid, lane, wave);
        }
        asm volatile("s_waitcnt vmcnt(0)" ::: "memory");
        __syncthreads();
    }
    if (IN(5)) for (int rep_ = 0; rep_ < REPS[5]; ++rep_) {
        const int lane = LANE_ID(), tid = wave * 64 + lane; (void)tid;
        for (int it = vcu; it < 512; it += G) {
            const int b = it >> 4, up = it & 15;
            dsa_attn_unit(proj, maskw, wuvF, args.in[19], args.in[11], mixin, lds, b, 31 - up, tid, lane, wave);
            dsa_attn_unit(proj, maskw, wuvF, args.in[19], args.in[11], mixin, lds, b, up, tid, lane, wave);
        }
        if (BOTH(5)) xcd_barrier(bar);
    }
    if (IN(6)) for (int rep_ = 0; rep_ < REPS[6]; ++rep_) {
        pg8::Gemm g{mixin, Wo_t, T, D, D}; pg8::StaticOrder So; So.init(T, D, G, (int)blockIdx.x);
        pg8::EpiBf16ResB E{x1b, x, mod + MOD_GATE_A};
        pg8::gemm_phase<pg8::EpiBf16ResB, pg8::StaticOrder, true, false>(lds + RING_OFF, g, So, E);
        if (BOTH(6)) xcd_barrier(bar);
    }
    if (IN(7)) for (int rep_ = 0; rep_ < REPS[7]; ++rep_) {
        const int lane = LANE_ID(), tid = wave * 64 + lane; (void)tid;
        for (int m = 4 * gw; m < T; m += 4 * NGW) norm_mod_rows<true, 4, true>(x1b + (size_t)m * D, g_norm_ffn, mod + (size_t)(m / S) * 6144, MOD_SHIFT_F, MOD_SCALE_F, hbuf + (size_t)m * D, lane, xq + (size_t)m * 1024, sxs + m);
        if (BOTH(7)) xcd_barrier(bar);
    }
    if (IN(8)) for (int rep_ = 0; rep_ < REPS[8]; ++rep_) {
        pg8::Gemm g{hbuf, Wq_t, T, D, D}; pg8::StaticOrder So; So.init(T, D, G, (int)blockIdx.x);
        pg8::EpiBf16Plain E{qb, D};
        pg8::gemm_phase<pg8::EpiBf16Plain, pg8::StaticOrder, true, true>(lds + RING_OFF, g, So, E);
        if (BOTH(8)) xcd_barrier(bar);
    }
    if (IN(9)) for (int rep_ = 0; rep_ < REPS[9]; ++rep_) {
        const int lane = LANE_ID();
        for (int base = blockIdx.x * NWAVES; base < T / 32; base += NGW)
            peer_select_wave(base + wave, qb, keysb, (unsigned short*)(ws + WS_EIDX), (float*)(ws + WS_GATE), lds + RING_OFF, wave * 64 + lane, lane, su, sv, (float*)(ws + WS_BIG + 256 * MiB));
        asm volatile("s_waitcnt vmcnt(0)" ::: "memory");
    }
    if (IN(10)) for (int rep_ = 0; rep_ < REPS[10]; ++rep_) {
        const int lane = LANE_ID();
        const unsigned short* eidx = (const unsigned short*)(ws + WS_EIDX); const float* gate = (const float*)(ws + WS_GATE);
        bf16_t* ybuf = (bf16_t*)(ws + WS_BIG);
        for (int tile = gw; tile < T / 32; tile += NGW)
            peer_gather_tile(tile, xq, sxs, eidx, gate, uq, vq, (const float*)(ws + WS_BIG + 256 * MiB)  , sv, mod, args.in[20], x1b, ybuf, out, lds + RING_OFF + wave * 16384, lds + 133120 + wave * 3584, lane);
    }
#undef IN
#undef BOTH
}
#ifndef PROBE_PREFIX_N
#define PROBE_PREFIX_N 0
#endif
constexpr int PROBE_PREFIX = PROBE_PREFIX_N;
extern "C" void kernel_launch(void* const* d_in, const int* in_sizes, int n_in, void* d_out, int out_size, void* d_ws, size_t ws_size, hipStream_t stream) {
    static int grid = 0;
    if (grid == 0) {
        if (n_in != 21 || out_size != T * D || ws_size < WS_END) { fprintf(stderr, "kernel_launch: unexpected shapes (n_in %d out %d ws %zu)\n", n_in, out_size, ws_size); grid = -1; return; }
        int dev = 0, cus = 0, per_cu = 0;
        if (hipGetDevice(&dev) != hipSuccess || hipDeviceGetAttribute(&cus, hipDeviceAttributeMultiprocessorCount, dev) != hipSuccess) { grid = -1; return; }
        if (hipFuncSetAttribute((const void*)fwd, hipFuncAttributeMaxDynamicSharedMemorySize, LDS_BYTES) != hipSuccess) { fprintf(stderr, "kernel_launch: hipFuncSetAttribute failed\n"); grid = -1; return; }
        if (hipOccupancyMaxActiveBlocksPerMultiprocessor(&per_cu, (const void*)fwd, NTHREADS, LDS_BYTES) != hipSuccess || per_cu < 1)
            fprintf(stderr, "kernel_launch: occupancy query reports %d workgroups per CU\n", per_cu);
        (void)hipGetLastError();
        grid = cus;
        if (grid != 256) fprintf(stderr, "kernel_launch: %d CUs (expected 256)\n", grid);
    }
    if (grid < 0) return;
    float* out = (float*)d_out;
    unsigned char* ws = (unsigned char*)d_ws;
    (void)hipMemsetAsync(ws + WS_CTL, 0, CTL_ZERO_BYTES, stream);
    Args a{};
    for (int i = 0; i < 21; ++i) a.in[i] = (const float*)d_in[i];
    a.out = out; a.ws = ws;

    if (PROBE_PREFIX > 0) {
        a.ph_lo = 0; a.ph_hi = PROBE_PREFIX; a.li = 1;
        hipLaunchKernelGGL(fwd, dim3(grid), dim3(NTHREADS), LDS_BYTES, stream, a);
    }
    a.ph_lo = 0; a.ph_hi = 11; a.li = 0;
    hipLaunchKernelGGL(fwd, dim3(grid), dim3(NTHREADS), LDS_BYTES, stream, a);
}
```
